# Optimizing an MI355X kernel written in HIP

```python
import math
import jax, jax.numpy as jnp
from jax import lax
import numpy as np

D_MODEL = 1024
BATCH = 16
SEQ = 2048
DEPTH = 1

EPS = 1e-5
HYENA_WIDTH = D_MODEL // 2
SHORT_CONV = 3
FILTER_EMB_DIM = 17
FILTER_BANDS = (FILTER_EMB_DIM - 1) // 2
FILTER_HIDDEN = 64
DECAY_TARGET = 1e-2
FAST_DECAY_PCT = 0.3
SLOW_DECAY_PCT = 1.5
ATTN_HEADS = 4
ATTN_HEAD_DIM = 64
ATTN_V_DIM = 2 * ATTN_HEAD_DIM
ATTN_WIDTH = ATTN_HEADS * ATTN_V_DIM
Q_BLOCK = 128
N_BRANCHES = 2
IN_COLS = 3 * HYENA_WIDTH + 3 * ATTN_WIDTH + N_BRANCHES * D_MODEL
N_EXPERTS = 32
TOP_K = 4
D_EXPERT = D_MODEL
SWIGLU_LIMIT = 7.0
SWIGLU_ALPHA = 1.702
EXPERT_BLOCK = 256

kernel_name = "hybrid_hyena_diffattn_moe_adaln"


def rms_norm(x, g):
    xf = x.astype(jnp.float32)
    y = xf * lax.rsqrt(jnp.mean(xf * xf, axis=-1, keepdims=True) + EPS)
    return (y * g.astype(jnp.float32)).astype(x.dtype)


def short_conv(u, w, b):
    L = u.shape[1]
    up = jnp.pad(u, ((0, 0), (1, 1), (0, 0)))
    return up[:, :L] * w[0] + up[:, 1:L + 1] * w[1] + up[:, 2:] * w[2] + b


def implicit_filters(L, w1, b1, w2, b2, w3, b3, w4, freq):
    f32 = jnp.float32
    t = jnp.linspace(0.0, 1.0, L, dtype=f32)[:, None]
    w = 2.0 * math.pi * jnp.arange(L, dtype=f32)[:, None] / L
    fr = jnp.linspace(1e-4, FILTER_BANDS - 1, FILTER_BANDS, dtype=f32)[None, :]
    z = jnp.concatenate([t, jnp.cos(fr * w), -jnp.sin(fr * w)], axis=-1)
    fq = freq.astype(f32)
    h = jnp.sin(fq * (z @ w1.astype(f32) + b1.astype(f32)))
    h = jnp.sin(fq * (h @ w2.astype(f32) + b2.astype(f32)))
    h = jnp.sin(fq * (h @ w3.astype(f32) + b3.astype(f32)))
    k = h @ w4.astype(f32)
    min_decay = math.log(DECAY_TARGET) / SLOW_DECAY_PCT
    max_decay = math.log(DECAY_TARGET) / FAST_DECAY_PCT
    deltas = jnp.linspace(min_decay, max_decay, HYENA_WIDTH, dtype=f32)
    decay = jnp.exp(-t * jnp.abs(deltas))
    k = k.reshape(L, 2, HYENA_WIDTH) * decay[:, None, :]
    return k[:, 0], k[:, 1]


def two_sided_long_conv(v, k_fwd, k_bwd):
    B, L, C = v.shape
    k_full = jnp.concatenate([k_fwd, jnp.zeros((1, C), jnp.float32), k_bwd[1:][::-1]], axis=0)
    kf = jnp.fft.rfft(k_full, n=2 * L, axis=0)
    vf = jnp.fft.rfft(v.astype(jnp.float32), n=2 * L, axis=1)
    y = jnp.fft.irfft(vf * kf[None], n=2 * L, axis=1)[:, :L]
    return y.astype(v.dtype)


def hyena_branch(u3, conv_w, conv_b, k_fwd, k_bwd, d_skip):
    uc = short_conv(u3, conv_w, conv_b)
    x0, x1, v = jnp.split(uc, 3, axis=-1)
    v = v * x1
    y = two_sided_long_conv(v, k_fwd, k_bwd) + v * d_skip
    return y * x0


def diff_attention(q, k, v, lam, lam_init, subln_g):
    B, L = q.shape[0], q.shape[1]
    nb = L // Q_BLOCK
    scale = 1.0 / math.sqrt(ATTN_HEAD_DIM)
    slopes = 2.0 ** (-8.0 * jnp.arange(1, ATTN_HEADS + 1, dtype=jnp.float32) / ATTN_HEADS)
    pos = jnp.arange(L, dtype=jnp.float32)
    kf = k.astype(jnp.float32)
    vf = v.astype(jnp.float32)
    qb = q.astype(jnp.float32).reshape(B, nb, Q_BLOCK, ATTN_HEADS, 2, ATTN_HEAD_DIM).transpose(1, 0, 2, 3, 4, 5)
    qpos = pos.reshape(nb, Q_BLOCK)

    def block(args):
        q_blk, q_pos = args
        s = jnp.einsum('bqhcd,bkhcd->bhcqk', q_blk, kf) * scale
        dist = jnp.abs(q_pos[:, None] - pos[None, :])
        s = s - slopes[None, :, None, None, None] * dist[None, None, None]
        p = jax.nn.softmax(s, axis=-1)
        a = p[:, :, 0] - lam * p[:, :, 1]
        return jnp.einsum('bhqk,bkhe->bqhe', a, vf)

    out = lax.map(block, (qb, qpos))
    out = out.transpose(1, 0, 2, 3, 4).reshape(B, L, ATTN_HEADS, ATTN_V_DIM)
    out = rms_norm(out, subln_g) * (1.0 - lam_init)
    return out.reshape(B, L, ATTN_WIDTH).astype(q.dtype)


def moe_ffn(h, w_router, b_router, w_gate_up, b_gate_up, w_down, b_down):
    B, L, D = h.shape
    T = B * L
    hf = h.reshape(T, D)
    logits = (hf @ w_router + b_router).astype(jnp.float32)
    top_val, top_idx = lax.top_k(logits, TOP_K)
    gates = jax.nn.softmax(top_val, axis=-1)
    P = T * TOP_K
    flat_e = top_idx.reshape(P)
    order = jnp.argsort(flat_e)
    e_sorted = flat_e[order]
    tok_sorted = (order // TOP_K).astype(jnp.int32)
    w_sorted = gates.reshape(P)[order]
    counts = jnp.zeros((N_EXPERTS,), jnp.int32).at[flat_e].add(1)
    padded = ((counts + EXPERT_BLOCK - 1) // EXPERT_BLOCK) * EXPERT_BLOCK
    pad_end = jnp.cumsum(padded)
    pad_start = pad_end - padded
    raw_start = jnp.cumsum(counts) - counts
    rank = jnp.arange(P, dtype=jnp.int32) - raw_start[e_sorted]
    dest = pad_start[e_sorted] + rank
    n_blocks = -(-P // EXPERT_BLOCK) + N_EXPERTS
    n_rows = n_blocks * EXPERT_BLOCK
    row_tok = jnp.zeros((n_rows,), jnp.int32).at[dest].set(tok_sorted)
    row_w = jnp.zeros((n_rows,), jnp.float32).at[dest].set(w_sorted)
    block_start = jnp.arange(n_blocks, dtype=jnp.int32) * EXPERT_BLOCK
    block_expert = jnp.minimum(jnp.searchsorted(pad_end, block_start, side='right'), N_EXPERTS - 1)

    def expert_block(args):
        toks, wts, e = args
        xb = hf[toks]
        gu = xb @ w_gate_up[e] + b_gate_up[e]
        gate, up = gu[:, :D_EXPERT], gu[:, D_EXPERT:]
        gate = jnp.minimum(gate, SWIGLU_LIMIT)
        up = jnp.clip(up, -SWIGLU_LIMIT, SWIGLU_LIMIT)
        glu = gate * jax.nn.sigmoid(SWIGLU_ALPHA * gate)
        y = ((up + 1.0) * glu) @ w_down[e] + b_down[e]
        return y * wts[:, None].astype(y.dtype)

    ys = lax.map(expert_block, (row_tok.reshape(n_blocks, EXPERT_BLOCK),
                                row_w.reshape(n_blocks, EXPERT_BLOCK), block_expert))
    out = jnp.zeros((T, D), h.dtype).at[row_tok].add(ys.reshape(n_rows, D).astype(h.dtype))
    return out.reshape(B, L, D)


def setup_inputs(seed: int = 0) -> dict:
    key = jax.random.key(seed)
    ks = jax.random.split(key, 32)
    f32 = jnp.float32
    D, HW, E, DE, FH = D_MODEL, HYENA_WIDTH, N_EXPERTS, D_EXPERT, FILTER_HIDDEN
    n = lambda k, shape, s: (jax.random.normal(k, shape, f32) * s)
    return {
        "x": n(ks[0], (BATCH, SEQ, D), 1.0),
        "c": n(ks[1], (BATCH, D), 1.0),
        "w_ada": n(ks[2], (DEPTH, D, 6 * D), 0.5 * D ** -0.5),
        "b_ada": n(ks[3], (DEPTH, 6 * D), 0.02),
        "norm_mix_g": 1.0 + n(ks[4], (DEPTH, D), 0.02),
        "w_in": n(ks[5], (DEPTH, D, IN_COLS), D ** -0.5),
        "b_in": n(ks[6], (DEPTH, IN_COLS), 0.02),
        "hy_conv_w": n(ks[7], (DEPTH, SHORT_CONV, 3 * HW), SHORT_CONV ** -0.5),
        "hy_conv_b": n(ks[8], (DEPTH, 3 * HW), 0.02),
        "filt_w1": n(ks[9], (DEPTH, FILTER_EMB_DIM, FH), FILTER_EMB_DIM ** -0.5),
        "filt_b1": n(ks[10], (DEPTH, FH), 0.02),
        "filt_w2": n(ks[11], (DEPTH, FH, FH), FH ** -0.5),
        "filt_b2": n(ks[12], (DEPTH, FH), 0.02),
        "filt_w3": n(ks[13], (DEPTH, FH, FH), FH ** -0.5),
        "filt_b3": n(ks[14], (DEPTH, FH), 0.02),
        "filt_w4": n(ks[15], (DEPTH, FH, 2 * HW), 0.2 * FH ** -0.5),
        "filt_freq": 1.0 + n(ks[16], (DEPTH, FH), 0.02),
        "hy_d_skip": n(ks[17], (DEPTH, HW), 1.0),
        "lambda_qk": n(ks[18], (DEPTH, 4, ATTN_HEAD_DIM), 0.1),
        "attn_subln_g": 1.0 + n(ks[19], (DEPTH, ATTN_V_DIM), 0.02),
        "w_hy_out": n(ks[20], (DEPTH, HW, D), HW ** -0.5),
        "w_attn_out": n(ks[21], (DEPTH, ATTN_WIDTH, D), ATTN_WIDTH ** -0.5),
        "w_mix_out": n(ks[22], (DEPTH, D, D), D ** -0.5),
        "norm_ffn_g": 1.0 + n(ks[23], (DEPTH, D), 0.02),
        "w_router": n(ks[24], (DEPTH, D, E), D ** -0.5),
        "b_router": n(ks[25], (DEPTH, E), 0.01),
        "w_gate_up": n(ks[26], (DEPTH, E, D, 2 * DE), D ** -0.5),
        "b_gate_up": n(ks[27], (DEPTH, E, 2 * DE), 0.01),
        "w_down": n(ks[28], (DEPTH, E, DE, D), DE ** -0.5),
        "b_down": n(ks[29], (DEPTH, E, D), 0.01),
        "final_norm_g": 1.0 + n(ks[30], (D,), 0.02),
    }


def reference(x, c, w_ada, b_ada, norm_mix_g, w_in, b_in, hy_conv_w, hy_conv_b,
              filt_w1, filt_b1, filt_w2, filt_b2, filt_w3, filt_b3, filt_w4, filt_freq,
              hy_d_skip, lambda_qk, attn_subln_g, w_hy_out, w_attn_out, w_mix_out,
              norm_ffn_g, w_router, b_router, w_gate_up, b_gate_up, w_down, b_down,
              final_norm_g):
    B, L, D = x.shape
    split_idx = [3 * HYENA_WIDTH, 3 * HYENA_WIDTH + ATTN_WIDTH,
                 3 * HYENA_WIDTH + 2 * ATTN_WIDTH, 3 * HYENA_WIDTH + 3 * ATTN_WIDTH]
    for l in range(DEPTH):
        lam_init = 0.8 - 0.6 * math.exp(-0.3 * l)
        mod = jax.nn.silu(c) @ w_ada[l] + b_ada[l]
        shift1, scale1, gate1, shift2, scale2, gate2 = jnp.split(mod[:, None, :], 6, axis=-1)

        h = rms_norm(x, norm_mix_g[l]) * (1.0 + scale1) + shift1
        u = h @ w_in[l] + b_in[l]
        u_hy, q, k, v, g = jnp.split(u, split_idx, axis=-1)

        k_fwd, k_bwd = implicit_filters(L, filt_w1[l], filt_b1[l], filt_w2[l], filt_b2[l],
                                        filt_w3[l], filt_b3[l], filt_w4[l], filt_freq[l])
        y_hy = hyena_branch(u_hy, hy_conv_w[l], hy_conv_b[l], k_fwd, k_bwd, hy_d_skip[l])

        lq = lambda_qk[l].astype(jnp.float32)
        lam = jnp.exp(jnp.sum(lq[0] * lq[1])) - jnp.exp(jnp.sum(lq[2] * lq[3])) + lam_init
        q = q.reshape(B, L, ATTN_HEADS, 2, ATTN_HEAD_DIM)
        k = k.reshape(B, L, ATTN_HEADS, 2, ATTN_HEAD_DIM)
        v = v.reshape(B, L, ATTN_HEADS, ATTN_V_DIM)
        y_at = diff_attention(q, k, v, lam, lam_init, attn_subln_g[l])

        gts = jax.nn.sigmoid(g.reshape(B, L, N_BRANCHES, D))
        merged = gts[:, :, 0] * (y_hy @ w_hy_out[l]) + gts[:, :, 1] * (y_at @ w_attn_out[l])
        x = x + gate1 * (merged @ w_mix_out[l])

        h = rms_norm(x, norm_ffn_g[l]) * (1.0 + scale2) + shift2
        x = x + gate2 * moe_ffn(h, w_router[l], b_router[l], w_gate_up[l], b_gate_up[l],
                                w_down[l], b_down[l])
    return rms_norm(x, final_norm_g)
```

```cpp
#include <hip/hip_runtime.h>
#include <hip/hip_cooperative_groups.h>
#include <cstdio>
#include <cstdint>
namespace cg = cooperative_groups;

namespace {
typedef unsigned short bf16_t;
typedef short bf16x8 __attribute__((ext_vector_type(8)));
typedef short s16x4 __attribute__((ext_vector_type(4)));
typedef float f32x4 __attribute__((ext_vector_type(4)));
typedef float f32x16 __attribute__((ext_vector_type(16)));
typedef unsigned u32x4 __attribute__((ext_vector_type(4)));
typedef unsigned u32x2 __attribute__((ext_vector_type(2)));

constexpr int D = 1024, NB = 16, SEQ = 2048, T = NB * SEQ, HW = 512, INC = 5120, NE = 32, FHID = 64;
constexpr int QOFF = 1536, KOFF = 2048, VOFF = 2560, GOFF = 3072;
constexpr int NTHREADS = 512, NWAVES = 8;
constexpr float EPS = 1e-5f;
constexpr float LOG2E = 1.4426950408889634f;
constexpr size_t MiB = 1u << 20;
constexpr size_t WS_CTL = 0;
constexpr size_t WS_MOD = 1 * MiB;
constexpr size_t WS_META = 1 * MiB + 512 * 1024;
constexpr size_t WS_BLKCNT = WS_META + 4096;
constexpr size_t WS_TILEEXP = WS_BLKCNT + 256 * 32 * 4;
constexpr size_t WS_LOGITS = 2 * MiB;
constexpr size_t WS_TOPE = 6 * MiB;
constexpr size_t WS_TOPW = 6 * MiB + 512 * 1024;
constexpr size_t WS_ROWPAIR = 7 * MiB;
constexpr size_t WS_KFILT = 8 * MiB;
constexpr size_t WS_U = 16 * MiB;
constexpr size_t WS_ACT = WS_U;
constexpr size_t WS_H = 336 * MiB;
constexpr size_t WS_R1 = 400 * MiB;
constexpr size_t WS_YCAT = WS_R1;
constexpr size_t WS_MERGED = WS_R1 + 64 * MiB;
constexpr size_t WS_VP = WS_R1 + 128 * MiB;
constexpr size_t WS_X0C = WS_R1 + 160 * MiB;
constexpr size_t WS_VT = WS_R1 + 192 * MiB;
constexpr size_t WS_H2LO = WS_R1 + 224 * MiB;
constexpr size_t WS_SLOTS = WS_R1;
constexpr size_t WS_WIN = 688 * MiB;
constexpr size_t WS_WCAT = 698 * MiB;
constexpr size_t WS_WMIX = 700 * MiB;
constexpr size_t WS_WGU = 702 * MiB;
constexpr size_t WS_WDN = 830 * MiB;
constexpr size_t WS_WRT = 894 * MiB;
constexpr size_t WS_END = 895 * MiB;
constexpr int MAXROWS = 4 * T + NE * 256;
constexpr int LDS_BYTES = 147456;

struct Params { const float* in[31]; float* out; unsigned char* ws; int ph_lo, ph_hi; };

__device__ __forceinline__ unsigned f2bf(float f) { unsigned u = __float_as_uint(f); return (u + 0x7fffu + ((u >> 16) & 1u)) >> 16; }
__device__ __forceinline__ unsigned pk2(float lo, float hi) { return f2bf(lo) | (f2bf(hi) << 16); }
__device__ __forceinline__ float bf2f(unsigned h) { return __uint_as_float(h << 16); }
__device__ __forceinline__ float bflo(unsigned w) { return __uint_as_float(w << 16); }
__device__ __forceinline__ float bfhi(unsigned w) { return __uint_as_float(w & 0xffff0000u); }
__device__ __forceinline__ float wave_sum(float v) {
#pragma unroll
    for (int o = 1; o < 64; o <<= 1) v += __shfl_xor(v, o);
    return v;
}
__device__ __forceinline__ float sigmoidf_(float x) { return 1.0f / (1.0f + __expf(-x)); }
__device__ __forceinline__ int crow(int r, int hi) { return (r & 3) + 8 * (r >> 2) + 4 * hi; }

struct Ctx {
    const float* in[31]; float* out; unsigned char* ws;
    int tid, lane, wave, gw, ngw, nblk, blk;
    unsigned char* lds;
};

__device__ __forceinline__ void transpose_item(const float* W, int N, int k0, int n0, bf16_t* WT, size_t ldt, int kdst0, int ndst0, float* scr, int lane) {
#pragma unroll 8
    for (int i = 0; i < 32; ++i) { const int kk = 2 * i + (lane >> 5); scr[kk * 33 + (lane & 31)] = W[(size_t)(k0 + kk) * N + n0 + (lane & 31)]; }
    __builtin_amdgcn_s_waitcnt(0xc07f); asm volatile("" ::: "memory");
    const int c = lane & 7;
#pragma unroll
    for (int j = 0; j < 4; ++j) { const int n = (lane >> 3) + 8 * j; const float* s = scr + (8 * c) * 33 + n;
        u32x4 o; o.x = pk2(s[0 * 33], s[1 * 33]); o.y = pk2(s[2 * 33], s[3 * 33]); o.z = pk2(s[4 * 33], s[5 * 33]); o.w = pk2(s[6 * 33], s[7 * 33]);
        *(u32x4*)(WT + (size_t)(ndst0 + n) * ldt + kdst0 + 8 * c) = o; }
    __builtin_amdgcn_s_waitcnt(0xc07f); asm volatile("" ::: "memory");
}

__device__ __forceinline__ void phase_weights(Ctx& C) {
    float* scr = (float*)(C.lds + C.wave * 16384);
    unsigned char* ws = C.ws;
    bf16_t* win = (bf16_t*)(ws + WS_WIN); bf16_t* wcat = (bf16_t*)(ws + WS_WCAT); bf16_t* wmix = (bf16_t*)(ws + WS_WMIX);
    bf16_t* wgu = (bf16_t*)(ws + WS_WGU); bf16_t* wdn = (bf16_t*)(ws + WS_WDN);
    constexpr int I_IN = (D / 64) * (INC / 32);
    constexpr int I_HY = (HW / 64) * (D / 32);
    constexpr int I_MIX = (D / 64) * (D / 32);
    constexpr int I_GU1 = (D / 64) * (2 * D / 32);
    constexpr int I_DN1 = (D / 64) * (D / 32);
    constexpr int NITEMS = I_IN + 2 * I_HY + I_MIX + NE * I_GU1 + NE * I_DN1;
    for (int it = C.gw; it < NITEMS; it += C.ngw) {
        int r = it;
        if (r < I_IN) { const int nb = INC / 32; transpose_item(C.in[5], INC, 64 * (r / nb), 32 * (r % nb), win, D, 64 * (r / nb), 32 * (r % nb), scr, C.lane); continue; } r -= I_IN;
        if (r < I_HY) { const int nb = D / 32; transpose_item(C.in[20], D, 64 * (r / nb), 32 * (r % nb), wcat, D, 64 * (r / nb), 32 * (r % nb), scr, C.lane); continue; } r -= I_HY;
        if (r < I_HY) { const int nb = D / 32; transpose_item(C.in[21], D, 64 * (r / nb), 32 * (r % nb), wcat, D, 512 + 64 * (r / nb), 32 * (r % nb), scr, C.lane); continue; } r -= I_HY;
        if (r < I_MIX) { const int nb = D / 32; transpose_item(C.in[22], D, 64 * (r / nb), 32 * (r % nb), wmix, D, 64 * (r / nb), 32 * (r % nb), scr, C.lane); continue; } r -= I_MIX;
        if (r < NE * I_GU1) { const int e = r / I_GU1, q = r % I_GU1; const int nb = 2 * D / 32; const int n0 = 32 * (q % nb), k0 = 64 * (q / nb);
            const int s = n0 / 1024, rem = n0 % 1024, j = rem / 128, i0 = rem % 128; const int nd = 256 * j + 128 * s + i0;
            transpose_item(C.in[26] + (size_t)e * D * 2 * D, 2 * D, k0, n0, wgu + (size_t)e * 2 * D * D, D, k0, nd, scr, C.lane); continue; } r -= NE * I_GU1;
        { const int e = r / I_DN1, q = r % I_DN1; const int nb = D / 32; const int n0 = 32 * (q % nb), k0 = 64 * (q / nb);
            transpose_item(C.in[28] + (size_t)e * D * D, D, k0, n0, wdn + (size_t)e * D * D, D, k0, n0, scr, C.lane); }
    }
    bf16_t* wrt = (bf16_t*)(ws + WS_WRT);
    for (int i = C.blk * NTHREADS + C.tid; i < NE * D; i += C.nblk * NTHREADS) {
        const int e = i / D, k = i % D; const float w = C.in[24][(size_t)k * NE + e];
        const unsigned hi = f2bf(w); const float lo = w - bf2f(hi);
        wrt[(size_t)e * 2048 + k] = (bf16_t)hi; wrt[(size_t)e * 2048 + 1024 + k] = (bf16_t)f2bf(lo);
    }
}

__device__ __forceinline__ void phase_mod(Ctx& C) {
    float* sc = (float*)C.lds;
    float* mod = (float*)(C.ws + WS_MOD);
    for (int vb = C.blk; vb < 16 * 12; vb += C.nblk) {
        const int b = vb / 12, j = (vb % 12) * 512 + C.tid;
        __syncthreads();
        for (int i = C.tid; i < D; i += NTHREADS) { const float c = C.in[1][b * D + i]; sc[i] = c / (1.0f + expf(-c)); }
        __syncthreads();
        float acc = 0.f; const float* w = C.in[2] + j;
        for (int i = 0; i < D; ++i) acc = fmaf(sc[i], w[(size_t)i * 6 * D], acc);
        mod[b * 6 * D + j] = acc + C.in[3][j];
    }
    __syncthreads();
}

__device__ __forceinline__ void phase_filters(Ctx& C) {
    float* sh = (float*)C.lds;
    float* kfilt = (float*)(C.ws + WS_KFILT);
    const float* w1 = C.in[9]; const float* b1 = C.in[10]; const float* w2 = C.in[11]; const float* b2 = C.in[12];
    const float* w3 = C.in[13]; const float* b3 = C.in[14]; const float* w4 = C.in[15]; const float* fq = C.in[16];
    const int pl = C.tid >> 6, j = C.tid & 63;
    float* z = sh + pl * 160; float* ha = z + 32; float* hb = ha + 64;
    for (int vb = C.blk; vb < SEQ / 8; vb += C.nblk) {
        const int pos = vb * 8 + pl;
        const float tt = (float)pos / (float)(SEQ - 1);
        const float w = 6.283185307179586f * (float)pos / (float)SEQ;
        __syncthreads();
        if (j < 17) {
            float v;
            if (j == 0) v = tt;
            else { const int i = (j - 1) & 7; const float fr = 1e-4f + (float)i * ((7.0f - 1e-4f) / 7.0f); v = (j <= 8) ? cosf(fr * w) : -sinf(fr * w); }
            z[j] = v;
        }
        __syncthreads();
        { float a = b1[j];
#pragma unroll 1
          for (int i = 0; i < 17; ++i) a = fmaf(z[i], w1[i * FHID + j], a); ha[j] = sinf(fq[j] * a); }
        __syncthreads();
        { float a = b2[j];
#pragma unroll 4
          for (int i = 0; i < FHID; ++i) a = fmaf(ha[i], w2[i * FHID + j], a); hb[j] = sinf(fq[j] * a); }
        __syncthreads();
        { float a = b3[j];
#pragma unroll 4
          for (int i = 0; i < FHID; ++i) a = fmaf(hb[i], w3[i * FHID + j], a); __syncthreads(); ha[j] = sinf(fq[j] * a); }
        __syncthreads();
        const float min_decay = logf(1e-2f) / 1.5f, max_decay = logf(1e-2f) / 0.3f;
#pragma unroll 1
        for (int q = 0; q < 16; ++q) {
            const int o = j + 64 * q;
            float a = 0.f;
#pragma unroll 4
            for (int i = 0; i < FHID; ++i) a = fmaf(ha[i], w4[i * 2 * HW + o], a);
            const int c = o & 511, dir = o >> 9;
            const float delta = min_decay + (float)c * ((max_decay - min_decay) / 511.0f);
            a *= expf(-tt * fabsf(delta));
            if (dir == 0) kfilt[(size_t)(2048 + pos) * HW + c] = a;
            else if (pos >= 1) kfilt[(size_t)(2048 - pos) * HW + c] = a;
        }
    }
    __syncthreads();
}

__device__ __forceinline__ void phase_norm1(Ctx& C) {
    const float* mod = (const float*)(C.ws + WS_MOD); bf16_t* h = (bf16_t*)(C.ws + WS_H);
    const float* g = C.in[4];
    for (int row = C.gw; row < T; row += C.ngw) {
        const int b = row / SEQ;
        const f32x4* xr = (const f32x4*)(C.in[0] + (size_t)row * D) + C.lane;
        f32x4 v[4]; float s = 0.f;
#pragma unroll
        for (int j = 0; j < 4; ++j) { v[j] = xr[64 * j]; s += (v[j].x * v[j].x + v[j].y * v[j].y) + (v[j].z * v[j].z + v[j].w * v[j].w); }
        const float rstd = 1.0f / sqrtf(wave_sum(s) * (1.0f / D) + EPS);
        const float* sh = mod + (size_t)b * 6 * D; const float* sc = sh + D;
        u32x2* o = (u32x2*)(h + (size_t)row * D) + C.lane;
#pragma unroll
        for (int j = 0; j < 4; ++j) { const int i0 = 4 * C.lane + 256 * j;
            const f32x4 gg = *(const f32x4*)(g + i0), s1 = *(const f32x4*)(sc + i0), s0 = *(const f32x4*)(sh + i0);
            f32x4 r; r.x = v[j].x * rstd * gg.x * (1.f + s1.x) + s0.x; r.y = v[j].y * rstd * gg.y * (1.f + s1.y) + s0.y;
            r.z = v[j].z * rstd * gg.z * (1.f + s1.z) + s0.z; r.w = v[j].w * rstd * gg.w * (1.f + s1.w) + s0.w;
            u32x2 w; w.x = pk2(r.x, r.y); w.y = pk2(r.z, r.w); o[64 * j] = w; }
    }
}

__device__ __forceinline__ void phase_norm2(Ctx& C) {
    const float* mod = (const float*)(C.ws + WS_MOD); bf16_t* h2 = (bf16_t*)(C.ws + WS_H); bf16_t* h2lo = (bf16_t*)(C.ws + WS_H2LO);
    const float* g = C.in[23];
    for (int row = C.gw; row < T; row += C.ngw) {
        const int b = row / SEQ;
        const f32x4* xr = (const f32x4*)(C.out + (size_t)row * D) + C.lane;
        f32x4 v[4]; float s = 0.f;
#pragma unroll
        for (int j = 0; j < 4; ++j) { v[j] = xr[64 * j]; s += (v[j].x * v[j].x + v[j].y * v[j].y) + (v[j].z * v[j].z + v[j].w * v[j].w); }
        const float rstd = 1.0f / sqrtf(wave_sum(s) * (1.0f / D) + EPS);
        const float* sh = mod + (size_t)b * 6 * D + 3 * D; const float* sc = sh + D;
        u32x2* o = (u32x2*)(h2 + (size_t)row * D) + C.lane; u32x2* ol = (u32x2*)(h2lo + (size_t)row * D) + C.lane;
#pragma unroll
        for (int j = 0; j < 4; ++j) { const int i0 = 4 * C.lane + 256 * j;
            const f32x4 gg = *(const f32x4*)(g + i0), s1 = *(const f32x4*)(sc + i0), s0 = *(const f32x4*)(sh + i0);
            f32x4 r; r.x = v[j].x * rstd * gg.x * (1.f + s1.x) + s0.x; r.y = v[j].y * rstd * gg.y * (1.f + s1.y) + s0.y;
            r.z = v[j].z * rstd * gg.z * (1.f + s1.z) + s0.z; r.w = v[j].w * rstd * gg.w * (1.f + s1.w) + s0.w;
            u32x2 w; w.x = pk2(r.x, r.y); w.y = pk2(r.z, r.w); o[64 * j] = w;
            f32x4 l; l.x = r.x - bflo(w.x); l.y = r.y - bfhi(w.x); l.z = r.z - bflo(w.y); l.w = r.w - bfhi(w.y);
            u32x2 wl; wl.x = pk2(l.x, l.y); wl.y = pk2(l.z, l.w); ol[64 * j] = wl; }
    }
}

__device__ __forceinline__ void phase_final(Ctx& C) {
    const float* mod = (const float*)(C.ws + WS_MOD); const bf16_t* slots = (const bf16_t*)(C.ws + WS_SLOTS);
    const float* g = C.in[30];
    for (int row = C.gw; row < T; row += C.ngw) {
        const int b = row / SEQ;
        f32x4* xr = (f32x4*)(C.out + (size_t)row * D) + C.lane;
        const float* g2 = mod + (size_t)b * 6 * D + 5 * D;
        f32x4 v[4]; float s = 0.f;
#pragma unroll
        for (int j = 0; j < 4; ++j) { const int i0 = 4 * C.lane + 256 * j;
            f32x4 m = {0.f, 0.f, 0.f, 0.f};
#pragma unroll
            for (int k = 0; k < 4; ++k) { const u32x2 w = *(const u32x2*)(slots + ((size_t)row * 4 + k) * D + i0);
                m.x += bflo(w.x); m.y += bfhi(w.x); m.z += bflo(w.y); m.w += bfhi(w.y); }
            const f32x4 gg = *(const f32x4*)(g2 + i0);
            v[j] = xr[64 * j]; v[j].x += gg.x * m.x; v[j].y += gg.y * m.y; v[j].z += gg.z * m.z; v[j].w += gg.w * m.w;
            s += (v[j].x * v[j].x + v[j].y * v[j].y) + (v[j].z * v[j].z + v[j].w * v[j].w); }
        const float rstd = 1.0f / sqrtf(wave_sum(s) * (1.0f / D) + EPS);
#pragma unroll
        for (int j = 0; j < 4; ++j) { const int i0 = 4 * C.lane + 256 * j; const f32x4 gg = *(const f32x4*)(g + i0);
            f32x4 r; r.x = v[j].x * rstd * gg.x; r.y = v[j].y * rstd * gg.y; r.z = v[j].z * rstd * gg.z; r.w = v[j].w * rstd * gg.w; xr[64 * j] = r; }
    }
}

template <class RowFn, class ColFn>
__device__ __forceinline__ void gemm_tile64(f32x4 (&acc)[4][4], const bf16_t* A, size_t lda, RowFn rowfn, const bf16_t* Bt, size_t ldb, ColFn colfn, int kbeg, int kend, int lane) {
    const int fr = lane & 15, fq = lane >> 4;
    const bf16_t* ap[4]; const bf16_t* bp[4];
#pragma unroll
    for (int m = 0; m < 4; ++m) ap[m] = A + (size_t)rowfn(m * 16 + fr) * lda + fq * 8;
#pragma unroll
    for (int n = 0; n < 4; ++n) bp[n] = Bt + (size_t)(colfn(n) + fr) * ldb + fq * 8;
    for (int k = kbeg; k < kend; k += 32) {
        bf16x8 a[4], b[4];
#pragma unroll
        for (int m = 0; m < 4; ++m) a[m] = *(const bf16x8*)(ap[m] + k);
#pragma unroll
        for (int n = 0; n < 4; ++n) b[n] = *(const bf16x8*)(bp[n] + k);
#pragma unroll
        for (int m = 0; m < 4; ++m)
#pragma unroll
            for (int n = 0; n < 4; ++n) acc[m][n] = __builtin_amdgcn_mfma_f32_16x16x32_bf16(b[n], a[m], acc[m][n], 0, 0, 0);
    }
}
__device__ __forceinline__ void zero_acc(f32x4 (&acc)[4][4]) {
#pragma unroll
    for (int m = 0; m < 4; ++m)
#pragma unroll
        for (int n = 0; n < 4; ++n) acc[m][n] = (f32x4){0.f, 0.f, 0.f, 0.f};
}

__device__ __forceinline__ void phase_inproj(Ctx& C) {
    const bf16_t* h = (const bf16_t*)(C.ws + WS_H); const bf16_t* win = (const bf16_t*)(C.ws + WS_WIN); bf16_t* u = (bf16_t*)(C.ws + WS_U);
    const float* bin = C.in[6];
    constexpr int NT = INC / 64, MT = T / 64;
    const int fr = C.lane & 15, fq = C.lane >> 4;
    for (int tile = C.gw; tile < MT * NT; tile += C.ngw) {
        const int mt = tile / NT, nt = tile % NT;
        f32x4 acc[4][4]; zero_acc(acc);
        gemm_tile64(acc, h, D, [&](int r) { return mt * 64 + r; }, win, D, [&](int n) { return nt * 64 + n * 16; }, 0, D, C.lane);
#pragma unroll
        for (int m = 0; m < 4; ++m)
#pragma unroll
            for (int n = 0; n < 4; ++n) { const int row = mt * 64 + m * 16 + fr, col = nt * 64 + n * 16 + 4 * fq;
                f32x4 v = acc[m][n] + *(const f32x4*)(bin + col);
                if (col >= GOFF) { v.x = sigmoidf_(v.x); v.y = sigmoidf_(v.y); v.z = sigmoidf_(v.z); v.w = sigmoidf_(v.w); }
                u32x2 w; w.x = pk2(v.x, v.y); w.y = pk2(v.z, v.w); *(u32x2*)(u + (size_t)row * INC + col) = w; }
    }
}

__device__ __forceinline__ void phase_cat(Ctx& C) {
    const bf16_t* ycat = (const bf16_t*)(C.ws + WS_YCAT); const bf16_t* wcat = (const bf16_t*)(C.ws + WS_WCAT); const bf16_t* u = (const bf16_t*)(C.ws + WS_U);
    bf16_t* merged = (bf16_t*)(C.ws + WS_MERGED);
    constexpr int NT = D / 64, MT = T / 64;
    const int fr = C.lane & 15, fq = C.lane >> 4;
    for (int tile = C.gw; tile < MT * NT; tile += C.ngw) {
        const int mt = tile / NT, nt = tile % NT;
        f32x4 a1[4][4], a2[4][4]; zero_acc(a1); zero_acc(a2);
        gemm_tile64(a1, ycat, D, [&](int r) { return mt * 64 + r; }, wcat, D, [&](int n) { return nt * 64 + n * 16; }, 0, 512, C.lane);
        gemm_tile64(a2, ycat, D, [&](int r) { return mt * 64 + r; }, wcat, D, [&](int n) { return nt * 64 + n * 16; }, 512, 1024, C.lane);
#pragma unroll
        for (int m = 0; m < 4; ++m)
#pragma unroll
            for (int n = 0; n < 4; ++n) { const int row = mt * 64 + m * 16 + fr, col = nt * 64 + n * 16 + 4 * fq;
                const u32x2 g1 = *(const u32x2*)(u + (size_t)row * INC + GOFF + col), g2 = *(const u32x2*)(u + (size_t)row * INC + GOFF + D + col);
                f32x4 v; v.x = bflo(g1.x) * a1[m][n].x + bflo(g2.x) * a2[m][n].x; v.y = bfhi(g1.x) * a1[m][n].y + bfhi(g2.x) * a2[m][n].y;
                v.z = bflo(g1.y) * a1[m][n].z + bflo(g2.y) * a2[m][n].z; v.w = bfhi(g1.y) * a1[m][n].w + bfhi(g2.y) * a2[m][n].w;
                u32x2 w; w.x = pk2(v.x, v.y); w.y = pk2(v.z, v.w); *(u32x2*)(merged + (size_t)row * D + col) = w; }
    }
}

__device__ __forceinline__ void phase_mix(Ctx& C) {
    const bf16_t* merged = (const bf16_t*)(C.ws + WS_MERGED); const bf16_t* wmix = (const bf16_t*)(C.ws + WS_WMIX); const float* mod = (const float*)(C.ws + WS_MOD);
    constexpr int NT = D / 64, MT = T / 64;
    const int fr = C.lane & 15, fq = C.lane >> 4;
    for (int tile = C.gw; tile < MT * NT; tile += C.ngw) {
        const int mt = tile / NT, nt = tile % NT;
        f32x4 acc[4][4]; zero_acc(acc);
        gemm_tile64(acc, merged, D, [&](int r) { return mt * 64 + r; }, wmix, D, [&](int n) { return nt * 64 + n * 16; }, 0, D, C.lane);
        const int b = (mt * 64) / SEQ;
#pragma unroll
        for (int m = 0; m < 4; ++m)
#pragma unroll
            for (int n = 0; n < 4; ++n) { const int row = mt * 64 + m * 16 + fr, col = nt * 64 + n * 16 + 4 * fq;
                const f32x4 g = *(const f32x4*)(mod + (size_t)b * 6 * D + 2 * D + col), xv = *(const f32x4*)(C.in[0] + (size_t)row * D + col);
                *(f32x4*)(C.out + (size_t)row * D + col) = xv + g * acc[m][n]; }
    }
}

__device__ __forceinline__ void phase_hy_pre(Ctx& C) {
    const bf16_t* u = (const bf16_t*)(C.ws + WS_U); bf16_t* vp = (bf16_t*)(C.ws + WS_VP); bf16_t* x0c = (bf16_t*)(C.ws + WS_X0C); bf16_t* vt = (bf16_t*)(C.ws + WS_VT);
    const float* cw = C.in[7]; const float* cb = C.in[8];
    const size_t total = (size_t)T * HW;
    for (size_t i = (size_t)C.blk * NTHREADS + C.tid; i < total; i += (size_t)C.nblk * NTHREADS) {
        const int c = (int)(i % HW); const int row = (int)(i / HW); const int t = row % SEQ;
        float r[3];
#pragma unroll
        for (int s = 0; s < 3; ++s) { const int ch = s * HW + c;
            const float um = (t > 0) ? bf2f(u[(size_t)(row - 1) * INC + ch]) : 0.f, u0 = bf2f(u[(size_t)row * INC + ch]), up = (t < SEQ - 1) ? bf2f(u[(size_t)(row + 1) * INC + ch]) : 0.f;
            r[s] = um * cw[ch] + u0 * cw[3 * HW + ch] + up * cw[2 * 3 * HW + ch] + cb[ch]; }
        x0c[i] = (bf16_t)f2bf(r[0]); vp[i] = (bf16_t)f2bf(r[2] * r[1]);
    }
    for (size_t i = (size_t)C.blk * NTHREADS + C.tid; i < total; i += (size_t)C.nblk * NTHREADS) {
        const int t = (int)(i % SEQ); const int e = (int)((i / SEQ) % 128); const int hh = (int)((i / ((size_t)SEQ * 128)) % 4); const int b = (int)(i / ((size_t)SEQ * 512));
        vt[i] = u[(size_t)(b * SEQ + t) * INC + VOFF + hh * 128 + e];
    }
}

__device__ __forceinline__ void phase_hy_conv(Ctx& C) {
    const bf16_t* vp = (const bf16_t*)(C.ws + WS_VP); const bf16_t* x0c = (const bf16_t*)(C.ws + WS_X0C); const float* kf = (const float*)(C.ws + WS_KFILT);
    bf16_t* ycat = (bf16_t*)(C.ws + WS_YCAT); const float* dsk = C.in[17];
    const size_t total = (size_t)NB * (SEQ / 4) * HW;
    for (size_t i = (size_t)C.blk * NTHREADS + C.tid; i < total; i += (size_t)C.nblk * NTHREADS) {
        const int c = (int)(i % HW); const int tb = (int)((i / HW) % (SEQ / 4)); const int b = (int)(i / ((size_t)HW * (SEQ / 4)));
        const int t0 = tb * 4;
        float a0 = 0.f, a1 = 0.f, a2 = 0.f, a3 = 0.f;
        float k0 = kf[(size_t)(2048 + t0) * HW + c], k1 = kf[(size_t)(2048 + t0 + 1) * HW + c], k2 = kf[(size_t)(2048 + t0 + 2) * HW + c], k3 = kf[(size_t)(2048 + t0 + 3) * HW + c];
        const bf16_t* vb = vp + (size_t)b * SEQ * HW + c;
        for (int s = 0; s < SEQ; ++s) {
            const float v = bf2f(vb[(size_t)s * HW]);
            a0 = fmaf(v, k0, a0); a1 = fmaf(v, k1, a1); a2 = fmaf(v, k2, a2); a3 = fmaf(v, k3, a3);
            k3 = k2; k2 = k1; k1 = k0;
            const int idx = 2048 + t0 - s - 1;
            k0 = (idx >= 1) ? kf[(size_t)idx * HW + c] : 0.f;
        }
        const float dd = dsk[c];
        float acc[4] = {a0, a1, a2, a3};
#pragma unroll
        for (int q = 0; q < 4; ++q) { const size_t row = (size_t)b * SEQ + t0 + q; const float v = bf2f(vp[row * HW + c]);
            ycat[row * D + c] = (bf16_t)f2bf((acc[q] + v * dd) * bf2f(x0c[row * HW + c])); }
    }
}

__device__ __forceinline__ void phase_attn(Ctx& C) {
    const bf16_t* u = (const bf16_t*)(C.ws + WS_U); const bf16_t* vt = (const bf16_t*)(C.ws + WS_VT); bf16_t* ycat = (bf16_t*)(C.ws + WS_YCAT);
    const int lane = C.lane, l31 = lane & 31, hi = lane >> 5;
    const float* lq = C.in[18];
    const float d1 = wave_sum(lq[lane] * lq[64 + lane]), d2 = wave_sum(lq[128 + lane] * lq[192 + lane]);
    const float lam_init = 0.2f;
    const float lam = expf(d1) - expf(d2) + lam_init;
    const float* sg = C.in[19];
    constexpr int NU = NB * 4 * (SEQ / 32);
    for (int unit = C.gw; unit < NU; unit += C.ngw) {
        const int qt = unit % (SEQ / 32); const int hh = (unit / (SEQ / 32)) % 4; const int b = unit / ((SEQ / 32) * 4);
        const int q0 = qt * 32;
        const float slope2 = exp2f(-2.0f * (float)(hh + 1)) * LOG2E;
        const float sc2 = 0.125f * LOG2E;
        const bf16_t* qrow = u + (size_t)(b * SEQ + q0 + l31) * INC + QOFF + hh * 128;
        const bf16_t* kbase = u + (size_t)(b * SEQ) * INC + KOFF + hh * 128;
        const bf16_t* vbase = vt + (size_t)((b * 4 + hh) * 128) * SEQ;
        const float qpos = (float)(q0 + l31);
        float* o1s = (float*)(C.lds + C.wave * 16384) + lane;
#pragma unroll 1
        for (int c = 0; c < 2; ++c) {
            bf16x8 qf[4];
#pragma unroll
            for (int ks = 0; ks < 4; ++ks) qf[ks] = *(const bf16x8*)(qrow + c * 64 + 16 * ks + 8 * hi);
            f32x16 o[4];
#pragma unroll
            for (int eb = 0; eb < 4; ++eb)
#pragma unroll
                for (int r = 0; r < 16; ++r) o[eb][r] = 0.f;
            float mrun = -1e30f, lsum = 0.f;
            for (int kv0 = 0; kv0 < SEQ; kv0 += 32) {
                f32x16 s;
#pragma unroll
                for (int r = 0; r < 16; ++r) s[r] = 0.f;
                const bf16_t* krow = kbase + (size_t)(kv0 + l31) * INC + c * 64 + 8 * hi;
#pragma unroll
                for (int ks = 0; ks < 4; ++ks) { const bf16x8 kf = *(const bf16x8*)(krow + 16 * ks); s = __builtin_amdgcn_mfma_f32_32x32x16_bf16(kf, qf[ks], s, 0, 0, 0); }
                float mt = -1e30f;
#pragma unroll
                for (int r = 0; r < 16; ++r) { const float kvpos = (float)(kv0 + crow(r, 0)) + 4.0f * (float)hi; s[r] = s[r] * sc2 - slope2 * fabsf(qpos - kvpos); mt = fmaxf(mt, s[r]); }
                mt = fmaxf(mt, __shfl_xor(mt, 32));
                const float mnew = fmaxf(mrun, mt); const float alpha = exp2f(mrun - mnew); mrun = mnew;
                float ps = 0.f;
#pragma unroll
                for (int r = 0; r < 16; ++r) { s[r] = exp2f(s[r] - mnew); ps += s[r]; }
                lsum = lsum * alpha + ps;
#pragma unroll
                for (int eb = 0; eb < 4; ++eb)
#pragma unroll
                    for (int r = 0; r < 16; ++r) o[eb][r] *= alpha;
                bf16x8 pf[2];
#pragma unroll
                for (int s2 = 0; s2 < 2; ++s2) { u32x4 w; w.x = pk2(s[8 * s2 + 0], s[8 * s2 + 1]); w.y = pk2(s[8 * s2 + 2], s[8 * s2 + 3]); w.z = pk2(s[8 * s2 + 4], s[8 * s2 + 5]); w.w = pk2(s[8 * s2 + 6], s[8 * s2 + 7]); pf[s2] = __builtin_bit_cast(bf16x8, w); }
#pragma unroll
                for (int eb = 0; eb < 4; ++eb) {
                    const bf16_t* vr = vbase + (size_t)(32 * eb + l31) * SEQ + kv0 + 4 * hi;
#pragma unroll
                    for (int s2 = 0; s2 < 2; ++s2) {
                        const s16x4 lo = *(const s16x4*)(vr + 16 * s2), hi4 = *(const s16x4*)(vr + 16 * s2 + 8);
                        const bf16x8 vf = (bf16x8){lo[0], lo[1], lo[2], lo[3], hi4[0], hi4[1], hi4[2], hi4[3]};
                        o[eb] = __builtin_amdgcn_mfma_f32_32x32x16_bf16(vf, pf[s2], o[eb], 0, 0, 0);
                    }
                }
            }
            lsum += __shfl_xor(lsum, 32);
            const float inv = 1.0f / lsum;
            if (c == 0) {
#pragma unroll
                for (int eb = 0; eb < 4; ++eb)
#pragma unroll
                    for (int r = 0; r < 16; ++r) o1s[(eb * 16 + r) * 64] = o[eb][r] * inv;
            } else {
                float ss = 0.f;
                f32x16 o1[4];
#pragma unroll
                for (int eb = 0; eb < 4; ++eb)
#pragma unroll
                    for (int r = 0; r < 16; ++r) { const float y = o1s[(eb * 16 + r) * 64] - lam * (o[eb][r] * inv); o1[eb][r] = y; ss += y * y; }
                ss += __shfl_xor(ss, 32);
                const float rinv = 1.0f / sqrtf(ss * (1.0f / 128.0f) + EPS) * (1.0f - lam_init);
                bf16_t* orow = ycat + (size_t)(b * SEQ + q0 + l31) * D + 512 + hh * 128;
#pragma unroll
                for (int eb = 0; eb < 4; ++eb)
#pragma unroll
                    for (int r = 0; r < 16; ++r) { const int e = 32 * eb + crow(r, 0) + 4 * hi; orow[e] = (bf16_t)f2bf(o1[eb][r] * rinv * sg[e]); }
            }
        }
    }
}

__device__ __forceinline__ void phase_router(Ctx& C) {
    const bf16_t* h2 = (const bf16_t*)(C.ws + WS_H); const bf16_t* h2lo = (const bf16_t*)(C.ws + WS_H2LO); const bf16_t* wrt = (const bf16_t*)(C.ws + WS_WRT);
    float* logits = (float*)(C.ws + WS_LOGITS);
    const int fr = C.lane & 15, fq = C.lane >> 4;
    for (int tile = C.gw; tile < T / 16; tile += C.ngw) {
        f32x4 acc[2]; acc[0] = (f32x4){0.f, 0.f, 0.f, 0.f}; acc[1] = acc[0];
        const bf16_t* ah = h2 + (size_t)(tile * 16 + fr) * D + fq * 8; const bf16_t* al = h2lo + (size_t)(tile * 16 + fr) * D + fq * 8;
        for (int k = 0; k < D; k += 32) {
            const bf16x8 a_h = *(const bf16x8*)(ah + k), a_l = *(const bf16x8*)(al + k);
#pragma unroll
            for (int n = 0; n < 2; ++n) { const bf16_t* bp = wrt + (size_t)(n * 16 + fr) * 2048 + fq * 8 + k;
                const bf16x8 b_h = *(const bf16x8*)(bp), b_l = *(const bf16x8*)(bp + 1024);
                acc[n] = __builtin_amdgcn_mfma_f32_16x16x32_bf16(b_h, a_h, acc[n], 0, 0, 0);
                acc[n] = __builtin_amdgcn_mfma_f32_16x16x32_bf16(b_h, a_l, acc[n], 0, 0, 0);
                acc[n] = __builtin_amdgcn_mfma_f32_16x16x32_bf16(b_l, a_h, acc[n], 0, 0, 0); }
        }
#pragma unroll
        for (int n = 0; n < 2; ++n) *(f32x4*)(logits + (size_t)(tile * 16 + fr) * NE + n * 16 + 4 * fq) = acc[n];
    }
}

__device__ __forceinline__ void phase_top4(Ctx& C) {
    const float* logits = (const float*)(C.ws + WS_LOGITS); int* tope = (int*)(C.ws + WS_TOPE); float* topw = (float*)(C.ws + WS_TOPW); int* blkcnt = (int*)(C.ws + WS_BLKCNT);
    int* hist = (int*)C.lds; const float* br = C.in[25];
    for (int vb = C.blk; vb < 256; vb += C.nblk) {
        __syncthreads();
        if (C.tid < NE) hist[C.tid] = 0;
        __syncthreads();
        if (C.tid < 128) {
            const int t = vb * 128 + C.tid;
            float v[32];
#pragma unroll
            for (int q = 0; q < 8; ++q) { const f32x4 x = *(const f32x4*)(logits + (size_t)t * NE + 4 * q), bb = *(const f32x4*)(br + 4 * q);
                v[4 * q] = x.x + bb.x; v[4 * q + 1] = x.y + bb.y; v[4 * q + 2] = x.z + bb.z; v[4 * q + 3] = x.w + bb.w; }
            float tv[4]; int ti[4];
#pragma unroll
            for (int k = 0; k < 4; ++k) {
                float best = -INFINITY; int bi = 0;
#pragma unroll
                for (int e = 0; e < 32; ++e) if (v[e] > best) { best = v[e]; bi = e; }
                tv[k] = best; ti[k] = bi;
#pragma unroll
                for (int e = 0; e < 32; ++e) v[e] = (e == bi) ? -INFINITY : v[e];
            }
            const float e0 = 1.0f, e1 = expf(tv[1] - tv[0]), e2 = expf(tv[2] - tv[0]), e3 = expf(tv[3] - tv[0]);
            const float inv = 1.0f / (e0 + e1 + e2 + e3);
            *(int4*)(tope + (size_t)t * 4) = make_int4(ti[0], ti[1], ti[2], ti[3]);
            *(f32x4*)(topw + (size_t)t * 4) = (f32x4){e0 * inv, e1 * inv, e2 * inv, e3 * inv};
#pragma unroll
            for (int k = 0; k < 4; ++k) atomicAdd(&hist[ti[k]], 1);
        }
        __syncthreads();
        if (C.tid < NE) blkcnt[vb * NE + C.tid] = hist[C.tid];
    }
    __syncthreads();
}

__device__ __forceinline__ void phase_rowlist(Ctx& C) {
    const int* tope = (const int*)(C.ws + WS_TOPE); const int* blkcnt = (const int*)(C.ws + WS_BLKCNT);
    int* rowpair = (int*)(C.ws + WS_ROWPAIR); int* tileexp = (int*)(C.ws + WS_TILEEXP); int* meta = (int*)(C.ws + WS_META);
    int* s_total = (int*)C.lds; int* s_base = s_total + 32; int* s_pstart = s_base + 32; int* s_e = s_pstart + 33;
    for (int vb = C.blk; vb < 256; vb += C.nblk) {
        __syncthreads();
        if (C.tid < NE) { int tot = 0, base = 0; for (int q = 0; q < 256; ++q) { const int c = blkcnt[q * NE + C.tid]; tot += c; if (q < vb) base += c; } s_total[C.tid] = tot; s_base[C.tid] = base; }
        s_e[C.tid] = tope[(size_t)vb * 512 + C.tid];
        __syncthreads();
        if (C.tid == 0) { int ps = 0; for (int e = 0; e < NE; ++e) { s_pstart[e] = ps; ps += ((s_total[e] + 255) / 256) * 256; } s_pstart[NE] = ps; }
        __syncthreads();
        { const int e = s_e[C.tid]; int rank = 0; for (int j = 0; j < C.tid; ++j) rank += (s_e[j] == e) ? 1 : 0;
          rowpair[s_pstart[e] + s_base[e] + rank] = vb * 512 + C.tid; }
        if (vb < NE) { const int e = vb; for (int r = s_pstart[e] + s_total[e] + C.tid; r < s_pstart[e + 1]; r += NTHREADS) rowpair[r] = -1; }
        if (vb == 0) {
            if (C.tid < NE) { for (int tl = s_pstart[C.tid] / 256; tl < s_pstart[C.tid + 1] / 256; ++tl) tileexp[tl] = C.tid; }
            if (C.tid == 0) meta[0] = s_pstart[NE] / 256;
        }
    }
    __syncthreads();
}

__device__ __forceinline__ void phase_gateup(Ctx& C) {
    const bf16_t* h2 = (const bf16_t*)(C.ws + WS_H); const bf16_t* wgu = (const bf16_t*)(C.ws + WS_WGU); bf16_t* act = (bf16_t*)(C.ws + WS_ACT);
    const int* rowpair = (const int*)(C.ws + WS_ROWPAIR); const int* tileexp = (const int*)(C.ws + WS_TILEEXP); const int* meta = (const int*)(C.ws + WS_META);
    const float* bgu = C.in[27];
    const int nmt = meta[0] * 4;
    const int fr = C.lane & 15, fq = C.lane >> 4;
    for (int tile = C.gw; tile < nmt * 32; tile += C.ngw) {
        const int mt = tile / 32, ntq = tile % 32; const int j = ntq >> 2, q = ntq & 3;
        const int e = tileexp[mt >> 2];
        f32x4 acc[4][4]; zero_acc(acc);
        gemm_tile64(acc, h2, D, [&](int r) { const int p = rowpair[mt * 64 + r]; return p >= 0 ? (p >> 2) : 0; },
                    wgu + (size_t)e * 2 * D * D, D, [&](int n) { return 256 * j + 128 * (n >> 1) + 32 * q + 16 * (n & 1); }, 0, D, C.lane);
#pragma unroll
        for (int m = 0; m < 4; ++m)
#pragma unroll
            for (int n = 0; n < 2; ++n) { const int row = mt * 64 + m * 16 + fr, col = 128 * j + 32 * q + 16 * n + 4 * fq;
                const f32x4 bg = *(const f32x4*)(bgu + (size_t)e * 2 * D + col), bu = *(const f32x4*)(bgu + (size_t)e * 2 * D + D + col);
                const f32x4 g = acc[m][n] + bg, uu = acc[m][n + 2] + bu; float r[4];
#pragma unroll
                for (int i = 0; i < 4; ++i) { const float gg = fminf(g[i], 7.0f), up = fminf(fmaxf(uu[i], -7.0f), 7.0f); r[i] = (up + 1.0f) * (gg * sigmoidf_(1.702f * gg)); }
                u32x2 w; w.x = pk2(r[0], r[1]); w.y = pk2(r[2], r[3]); *(u32x2*)(act + (size_t)row * D + col) = w; }
    }
}

__device__ __forceinline__ void phase_down(Ctx& C) {
    const bf16_t* act = (const bf16_t*)(C.ws + WS_ACT); const bf16_t* wdn = (const bf16_t*)(C.ws + WS_WDN); bf16_t* slots = (bf16_t*)(C.ws + WS_SLOTS);
    const int* rowpair = (const int*)(C.ws + WS_ROWPAIR); const int* tileexp = (const int*)(C.ws + WS_TILEEXP); const int* meta = (const int*)(C.ws + WS_META);
    const float* topw = (const float*)(C.ws + WS_TOPW); const float* bd = C.in[29];
    const int nmt = meta[0] * 4;
    const int fr = C.lane & 15, fq = C.lane >> 4;
    for (int tile = C.gw; tile < nmt * 16; tile += C.ngw) {
        const int mt = tile / 16, nt = tile % 16; const int e = tileexp[mt >> 2];
        f32x4 acc[4][4]; zero_acc(acc);
        gemm_tile64(acc, act, D, [&](int r) { return mt * 64 + r; }, wdn + (size_t)e * D * D, D, [&](int n) { return nt * 64 + n * 16; }, 0, D, C.lane);
#pragma unroll
        for (int m = 0; m < 4; ++m) { const int row = mt * 64 + m * 16 + fr; const int p = rowpair[row];
            if (p >= 0) { const float w = topw[p];
#pragma unroll
                for (int n = 0; n < 4; ++n) { const int col = nt * 64 + n * 16 + 4 * fq; const f32x4 v = (acc[m][n] + *(const f32x4*)(bd + (size_t)e * D + col)) * w;
                    u32x2 o; o.x = pk2(v.x, v.y); o.y = pk2(v.z, v.w); *(u32x2*)(slots + (size_t)p * D + col) = o; } } }
    }
}

constexpr int NPHASES = 15;
}

__global__ void __launch_bounds__(NTHREADS, 2) fwd_kernel(Params p) {
    extern __shared__ __attribute__((aligned(16))) unsigned char lds[];
    cg::grid_group grid = cg::this_grid();
    Ctx C;
#pragma unroll
    for (int i = 0; i < 31; ++i) C.in[i] = p.in[i];
    C.out = p.out; C.ws = p.ws; C.lds = lds;
    C.tid = threadIdx.x; C.lane = C.tid & 63; C.wave = __builtin_amdgcn_readfirstlane(C.tid >> 6);
    C.blk = blockIdx.x; C.nblk = gridDim.x; C.gw = C.blk * NWAVES + C.wave; C.ngw = C.nblk * NWAVES;
    const int lo = p.ph_lo, hi = p.ph_hi;
#ifndef PHMASK
#define PHMASK 0xffff
#endif
#define PH(k, body) do { if ((PHMASK >> (k)) & 1) { if (lo <= (k) && (k) < hi) { body; if ((k) + 1 < hi) grid.sync(); } } } while (0)
    PH(0, { phase_weights(C); __syncthreads(); phase_mod(C); phase_filters(C); });
    PH(1, phase_norm1(C));
    PH(2, phase_inproj(C));
    PH(3, phase_hy_pre(C));
    PH(4, phase_hy_conv(C));
    PH(5, phase_attn(C));
    PH(6, phase_cat(C));
    PH(7, phase_mix(C));
    PH(8, phase_norm2(C));
    PH(9, phase_router(C));
    PH(10, phase_top4(C));
    PH(11, phase_rowlist(C));
    PH(12, phase_gateup(C));
    PH(13, phase_down(C));
    PH(14, phase_final(C));
#undef PH
}

extern "C" void kernel_launch(void* const* d_in, const int* in_sizes, int n_in, void* d_out, int out_size, void* d_ws, size_t ws_size, hipStream_t stream) {
    static int grid = 0;
    if (grid == 0) {
        if (n_in != 31 || ws_size < WS_END) { fprintf(stderr, "kernel_launch: unexpected n_in %d or ws_size %zu\n", n_in, ws_size); grid = -1; return; }
        int dev = 0, cus = 0, per_cu = 0;
        hipGetDevice(&dev); hipDeviceGetAttribute(&cus, hipDeviceAttributeMultiprocessorCount, dev);
        hipFuncSetAttribute((const void*)fwd_kernel, hipFuncAttributeMaxDynamicSharedMemorySize, LDS_BYTES);
        hipOccupancyMaxActiveBlocksPerMultiprocessor(&per_cu, (const void*)fwd_kernel, NTHREADS, LDS_BYTES);
        if (per_cu < 1) { fprintf(stderr, "kernel_launch: occupancy query says %d blocks/CU\n", per_cu); per_cu = 1; }
        (void)hipGetLastError();
        grid = cus * 1;
        fprintf(stderr, "kernel_launch: cus %d per_cu %d grid %d\n", cus, per_cu, grid);
    }
    if (grid < 0) return;
    Params p{};
    for (int i = 0; i < 31; ++i) p.in[i] = (const float*)d_in[i];
    p.out = (float*)d_out; p.ws = (unsigned char*)d_ws; p.ph_lo = 0; p.ph_hi = NPHASES;
    void* args[] = {&p};
    hipError_t e = hipLaunchCooperativeKernel((const void*)fwd_kernel, dim3(grid), dim3(NTHREADS), args, LDS_BYTES, stream);
    if (e != hipSuccess) fprintf(stderr, "cooperative launch failed: %s (grid %d)\n", hipGetErrorString(e), grid);
}
```

```cpp
#include <hip/hip_runtime.h>
#include <hip/hip_cooperative_groups.h>
#include <cstdio>
#include <cstdint>
namespace cg = cooperative_groups;

namespace {
typedef unsigned short bf16_t;
typedef short bf16x8 __attribute__((ext_vector_type(8)));
typedef short s16x4 __attribute__((ext_vector_type(4)));
typedef float f32x4 __attribute__((ext_vector_type(4)));
typedef float f32x16 __attribute__((ext_vector_type(16)));
typedef unsigned u32x4 __attribute__((ext_vector_type(4)));
typedef unsigned u32x2 __attribute__((ext_vector_type(2)));

constexpr int D = 1024, NB = 16, SEQ = 2048, T = NB * SEQ, HW = 512, INC = 5120, NE = 32, FHID = 64;
constexpr int QOFF = 1536, KOFF = 2048, VOFF = 2560, GOFF = 3072;
constexpr int NTHREADS = 512, NWAVES = 8;
constexpr float EPS = 1e-5f;
constexpr float LOG2E = 1.4426950408889634f;
constexpr float QSCALE = 0.125f * 1.4426950408889634f;
constexpr size_t MiB = 1u << 20;
constexpr size_t WS_CTL = 0;
constexpr size_t WS_MOD = 1 * MiB;
constexpr size_t WS_META = 1 * MiB + 512 * 1024;
constexpr size_t WS_BLKCNT = WS_META + 4096;
constexpr size_t WS_TILEEXP = WS_BLKCNT + 256 * 32 * 4;
constexpr size_t WS_LOGITS = 2 * MiB;
constexpr size_t WS_TOPE = 6 * MiB;
constexpr size_t WS_TOPW = 6 * MiB + 512 * 1024;
constexpr size_t WS_ROWPAIR = 7 * MiB;
constexpr size_t WS_KFILT = 8 * MiB;
constexpr size_t WS_U = 16 * MiB;
constexpr size_t WS_ACT = WS_U;
constexpr size_t WS_H = 336 * MiB;
constexpr size_t WS_R1 = 400 * MiB;
constexpr size_t WS_YCAT = WS_R1;
constexpr size_t WS_MERGED = WS_R1 + 64 * MiB;
constexpr size_t WS_VP = WS_R1 + 128 * MiB;
constexpr size_t WS_X0C = WS_R1 + 160 * MiB;
constexpr size_t WS_VT = WS_R1 + 192 * MiB;
constexpr size_t WS_H2LO = WS_R1 + 224 * MiB;
constexpr size_t WS_SLOTS = WS_R1;
constexpr size_t WS_WIN = 688 * MiB;
constexpr size_t WS_WCAT = 698 * MiB;
constexpr size_t WS_WMIX = 700 * MiB;
constexpr size_t WS_WGU = 702 * MiB;
constexpr size_t WS_WDN = 830 * MiB;
constexpr size_t WS_WRT = 894 * MiB;
constexpr size_t WS_KFC = 896 * MiB;
constexpr size_t WS_END = 904 * MiB;
constexpr size_t WS_YT = WS_R1 + 192 * MiB;
constexpr int MAXROWS = 4 * T + NE * 256;
constexpr int LDS_BYTES = 147456;

struct Params { const float* in[31]; float* out; unsigned char* ws; int ph_lo, ph_hi; };

__device__ __forceinline__ unsigned f2bf(float f) { unsigned u = __float_as_uint(f); return (u + 0x7fffu + ((u >> 16) & 1u)) >> 16; }
__device__ __forceinline__ unsigned pk2(float lo, float hi) { return f2bf(lo) | (f2bf(hi) << 16); }
__device__ __forceinline__ float bf2f(unsigned h) { return __uint_as_float(h << 16); }
__device__ __forceinline__ float bflo(unsigned w) { return __uint_as_float(w << 16); }
__device__ __forceinline__ float bfhi(unsigned w) { return __uint_as_float(w & 0xffff0000u); }
__device__ __forceinline__ float wave_sum(float v) {
#pragma unroll
    for (int o = 1; o < 64; o <<= 1) v += __shfl_xor(v, o);
    return v;
}
__device__ __forceinline__ float sigmoidf_(float x) { return 1.0f / (1.0f + __expf(-x)); }
__device__ __forceinline__ int crow(int r, int hi) { return (r & 3) + 8 * (r >> 2) + 4 * hi; }

struct Ctx {
    const float* in[31]; float* out; unsigned char* ws;
    int tid, lane, wave, gw, ngw, nblk, blk;
    unsigned char* lds;
};

__device__ __forceinline__ void transpose_item(const float* W, int N, int k0, int n0, bf16_t* WT, size_t ldt, int kdst0, int ndst0, float* scr, int lane) {
#pragma unroll 8
    for (int i = 0; i < 32; ++i) { const int kk = 2 * i + (lane >> 5); scr[kk * 33 + (lane & 31)] = W[(size_t)(k0 + kk) * N + n0 + (lane & 31)]; }
    __builtin_amdgcn_s_waitcnt(0xc07f); asm volatile("" ::: "memory");
    const int c = lane & 7;
#pragma unroll
    for (int j = 0; j < 4; ++j) { const int n = (lane >> 3) + 8 * j; const float* s = scr + (8 * c) * 33 + n;
        u32x4 o; o.x = pk2(s[0 * 33], s[1 * 33]); o.y = pk2(s[2 * 33], s[3 * 33]); o.z = pk2(s[4 * 33], s[5 * 33]); o.w = pk2(s[6 * 33], s[7 * 33]);
        *(u32x4*)(WT + (size_t)(ndst0 + n) * ldt + kdst0 + 8 * c) = o; }
    __builtin_amdgcn_s_waitcnt(0xc07f); asm volatile("" ::: "memory");
}

__device__ __forceinline__ void phase_weights(Ctx& C) {
    float* scr = (float*)(C.lds + C.wave * 16384);
    unsigned char* ws = C.ws;
    bf16_t* win = (bf16_t*)(ws + WS_WIN); bf16_t* wcat = (bf16_t*)(ws + WS_WCAT); bf16_t* wmix = (bf16_t*)(ws + WS_WMIX);
    bf16_t* wgu = (bf16_t*)(ws + WS_WGU); bf16_t* wdn = (bf16_t*)(ws + WS_WDN);
    constexpr int I_IN = (D / 64) * (INC / 32);
    constexpr int I_HY = (HW / 64) * (D / 32);
    constexpr int I_MIX = (D / 64) * (D / 32);
    constexpr int I_GU1 = (D / 64) * (2 * D / 32);
    constexpr int I_DN1 = (D / 64) * (D / 32);
    constexpr int NITEMS = I_IN + 2 * I_HY + I_MIX + NE * I_GU1 + NE * I_DN1;
    for (int it = C.gw; it < NITEMS; it += C.ngw) {
        int r = it;
        if (r < I_IN) { const int nb = INC / 32; transpose_item(C.in[5], INC, 64 * (r / nb), 32 * (r % nb), win, D, 64 * (r / nb), 32 * (r % nb), scr, C.lane); continue; } r -= I_IN;
        if (r < I_HY) { const int nb = D / 32; transpose_item(C.in[20], D, 64 * (r / nb), 32 * (r % nb), wcat, D, 64 * (r / nb), 32 * (r % nb), scr, C.lane); continue; } r -= I_HY;
        if (r < I_HY) { const int nb = D / 32; transpose_item(C.in[21], D, 64 * (r / nb), 32 * (r % nb), wcat, D, 512 + 64 * (r / nb), 32 * (r % nb), scr, C.lane); continue; } r -= I_HY;
        if (r < I_MIX) { const int nb = D / 32; transpose_item(C.in[22], D, 64 * (r / nb), 32 * (r % nb), wmix, D, 64 * (r / nb), 32 * (r % nb), scr, C.lane); continue; } r -= I_MIX;
        if (r < NE * I_GU1) { const int e = r / I_GU1, q = r % I_GU1; const int nb = 2 * D / 32; const int n0 = 32 * (q % nb), k0 = 64 * (q / nb);
            const int s = n0 / 1024, rem = n0 % 1024, j = rem / 128, i0 = rem % 128; const int nd = 256 * j + 128 * s + i0;
            transpose_item(C.in[26] + (size_t)e * D * 2 * D, 2 * D, k0, n0, wgu + (size_t)e * 2 * D * D, D, k0, nd, scr, C.lane); continue; } r -= NE * I_GU1;
        { const int e = r / I_DN1, q = r % I_DN1; const int nb = D / 32; const int n0 = 32 * (q % nb), k0 = 64 * (q / nb);
            transpose_item(C.in[28] + (size_t)e * D * D, D, k0, n0, wdn + (size_t)e * D * D, D, k0, n0, scr, C.lane); }
    }
    bf16_t* wrt = (bf16_t*)(ws + WS_WRT);
    for (int i = C.blk * NTHREADS + C.tid; i < NE * D; i += C.nblk * NTHREADS) {
        const int e = i / D, k = i % D; const float w = C.in[24][(size_t)k * NE + e];
        const unsigned hi = f2bf(w); const float lo = w - bf2f(hi);
        wrt[(size_t)e * 2048 + k] = (bf16_t)hi; wrt[(size_t)e * 2048 + 1024 + k] = (bf16_t)f2bf(lo);
    }
}

__device__ __forceinline__ void phase_mod(Ctx& C) {
    float* sc = (float*)C.lds;
    float* mod = (float*)(C.ws + WS_MOD);
    for (int vb = C.blk; vb < 16 * 12; vb += C.nblk) {
        const int b = vb / 12, j = (vb % 12) * 512 + C.tid;
        __syncthreads();
        for (int i = C.tid; i < D; i += NTHREADS) { const float c = C.in[1][b * D + i]; sc[i] = c / (1.0f + expf(-c)); }
        __syncthreads();
        float acc = 0.f; const float* w = C.in[2] + j;
        for (int i = 0; i < D; ++i) acc = fmaf(sc[i], w[(size_t)i * 6 * D], acc);
        mod[b * 6 * D + j] = acc + C.in[3][j];
    }
    __syncthreads();
}

__device__ __forceinline__ void phase_filters(Ctx& C) {
    float* sh = (float*)C.lds;
    float* kfilt = (float*)(C.ws + WS_KFILT); float* kfc = (float*)(C.ws + WS_KFC); float* ks = (float*)(C.lds + 8192);
    const float* w1 = C.in[9]; const float* b1 = C.in[10]; const float* w2 = C.in[11]; const float* b2 = C.in[12];
    const float* w3 = C.in[13]; const float* b3 = C.in[14]; const float* w4 = C.in[15]; const float* fq = C.in[16];
    const int pl = C.tid >> 6, j = C.tid & 63;
    float* z = sh + pl * 160; float* ha = z + 32; float* hb = ha + 64;
    for (int vb = C.blk; vb < SEQ / 8; vb += C.nblk) {
        const int pos = vb * 8 + pl;
        const float tt = (float)pos / (float)(SEQ - 1);
        const float w = 6.283185307179586f * (float)pos / (float)SEQ;
        __syncthreads();
        if (j < 17) {
            float v;
            if (j == 0) v = tt;
            else { const int i = (j - 1) & 7; const float fr = 1e-4f + (float)i * ((7.0f - 1e-4f) / 7.0f); v = (j <= 8) ? cosf(fr * w) : -sinf(fr * w); }
            z[j] = v;
        }
        __syncthreads();
        { float a = b1[j];
#pragma unroll 1
          for (int i = 0; i < 17; ++i) a = fmaf(z[i], w1[i * FHID + j], a); ha[j] = sinf(fq[j] * a); }
        __syncthreads();
        { float a = b2[j];
#pragma unroll 4
          for (int i = 0; i < FHID; ++i) a = fmaf(ha[i], w2[i * FHID + j], a); hb[j] = sinf(fq[j] * a); }
        __syncthreads();
        { float a = b3[j];
#pragma unroll 4
          for (int i = 0; i < FHID; ++i) a = fmaf(hb[i], w3[i * FHID + j], a); __syncthreads(); ha[j] = sinf(fq[j] * a); }
        __syncthreads();
        const float min_decay = logf(1e-2f) / 1.5f, max_decay = logf(1e-2f) / 0.3f;
#pragma unroll 1
        for (int q = 0; q < 16; ++q) {
            const int o = j + 64 * q;
            float a = 0.f;
#pragma unroll 4
            for (int i = 0; i < FHID; ++i) a = fmaf(ha[i], w4[i * 2 * HW + o], a);
            const int c = o & 511, dir = o >> 9;
            const float delta = min_decay + (float)c * ((max_decay - min_decay) / 511.0f);
            a *= expf(-tt * fabsf(delta));
            if (dir == 0) kfilt[(size_t)(2048 + pos) * HW + c] = a;
            else if (pos >= 1) kfilt[(size_t)(2048 - pos) * HW + c] = a;
            ks[pl * 1024 + o] = a;
        }
        __syncthreads();
        {   const int pos0 = vb * 8;
            { const int c = C.tid; float* dst = kfc + (size_t)c * 4096 + 2048 + pos0;
              *(f32x4*)dst = (f32x4){ks[0 * 1024 + c], ks[1 * 1024 + c], ks[2 * 1024 + c], ks[3 * 1024 + c]};
              *(f32x4*)(dst + 4) = (f32x4){ks[4 * 1024 + c], ks[5 * 1024 + c], ks[6 * 1024 + c], ks[7 * 1024 + c]}; }
            { const int c = C.tid; float* dst = kfc + (size_t)c * 4096 + 2048 - pos0;
#pragma unroll
              for (int i = 0; i < 8; ++i) if (pos0 + i >= 1) dst[-i] = ks[i * 1024 + 512 + c]; }
        }
    }
    __syncthreads();
}

__device__ __forceinline__ void phase_norm1(Ctx& C) {
    const float* mod = (const float*)(C.ws + WS_MOD); bf16_t* h = (bf16_t*)(C.ws + WS_H);
    const float* g = C.in[4];
    for (int row = C.gw; row < T; row += C.ngw) {
        const int b = row / SEQ;
        const f32x4* xr = (const f32x4*)(C.in[0] + (size_t)row * D) + C.lane;
        f32x4 v[4]; float s = 0.f;
#pragma unroll
        for (int j = 0; j < 4; ++j) { v[j] = xr[64 * j]; s += (v[j].x * v[j].x + v[j].y * v[j].y) + (v[j].z * v[j].z + v[j].w * v[j].w); }
        const float rstd = 1.0f / sqrtf(wave_sum(s) * (1.0f / D) + EPS);
        const float* sh = mod + (size_t)b * 6 * D; const float* sc = sh + D;
        u32x2* o = (u32x2*)(h + (size_t)row * D) + C.lane;
#pragma unroll
        for (int j = 0; j < 4; ++j) { const int i0 = 4 * C.lane + 256 * j;
            const f32x4 gg = *(const f32x4*)(g + i0), s1 = *(const f32x4*)(sc + i0), s0 = *(const f32x4*)(sh + i0);
            f32x4 r; r.x = v[j].x * rstd * gg.x * (1.f + s1.x) + s0.x; r.y = v[j].y * rstd * gg.y * (1.f + s1.y) + s0.y;
            r.z = v[j].z * rstd * gg.z * (1.f + s1.z) + s0.z; r.w = v[j].w * rstd * gg.w * (1.f + s1.w) + s0.w;
            u32x2 w; w.x = pk2(r.x, r.y); w.y = pk2(r.z, r.w); o[64 * j] = w; }
    }
}

__device__ __forceinline__ void phase_norm2(Ctx& C) {
    const float* mod = (const float*)(C.ws + WS_MOD); bf16_t* h2 = (bf16_t*)(C.ws + WS_H); bf16_t* h2lo = (bf16_t*)(C.ws + WS_H2LO);
    const float* g = C.in[23];
    for (int row = C.gw; row < T; row += C.ngw) {
        const int b = row / SEQ;
        const f32x4* xr = (const f32x4*)(C.out + (size_t)row * D) + C.lane;
        f32x4 v[4]; float s = 0.f;
#pragma unroll
        for (int j = 0; j < 4; ++j) { v[j] = xr[64 * j]; s += (v[j].x * v[j].x + v[j].y * v[j].y) + (v[j].z * v[j].z + v[j].w * v[j].w); }
        const float rstd = 1.0f / sqrtf(wave_sum(s) * (1.0f / D) + EPS);
        const float* sh = mod + (size_t)b * 6 * D + 3 * D; const float* sc = sh + D;
        u32x2* o = (u32x2*)(h2 + (size_t)row * D) + C.lane; u32x2* ol = (u32x2*)(h2lo + (size_t)row * D) + C.lane;
#pragma unroll
        for (int j = 0; j < 4; ++j) { const int i0 = 4 * C.lane + 256 * j;
            const f32x4 gg = *(const f32x4*)(g + i0), s1 = *(const f32x4*)(sc + i0), s0 = *(const f32x4*)(sh + i0);
            f32x4 r; r.x = v[j].x * rstd * gg.x * (1.f + s1.x) + s0.x; r.y = v[j].y * rstd * gg.y * (1.f + s1.y) + s0.y;
            r.z = v[j].z * rstd * gg.z * (1.f + s1.z) + s0.z; r.w = v[j].w * rstd * gg.w * (1.f + s1.w) + s0.w;
            u32x2 w; w.x = pk2(r.x, r.y); w.y = pk2(r.z, r.w); o[64 * j] = w;
            f32x4 l; l.x = r.x - bflo(w.x); l.y = r.y - bfhi(w.x); l.z = r.z - bflo(w.y); l.w = r.w - bfhi(w.y);
            u32x2 wl; wl.x = pk2(l.x, l.y); wl.y = pk2(l.z, l.w); ol[64 * j] = wl; }
    }
}

__device__ __forceinline__ void phase_final(Ctx& C) {
    const float* mod = (const float*)(C.ws + WS_MOD); const bf16_t* slots = (const bf16_t*)(C.ws + WS_SLOTS);
    const float* g = C.in[30];
    for (int row = C.gw; row < T; row += C.ngw) {
        const int b = row / SEQ;
        f32x4* xr = (f32x4*)(C.out + (size_t)row * D) + C.lane;
        const float* g2 = mod + (size_t)b * 6 * D + 5 * D;
        f32x4 v[4]; float s = 0.f;
#pragma unroll
        for (int j = 0; j < 4; ++j) { const int i0 = 4 * C.lane + 256 * j;
            f32x4 m = {0.f, 0.f, 0.f, 0.f};
#pragma unroll
            for (int k = 0; k < 4; ++k) { const u32x2 w = *(const u32x2*)(slots + ((size_t)row * 4 + k) * D + i0);
                m.x += bflo(w.x); m.y += bfhi(w.x); m.z += bflo(w.y); m.w += bfhi(w.y); }
            const f32x4 gg = *(const f32x4*)(g2 + i0);
            v[j] = xr[64 * j]; v[j].x += gg.x * m.x; v[j].y += gg.y * m.y; v[j].z += gg.z * m.z; v[j].w += gg.w * m.w;
            s += (v[j].x * v[j].x + v[j].y * v[j].y) + (v[j].z * v[j].z + v[j].w * v[j].w); }
        const float rstd = 1.0f / sqrtf(wave_sum(s) * (1.0f / D) + EPS);
#pragma unroll
        for (int j = 0; j < 4; ++j) { const int i0 = 4 * C.lane + 256 * j; const f32x4 gg = *(const f32x4*)(g + i0);
            f32x4 r; r.x = v[j].x * rstd * gg.x; r.y = v[j].y * rstd * gg.y; r.z = v[j].z * rstd * gg.z; r.w = v[j].w * rstd * gg.w; xr[64 * j] = r; }
    }
}

template <class RowFn, class ColFn>
__device__ __forceinline__ void gemm_tile64(f32x4 (&acc)[4][4], const bf16_t* A, size_t lda, RowFn rowfn, const bf16_t* Bt, size_t ldb, ColFn colfn, int kbeg, int kend, int lane) {
    const int fr = lane & 15, fq = lane >> 4;
    const bf16_t* ap[4]; const bf16_t* bp[4];
#pragma unroll
    for (int m = 0; m < 4; ++m) ap[m] = A + (size_t)rowfn(m * 16 + fr) * lda + fq * 8;
#pragma unroll
    for (int n = 0; n < 4; ++n) bp[n] = Bt + (size_t)(colfn(n) + fr) * ldb + fq * 8;
    for (int k = kbeg; k < kend; k += 32) {
        bf16x8 a[4], b[4];
#pragma unroll
        for (int m = 0; m < 4; ++m) a[m] = *(const bf16x8*)(ap[m] + k);
#pragma unroll
        for (int n = 0; n < 4; ++n) b[n] = *(const bf16x8*)(bp[n] + k);
#pragma unroll
        for (int m = 0; m < 4; ++m)
#pragma unroll
            for (int n = 0; n < 4; ++n) acc[m][n] = __builtin_amdgcn_mfma_f32_16x16x32_bf16(b[n], a[m], acc[m][n], 0, 0, 0);
    }
}
__device__ __forceinline__ void zero_acc(f32x4 (&acc)[4][4]) {
#pragma unroll
    for (int m = 0; m < 4; ++m)
#pragma unroll
        for (int n = 0; n < 4; ++n) acc[m][n] = (f32x4){0.f, 0.f, 0.f, 0.f};
}


namespace pg8 {
#define PG8_LAS __attribute__((address_space(3)))
constexpr int BM = 256, BK = 64, HALF = 128, HTB = HALF * BK * 2, STAGE_BYTES = 8 * HTB, NXCD = 8, WGM = 8;
__device__ __forceinline__ int lds_byte(int r, int c) { const int st = (r >> 4) * 2 + (c >> 5), rr = r & 15, cc = c & 31, ob = rr * 64 + cc * 2; return st * 1024 + (ob ^ (((ob >> 9) & 1) << 5)); }
__device__ __forceinline__ void stage_rc(int b, int& R, int& C) { const int st = b / 1024, sb = b % 1024, swz = sb ^ (((sb >> 9) & 1) << 5); R = (st >> 1) * 16 + swz / 64; C = (st & 1) * 32 + (swz % 64) / 2; }
__device__ __forceinline__ int perm32(int rho) { const int n = rho >> 4, i = rho & 15; return 8 * (i >> 2) + 4 * n + (i & 3); }
struct Unit { int pm, pn; };
struct Gemm { const bf16_t* A; const bf16_t* Bt; int lda, ldb, K; const int* rowidx; };
struct StaticOrder {
    int nM, nN, nwg, G, c;
    __device__ void init(int nM_, int nN_, int G_, int c_) { nM = nM_; nN = nN_; nwg = nM * nN; G = G_; c = c_; }
    __device__ bool next(int i, Unit& u) const {
        const long L = (long)i * G + c; if (L >= nwg) return false;
        int wgid = (int)L; { const int q = nwg / NXCD, r = nwg % NXCD, xcd = wgid % NXCD, off = wgid / NXCD; wgid = (xcd < r ? xcd * (q + 1) : r * (q + 1) + (xcd - r) * q) + off; }
        const int nig = WGM * nN, gid = wgid / nig, fm = gid * WGM, gsz = (nM - fm) < WGM ? (nM - fm) : WGM;
        u.pm = fm + ((wgid % nig) % gsz); u.pn = (wgid % nig) / gsz; return true;
    }
};
struct MoeOrder {
    StaticOrder b; const int* tileexp; int nN;
    __device__ bool next(int i, Unit& u) const { if (!b.next(i, u)) return false; u.pn = tileexp[u.pm] * nN + u.pn; return true; }
};
__device__ __forceinline__ unsigned cvt_pk_bf16(float lo, float hi) { unsigned r; asm volatile("v_cvt_pk_bf16_f32 %0, %1, %2" : "=v"(r) : "v"(lo), "v"(hi)); return r; }

template <class Epi, class Sched, bool GATHER>
__device__ __forceinline__ void gemm_phase(PG8_LAS unsigned char* lds, const Gemm g, const Sched& S, const Epi& E) {
    const int tid = threadIdx.x, wid = __builtin_amdgcn_readfirstlane(tid >> 6), lane = tid & 63, wr = wid >> 2, wc = wid & 3, fr = lane & 15, fq = lane >> 4;
    const int K = g.K, nt = K / BK;
    int RA[2]; unsigned cA2[2], voffB[2];
#pragma unroll
    for (int i = 0; i < 2; ++i) { int R, C; stage_rc(tid * 16 + i * 8192, R, C); const int Rb = Epi::PERM ? ((R & ~31) + perm32(R & 31)) : R;
        RA[i] = R; cA2[i] = (unsigned)C * 2u; voffB[i] = (unsigned)(Rb * g.ldb + C) * 2u; }
    const unsigned lda2 = (unsigned)g.lda * 2u;
    const size_t kstep = (size_t)(BK * 2);
    const size_t hstep = (size_t)HALF * g.ldb * 2;
    const size_t tstep = 2 * hstep;
    const unsigned ldsw = (unsigned)wid * 1024u;
    const int aoff = lds_byte(wr * 64 + fr, fq * 8), boff = lds_byte(wc * 32 + fr, fq * 8);
#define PG8_SA(b, h) (((b) * 2 + (h)) * HTB)
#define PG8_SB(b, h) ((4 + (b) * 2 + (h)) * HTB)
#define PG8_STAGE(bufoff, gbase, voff) do { _Pragma("unroll") for (int _i = 0; _i < 2; ++_i) \
        __builtin_amdgcn_global_load_lds((const unsigned*)((const char*)(gbase) + (voff)[_i]), (PG8_LAS unsigned*)(lds + (bufoff) + ldsw + _i * 8192), 16, 0, 0); } while (0)
#define PG8_AOFFS(dst, u_) do { _Pragma("unroll") for (int _h = 0; _h < 2; ++_h) _Pragma("unroll") for (int _i = 0; _i < 2; ++_i) { \
        int _row = (u_).pm * BM + _h * HALF + RA[_i]; if (GATHER) { const int _p = g.rowidx[_row]; _row = _p >= 0 ? (_p >> 2) : 0; } \
        dst[_h][_i] = (unsigned)_row * lda2 + cA2[_i]; } } while (0)
#define PG8_LDA(dst, b, h) do { _Pragma("unroll") for (int m = 0; m < 4; ++m) _Pragma("unroll") for (int k = 0; k < 2; ++k) dst[m][k] = *(const PG8_LAS bf16x8*)(lds + PG8_SA(b, h) + aoff + m * 2048 + k * 1024); } while (0)
#define PG8_LDB(dst, b, h) do { _Pragma("unroll") for (int n = 0; n < 2; ++n) _Pragma("unroll") for (int k = 0; k < 2; ++k) dst[n][k] = *(const PG8_LAS bf16x8*)(lds + PG8_SB(b, h) + boff + n * 2048 + k * 1024); } while (0)
#define PG8_MMA(ai, bj, At, Bt) do { __builtin_amdgcn_s_setprio(1); _Pragma("unroll") for (int m = 0; m < 4; ++m) _Pragma("unroll") for (int n = 0; n < 2; ++n) _Pragma("unroll") for (int k = 0; k < 2; ++k) \
        acc[ai][bj][m][n] = __builtin_amdgcn_mfma_f32_16x16x32_bf16(Bt[n][k], At[m][k], acc[ai][bj][m][n], 0, 0, 0); __builtin_amdgcn_s_setprio(0); } while (0)
#define PG8_WAIT_V(n) asm volatile("s_waitcnt vmcnt(" #n ")" ::: "memory")
#define PG8_WAIT_L(n) asm volatile("s_waitcnt lgkmcnt(" #n ")" ::: "memory")
#define PG8_BAR __builtin_amdgcn_s_barrier()
#define PG8_SCHED __builtin_amdgcn_sched_barrier(0)
    Unit cur, nxt; int ui = 0;
    if (!S.next(0, cur)) return;
    f32x4 acc[2][2][4][2];
#pragma unroll
    for (int a = 0; a < 2; ++a)
#pragma unroll
        for (int b = 0; b < 2; ++b)
#pragma unroll
            for (int m = 0; m < 4; ++m)
#pragma unroll
                for (int n = 0; n < 2; ++n) acc[a][b][m][n] = (f32x4){0.f, 0.f, 0.f, 0.f};
    bf16x8 At[4][2], B0[2][2], B1[2][2];
    unsigned cv[2][2], nv[2][2];
    PG8_AOFFS(cv, cur);
    const char* const Ab = (const char*)g.A;
    const char* cB = (const char*)g.Bt + (size_t)cur.pn * tstep;
    PG8_STAGE(PG8_SB(0, 0), cB, voffB); PG8_STAGE(PG8_SB(0, 1), cB + hstep, voffB); PG8_STAGE(PG8_SA(0, 0), Ab, cv[0]); PG8_STAGE(PG8_SA(0, 1), Ab, cv[1]);
    if (wr == 1) PG8_BAR;
    PG8_WAIT_V(2); PG8_BAR;
    PG8_STAGE(PG8_SB(1, 0), cB + kstep, voffB); PG8_STAGE(PG8_SA(1, 0), Ab + kstep, cv[0]); PG8_STAGE(PG8_SB(1, 1), cB + hstep + kstep, voffB);
    PG8_WAIT_V(6); PG8_BAR;
    for (;;) {
        const bool has_next = S.next(ui + 1, nxt);
        if (has_next) { PG8_AOFFS(nv, nxt); } else {
#pragma unroll
            for (int h = 0; h < 2; ++h)
#pragma unroll
                for (int i = 0; i < 2; ++i) nv[h][i] = cv[h][i]; }
        const char* nB = has_next ? (const char*)g.Bt + (size_t)nxt.pn * tstep : cB;
        for (int t = 0; t < nt; t += 2) {
            const bool last = (t == nt - 2);
            const char* a1 = Ab + (size_t)(t + 1) * kstep;
            const char* a2 = last ? Ab : Ab + (size_t)(t + 2) * kstep; const char* b2 = last ? nB : cB + (size_t)(t + 2) * kstep;
            const char* a3 = a2 + kstep; const char* b3 = b2 + kstep;
            unsigned sv[2][2];
#pragma unroll
            for (int h = 0; h < 2; ++h)
#pragma unroll
                for (int i = 0; i < 2; ++i) sv[h][i] = last ? nv[h][i] : cv[h][i];
            PG8_LDB(B0, 0, 0); PG8_LDB(B1, 0, 1); PG8_SCHED; PG8_LDA(At, 0, 0); PG8_STAGE(PG8_SA(1, 1), a1, cv[1]);
            PG8_WAIT_V(8); PG8_WAIT_L(0); PG8_BAR; PG8_MMA(0, 0, At, B0); PG8_MMA(0, 1, At, B1); PG8_BAR; PG8_SCHED;
            PG8_LDA(At, 0, 1); PG8_STAGE(PG8_SB(0, 0), b2, voffB); PG8_STAGE(PG8_SB(0, 1), b2 + hstep, voffB); PG8_STAGE(PG8_SA(0, 0), a2, sv[0]);
            PG8_WAIT_V(8); PG8_WAIT_L(0); PG8_BAR; PG8_MMA(1, 0, At, B0); PG8_MMA(1, 1, At, B1); PG8_BAR; PG8_SCHED;
            PG8_LDB(B0, 1, 0); PG8_LDB(B1, 1, 1); PG8_SCHED; PG8_LDA(At, 1, 0); PG8_STAGE(PG8_SA(0, 1), a2, sv[1]);
            PG8_WAIT_V(8); PG8_WAIT_L(0); PG8_BAR; PG8_MMA(0, 0, At, B0); PG8_MMA(0, 1, At, B1); PG8_BAR; PG8_SCHED;
            PG8_LDA(At, 1, 1); PG8_STAGE(PG8_SB(1, 0), b3, voffB); PG8_STAGE(PG8_SB(1, 1), b3 + hstep, voffB); PG8_STAGE(PG8_SA(1, 0), a3, sv[0]);
            PG8_WAIT_V(8); PG8_WAIT_L(0); PG8_BAR; PG8_MMA(1, 0, At, B0); PG8_MMA(1, 1, At, B1); PG8_BAR; PG8_SCHED;
        }
        if (wr == 0) PG8_BAR;
        E(acc, cur, wr, wc, fr, fq);
        if (!has_next) break;
#pragma unroll
        for (int a = 0; a < 2; ++a)
#pragma unroll
            for (int b = 0; b < 2; ++b)
#pragma unroll
                for (int m = 0; m < 4; ++m)
#pragma unroll
                    for (int n = 0; n < 2; ++n) acc[a][b][m][n] = (f32x4){0.f, 0.f, 0.f, 0.f};
        cur = nxt; cB = nB; ++ui;
#pragma unroll
        for (int h = 0; h < 2; ++h)
#pragma unroll
            for (int i = 0; i < 2; ++i) cv[h][i] = nv[h][i];
        if (wr == 1) PG8_BAR;
    }
    PG8_WAIT_V(0);
    PG8_BAR;
#undef PG8_SA
#undef PG8_SB
#undef PG8_STAGE
#undef PG8_AOFFS
#undef PG8_LDA
#undef PG8_LDB
#undef PG8_MMA
#undef PG8_WAIT_V
#undef PG8_WAIT_L
#undef PG8_BAR
#undef PG8_SCHED
}

__device__ __forceinline__ u32x4 pack8(const f32x4& v0, const f32x4& v1) { u32x4 w; w.x = cvt_pk_bf16(v0[0], v0[1]); w.y = cvt_pk_bf16(v0[2], v0[3]); w.z = cvt_pk_bf16(v1[0], v1[1]); w.w = cvt_pk_bf16(v1[2], v1[3]); return w; }
__device__ __forceinline__ void unpack8(const u32x4& w, f32x4& v0, f32x4& v1) { v0 = (f32x4){bflo(w.x), bfhi(w.x), bflo(w.y), bfhi(w.y)}; v1 = (f32x4){bflo(w.z), bfhi(w.z), bflo(w.w), bfhi(w.w)}; }
__device__ __forceinline__ float fsig(float x) { return __builtin_amdgcn_rcpf(1.0f + __builtin_amdgcn_exp2f(-LOG2E * x)); }

struct EpiInproj {
    static constexpr bool PERM = true;
    bf16_t* U; const float* bias;
    __device__ __forceinline__ void operator()(const f32x4 (&acc)[2][2][4][2], const Unit& u, int wr, int wc, int fr, int fq) const {
        const int row0 = u.pm * BM + wr * 64 + fr, col0 = u.pn * BM + wc * 32 + 8 * fq; const bool sig = u.pn >= 12; const float qs = (u.pn == 6 || u.pn == 7) ? QSCALE : 1.0f;
        f32x4 bv[2][2];
#pragma unroll
        for (int bj = 0; bj < 2; ++bj)
#pragma unroll
            for (int n = 0; n < 2; ++n) bv[bj][n] = *(const f32x4*)(bias + col0 + bj * HALF + 4 * n);
#pragma unroll
        for (int ai = 0; ai < 2; ++ai)
#pragma unroll
            for (int m = 0; m < 4; ++m) { bf16_t* rowp = U + (size_t)(row0 + ai * HALF + m * 16) * INC + col0;
#pragma unroll
                for (int bj = 0; bj < 2; ++bj) { f32x4 v0 = (acc[ai][bj][m][0] + bv[bj][0]) * qs, v1 = (acc[ai][bj][m][1] + bv[bj][1]) * qs;
                    if (sig) {
#pragma unroll
                        for (int i = 0; i < 4; ++i) { v0[i] = fsig(v0[i]); v1[i] = fsig(v1[i]); } }
                    *(u32x4*)(rowp + bj * HALF) = pack8(v0, v1); } }
    }
};
template <int P> struct EpiCat {
    static constexpr bool PERM = true;
    bf16_t* Mg; const bf16_t* U;
    __device__ __forceinline__ void operator()(const f32x4 (&acc)[2][2][4][2], const Unit& u, int wr, int wc, int fr, int fq) const {
        const int row0 = u.pm * BM + wr * 64 + fr, col0 = u.pn * BM + wc * 32 + 8 * fq;
#pragma unroll
        for (int ai = 0; ai < 2; ++ai)
#pragma unroll
            for (int m = 0; m < 4; ++m) { const size_t row = (size_t)(row0 + ai * HALF + m * 16);
#pragma unroll
                for (int bj = 0; bj < 2; ++bj) { const u32x4 gw = *(const u32x4*)(U + row * INC + GOFF + P * D + col0 + bj * HALF);
                    f32x4 g0, g1; unpack8(gw, g0, g1); f32x4 v0 = acc[ai][bj][m][0] * g0, v1 = acc[ai][bj][m][1] * g1;
                    bf16_t* mp = Mg + row * D + col0 + bj * HALF;
                    if (P == 1) { const u32x4 tw = *(const u32x4*)mp; f32x4 t0, t1; unpack8(tw, t0, t1); v0 += t0; v1 += t1; }
                    *(u32x4*)mp = pack8(v0, v1); } }
    }
};
struct EpiMix {
    static constexpr bool PERM = false;
    const float* X; float* O; const float* mod;
    __device__ __forceinline__ void operator()(const f32x4 (&acc)[2][2][4][2], const Unit& u, int wr, int wc, int fr, int fq) const {
        const int row0 = u.pm * BM + wr * 64 + fr, col0 = u.pn * BM + wc * 32 + 4 * fq; const int b = (u.pm * BM) / SEQ;
        f32x4 gv[2][2];
#pragma unroll
        for (int bj = 0; bj < 2; ++bj)
#pragma unroll
            for (int n = 0; n < 2; ++n) gv[bj][n] = *(const f32x4*)(mod + (size_t)b * 6 * D + 2 * D + col0 + bj * HALF + n * 16);
#pragma unroll
        for (int ai = 0; ai < 2; ++ai)
#pragma unroll
            for (int m = 0; m < 4; ++m) { const size_t off = (size_t)(row0 + ai * HALF + m * 16) * D + col0;
#pragma unroll
                for (int bj = 0; bj < 2; ++bj)
#pragma unroll
                    for (int n = 0; n < 2; ++n) *(f32x4*)(O + off + bj * HALF + n * 16) = *(const f32x4*)(X + off + bj * HALF + n * 16) + gv[bj][n] * acc[ai][bj][m][n]; }
    }
};
struct EpiGateUp {
    static constexpr bool PERM = true;
    bf16_t* Act; const float* bgu;
    __device__ __forceinline__ void operator()(const f32x4 (&acc)[2][2][4][2], const Unit& u, int wr, int wc, int fr, int fq) const {
        const int e = u.pn >> 3, j = u.pn & 7; const int row0 = u.pm * BM + wr * 64 + fr, col0 = 128 * j + wc * 32 + 8 * fq;
        f32x4 bg[2], bu[2];
#pragma unroll
        for (int n = 0; n < 2; ++n) { bg[n] = *(const f32x4*)(bgu + (size_t)e * 2 * D + col0 + 4 * n); bu[n] = *(const f32x4*)(bgu + (size_t)e * 2 * D + D + col0 + 4 * n); }
#pragma unroll
        for (int ai = 0; ai < 2; ++ai)
#pragma unroll
            for (int m = 0; m < 4; ++m) { f32x4 r[2];
#pragma unroll
                for (int n = 0; n < 2; ++n) { const f32x4 gt = acc[ai][0][m][n] + bg[n], up = acc[ai][1][m][n] + bu[n];
#pragma unroll
                    for (int i = 0; i < 4; ++i) { const float gg = fminf(gt[i], 7.0f), uu = fminf(fmaxf(up[i], -7.0f), 7.0f); r[n][i] = (uu + 1.0f) * (gg * fsig(1.702f * gg)); } }
                *(u32x4*)(Act + (size_t)(row0 + ai * HALF + m * 16) * D + col0) = pack8(r[0], r[1]); }
    }
};
struct EpiDown {
    static constexpr bool PERM = true;
    bf16_t* Slots; const float* bd; const int* rowpair; const float* topw;
    __device__ __forceinline__ void operator()(const f32x4 (&acc)[2][2][4][2], const Unit& u, int wr, int wc, int fr, int fq) const {
        const int e = u.pn >> 2, j = u.pn & 3; const int row0 = u.pm * BM + wr * 64 + fr, col0 = 256 * j + wc * 32 + 8 * fq;
        f32x4 bv[2][2];
#pragma unroll
        for (int bj = 0; bj < 2; ++bj)
#pragma unroll
            for (int n = 0; n < 2; ++n) bv[bj][n] = *(const f32x4*)(bd + (size_t)e * D + col0 + bj * HALF + 4 * n);
#pragma unroll
        for (int ai = 0; ai < 2; ++ai)
#pragma unroll
            for (int m = 0; m < 4; ++m) { const int p = rowpair[row0 + ai * HALF + m * 16];
                if (p >= 0) { const float w = topw[p];
#pragma unroll
                    for (int bj = 0; bj < 2; ++bj) { const f32x4 v0 = (acc[ai][bj][m][0] + bv[bj][0]) * w, v1 = (acc[ai][bj][m][1] + bv[bj][1]) * w;
                        *(u32x4*)(Slots + (size_t)p * D + col0 + bj * HALF) = pack8(v0, v1); } } }
    }
};
}

__device__ __forceinline__ void phase_inproj(Ctx& C) {
    const bf16_t* h = (const bf16_t*)(C.ws + WS_H); const bf16_t* win = (const bf16_t*)(C.ws + WS_WIN); bf16_t* u = (bf16_t*)(C.ws + WS_U);
    const float* bin = C.in[6];
    constexpr int NT = INC / 64, MT = T / 64;
    const int fr = C.lane & 15, fq = C.lane >> 4;
    for (int tile = C.gw; tile < MT * NT; tile += C.ngw) {
        const int mt = tile / NT, nt = tile % NT;
        f32x4 acc[4][4]; zero_acc(acc);
        gemm_tile64(acc, h, D, [&](int r) { return mt * 64 + r; }, win, D, [&](int n) { return nt * 64 + n * 16; }, 0, D, C.lane);
#pragma unroll
        for (int m = 0; m < 4; ++m)
#pragma unroll
            for (int n = 0; n < 4; ++n) { const int row = mt * 64 + m * 16 + fr, col = nt * 64 + n * 16 + 4 * fq;
                f32x4 v = acc[m][n] + *(const f32x4*)(bin + col);
                if (col >= QOFF && col < KOFF) v = v * QSCALE;
                if (col >= GOFF) { v.x = sigmoidf_(v.x); v.y = sigmoidf_(v.y); v.z = sigmoidf_(v.z); v.w = sigmoidf_(v.w); }
                u32x2 w; w.x = pk2(v.x, v.y); w.y = pk2(v.z, v.w); *(u32x2*)(u + (size_t)row * INC + col) = w; }
    }
}

__device__ __forceinline__ void phase_cat(Ctx& C) {
    const bf16_t* ycat = (const bf16_t*)(C.ws + WS_YCAT); const bf16_t* wcat = (const bf16_t*)(C.ws + WS_WCAT); const bf16_t* u = (const bf16_t*)(C.ws + WS_U);
    bf16_t* merged = (bf16_t*)(C.ws + WS_MERGED);
    constexpr int NT = D / 64, MT = T / 64;
    const int fr = C.lane & 15, fq = C.lane >> 4;
    for (int tile = C.gw; tile < MT * NT; tile += C.ngw) {
        const int mt = tile / NT, nt = tile % NT;
        f32x4 a1[4][4], a2[4][4]; zero_acc(a1); zero_acc(a2);
        gemm_tile64(a1, ycat, D, [&](int r) { return mt * 64 + r; }, wcat, D, [&](int n) { return nt * 64 + n * 16; }, 0, 512, C.lane);
        gemm_tile64(a2, ycat, D, [&](int r) { return mt * 64 + r; }, wcat, D, [&](int n) { return nt * 64 + n * 16; }, 512, 1024, C.lane);
#pragma unroll
        for (int m = 0; m < 4; ++m)
#pragma unroll
            for (int n = 0; n < 4; ++n) { const int row = mt * 64 + m * 16 + fr, col = nt * 64 + n * 16 + 4 * fq;
                const u32x2 g1 = *(const u32x2*)(u + (size_t)row * INC + GOFF + col), g2 = *(const u32x2*)(u + (size_t)row * INC + GOFF + D + col);
                f32x4 v; v.x = bflo(g1.x) * a1[m][n].x + bflo(g2.x) * a2[m][n].x; v.y = bfhi(g1.x) * a1[m][n].y + bfhi(g2.x) * a2[m][n].y;
                v.z = bflo(g1.y) * a1[m][n].z + bflo(g2.y) * a2[m][n].z; v.w = bfhi(g1.y) * a1[m][n].w + bfhi(g2.y) * a2[m][n].w;
                u32x2 w; w.x = pk2(v.x, v.y); w.y = pk2(v.z, v.w); *(u32x2*)(merged + (size_t)row * D + col) = w; }
    }
}

__device__ __forceinline__ void phase_mix(Ctx& C) {
    const bf16_t* merged = (const bf16_t*)(C.ws + WS_MERGED); const bf16_t* wmix = (const bf16_t*)(C.ws + WS_WMIX); const float* mod = (const float*)(C.ws + WS_MOD);
    constexpr int NT = D / 64, MT = T / 64;
    const int fr = C.lane & 15, fq = C.lane >> 4;
    for (int tile = C.gw; tile < MT * NT; tile += C.ngw) {
        const int mt = tile / NT, nt = tile % NT;
        f32x4 acc[4][4]; zero_acc(acc);
        gemm_tile64(acc, merged, D, [&](int r) { return mt * 64 + r; }, wmix, D, [&](int n) { return nt * 64 + n * 16; }, 0, D, C.lane);
        const int b = (mt * 64) / SEQ;
#pragma unroll
        for (int m = 0; m < 4; ++m)
#pragma unroll
            for (int n = 0; n < 4; ++n) { const int row = mt * 64 + m * 16 + fr, col = nt * 64 + n * 16 + 4 * fq;
                const f32x4 g = *(const f32x4*)(mod + (size_t)b * 6 * D + 2 * D + col), xv = *(const f32x4*)(C.in[0] + (size_t)row * D + col);
                *(f32x4*)(C.out + (size_t)row * D + col) = xv + g * acc[m][n]; }
    }
}

__device__ __forceinline__ void phase_hy_pre(Ctx& C) {
    const bf16_t* u = (const bf16_t*)(C.ws + WS_U); bf16_t* vp = (bf16_t*)(C.ws + WS_VP); bf16_t* x0c = (bf16_t*)(C.ws + WS_X0C); bf16_t* vt = (bf16_t*)(C.ws + WS_VT);
    const float* cw = C.in[7]; const float* cb = C.in[8];
    const size_t total = (size_t)T * HW;
    for (size_t i = (size_t)C.blk * NTHREADS + C.tid; i < total; i += (size_t)C.nblk * NTHREADS) {
        const int c = (int)(i % HW); const int row = (int)(i / HW); const int t = row % SEQ;
        float r[3];
#pragma unroll
        for (int s = 0; s < 3; ++s) { const int ch = s * HW + c;
            const float um = (t > 0) ? bf2f(u[(size_t)(row - 1) * INC + ch]) : 0.f, u0 = bf2f(u[(size_t)row * INC + ch]), up = (t < SEQ - 1) ? bf2f(u[(size_t)(row + 1) * INC + ch]) : 0.f;
            r[s] = um * cw[ch] + u0 * cw[3 * HW + ch] + up * cw[2 * 3 * HW + ch] + cb[ch]; }
        x0c[i] = (bf16_t)f2bf(r[0]); vp[i] = (bf16_t)f2bf(r[2] * r[1]);
    }
    for (size_t i = (size_t)C.blk * NTHREADS + C.tid; i < total; i += (size_t)C.nblk * NTHREADS) {
        const int t = (int)(i % SEQ); const int e = (int)((i / SEQ) % 128); const int hh = (int)((i / ((size_t)SEQ * 128)) % 4); const int b = (int)(i / ((size_t)SEQ * 512));
        vt[i] = u[(size_t)(b * SEQ + t) * INC + VOFF + hh * 128 + e];
    }
}

__device__ __forceinline__ void phase_hy_conv(Ctx& C) {
    const bf16_t* vp = (const bf16_t*)(C.ws + WS_VP); const bf16_t* x0c = (const bf16_t*)(C.ws + WS_X0C); const float* kf = (const float*)(C.ws + WS_KFILT);
    bf16_t* ycat = (bf16_t*)(C.ws + WS_YCAT); const float* dsk = C.in[17];
    const size_t total = (size_t)NB * (SEQ / 4) * HW;
    for (size_t i = (size_t)C.blk * NTHREADS + C.tid; i < total; i += (size_t)C.nblk * NTHREADS) {
        const int c = (int)(i % HW); const int tb = (int)((i / HW) % (SEQ / 4)); const int b = (int)(i / ((size_t)HW * (SEQ / 4)));
        const int t0 = tb * 4;
        float a0 = 0.f, a1 = 0.f, a2 = 0.f, a3 = 0.f;
        float k0 = kf[(size_t)(2048 + t0) * HW + c], k1 = kf[(size_t)(2048 + t0 + 1) * HW + c], k2 = kf[(size_t)(2048 + t0 + 2) * HW + c], k3 = kf[(size_t)(2048 + t0 + 3) * HW + c];
        const bf16_t* vb = vp + (size_t)b * SEQ * HW + c;
        for (int s = 0; s < SEQ; ++s) {
            const float v = bf2f(vb[(size_t)s * HW]);
            a0 = fmaf(v, k0, a0); a1 = fmaf(v, k1, a1); a2 = fmaf(v, k2, a2); a3 = fmaf(v, k3, a3);
            k3 = k2; k2 = k1; k1 = k0;
            const int idx = 2048 + t0 - s - 1;
            k0 = (idx >= 1) ? kf[(size_t)idx * HW + c] : 0.f;
        }
        const float dd = dsk[c];
        float acc[4] = {a0, a1, a2, a3};
#pragma unroll
        for (int q = 0; q < 4; ++q) { const size_t row = (size_t)b * SEQ + t0 + q; const float v = bf2f(vp[row * HW + c]);
            ycat[row * D + c] = (bf16_t)f2bf((acc[q] + v * dd) * bf2f(x0c[row * HW + c])); }
    }
}

__device__ __forceinline__ void phase_attn(Ctx& C) {
    const bf16_t* u = (const bf16_t*)(C.ws + WS_U); const bf16_t* vt = (const bf16_t*)(C.ws + WS_VT); bf16_t* ycat = (bf16_t*)(C.ws + WS_YCAT);
    const int lane = C.lane, l31 = lane & 31, hi = lane >> 5;
    const float* lq = C.in[18];
    const float d1 = wave_sum(lq[lane] * lq[64 + lane]), d2 = wave_sum(lq[128 + lane] * lq[192 + lane]);
    const float lam_init = 0.2f;
    const float lam = expf(d1) - expf(d2) + lam_init;
    const float* sg = C.in[19];
    constexpr int NU = NB * 4 * (SEQ / 32);
    for (int unit = C.gw; unit < NU; unit += C.ngw) {
        const int qt = unit % (SEQ / 32); const int hh = (unit / (SEQ / 32)) % 4; const int b = unit / ((SEQ / 32) * 4);
        const int q0 = qt * 32;
        const float slope2 = exp2f(-2.0f * (float)(hh + 1)) * LOG2E;
        const bf16_t* qrow = u + (size_t)(b * SEQ + q0 + l31) * INC + QOFF + hh * 128;
        const bf16_t* kbase = u + (size_t)(b * SEQ) * INC + KOFF + hh * 128;
        const bf16_t* vbase = vt + (size_t)((b * 4 + hh) * 128) * SEQ;
        const float qpos = (float)(q0 + l31);
        float* o1s = (float*)(C.lds + C.wave * 16384) + lane;
#pragma unroll 1
        for (int c = 0; c < 2; ++c) {
            bf16x8 qf[4];
#pragma unroll
            for (int ks = 0; ks < 4; ++ks) qf[ks] = *(const bf16x8*)(qrow + c * 64 + 16 * ks + 8 * hi);
            f32x16 o[4];
#pragma unroll
            for (int eb = 0; eb < 4; ++eb)
#pragma unroll
                for (int r = 0; r < 16; ++r) o[eb][r] = 0.f;
            float mrun = -1e30f, lsum = 0.f;
            for (int kv0 = 0; kv0 < SEQ; kv0 += 32) {
                f32x16 s;
#pragma unroll
                for (int r = 0; r < 16; ++r) s[r] = 0.f;
                const bf16_t* krow = kbase + (size_t)(kv0 + l31) * INC + c * 64 + 8 * hi;
#pragma unroll
                for (int ks = 0; ks < 4; ++ks) { const bf16x8 kf = *(const bf16x8*)(krow + 16 * ks); s = __builtin_amdgcn_mfma_f32_32x32x16_bf16(kf, qf[ks], s, 0, 0, 0); }
                float mt = -1e30f;
#pragma unroll
                for (int r = 0; r < 16; ++r) { const float kvpos = (float)(kv0 + crow(r, 0)) + 4.0f * (float)hi; s[r] = s[r] - slope2 * fabsf(qpos - kvpos); mt = fmaxf(mt, s[r]); }
                mt = fmaxf(mt, __shfl_xor(mt, 32));
                const float mnew = fmaxf(mrun, mt); const float alpha = exp2f(mrun - mnew); mrun = mnew;
                float ps = 0.f;
#pragma unroll
                for (int r = 0; r < 16; ++r) { s[r] = exp2f(s[r] - mnew); ps += s[r]; }
                lsum = lsum * alpha + ps;
#pragma unroll
                for (int eb = 0; eb < 4; ++eb)
#pragma unroll
                    for (int r = 0; r < 16; ++r) o[eb][r] *= alpha;
                bf16x8 pf[2];
#pragma unroll
                for (int s2 = 0; s2 < 2; ++s2) { u32x4 w; w.x = pk2(s[8 * s2 + 0], s[8 * s2 + 1]); w.y = pk2(s[8 * s2 + 2], s[8 * s2 + 3]); w.z = pk2(s[8 * s2 + 4], s[8 * s2 + 5]); w.w = pk2(s[8 * s2 + 6], s[8 * s2 + 7]); pf[s2] = __builtin_bit_cast(bf16x8, w); }
#pragma unroll
                for (int eb = 0; eb < 4; ++eb) {
                    const bf16_t* vr = vbase + (size_t)(32 * eb + l31) * SEQ + kv0 + 4 * hi;
#pragma unroll
                    for (int s2 = 0; s2 < 2; ++s2) {
                        const s16x4 lo = *(const s16x4*)(vr + 16 * s2), hi4 = *(const s16x4*)(vr + 16 * s2 + 8);
                        const bf16x8 vf = (bf16x8){lo[0], lo[1], lo[2], lo[3], hi4[0], hi4[1], hi4[2], hi4[3]};
                        o[eb] = __builtin_amdgcn_mfma_f32_32x32x16_bf16(vf, pf[s2], o[eb], 0, 0, 0);
                    }
                }
            }
            lsum += __shfl_xor(lsum, 32);
            const float inv = 1.0f / lsum;
            if (c == 0) {
#pragma unroll
                for (int eb = 0; eb < 4; ++eb)
#pragma unroll
                    for (int r = 0; r < 16; ++r) o1s[(eb * 16 + r) * 64] = o[eb][r] * inv;
            } else {
                float ss = 0.f;
                f32x16 o1[4];
#pragma unroll
                for (int eb = 0; eb < 4; ++eb)
#pragma unroll
                    for (int r = 0; r < 16; ++r) { const float y = o1s[(eb * 16 + r) * 64] - lam * (o[eb][r] * inv); o1[eb][r] = y; ss += y * y; }
                ss += __shfl_xor(ss, 32);
                const float rinv = 1.0f / sqrtf(ss * (1.0f / 128.0f) + EPS) * (1.0f - lam_init);
                bf16_t* orow = ycat + (size_t)(b * SEQ + q0 + l31) * D + 512 + hh * 128;
#pragma unroll
                for (int eb = 0; eb < 4; ++eb)
#pragma unroll
                    for (int r = 0; r < 16; ++r) { const int e = 32 * eb + crow(r, 0) + 4 * hi; orow[e] = (bf16_t)f2bf(o1[eb][r] * rinv * sg[e]); }
            }
        }
    }
}


#define LASP __attribute__((address_space(3)))
__device__ __forceinline__ void glds16(const void* gsrc, unsigned lds_dst) { unsigned keep;
    asm volatile("s_mov_b32 %0, m0\n\ts_mov_b32 m0, %2\n\ts_nop 0\n\tglobal_load_lds_dwordx4 %1, off\n\ts_mov_b32 m0, %0" : "=&s"(keep) : "v"(gsrc), "s"(lds_dst) : "memory"); }
typedef short v4i16_t __attribute__((ext_vector_type(4)));
__device__ __forceinline__ s16x4 vtr(const LASP char* p) { return __builtin_bit_cast(s16x4, __builtin_amdgcn_ds_read_tr16_b64_v4i16((LASP v4i16_t*)p)); }
__device__ __forceinline__ unsigned cvtpk(float lo, float hi) { unsigned r; asm volatile("v_cvt_pk_bf16_f32 %0, %1, %2" : "=v"(r) : "v"(lo), "v"(hi)); return r; }

__device__ __forceinline__ void phase_attn_fast(Ctx& C) {
    const bf16_t* u = (const bf16_t*)(C.ws + WS_U); bf16_t* ycat = (bf16_t*)(C.ws + WS_YCAT);
    const int lane = C.lane, l31 = lane & 31, hi = lane >> 5, wave = C.wave;
    float* park = (float*)(C.ws + WS_H2LO) + (size_t)C.gw * 4096 + lane;
    const float* lq = C.in[18];
    const float d1 = wave_sum(lq[lane] * lq[64 + lane]), d2 = wave_sum(lq[128 + lane] * lq[192 + lane]);
    const float lam_init = 0.2f;
    const float lam = expf(d1) - expf(d2) + lam_init;
    const float* sg = C.in[19];
    const unsigned lds0 = (unsigned)(uintptr_t)C.lds;
    const LASP char* ldsp = (const LASP char*)C.lds;
    constexpr int SLOT = 24576;
    const int krow = 8 * wave + (lane >> 3), kchunk = (lane & 7) ^ (lane >> 3);
    const int st0 = 4 * wave + (lane >> 5), st1 = st0 + 2;
    const int vrow = (lane & 31) >> 2, vch = lane & 3;
    const int koff0 = l31 * 128, kx = l31 & 7;
    const int vboff = (4 * hi + ((lane & 15) >> 2)) * 64 + ((lane >> 4) & 1) * 32 + (lane & 3) * 8;
    for (int unit = C.blk; unit < NB * 4 * 8; unit += C.nblk) {
        const int b = unit >> 5, hh = (unit >> 3) & 3, qb = unit & 7;
        const int q0 = qb * 256 + wave * 32;
        const float slope2 = exp2f(-2.0f * (float)(hh + 1)) * LOG2E;
        const float qpos = (float)(q0 + l31 - 4 * hi);
        const bf16_t* qrow = u + (size_t)(b * SEQ + q0 + l31) * INC + QOFF + hh * 128;
        const bf16_t* kgb = u + (size_t)(b * SEQ) * INC + KOFF + hh * 128;
        const bf16_t* vgb = u + (size_t)(b * SEQ) * INC + VOFF + hh * 128;
        const bf16_t* vsrc0 = vgb + (size_t)(8 * (st0 >> 2) + vrow) * INC + 32 * (st0 & 3) + 8 * vch;
        const bf16_t* vsrc1 = vgb + (size_t)(8 * (st1 >> 2) + vrow) * INC + 32 * (st1 & 3) + 8 * vch;
#pragma unroll 1
        for (int c = 0; c < 2; ++c) {
            const bf16_t* ksrc = kgb + c * 64 + (size_t)krow * INC + kchunk * 8;
#define ATT_DMA(t, sl) do { const size_t _o = (size_t)(t) * 64 * INC; const unsigned _b = lds0 + (unsigned)(sl) * SLOT; \
        glds16(ksrc + _o, (unsigned)__builtin_amdgcn_readfirstlane(_b + wave * 1024)); \
        glds16(vsrc0 + _o, (unsigned)__builtin_amdgcn_readfirstlane(_b + 8192 + (2 * wave) * 1024)); \
        glds16(vsrc1 + _o, (unsigned)__builtin_amdgcn_readfirstlane(_b + 8192 + (2 * wave + 1) * 1024)); } while (0)
            const int t0 = qb * 4;
            ATT_DMA(t0, 0);
            bf16x8 qf[4];
#pragma unroll
            for (int ks = 0; ks < 4; ++ks) qf[ks] = *(const bf16x8*)(qrow + c * 64 + 16 * ks + 8 * hi);
            f32x16 o[4];
#pragma unroll
            for (int eb = 0; eb < 4; ++eb)
#pragma unroll
                for (int r = 0; r < 16; ++r) o[eb][r] = 0.f;
            float mhat = 0.f, lsum = 0.f;
            f32x16 negm;
#pragma unroll
            for (int r = 0; r < 16; ++r) negm[r] = 0.f;
#pragma unroll 1
            for (int i = 0; i < 32; ++i) {
                const int tt = (t0 + i) & 31, sl = i & 1;
                asm volatile("s_waitcnt vmcnt(0) lgkmcnt(0)\n\ts_barrier" ::: "memory");
                if (i + 1 < 32) ATT_DMA((t0 + i + 1) & 31, sl ^ 1);
                const LASP char* Kb = ldsp + sl * SLOT; const LASP char* Vb = Kb + 8192 + vboff;
                f32x16 p0 = negm, p1 = negm;
#pragma unroll
                for (int ks = 0; ks < 4; ++ks) {
                    const bf16x8 kf0 = *(const LASP bf16x8*)(Kb + koff0 + (((2 * ks + hi) ^ kx) * 16));
                    const bf16x8 kf1 = *(const LASP bf16x8*)(Kb + 4096 + koff0 + (((2 * ks + hi) ^ kx) * 16));
                    p0 = __builtin_amdgcn_mfma_f32_32x32x16_bf16(kf0, qf[ks], p0, 0, 0, 0);
                    p1 = __builtin_amdgcn_mfma_f32_32x32x16_bf16(kf1, qf[ks], p1, 0, 0, 0);
                }
                const float a = qpos - (float)(tt * 64);
                float rm = -1e30f;
#pragma unroll
                for (int r = 0; r < 16; ++r) { const float x0 = a - (float)crow(r, 0); p0[r] = fmaf(fabsf(x0), -slope2, p0[r]); p1[r] = fmaf(fabsf(x0 - 32.0f), -slope2, p1[r]); rm = fmaxf(rm, fmaxf(p0[r], p1[r])); }
                { auto rr = __builtin_amdgcn_permlane32_swap(__float_as_uint(rm), __float_as_uint(rm), false, false); rm = fmaxf(__uint_as_float(rr[0]), __uint_as_float(rr[1])); }
                if (__any(rm > 8.0f)) {
                    const float dl = fmaxf(rm, 0.f); mhat += dl;
#pragma unroll
                    for (int r = 0; r < 16; ++r) { p0[r] -= dl; p1[r] -= dl; negm[r] = -mhat; }
                    const float f = exp2f(-dl); lsum *= f;
#pragma unroll
                    for (int eb = 0; eb < 4; ++eb)
#pragma unroll
                        for (int r = 0; r < 16; ++r) o[eb][r] *= f;
                }
                float ps = 0.f;
#pragma unroll
                for (int r = 0; r < 16; ++r) { p0[r] = __builtin_amdgcn_exp2f(p0[r]); p1[r] = __builtin_amdgcn_exp2f(p1[r]); ps += p0[r] + p1[r]; }
                lsum += ps;
                bf16x8 pf[4];
#pragma unroll
                for (int s2 = 0; s2 < 2; ++s2) {
                    u32x4 w; w.x = cvtpk(p0[8 * s2 + 0], p0[8 * s2 + 1]); w.y = cvtpk(p0[8 * s2 + 2], p0[8 * s2 + 3]); w.z = cvtpk(p0[8 * s2 + 4], p0[8 * s2 + 5]); w.w = cvtpk(p0[8 * s2 + 6], p0[8 * s2 + 7]); pf[s2] = __builtin_bit_cast(bf16x8, w);
                    u32x4 v; v.x = cvtpk(p1[8 * s2 + 0], p1[8 * s2 + 1]); v.y = cvtpk(p1[8 * s2 + 2], p1[8 * s2 + 3]); v.z = cvtpk(p1[8 * s2 + 4], p1[8 * s2 + 5]); v.w = cvtpk(p1[8 * s2 + 6], p1[8 * s2 + 7]); pf[2 + s2] = __builtin_bit_cast(bf16x8, v);
                }
#pragma unroll
                for (int eb = 0; eb < 4; ++eb)
#pragma unroll
                    for (int s = 0; s < 4; ++s) {
                        const s16x4 lo = vtr(Vb + s * 4096 + eb * 512), h4 = vtr(Vb + s * 4096 + 2048 + eb * 512);
                        const bf16x8 vf = (bf16x8){lo[0], lo[1], lo[2], lo[3], h4[0], h4[1], h4[2], h4[3]};
                        o[eb] = __builtin_amdgcn_mfma_f32_32x32x16_bf16(vf, pf[s], o[eb], 0, 0, 0);
                        if (s == 3) __builtin_amdgcn_sched_barrier(0);
                    }
            }
#undef ATT_DMA
            { auto rr = __builtin_amdgcn_permlane32_swap(__float_as_uint(lsum), __float_as_uint(lsum), false, false); lsum = __uint_as_float(rr[0]) + __uint_as_float(rr[1]); }
            const float inv = 1.0f / lsum;
            float* pk = park; asm volatile("" : "+v"(pk));
            if (c == 0) {
#pragma unroll
                for (int eb = 0; eb < 4; ++eb)
#pragma unroll
                    for (int r = 0; r < 16; ++r) pk[(eb * 16 + r) * 64] = o[eb][r] * inv;
            } else {
                float ss = 0.f;
#pragma unroll
                for (int eb = 0; eb < 4; ++eb)
#pragma unroll
                    for (int r = 0; r < 16; ++r) { const float y = pk[(eb * 16 + r) * 64] - lam * (o[eb][r] * inv); o[eb][r] = y; ss += y * y; }
                { auto rr = __builtin_amdgcn_permlane32_swap(__float_as_uint(ss), __float_as_uint(ss), false, false); ss = __uint_as_float(rr[0]) + __uint_as_float(rr[1]); }
                const float rinv = 1.0f / sqrtf(ss * (1.0f / 128.0f) + EPS) * (1.0f - lam_init);
                bf16_t* orow = ycat + (size_t)(b * SEQ + q0 + l31) * D + 512 + hh * 128 + 4 * hi;
#pragma unroll
                for (int eb = 0; eb < 4; ++eb)
#pragma unroll
                    for (int g4 = 0; g4 < 4; ++g4) { const int e = 32 * eb + 8 * g4;
                        const f32x4 gg = *(const f32x4*)(sg + e + 4 * hi);
                        u32x2 w; w.x = cvtpk(o[eb][4 * g4] * rinv * gg.x, o[eb][4 * g4 + 1] * rinv * gg.y); w.y = cvtpk(o[eb][4 * g4 + 2] * rinv * gg.z, o[eb][4 * g4 + 3] * rinv * gg.w);
                        *(u32x2*)(orow + e) = w; }
            }
        }
    }
    asm volatile("s_waitcnt vmcnt(0) lgkmcnt(0)\n\ts_barrier" ::: "memory");
}


__device__ __forceinline__ void phase_hy_pre_fast(Ctx& C) {
    const bf16_t* u = (const bf16_t*)(C.ws + WS_U); bf16_t* vpt = (bf16_t*)(C.ws + WS_VP); bf16_t* x0t = (bf16_t*)(C.ws + WS_X0C);
    const float* cw = C.in[7]; const float* cb = C.in[8];
    bf16_t* sv = (bf16_t*)C.lds; bf16_t* sx = sv + 64 * 72;
    const int tl = C.tid >> 3, c8 = C.tid & 7;
    for (int tile = C.blk; tile < NB * 32 * 8; tile += C.nblk) {
        const int cq = tile & 7, tq = (tile >> 3) & 31, b = tile >> 8;
        const int c0 = cq * 64 + c8 * 8, t = tq * 64 + tl; const size_t row = (size_t)b * SEQ + t;
        float r[3][8];
#pragma unroll
        for (int s = 0; s < 3; ++s) {
            const int ch = s * HW + c0;
            const u32x4 z = {0u, 0u, 0u, 0u};
            const u32x4 um = (t > 0) ? *(const u32x4*)(u + (row - 1) * INC + ch) : z, u0 = *(const u32x4*)(u + row * INC + ch), up = (t < SEQ - 1) ? *(const u32x4*)(u + (row + 1) * INC + ch) : z;
            f32x4 m0, m1, z0, z1, p0, p1; pg8::unpack8(um, m0, m1); pg8::unpack8(u0, z0, z1); pg8::unpack8(up, p0, p1);
            const f32x4 w00 = *(const f32x4*)(cw + ch), w01 = *(const f32x4*)(cw + ch + 4), w10 = *(const f32x4*)(cw + 3 * HW + ch), w11 = *(const f32x4*)(cw + 3 * HW + ch + 4);
            const f32x4 w20 = *(const f32x4*)(cw + 6 * HW + ch), w21 = *(const f32x4*)(cw + 6 * HW + ch + 4), bb0 = *(const f32x4*)(cb + ch), bb1 = *(const f32x4*)(cb + ch + 4);
            const f32x4 a0 = m0 * w00 + z0 * w10 + p0 * w20 + bb0, a1 = m1 * w01 + z1 * w11 + p1 * w21 + bb1;
#pragma unroll
            for (int i = 0; i < 4; ++i) { r[s][i] = a0[i]; r[s][4 + i] = a1[i]; }
        }
        __syncthreads();
#pragma unroll
        for (int i = 0; i < 8; ++i) { sx[(c8 * 8 + i) * 72 + tl] = (bf16_t)f2bf(r[0][i]); sv[(c8 * 8 + i) * 72 + tl] = (bf16_t)f2bf(r[2][i] * r[1][i]); }
        __syncthreads();
        { const int cl = C.tid >> 3, chk = C.tid & 7; const size_t o = ((size_t)(cq * 64 + cl) * NB + b) * SEQ + tq * 64 + chk * 8;
          *(u32x4*)(vpt + o) = *(const u32x4*)(sv + cl * 72 + chk * 8); *(u32x4*)(x0t + o) = *(const u32x4*)(sx + cl * 72 + chk * 8); }
    }
    __syncthreads();
}

__device__ __forceinline__ void phase_toeplitz(Ctx& C) {
    constexpr int VROW = 4096 + 16, FCOPY = 8192 + 32, FL = 16 * VROW;
    const bf16_t* vpt = (const bf16_t*)(C.ws + WS_VP); const bf16_t* x0t = (const bf16_t*)(C.ws + WS_X0C); bf16_t* yt = (bf16_t*)(C.ws + WS_YT);
    const float* kfc = (const float*)(C.ws + WS_KFC); const float* dsk = C.in[17];
    const int lane = C.lane, a = lane & 15, g = lane >> 4, wave = C.wave;
    const unsigned lds0 = (unsigned)(uintptr_t)C.lds;
    const LASP char* ldsp = (const LASP char*)C.lds;
    const int t0 = 256 * wave;
    const int c0 = 2048 - t0 + 8 * g - a;
    const LASP char* fbase = ldsp + FL + (c0 & 7) * FCOPY + 2 * (c0 & ~7);
    const LASP char* vbase = ldsp + a * VROW + 16 * g;
    for (int c = C.blk; c < HW; c += C.nblk) {
        asm volatile("s_waitcnt vmcnt(0) lgkmcnt(0)\n\ts_barrier" ::: "memory");
        { const char* src = (const char*)(vpt + (size_t)c * NB * SEQ) + lane * 16;
#pragma unroll
          for (int j = 0; j < 8; ++j) { const int p = wave * 8 + j;
              glds16(src + (size_t)p * 1024, (unsigned)__builtin_amdgcn_readfirstlane(lds0 + (p >> 2) * VROW + (p & 3) * 1024)); } }
        { const int q = C.tid; const float* kc = kfc + (size_t)c * 4096; float f[15];
#pragma unroll
          for (int i = 0; i < 15; ++i) { const int idx = 4096 - 8 * q - i; f[i] = (idx >= 1 && idx <= 4095) ? kc[idx] : 0.f; }
#pragma unroll
          for (int m = 0; m < 8; ++m) { u32x4 w; w.x = pk2(f[m], f[m + 1]); w.y = pk2(f[m + 2], f[m + 3]); w.z = pk2(f[m + 4], f[m + 5]); w.w = pk2(f[m + 6], f[m + 7]);
              *(LASP u32x4*)((LASP char*)C.lds + FL + m * FCOPY + q * 16) = w; } }
        asm volatile("s_waitcnt vmcnt(0) lgkmcnt(0)\n\ts_barrier" ::: "memory");
        f32x4 acc[16]; bf16x8 W[16];
#pragma unroll
        for (int r = 0; r < 16; ++r) { acc[r] = (f32x4){0.f, 0.f, 0.f, 0.f}; W[r] = *(const LASP bf16x8*)(fbase - 32 * r); }
#pragma unroll 1
        for (int ko = 0; ko < 8; ++ko) {
            const LASP char* fb = fbase + ko * 512; const LASP char* vb = vbase + ko * 512;
#pragma unroll
            for (int kk = 0; kk < 8; ++kk) {
                const bf16x8 Bf = *(const LASP bf16x8*)(vb + 64 * kk);
#pragma unroll
                for (int r = 0; r < 16; ++r) acc[r] = __builtin_amdgcn_mfma_f32_16x16x32_bf16(W[(r - 2 * kk) & 15], Bf, acc[r], 0, 0, 0);
                if (ko < 7 || kk < 7) { W[(-2 * kk - 2) & 15] = *(const LASP bf16x8*)(fb + 64 * kk + 64); W[(-2 * kk - 1) & 15] = *(const LASP bf16x8*)(fb + 64 * kk + 32); }
            }
        }
        const float dd = dsk[c];
#pragma unroll
        for (int r = 0; r < 16; ++r) { const int t = t0 + 16 * r + 4 * g; const size_t o = ((size_t)c * NB + a) * SEQ + t;
            const u32x2 vv = *(const LASP u32x2*)(ldsp + a * VROW + t * 2); const u32x2 xx = *(const u32x2*)(x0t + o);
            const float y0 = (acc[r][0] + bflo(vv.x) * dd) * bflo(xx.x), y1 = (acc[r][1] + bfhi(vv.x) * dd) * bfhi(xx.x);
            const float y2 = (acc[r][2] + bflo(vv.y) * dd) * bflo(xx.y), y3 = (acc[r][3] + bfhi(vv.y) * dd) * bfhi(xx.y);
            u32x2 w; w.x = pk2(y0, y1); w.y = pk2(y2, y3); *(u32x2*)(yt + o) = w; }
    }
    asm volatile("s_waitcnt vmcnt(0) lgkmcnt(0)\n\ts_barrier" ::: "memory");
}

__device__ __forceinline__ void phase_hy_post(Ctx& C) {
    const bf16_t* yt = (const bf16_t*)(C.ws + WS_YT); bf16_t* ycat = (bf16_t*)(C.ws + WS_YCAT);
    bf16_t* sy = (bf16_t*)C.lds;
    for (int tile = C.blk; tile < NB * 32 * 8; tile += C.nblk) {
        const int cq = tile & 7, tq = (tile >> 3) & 31, b = tile >> 8;
        __syncthreads();
        { const int cl = C.tid >> 3, chk = C.tid & 7; *(u32x4*)(sy + cl * 72 + chk * 8) = *(const u32x4*)(yt + ((size_t)(cq * 64 + cl) * NB + b) * SEQ + tq * 64 + chk * 8); }
        __syncthreads();
        { const int tl = C.tid >> 3, c8 = C.tid & 7; unsigned short e[8];
#pragma unroll
          for (int i = 0; i < 8; ++i) e[i] = sy[(c8 * 8 + i) * 72 + tl];
          u32x4 w; w.x = e[0] | ((unsigned)e[1] << 16); w.y = e[2] | ((unsigned)e[3] << 16); w.z = e[4] | ((unsigned)e[5] << 16); w.w = e[6] | ((unsigned)e[7] << 16);
          *(u32x4*)(ycat + ((size_t)b * SEQ + tq * 64 + tl) * D + cq * 64 + c8 * 8) = w; }
    }
    __syncthreads();
}

__device__ __forceinline__ void phase_router(Ctx& C) {
    const bf16_t* h2 = (const bf16_t*)(C.ws + WS_H); const bf16_t* h2lo = (const bf16_t*)(C.ws + WS_H2LO); const bf16_t* wrt = (const bf16_t*)(C.ws + WS_WRT);
    float* logits = (float*)(C.ws + WS_LOGITS);
    const int fr = C.lane & 15, fq = C.lane >> 4;
    for (int tile = C.gw; tile < T / 16; tile += C.ngw) {
        f32x4 acc[2]; acc[0] = (f32x4){0.f, 0.f, 0.f, 0.f}; acc[1] = acc[0];
        const bf16_t* ah = h2 + (size_t)(tile * 16 + fr) * D + fq * 8; const bf16_t* al = h2lo + (size_t)(tile * 16 + fr) * D + fq * 8;
        for (int k = 0; k < D; k += 32) {
            const bf16x8 a_h = *(const bf16x8*)(ah + k), a_l = *(const bf16x8*)(al + k);
#pragma unroll
            for (int n = 0; n < 2; ++n) { const bf16_t* bp = wrt + (size_t)(n * 16 + fr) * 2048 + fq * 8 + k;
                const bf16x8 b_h = *(const bf16x8*)(bp), b_l = *(const bf16x8*)(bp + 1024);
                acc[n] = __builtin_amdgcn_mfma_f32_16x16x32_bf16(b_h, a_h, acc[n], 0, 0, 0);
                acc[n] = __builtin_amdgcn_mfma_f32_16x16x32_bf16(b_h, a_l, acc[n], 0, 0, 0);
                acc[n] = __builtin_amdgcn_mfma_f32_16x16x32_bf16(b_l, a_h, acc[n], 0, 0, 0); }
        }
#pragma unroll
        for (int n = 0; n < 2; ++n) *(f32x4*)(logits + (size_t)(tile * 16 + fr) * NE + n * 16 + 4 * fq) = acc[n];
    }
}

__device__ __forceinline__ void phase_top4(Ctx& C) {
    const float* logits = (const float*)(C.ws + WS_LOGITS); int* tope = (int*)(C.ws + WS_TOPE); float* topw = (float*)(C.ws + WS_TOPW); int* blkcnt = (int*)(C.ws + WS_BLKCNT);
    int* hist = (int*)C.lds; const float* br = C.in[25];
    for (int vb = C.blk; vb < 256; vb += C.nblk) {
        __syncthreads();
        if (C.tid < NE) hist[C.tid] = 0;
        __syncthreads();
        if (C.tid < 128) {
            const int t = vb * 128 + C.tid;
            float v[32];
#pragma unroll
            for (int q = 0; q < 8; ++q) { const f32x4 x = *(const f32x4*)(logits + (size_t)t * NE + 4 * q), bb = *(const f32x4*)(br + 4 * q);
                v[4 * q] = x.x + bb.x; v[4 * q + 1] = x.y + bb.y; v[4 * q + 2] = x.z + bb.z; v[4 * q + 3] = x.w + bb.w; }
            float tv[4]; int ti[4];
#pragma unroll
            for (int k = 0; k < 4; ++k) {
                float best = -INFINITY; int bi = 0;
#pragma unroll
                for (int e = 0; e < 32; ++e) if (v[e] > best) { best = v[e]; bi = e; }
                tv[k] = best; ti[k] = bi;
#pragma unroll
                for (int e = 0; e < 32; ++e) v[e] = (e == bi) ? -INFINITY : v[e];
            }
            const float e0 = 1.0f, e1 = expf(tv[1] - tv[0]), e2 = expf(tv[2] - tv[0]), e3 = expf(tv[3] - tv[0]);
            const float inv = 1.0f / (e0 + e1 + e2 + e3);
            *(int4*)(tope + (size_t)t * 4) = make_int4(ti[0], ti[1], ti[2], ti[3]);
            *(f32x4*)(topw + (size_t)t * 4) = (f32x4){e0 * inv, e1 * inv, e2 * inv, e3 * inv};
#pragma unroll
            for (int k = 0; k < 4; ++k) atomicAdd(&hist[ti[k]], 1);
        }
        __syncthreads();
        if (C.tid < NE) blkcnt[vb * NE + C.tid] = hist[C.tid];
    }
    __syncthreads();
}

__device__ __forceinline__ void phase_rowlist(Ctx& C) {
    const int* tope = (const int*)(C.ws + WS_TOPE); const int* blkcnt = (const int*)(C.ws + WS_BLKCNT);
    int* rowpair = (int*)(C.ws + WS_ROWPAIR); int* tileexp = (int*)(C.ws + WS_TILEEXP); int* meta = (int*)(C.ws + WS_META);
    int* s_total = (int*)C.lds; int* s_base = s_total + 32; int* s_pstart = s_base + 32; int* s_e = s_pstart + 33;
    for (int vb = C.blk; vb < 256; vb += C.nblk) {
        __syncthreads();
        if (C.tid < NE) { int tot = 0, base = 0; for (int q = 0; q < 256; ++q) { const int c = blkcnt[q * NE + C.tid]; tot += c; if (q < vb) base += c; } s_total[C.tid] = tot; s_base[C.tid] = base; }
        s_e[C.tid] = tope[(size_t)vb * 512 + C.tid];
        __syncthreads();
        if (C.tid == 0) { int ps = 0; for (int e = 0; e < NE; ++e) { s_pstart[e] = ps; ps += ((s_total[e] + 255) / 256) * 256; } s_pstart[NE] = ps; }
        __syncthreads();
        { const int e = s_e[C.tid]; int rank = 0; for (int j = 0; j < C.tid; ++j) rank += (s_e[j] == e) ? 1 : 0;
          rowpair[s_pstart[e] + s_base[e] + rank] = vb * 512 + C.tid; }
        if (vb < NE) { const int e = vb; for (int r = s_pstart[e] + s_total[e] + C.tid; r < s_pstart[e + 1]; r += NTHREADS) rowpair[r] = -1; }
        if (vb == 0) {
            if (C.tid < NE) { for (int tl = s_pstart[C.tid] / 256; tl < s_pstart[C.tid + 1] / 256; ++tl) tileexp[tl] = C.tid; }
            if (C.tid == 0) meta[0] = s_pstart[NE] / 256;
        }
    }
    __syncthreads();
}

__device__ __forceinline__ void phase_gateup(Ctx& C) {
    const bf16_t* h2 = (const bf16_t*)(C.ws + WS_H); const bf16_t* wgu = (const bf16_t*)(C.ws + WS_WGU); bf16_t* act = (bf16_t*)(C.ws + WS_ACT);
    const int* rowpair = (const int*)(C.ws + WS_ROWPAIR); const int* tileexp = (const int*)(C.ws + WS_TILEEXP); const int* meta = (const int*)(C.ws + WS_META);
    const float* bgu = C.in[27];
    const int nmt = meta[0] * 4;
    const int fr = C.lane & 15, fq = C.lane >> 4;
    for (int tile = C.gw; tile < nmt * 32; tile += C.ngw) {
        const int mt = tile / 32, ntq = tile % 32; const int j = ntq >> 2, q = ntq & 3;
        const int e = tileexp[mt >> 2];
        f32x4 acc[4][4]; zero_acc(acc);
        gemm_tile64(acc, h2, D, [&](int r) { const int p = rowpair[mt * 64 + r]; return p >= 0 ? (p >> 2) : 0; },
                    wgu + (size_t)e * 2 * D * D, D, [&](int n) { return 256 * j + 128 * (n >> 1) + 32 * q + 16 * (n & 1); }, 0, D, C.lane);
#pragma unroll
        for (int m = 0; m < 4; ++m)
#pragma unroll
            for (int n = 0; n < 2; ++n) { const int row = mt * 64 + m * 16 + fr, col = 128 * j + 32 * q + 16 * n + 4 * fq;
                const f32x4 bg = *(const f32x4*)(bgu + (size_t)e * 2 * D + col), bu = *(const f32x4*)(bgu + (size_t)e * 2 * D + D + col);
                const f32x4 g = acc[m][n] + bg, uu = acc[m][n + 2] + bu; float r[4];
#pragma unroll
                for (int i = 0; i < 4; ++i) { const float gg = fminf(g[i], 7.0f), up = fminf(fmaxf(uu[i], -7.0f), 7.0f); r[i] = (up + 1.0f) * (gg * sigmoidf_(1.702f * gg)); }
                u32x2 w; w.x = pk2(r[0], r[1]); w.y = pk2(r[2], r[3]); *(u32x2*)(act + (size_t)row * D + col) = w; }
    }
}

__device__ __forceinline__ void phase_down(Ctx& C) {
    const bf16_t* act = (const bf16_t*)(C.ws + WS_ACT); const bf16_t* wdn = (const bf16_t*)(C.ws + WS_WDN); bf16_t* slots = (bf16_t*)(C.ws + WS_SLOTS);
    const int* rowpair = (const int*)(C.ws + WS_ROWPAIR); const int* tileexp = (const int*)(C.ws + WS_TILEEXP); const int* meta = (const int*)(C.ws + WS_META);
    const float* topw = (const float*)(C.ws + WS_TOPW); const float* bd = C.in[29];
    const int nmt = meta[0] * 4;
    const int fr = C.lane & 15, fq = C.lane >> 4;
    for (int tile = C.gw; tile < nmt * 16; tile += C.ngw) {
        const int mt = tile / 16, nt = tile % 16; const int e = tileexp[mt >> 2];
        f32x4 acc[4][4]; zero_acc(acc);
        gemm_tile64(acc, act, D, [&](int r) { return mt * 64 + r; }, wdn + (size_t)e * D * D, D, [&](int n) { return nt * 64 + n * 16; }, 0, D, C.lane);
#pragma unroll
        for (int m = 0; m < 4; ++m) { const int row = mt * 64 + m * 16 + fr; const int p = rowpair[row];
            if (p >= 0) { const float w = topw[p];
#pragma unroll
                for (int n = 0; n < 4; ++n) { const int col = nt * 64 + n * 16 + 4 * fq; const f32x4 v = (acc[m][n] + *(const f32x4*)(bd + (size_t)e * D + col)) * w;
                    u32x2 o; o.x = pk2(v.x, v.y); o.y = pk2(v.z, v.w); *(u32x2*)(slots + (size_t)p * D + col) = o; } } }
    }
}


#define LDS3(C) ((PG8_LAS unsigned char*)(C).lds)
__device__ __forceinline__ void phase_inproj_fast(Ctx& C) {
    pg8::Gemm g{(const bf16_t*)(C.ws + WS_H), (const bf16_t*)(C.ws + WS_WIN), D, D, D, nullptr};
    pg8::StaticOrder S; S.init(T / 256, INC / 256, C.nblk, C.blk);
    pg8::EpiInproj E{(bf16_t*)(C.ws + WS_U), C.in[6]};
    pg8::gemm_phase<pg8::EpiInproj, pg8::StaticOrder, false>(LDS3(C), g, S, E);
}
__device__ __forceinline__ void phase_cat_fast(Ctx& C) {
    pg8::StaticOrder S; S.init(T / 256, D / 256, C.nblk, C.blk);
    { pg8::Gemm g{(const bf16_t*)(C.ws + WS_YCAT), (const bf16_t*)(C.ws + WS_WCAT), D, D, 512, nullptr};
      pg8::EpiCat<0> E{(bf16_t*)(C.ws + WS_MERGED), (const bf16_t*)(C.ws + WS_U)};
      pg8::gemm_phase<pg8::EpiCat<0>, pg8::StaticOrder, false>(LDS3(C), g, S, E); }
    { pg8::Gemm g{(const bf16_t*)(C.ws + WS_YCAT) + 512, (const bf16_t*)(C.ws + WS_WCAT) + 512, D, D, 512, nullptr};
      pg8::EpiCat<1> E{(bf16_t*)(C.ws + WS_MERGED), (const bf16_t*)(C.ws + WS_U)};
      pg8::gemm_phase<pg8::EpiCat<1>, pg8::StaticOrder, false>(LDS3(C), g, S, E); }
}
__device__ __forceinline__ void phase_mix_fast(Ctx& C) {
    pg8::Gemm g{(const bf16_t*)(C.ws + WS_MERGED), (const bf16_t*)(C.ws + WS_WMIX), D, D, D, nullptr};
    pg8::StaticOrder S; S.init(T / 256, D / 256, C.nblk, C.blk);
    pg8::EpiMix E{C.in[0], C.out, (const float*)(C.ws + WS_MOD)};
    pg8::gemm_phase<pg8::EpiMix, pg8::StaticOrder, false>(LDS3(C), g, S, E);
}
__device__ __forceinline__ void phase_gateup_fast(Ctx& C) {
    const int nmt = ((const int*)(C.ws + WS_META))[0];
    pg8::Gemm g{(const bf16_t*)(C.ws + WS_H), (const bf16_t*)(C.ws + WS_WGU), D, D, D, (const int*)(C.ws + WS_ROWPAIR)};
    pg8::MoeOrder S; S.b.init(nmt, 8, C.nblk, C.blk); S.tileexp = (const int*)(C.ws + WS_TILEEXP); S.nN = 8;
    pg8::EpiGateUp E{(bf16_t*)(C.ws + WS_ACT), C.in[27]};
    pg8::gemm_phase<pg8::EpiGateUp, pg8::MoeOrder, true>(LDS3(C), g, S, E);
}
__device__ __forceinline__ void phase_down_fast(Ctx& C) {
    const int nmt = ((const int*)(C.ws + WS_META))[0];
    pg8::Gemm g{(const bf16_t*)(C.ws + WS_ACT), (const bf16_t*)(C.ws + WS_WDN), D, D, D, nullptr};
    pg8::MoeOrder S; S.b.init(nmt, 4, C.nblk, C.blk); S.tileexp = (const int*)(C.ws + WS_TILEEXP); S.nN = 4;
    pg8::EpiDown E{(bf16_t*)(C.ws + WS_SLOTS), C.in[29], (const int*)(C.ws + WS_ROWPAIR), (const float*)(C.ws + WS_TOPW)};
    pg8::gemm_phase<pg8::EpiDown, pg8::MoeOrder, false>(LDS3(C), g, S, E);
}

constexpr int NPHASES = 15;
}

__global__ void __launch_bounds__(NTHREADS, 2) fwd_kernel(Params p) {
    extern __shared__ __attribute__((aligned(16))) unsigned char lds[];
    cg::grid_group grid = cg::this_grid();
    Ctx C;
#pragma unroll
    for (int i = 0; i < 31; ++i) C.in[i] = p.in[i];
    C.out = p.out; C.ws = p.ws; C.lds = lds;
    C.tid = threadIdx.x; C.lane = C.tid & 63; C.wave = __builtin_amdgcn_readfirstlane(C.tid >> 6);
    C.blk = blockIdx.x; C.nblk = gridDim.x; C.gw = C.blk * NWAVES + C.wave; C.ngw = C.nblk * NWAVES;
    const int lo = p.ph_lo, hi = p.ph_hi;
#ifndef PHMASK
#define PHMASK 0xffff
#endif
#define PH(k, body) do { if ((PHMASK >> (k)) & 1) { if (lo <= (k) && (k) < hi) { body; if ((k) + 1 < hi) grid.sync(); } } } while (0)
    PH(0, { phase_weights(C); __syncthreads(); phase_mod(C); phase_filters(C); });
    PH(1, phase_norm1(C));
#ifndef FASTMASK
#define FASTMASK 0xffff
#endif
#define FAST(k) ((FASTMASK >> (k)) & 1)
    PH(2, { if (FAST(2)) phase_inproj_fast(C); else phase_inproj(C); });
    PH(3, { if (FAST(3)) phase_hy_pre_fast(C); else phase_hy_pre(C); });
    PH(4, { if (FAST(3)) { phase_toeplitz(C); grid.sync(); phase_hy_post(C); } else phase_hy_conv(C); });
    PH(5, { if (FAST(5)) phase_attn_fast(C); else phase_attn(C); });
    PH(6, { if (FAST(6)) phase_cat_fast(C); else phase_cat(C); });
    PH(7, { if (FAST(7)) phase_mix_fast(C); else phase_mix(C); });
    PH(8, phase_norm2(C));
    PH(9, phase_router(C));
    PH(10, phase_top4(C));
    PH(11, phase_rowlist(C));
    PH(12, { if (FAST(12)) phase_gateup_fast(C); else phase_gateup(C); });
    PH(13, { if (FAST(13)) phase_down_fast(C); else phase_down(C); });
    PH(14, phase_final(C));
#undef PH
}

extern "C" void kernel_launch(void* const* d_in, const int* in_sizes, int n_in, void* d_out, int out_size, void* d_ws, size_t ws_size, hipStream_t stream) {
    static int grid = 0;
    if (grid == 0) {
        if (n_in != 31 || ws_size < WS_END) { fprintf(stderr, "kernel_launch: unexpected n_in %d or ws_size %zu\n", n_in, ws_size); grid = -1; return; }
        int dev = 0, cus = 0, per_cu = 0;
        hipGetDevice(&dev); hipDeviceGetAttribute(&cus, hipDeviceAttributeMultiprocessorCount, dev);
        hipFuncSetAttribute((const void*)fwd_kernel, hipFuncAttributeMaxDynamicSharedMemorySize, LDS_BYTES);
        hipOccupancyMaxActiveBlocksPerMultiprocessor(&per_cu, (const void*)fwd_kernel, NTHREADS, LDS_BYTES);
        if (per_cu < 1) { fprintf(stderr, "kernel_launch: occupancy query says %d blocks/CU\n", per_cu); per_cu = 1; }
        (void)hipGetLastError();
        grid = cus * 1;
        fprintf(stderr, "kernel_launch: cus %d per_cu %d grid %d\n", cus, per_cu, grid);
    }
    if (grid < 0) return;
    Params p{};
    for (int i = 0; i < 31; ++i) p.in[i] = (const float*)d_in[i];
    p.out = (float*)d_out; p.ws = (unsigned char*)d_ws; p.ph_lo = 0; p.ph_hi = NPHASES;
    void* args[] = {&p};
    hipError_t e = hipLaunchCooperativeKernel((const void*)fwd_kernel, dim3(grid), dim3(NTHREADS), args, LDS_BYTES, stream);
    if (e != hipSuccess) fprintf(stderr, "cooperative launch failed: %s (grid %d)\n", hipGetErrorString(e), grid);
}
```

```cpp
#include <hip/hip_runtime.h>
#include <hip/hip_cooperative_groups.h>
#include <cstdio>
#include <cstdint>
namespace cg = cooperative_groups;

namespace {
typedef unsigned short bf16_t;
typedef short bf16x8 __attribute__((ext_vector_type(8)));
typedef short s16x4 __attribute__((ext_vector_type(4)));
typedef float f32x4 __attribute__((ext_vector_type(4)));
typedef float f32x16 __attribute__((ext_vector_type(16)));
typedef unsigned u32x4 __attribute__((ext_vector_type(4)));
typedef unsigned u32x2 __attribute__((ext_vector_type(2)));

constexpr int D = 1024, NB = 16, SEQ = 2048, T = NB * SEQ, HW = 512, INC = 5120, NE = 32, FHID = 64;
constexpr int QOFF = 1536, KOFF = 2048, VOFF = 2560, GOFF = 3072;
constexpr int NTHREADS = 512, NWAVES = 8;
constexpr float EPS = 1e-5f;
constexpr float LOG2E = 1.4426950408889634f;
constexpr float QSCALE = 0.125f * 1.4426950408889634f;
constexpr size_t MiB = 1u << 20;
constexpr size_t WS_CTL = 0;
constexpr size_t WS_MOD = 1 * MiB;
constexpr size_t WS_META = 1 * MiB + 512 * 1024;
constexpr size_t WS_BLKCNT = WS_META + 4096;
constexpr size_t WS_TILEEXP = WS_BLKCNT + 256 * 32 * 4;
constexpr size_t WS_LOGITS = 2 * MiB;
constexpr size_t WS_TOPE = 6 * MiB;
constexpr size_t WS_TOPW = 6 * MiB + 512 * 1024;
constexpr size_t WS_ROWPAIR = 7 * MiB;
constexpr size_t WS_KFILT = 8 * MiB;
constexpr size_t WS_U = 16 * MiB;
constexpr size_t WS_ACT = WS_U;
constexpr size_t WS_H = 336 * MiB;
constexpr size_t WS_R1 = 400 * MiB;
constexpr size_t WS_YCAT = WS_R1;
constexpr size_t WS_MERGED = WS_R1 + 64 * MiB;
constexpr size_t WS_VP = WS_R1 + 128 * MiB;
constexpr size_t WS_X0C = WS_R1 + 160 * MiB;
constexpr size_t WS_VT = WS_R1 + 192 * MiB;
constexpr size_t WS_H2LO = WS_R1 + 224 * MiB;
constexpr size_t WS_SLOTS = WS_R1;
constexpr size_t WS_WIN = 688 * MiB;
constexpr size_t WS_WCAT = 698 * MiB;
constexpr size_t WS_WMIX = 700 * MiB;
constexpr size_t WS_WGU = 702 * MiB;
constexpr size_t WS_WDN = 830 * MiB;
constexpr size_t WS_WRT = 894 * MiB;
constexpr size_t WS_KFC = 896 * MiB;
constexpr size_t WS_END = 904 * MiB;
constexpr size_t WS_YT = WS_R1 + 192 * MiB;
constexpr int MAXROWS = 4 * T + NE * 256;
constexpr int LDS_BYTES = 147456;

struct Params { const float* in[31]; float* out; unsigned char* ws; int ph_lo, ph_hi; };

__device__ __forceinline__ unsigned f2bf(float f) { unsigned u = __float_as_uint(f); return (u + 0x7fffu + ((u >> 16) & 1u)) >> 16; }
__device__ __forceinline__ unsigned pk2(float lo, float hi) { return f2bf(lo) | (f2bf(hi) << 16); }
__device__ __forceinline__ float bf2f(unsigned h) { return __uint_as_float(h << 16); }
__device__ __forceinline__ float bflo(unsigned w) { return __uint_as_float(w << 16); }
__device__ __forceinline__ float bfhi(unsigned w) { return __uint_as_float(w & 0xffff0000u); }
__device__ __forceinline__ float wave_sum(float v) {
#pragma unroll
    for (int o = 1; o < 64; o <<= 1) v += __shfl_xor(v, o);
    return v;
}
__device__ __forceinline__ float sigmoidf_(float x) { return 1.0f / (1.0f + __expf(-x)); }
__device__ __forceinline__ int crow(int r, int hi) { return (r & 3) + 8 * (r >> 2) + 4 * hi; }

struct Ctx {
    const float* in[31]; float* out; unsigned char* ws;
    int tid, lane, wave, gw, ngw, nblk, blk;
    unsigned char* lds;
};

struct WItem { const float* src; bf16_t* dst; int N; };
__device__ __forceinline__ WItem witem(const Ctx& C, int it) {
    constexpr int I_IN = (D / 64) * (INC / 64), I_HY = (HW / 64) * (D / 64), I_MIX = (D / 64) * (D / 64), I_GU1 = (D / 64) * (2 * D / 64), I_DN1 = (D / 64) * (D / 64);
    const float* W; int N, k0, n0, kd, nd; bf16_t* WT;
    int r = it;
    if (r < NE * I_GU1) { const int e = r / I_GU1, q = r % I_GU1; const int nb = 2 * D / 64; n0 = 64 * (q % nb); k0 = 64 * (q / nb);
        const int s = n0 / 1024, rem = n0 % 1024, j = rem / 128, i0 = rem % 128; nd = 256 * j + 128 * s + i0; kd = k0; N = 2 * D;
        W = C.in[26] + (size_t)e * D * 2 * D; WT = (bf16_t*)(C.ws + WS_WGU) + (size_t)e * 2 * D * D; }
    else if ((r -= NE * I_GU1) < NE * I_DN1) { const int e = r / I_DN1, q = r % I_DN1; const int nb = D / 64; n0 = 64 * (q % nb); k0 = 64 * (q / nb); nd = n0; kd = k0; N = D;
        W = C.in[28] + (size_t)e * D * D; WT = (bf16_t*)(C.ws + WS_WDN) + (size_t)e * D * D; }
    else if ((r -= NE * I_DN1) < I_IN) { const int nb = INC / 64; n0 = 64 * (r % nb); k0 = 64 * (r / nb); nd = n0; kd = k0; N = INC; W = C.in[5]; WT = (bf16_t*)(C.ws + WS_WIN); }
    else if ((r -= I_IN) < I_HY) { const int nb = D / 64; n0 = 64 * (r % nb); k0 = 64 * (r / nb); nd = n0; kd = k0; N = D; W = C.in[20]; WT = (bf16_t*)(C.ws + WS_WCAT); }
    else if ((r -= I_HY) < I_HY) { const int nb = D / 64; n0 = 64 * (r % nb); k0 = 64 * (r / nb); nd = n0; kd = 512 + k0; N = D; W = C.in[21]; WT = (bf16_t*)(C.ws + WS_WCAT); }
    else { r -= I_HY; const int nb = D / 64; n0 = 64 * (r % nb); k0 = 64 * (r / nb); nd = n0; kd = k0; N = D; W = C.in[22]; WT = (bf16_t*)(C.ws + WS_WMIX); }
    WItem w; w.N = N; w.src = W + (size_t)(k0 + (C.lane >> 4)) * N + n0 + 4 * (C.lane & 15); w.dst = WT + (size_t)(nd + (C.lane >> 3)) * D + kd + 8 * (C.lane & 7);
    return w;
}
__device__ __forceinline__ void phase_weights(Ctx& C) {
    float* scr = (float*)(C.lds + C.wave * 16640);
    constexpr int NITEMS = (D / 64) * (INC / 64) + 2 * (HW / 64) * (D / 64) + (D / 64) * (D / 64) + NE * (D / 64) * (2 * D / 64) + NE * (D / 64) * (D / 64);
    const int lane = C.lane;
    int it = C.gw;
    f32x4 v[16], vn[16];
    WItem cur;
    if (it < NITEMS) { cur = witem(C, it);
#pragma unroll
        for (int i = 0; i < 16; ++i) v[i] = *(const f32x4*)(cur.src + (size_t)(4 * i) * cur.N); }
    for (; it < NITEMS; it += C.ngw) {
        const bool more = it + C.ngw < NITEMS; WItem nx = cur;
        if (more) { nx = witem(C, it + C.ngw);
#pragma unroll
            for (int i = 0; i < 16; ++i) vn[i] = *(const f32x4*)(nx.src + (size_t)(4 * i) * nx.N); }
#pragma unroll
        for (int i = 0; i < 16; ++i) { float* d = scr + (4 * i + (lane >> 4)) * 65 + 4 * (lane & 15); d[0] = v[i].x; d[1] = v[i].y; d[2] = v[i].z; d[3] = v[i].w; }
        __builtin_amdgcn_s_waitcnt(0xc07f); asm volatile("" ::: "memory");
        const int c = lane & 7;
#pragma unroll
        for (int j = 0; j < 8; ++j) { const int n = (lane >> 3) + 8 * j; const float* s = scr + (8 * c) * 65 + n;
            u32x4 o; o.x = pk2(s[0 * 65], s[1 * 65]); o.y = pk2(s[2 * 65], s[3 * 65]); o.z = pk2(s[4 * 65], s[5 * 65]); o.w = pk2(s[6 * 65], s[7 * 65]);
            *(u32x4*)(cur.dst + (size_t)(8 * j) * D) = o; }
        __builtin_amdgcn_s_waitcnt(0xc07f); asm volatile("" ::: "memory");
        if (more) {
#pragma unroll
            for (int i = 0; i < 16; ++i) v[i] = vn[i]; }
        cur = nx;
    }
    bf16_t* wrt = (bf16_t*)(C.ws + WS_WRT);
    for (int i = C.blk * NTHREADS + C.tid; i < NE * D; i += C.nblk * NTHREADS) {
        const int e = i / D, k = i % D; const float w = C.in[24][(size_t)k * NE + e];
        const unsigned hi = f2bf(w); const float lo = w - bf2f(hi);
        wrt[(size_t)e * 2048 + k] = (bf16_t)hi; wrt[(size_t)e * 2048 + 1024 + k] = (bf16_t)f2bf(lo);
    }
}

__device__ __forceinline__ void phase_mod(Ctx& C) {
    float* sc = (float*)C.lds;
    float* part = sc + 16 * 1024;
    float* mod = (float*)(C.ws + WS_MOD);
    for (int vb = C.blk; vb < 256; vb += C.nblk) {
        const int j0 = vb * 24;
        __syncthreads();
        for (int i = C.tid; i < 16 * D; i += NTHREADS) { const float c = C.in[1][i]; sc[i] = c / (1.0f + expf(-c)); }
        __syncthreads();
        if (C.tid < 504) {
            const int jj = C.tid % 24, isub = C.tid / 24;
            float acc[16];
#pragma unroll
            for (int b = 0; b < 16; ++b) acc[b] = 0.f;
            const float* w = C.in[2] + j0 + jj;
#pragma unroll 7
            for (int i = isub; i < D; i += 21) { const float wv = w[(size_t)i * 6 * D];
#pragma unroll
                for (int b = 0; b < 16; ++b) acc[b] = fmaf(sc[b * D + i], wv, acc[b]); }
#pragma unroll
            for (int b = 0; b < 16; ++b) part[(isub * 16 + b) * 24 + jj] = acc[b];
        }
        __syncthreads();
        if (C.tid < 384) { const int b = C.tid / 24, jj = C.tid % 24; float a = C.in[3][j0 + jj];
            for (int q = 0; q < 21; ++q) a += part[(q * 16 + b) * 24 + jj];
            mod[b * 6 * D + j0 + jj] = a; }
    }
    __syncthreads();
}

__device__ __forceinline__ void phase_filters(Ctx& C) {
    float* sh = (float*)C.lds;
    float* h3t = sh + 8 * 160;
    float* kfc = (float*)(C.ws + WS_KFC);
    const float* w1 = C.in[9]; const float* b1 = C.in[10]; const float* w2 = C.in[11]; const float* b2 = C.in[12];
    const float* w3 = C.in[13]; const float* b3 = C.in[14]; const float* w4 = C.in[15]; const float* fq = C.in[16];
    const int pl = C.tid >> 6, j = C.tid & 63;
    float* z = sh + pl * 160; float* ha = z + 32; float* hb = ha + 64;
    for (int vb = C.blk; vb < SEQ / 8; vb += C.nblk) {
        const int pos = vb * 8 + pl;
        const float tt = (float)pos / (float)(SEQ - 1);
        const float w = 6.283185307179586f * (float)pos / (float)SEQ;
        __syncthreads();
        if (j < 17) {
            float v;
            if (j == 0) v = tt;
            else { const int i = (j - 1) & 7; const float fr = 1e-4f + (float)i * ((7.0f - 1e-4f) / 7.0f); v = (j <= 8) ? cosf(fr * w) : -sinf(fr * w); }
            z[j] = v;
        }
        __syncthreads();
        { float a = b1[j];
#pragma unroll
          for (int i = 0; i < 17; ++i) a = fmaf(z[i], w1[i * FHID + j], a); ha[j] = sinf(fq[j] * a); }
        __syncthreads();
        { float a = b2[j];
#pragma unroll 32
          for (int i = 0; i < FHID; ++i) a = fmaf(ha[i], w2[i * FHID + j], a); hb[j] = sinf(fq[j] * a); }
        __syncthreads();
        { float a = b3[j];
#pragma unroll 32
          for (int i = 0; i < FHID; ++i) a = fmaf(hb[i], w3[i * FHID + j], a); h3t[j * 8 + pl] = sinf(fq[j] * a); }
        __syncthreads();
        float af[8], ab[8];
#pragma unroll
        for (int p = 0; p < 8; ++p) { af[p] = 0.f; ab[p] = 0.f; }
#pragma unroll 16
        for (int i = 0; i < FHID; ++i) { const float wa = w4[i * 2 * HW + C.tid], wb = w4[i * 2 * HW + HW + C.tid];
            const f32x4 h0 = *(const f32x4*)(h3t + i * 8), h1 = *(const f32x4*)(h3t + i * 8 + 4);
#pragma unroll
            for (int p = 0; p < 4; ++p) { af[p] = fmaf(h0[p], wa, af[p]); af[4 + p] = fmaf(h1[p], wa, af[4 + p]); ab[p] = fmaf(h0[p], wb, ab[p]); ab[4 + p] = fmaf(h1[p], wb, ab[4 + p]); } }
        const float min_decay = logf(1e-2f) / 1.5f, max_decay = logf(1e-2f) / 0.3f;
        const int c = C.tid, pos0 = vb * 8;
        const float adelta = fabsf(min_decay + (float)c * ((max_decay - min_decay) / 511.0f));
#pragma unroll
        for (int p = 0; p < 8; ++p) { const float dec = expf(-((float)(pos0 + p) / (float)(SEQ - 1)) * adelta); af[p] *= dec; ab[p] *= dec; }
        float* dst = kfc + (size_t)c * 4096 + 2048 + pos0;
        *(f32x4*)dst = (f32x4){af[0], af[1], af[2], af[3]}; *(f32x4*)(dst + 4) = (f32x4){af[4], af[5], af[6], af[7]};
        float* dsb = kfc + (size_t)c * 4096 + 2048 - pos0;
#pragma unroll
        for (int p = 0; p < 8; ++p) if (pos0 + p >= 1) dsb[-p] = ab[p];
    }
    __syncthreads();
}

__device__ __forceinline__ void phase_norm1(Ctx& C) {
    const float* mod = (const float*)(C.ws + WS_MOD); bf16_t* h = (bf16_t*)(C.ws + WS_H);
    const float* g = C.in[4];
    for (int row = C.gw; row < T; row += C.ngw) {
        const int b = row / SEQ;
        const f32x4* xr = (const f32x4*)(C.in[0] + (size_t)row * D) + C.lane;
        f32x4 v[4]; float s = 0.f;
#pragma unroll
        for (int j = 0; j < 4; ++j) { v[j] = xr[64 * j]; s += (v[j].x * v[j].x + v[j].y * v[j].y) + (v[j].z * v[j].z + v[j].w * v[j].w); }
        const float rstd = 1.0f / sqrtf(wave_sum(s) * (1.0f / D) + EPS);
        const float* sh = mod + (size_t)b * 6 * D; const float* sc = sh + D;
        u32x2* o = (u32x2*)(h + (size_t)row * D) + C.lane;
#pragma unroll
        for (int j = 0; j < 4; ++j) { const int i0 = 4 * C.lane + 256 * j;
            const f32x4 gg = *(const f32x4*)(g + i0), s1 = *(const f32x4*)(sc + i0), s0 = *(const f32x4*)(sh + i0);
            f32x4 r; r.x = v[j].x * rstd * gg.x * (1.f + s1.x) + s0.x; r.y = v[j].y * rstd * gg.y * (1.f + s1.y) + s0.y;
            r.z = v[j].z * rstd * gg.z * (1.f + s1.z) + s0.z; r.w = v[j].w * rstd * gg.w * (1.f + s1.w) + s0.w;
            u32x2 w; w.x = pk2(r.x, r.y); w.y = pk2(r.z, r.w); o[64 * j] = w; }
    }
}

__device__ __forceinline__ void phase_norm2(Ctx& C) {
    const float* mod = (const float*)(C.ws + WS_MOD); bf16_t* h2 = (bf16_t*)(C.ws + WS_H); bf16_t* h2lo = (bf16_t*)(C.ws + WS_H2LO);
    const float* g = C.in[23];
    for (int row = C.gw; row < T; row += C.ngw) {
        const int b = row / SEQ;
        const f32x4* xr = (const f32x4*)(C.out + (size_t)row * D) + C.lane;
        f32x4 v[4]; float s = 0.f;
#pragma unroll
        for (int j = 0; j < 4; ++j) { v[j] = xr[64 * j]; s += (v[j].x * v[j].x + v[j].y * v[j].y) + (v[j].z * v[j].z + v[j].w * v[j].w); }
        const float rstd = 1.0f / sqrtf(wave_sum(s) * (1.0f / D) + EPS);
        const float* sh = mod + (size_t)b * 6 * D + 3 * D; const float* sc = sh + D;
        u32x2* o = (u32x2*)(h2 + (size_t)row * D) + C.lane; u32x2* ol = (u32x2*)(h2lo + (size_t)row * D) + C.lane;
#pragma unroll
        for (int j = 0; j < 4; ++j) { const int i0 = 4 * C.lane + 256 * j;
            const f32x4 gg = *(const f32x4*)(g + i0), s1 = *(const f32x4*)(sc + i0), s0 = *(const f32x4*)(sh + i0);
            f32x4 r; r.x = v[j].x * rstd * gg.x * (1.f + s1.x) + s0.x; r.y = v[j].y * rstd * gg.y * (1.f + s1.y) + s0.y;
            r.z = v[j].z * rstd * gg.z * (1.f + s1.z) + s0.z; r.w = v[j].w * rstd * gg.w * (1.f + s1.w) + s0.w;
            u32x2 w; w.x = pk2(r.x, r.y); w.y = pk2(r.z, r.w); o[64 * j] = w;
            f32x4 l; l.x = r.x - bflo(w.x); l.y = r.y - bfhi(w.x); l.z = r.z - bflo(w.y); l.w = r.w - bfhi(w.y);
            u32x2 wl; wl.x = pk2(l.x, l.y); wl.y = pk2(l.z, l.w); ol[64 * j] = wl; }
    }
}

__device__ __forceinline__ void phase_final(Ctx& C) {
    const float* mod = (const float*)(C.ws + WS_MOD); const bf16_t* slots = (const bf16_t*)(C.ws + WS_SLOTS);
    const float* g = C.in[30];
    for (int row = C.gw; row < T; row += C.ngw) {
        const int b = row / SEQ;
        f32x4* xr = (f32x4*)(C.out + (size_t)row * D) + C.lane;
        const float* g2 = mod + (size_t)b * 6 * D + 5 * D;
        f32x4 v[4]; float s = 0.f;
#pragma unroll
        for (int j = 0; j < 4; ++j) { const int i0 = 4 * C.lane + 256 * j;
            f32x4 m = {0.f, 0.f, 0.f, 0.f};
#pragma unroll
            for (int k = 0; k < 4; ++k) { const u32x2 w = *(const u32x2*)(slots + ((size_t)row * 4 + k) * D + i0);
                m.x += bflo(w.x); m.y += bfhi(w.x); m.z += bflo(w.y); m.w += bfhi(w.y); }
            const f32x4 gg = *(const f32x4*)(g2 + i0);
            v[j] = xr[64 * j]; v[j].x += gg.x * m.x; v[j].y += gg.y * m.y; v[j].z += gg.z * m.z; v[j].w += gg.w * m.w;
            s += (v[j].x * v[j].x + v[j].y * v[j].y) + (v[j].z * v[j].z + v[j].w * v[j].w); }
        const float rstd = 1.0f / sqrtf(wave_sum(s) * (1.0f / D) + EPS);
#pragma unroll
        for (int j = 0; j < 4; ++j) { const int i0 = 4 * C.lane + 256 * j; const f32x4 gg = *(const f32x4*)(g + i0);
            f32x4 r; r.x = v[j].x * rstd * gg.x; r.y = v[j].y * rstd * gg.y; r.z = v[j].z * rstd * gg.z; r.w = v[j].w * rstd * gg.w; xr[64 * j] = r; }
    }
}

namespace pg8 {
#define PG8_LAS __attribute__((address_space(3)))
constexpr int BM = 256, BK = 64, HALF = 128, HTB = HALF * BK * 2, STAGE_BYTES = 8 * HTB, NXCD = 8, WGM = 8;
__device__ __forceinline__ int lds_byte(int r, int c) { const int st = (r >> 4) * 2 + (c >> 5), rr = r & 15, cc = c & 31, ob = rr * 64 + cc * 2; return st * 1024 + (ob ^ (((ob >> 9) & 1) << 5)); }
__device__ __forceinline__ void stage_rc(int b, int& R, int& C) { const int st = b / 1024, sb = b % 1024, swz = sb ^ (((sb >> 9) & 1) << 5); R = (st >> 1) * 16 + swz / 64; C = (st & 1) * 32 + (swz % 64) / 2; }
__device__ __forceinline__ int perm32(int rho) { const int n = rho >> 4, i = rho & 15; return 8 * (i >> 2) + 4 * n + (i & 3); }
struct Unit { int pm, pn; };
struct Gemm { const bf16_t* A; const bf16_t* Bt; int lda, ldb, K; const int* rowidx; };
struct StaticOrder {
    int nM, nN, nwg, G, c;
    __device__ void init(int nM_, int nN_, int G_, int c_) { nM = nM_; nN = nN_; nwg = nM * nN; G = G_; c = c_; }
    __device__ bool next(int i, Unit& u) const {
        const long L = (long)i * G + c; if (L >= nwg) return false;
        int wgid = (int)L; { const int q = nwg / NXCD, r = nwg % NXCD, xcd = wgid % NXCD, off = wgid / NXCD; wgid = (xcd < r ? xcd * (q + 1) : r * (q + 1) + (xcd - r) * q) + off; }
        const int nig = WGM * nN, gid = wgid / nig, fm = gid * WGM, gsz = (nM - fm) < WGM ? (nM - fm) : WGM;
        u.pm = fm + ((wgid % nig) % gsz); u.pn = (wgid % nig) / gsz; return true;
    }
};
struct MoeOrder {
    StaticOrder b; const int* tileexp; int nN;
    __device__ bool next(int i, Unit& u) const { if (!b.next(i, u)) return false; u.pn = tileexp[u.pm] * nN + u.pn; return true; }
};
__device__ __forceinline__ unsigned cvt_pk_bf16(float lo, float hi) { unsigned r; asm volatile("v_cvt_pk_bf16_f32 %0, %1, %2" : "=v"(r) : "v"(lo), "v"(hi)); return r; }

template <class Epi, class Sched, bool GATHER>
__device__ __forceinline__ void gemm_phase(PG8_LAS unsigned char* lds, const Gemm g, const Sched& S, const Epi& E) {
    const int tid = threadIdx.x, wid = __builtin_amdgcn_readfirstlane(tid >> 6), lane = tid & 63, wr = wid >> 2, wc = wid & 3, fr = lane & 15, fq = lane >> 4;
    const int K = g.K, nt = K / BK;
    int RA[2]; unsigned cA2[2], voffB[2];
#pragma unroll
    for (int i = 0; i < 2; ++i) { int R, C; stage_rc(tid * 16 + i * 8192, R, C); const int Rb = Epi::PERM ? ((R & ~31) + perm32(R & 31)) : R;
        RA[i] = R; cA2[i] = (unsigned)C * 2u; voffB[i] = (unsigned)(Rb * g.ldb + C) * 2u; }
    const unsigned lda2 = (unsigned)g.lda * 2u;
    const size_t kstep = (size_t)(BK * 2);
    const size_t hstep = (size_t)HALF * g.ldb * 2;
    const size_t tstep = 2 * hstep;
    const unsigned ldsw = (unsigned)wid * 1024u;
    const int aoff = lds_byte(wr * 64 + fr, fq * 8), boff = lds_byte(wc * 32 + fr, fq * 8);
#define PG8_SA(b, h) (((b) * 2 + (h)) * HTB)
#define PG8_SB(b, h) ((4 + (b) * 2 + (h)) * HTB)
#define PG8_STAGE(bufoff, gbase, voff) do { _Pragma("unroll") for (int _i = 0; _i < 2; ++_i) \
        __builtin_amdgcn_global_load_lds((const unsigned*)((const char*)(gbase) + (voff)[_i]), (PG8_LAS unsigned*)(lds + (bufoff) + ldsw + _i * 8192), 16, 0, 0); } while (0)
#define PG8_AOFFS(dst, u_) do { _Pragma("unroll") for (int _h = 0; _h < 2; ++_h) _Pragma("unroll") for (int _i = 0; _i < 2; ++_i) { \
        int _row = (u_).pm * BM + _h * HALF + RA[_i]; if (GATHER) { const int _p = g.rowidx[_row]; _row = _p >= 0 ? (_p >> 2) : 0; } \
        dst[_h][_i] = (unsigned)_row * lda2 + cA2[_i]; } } while (0)
#define PG8_LDA(dst, b, h) do { _Pragma("unroll") for (int m = 0; m < 4; ++m) _Pragma("unroll") for (int k = 0; k < 2; ++k) dst[m][k] = *(const PG8_LAS bf16x8*)(lds + PG8_SA(b, h) + aoff + m * 2048 + k * 1024); } while (0)
#define PG8_LDB(dst, b, h) do { _Pragma("unroll") for (int n = 0; n < 2; ++n) _Pragma("unroll") for (int k = 0; k < 2; ++k) dst[n][k] = *(const PG8_LAS bf16x8*)(lds + PG8_SB(b, h) + boff + n * 2048 + k * 1024); } while (0)
#define PG8_MMA(ai, bj, At, Bt) do { __builtin_amdgcn_s_setprio(1); _Pragma("unroll") for (int m = 0; m < 4; ++m) _Pragma("unroll") for (int n = 0; n < 2; ++n) _Pragma("unroll") for (int k = 0; k < 2; ++k) \
        acc[ai][bj][m][n] = __builtin_amdgcn_mfma_f32_16x16x32_bf16(Bt[n][k], At[m][k], acc[ai][bj][m][n], 0, 0, 0); __builtin_amdgcn_s_setprio(0); } while (0)
#define PG8_WAIT_V(n) asm volatile("s_waitcnt vmcnt(" #n ")" ::: "memory")
#define PG8_WAIT_L(n) asm volatile("s_waitcnt lgkmcnt(" #n ")" ::: "memory")
#define PG8_BAR __builtin_amdgcn_s_barrier()
#define PG8_SCHED __builtin_amdgcn_sched_barrier(0)
    Unit cur, nxt; int ui = 0;
    if (!S.next(0, cur)) return;
    f32x4 acc[2][2][4][2];
#pragma unroll
    for (int a = 0; a < 2; ++a)
#pragma unroll
        for (int b = 0; b < 2; ++b)
#pragma unroll
            for (int m = 0; m < 4; ++m)
#pragma unroll
                for (int n = 0; n < 2; ++n) acc[a][b][m][n] = (f32x4){0.f, 0.f, 0.f, 0.f};
    bf16x8 At[4][2], B0[2][2], B1[2][2];
    unsigned cv[2][2], nv[2][2];
    PG8_AOFFS(cv, cur);
    const char* const Ab = (const char*)g.A;
    const char* cB = (const char*)g.Bt + (size_t)cur.pn * tstep;
    PG8_STAGE(PG8_SB(0, 0), cB, voffB); PG8_STAGE(PG8_SB(0, 1), cB + hstep, voffB); PG8_STAGE(PG8_SA(0, 0), Ab, cv[0]); PG8_STAGE(PG8_SA(0, 1), Ab, cv[1]);
    if (wr == 1) PG8_BAR;
    PG8_WAIT_V(2); PG8_BAR;
    PG8_STAGE(PG8_SB(1, 0), cB + kstep, voffB); PG8_STAGE(PG8_SA(1, 0), Ab + kstep, cv[0]); PG8_STAGE(PG8_SB(1, 1), cB + hstep + kstep, voffB);
    PG8_WAIT_V(6); PG8_BAR;
    for (;;) {
        const bool has_next = S.next(ui + 1, nxt);
        if (has_next) { PG8_AOFFS(nv, nxt); } else {
#pragma unroll
            for (int h = 0; h < 2; ++h)
#pragma unroll
                for (int i = 0; i < 2; ++i) nv[h][i] = cv[h][i]; }
        const char* nB = has_next ? (const char*)g.Bt + (size_t)nxt.pn * tstep : cB;
        for (int t = 0; t < nt; t += 2) {
            const bool last = (t == nt - 2);
            const char* a1 = Ab + (size_t)(t + 1) * kstep;
            const char* a2 = last ? Ab : Ab + (size_t)(t + 2) * kstep; const char* b2 = last ? nB : cB + (size_t)(t + 2) * kstep;
            const char* a3 = a2 + kstep; const char* b3 = b2 + kstep;
            unsigned sv[2][2];
#pragma unroll
            for (int h = 0; h < 2; ++h)
#pragma unroll
                for (int i = 0; i < 2; ++i) sv[h][i] = last ? nv[h][i] : cv[h][i];
            PG8_LDB(B0, 0, 0); PG8_LDB(B1, 0, 1); PG8_SCHED; PG8_LDA(At, 0, 0); PG8_STAGE(PG8_SA(1, 1), a1, cv[1]);
            PG8_WAIT_V(8); PG8_WAIT_L(0); PG8_BAR; PG8_MMA(0, 0, At, B0); PG8_MMA(0, 1, At, B1); PG8_BAR; PG8_SCHED;
            PG8_LDA(At, 0, 1); PG8_STAGE(PG8_SB(0, 0), b2, voffB); PG8_STAGE(PG8_SB(0, 1), b2 + hstep, voffB); PG8_STAGE(PG8_SA(0, 0), a2, sv[0]);
            PG8_WAIT_V(8); PG8_WAIT_L(0); PG8_BAR; PG8_MMA(1, 0, At, B0); PG8_MMA(1, 1, At, B1); PG8_BAR; PG8_SCHED;
            PG8_LDB(B0, 1, 0); PG8_LDB(B1, 1, 1); PG8_SCHED; PG8_LDA(At, 1, 0); PG8_STAGE(PG8_SA(0, 1), a2, sv[1]);
            PG8_WAIT_V(8); PG8_WAIT_L(0); PG8_BAR; PG8_MMA(0, 0, At, B0); PG8_MMA(0, 1, At, B1); PG8_BAR; PG8_SCHED;
            PG8_LDA(At, 1, 1); PG8_STAGE(PG8_SB(1, 0), b3, voffB); PG8_STAGE(PG8_SB(1, 1), b3 + hstep, voffB); PG8_STAGE(PG8_SA(1, 0), a3, sv[0]);
            PG8_WAIT_V(8); PG8_WAIT_L(0); PG8_BAR; PG8_MMA(1, 0, At, B0); PG8_MMA(1, 1, At, B1); PG8_BAR; PG8_SCHED;
        }
        if (wr == 0) PG8_BAR;
        E(acc, cur, wr, wc, fr, fq);
        if (!has_next) break;
#pragma unroll
        for (int a = 0; a < 2; ++a)
#pragma unroll
            for (int b = 0; b < 2; ++b)
#pragma unroll
                for (int m = 0; m < 4; ++m)
#pragma unroll
                    for (int n = 0; n < 2; ++n) acc[a][b][m][n] = (f32x4){0.f, 0.f, 0.f, 0.f};
        cur = nxt; cB = nB; ++ui;
#pragma unroll
        for (int h = 0; h < 2; ++h)
#pragma unroll
            for (int i = 0; i < 2; ++i) cv[h][i] = nv[h][i];
        if (wr == 1) PG8_BAR;
    }
    PG8_WAIT_V(0);
    PG8_BAR;
#undef PG8_SA
#undef PG8_SB
#undef PG8_STAGE
#undef PG8_AOFFS
#undef PG8_LDA
#undef PG8_LDB
#undef PG8_MMA
#undef PG8_WAIT_V
#undef PG8_WAIT_L
#undef PG8_BAR
#undef PG8_SCHED
}

__device__ __forceinline__ u32x4 pack8(const f32x4& v0, const f32x4& v1) { u32x4 w; w.x = cvt_pk_bf16(v0[0], v0[1]); w.y = cvt_pk_bf16(v0[2], v0[3]); w.z = cvt_pk_bf16(v1[0], v1[1]); w.w = cvt_pk_bf16(v1[2], v1[3]); return w; }
__device__ __forceinline__ void unpack8(const u32x4& w, f32x4& v0, f32x4& v1) { v0 = (f32x4){bflo(w.x), bfhi(w.x), bflo(w.y), bfhi(w.y)}; v1 = (f32x4){bflo(w.z), bfhi(w.z), bflo(w.w), bfhi(w.w)}; }
__device__ __forceinline__ float fsig(float x) { return __builtin_amdgcn_rcpf(1.0f + __builtin_amdgcn_exp2f(-LOG2E * x)); }

struct EpiInproj {
    static constexpr bool PERM = true;
    bf16_t* U; const float* bias;
    __device__ __forceinline__ void operator()(const f32x4 (&acc)[2][2][4][2], const Unit& u, int wr, int wc, int fr, int fq) const {
        const int row0 = u.pm * BM + wr * 64 + fr, col0 = u.pn * BM + wc * 32 + 8 * fq; const bool sig = u.pn >= 12; const float qs = (u.pn == 6 || u.pn == 7) ? QSCALE : 1.0f;
        f32x4 bv[2][2];
#pragma unroll
        for (int bj = 0; bj < 2; ++bj)
#pragma unroll
            for (int n = 0; n < 2; ++n) bv[bj][n] = *(const f32x4*)(bias + col0 + bj * HALF + 4 * n);
#pragma unroll
        for (int ai = 0; ai < 2; ++ai)
#pragma unroll
            for (int m = 0; m < 4; ++m) { bf16_t* rowp = U + (size_t)(row0 + ai * HALF + m * 16) * INC + col0;
#pragma unroll
                for (int bj = 0; bj < 2; ++bj) { f32x4 v0 = (acc[ai][bj][m][0] + bv[bj][0]) * qs, v1 = (acc[ai][bj][m][1] + bv[bj][1]) * qs;
                    if (sig) {
#pragma unroll
                        for (int i = 0; i < 4; ++i) { v0[i] = fsig(v0[i]); v1[i] = fsig(v1[i]); } }
                    *(u32x4*)(rowp + bj * HALF) = pack8(v0, v1); } }
    }
};
template <int P> struct EpiCat {
    static constexpr bool PERM = true;
    bf16_t* Mg; const bf16_t* U;
    __device__ __forceinline__ void operator()(const f32x4 (&acc)[2][2][4][2], const Unit& u, int wr, int wc, int fr, int fq) const {
        const int row0 = u.pm * BM + wr * 64 + fr, col0 = u.pn * BM + wc * 32 + 8 * fq;
#pragma unroll
        for (int ai = 0; ai < 2; ++ai)
#pragma unroll
            for (int m = 0; m < 4; ++m) { const size_t row = (size_t)(row0 + ai * HALF + m * 16);
#pragma unroll
                for (int bj = 0; bj < 2; ++bj) { const u32x4 gw = *(const u32x4*)(U + row * INC + GOFF + P * D + col0 + bj * HALF);
                    f32x4 g0, g1; unpack8(gw, g0, g1); f32x4 v0 = acc[ai][bj][m][0] * g0, v1 = acc[ai][bj][m][1] * g1;
                    bf16_t* mp = Mg + row * D + col0 + bj * HALF;
                    if (P == 1) { const u32x4 tw = *(const u32x4*)mp; f32x4 t0, t1; unpack8(tw, t0, t1); v0 += t0; v1 += t1; }
                    *(u32x4*)mp = pack8(v0, v1); } }
    }
};
struct EpiMix {
    static constexpr bool PERM = false;
    const float* X; float* O; const float* mod;
    __device__ __forceinline__ void operator()(const f32x4 (&acc)[2][2][4][2], const Unit& u, int wr, int wc, int fr, int fq) const {
        const int row0 = u.pm * BM + wr * 64 + fr, col0 = u.pn * BM + wc * 32 + 4 * fq; const int b = (u.pm * BM) / SEQ;
        f32x4 gv[2][2];
#pragma unroll
        for (int bj = 0; bj < 2; ++bj)
#pragma unroll
            for (int n = 0; n < 2; ++n) gv[bj][n] = *(const f32x4*)(mod + (size_t)b * 6 * D + 2 * D + col0 + bj * HALF + n * 16);
#pragma unroll
        for (int ai = 0; ai < 2; ++ai)
#pragma unroll
            for (int m = 0; m < 4; ++m) { const size_t off = (size_t)(row0 + ai * HALF + m * 16) * D + col0;
#pragma unroll
                for (int bj = 0; bj < 2; ++bj)
#pragma unroll
                    for (int n = 0; n < 2; ++n) *(f32x4*)(O + off + bj * HALF + n * 16) = *(const f32x4*)(X + off + bj * HALF + n * 16) + gv[bj][n] * acc[ai][bj][m][n]; }
    }
};
struct EpiGateUp {
    static constexpr bool PERM = true;
    bf16_t* Act; const float* bgu;
    __device__ __forceinline__ void operator()(const f32x4 (&acc)[2][2][4][2], const Unit& u, int wr, int wc, int fr, int fq) const {
        const int e = u.pn >> 3, j = u.pn & 7; const int row0 = u.pm * BM + wr * 64 + fr, col0 = 128 * j + wc * 32 + 8 * fq;
        f32x4 bg[2], bu[2];
#pragma unroll
        for (int n = 0; n < 2; ++n) { bg[n] = *(const f32x4*)(bgu + (size_t)e * 2 * D + col0 + 4 * n); bu[n] = *(const f32x4*)(bgu + (size_t)e * 2 * D + D + col0 + 4 * n); }
#pragma unroll
        for (int ai = 0; ai < 2; ++ai)
#pragma unroll
            for (int m = 0; m < 4; ++m) { f32x4 r[2];
#pragma unroll
                for (int n = 0; n < 2; ++n) { const f32x4 gt = acc[ai][0][m][n] + bg[n], up = acc[ai][1][m][n] + bu[n];
#pragma unroll
                    for (int i = 0; i < 4; ++i) { const float gg = fminf(gt[i], 7.0f), uu = fminf(fmaxf(up[i], -7.0f), 7.0f); r[n][i] = (uu + 1.0f) * (gg * fsig(1.702f * gg)); } }
                *(u32x4*)(Act + (size_t)(row0 + ai * HALF + m * 16) * D + col0) = pack8(r[0], r[1]); }
    }
};
struct EpiDown {
    static constexpr bool PERM = true;
    bf16_t* Slots; const float* bd; const int* rowpair; const float* topw;
    __device__ __forceinline__ void operator()(const f32x4 (&acc)[2][2][4][2], const Unit& u, int wr, int wc, int fr, int fq) const {
        const int e = u.pn >> 2, j = u.pn & 3; const int row0 = u.pm * BM + wr * 64 + fr, col0 = 256 * j + wc * 32 + 8 * fq;
        f32x4 bv[2][2];
#pragma unroll
        for (int bj = 0; bj < 2; ++bj)
#pragma unroll
            for (int n = 0; n < 2; ++n) bv[bj][n] = *(const f32x4*)(bd + (size_t)e * D + col0 + bj * HALF + 4 * n);
#pragma unroll
        for (int ai = 0; ai < 2; ++ai)
#pragma unroll
            for (int m = 0; m < 4; ++m) { const int p = rowpair[row0 + ai * HALF + m * 16];
                if (p >= 0) { const float w = topw[p];
#pragma unroll
                    for (int bj = 0; bj < 2; ++bj) { const f32x4 v0 = (acc[ai][bj][m][0] + bv[bj][0]) * w, v1 = (acc[ai][bj][m][1] + bv[bj][1]) * w;
                        *(u32x4*)(Slots + (size_t)p * D + col0 + bj * HALF) = pack8(v0, v1); } } }
    }
};
}

#define LASP __attribute__((address_space(3)))
__device__ __forceinline__ void glds16(const void* gsrc, unsigned lds_dst) { unsigned keep;
    asm volatile("s_mov_b32 %0, m0\n\ts_mov_b32 m0, %2\n\ts_nop 0\n\tglobal_load_lds_dwordx4 %1, off\n\ts_mov_b32 m0, %0" : "=&s"(keep) : "v"(gsrc), "s"(lds_dst) : "memory"); }
__device__ __forceinline__ void glds16s(const void* sbase, unsigned voff, unsigned lds_dst) { unsigned keep;
    asm volatile("s_nop 4\n\ts_mov_b32 %0, m0\n\ts_mov_b32 m0, %3\n\ts_nop 0\n\tglobal_load_lds_dwordx4 %1, %2\n\ts_mov_b32 m0, %0" : "=&s"(keep) : "v"(voff), "s"(sbase), "s"(lds_dst) : "memory"); }
typedef short v4i16_t __attribute__((ext_vector_type(4)));
__device__ __forceinline__ s16x4 vtr(const LASP char* p) { return __builtin_bit_cast(s16x4, __builtin_amdgcn_ds_read_tr16_b64_v4i16((LASP v4i16_t*)p)); }
__device__ __forceinline__ unsigned cvtpk(float lo, float hi) { unsigned r; asm volatile("v_cvt_pk_bf16_f32 %0, %1, %2" : "=v"(r) : "v"(lo), "v"(hi)); return r; }

__device__ __forceinline__ void phase_attn_fast(Ctx& C) {
    const bf16_t* u = (const bf16_t*)(C.ws + WS_U); bf16_t* ycat = (bf16_t*)(C.ws + WS_YCAT);
    const int lane = C.lane, l31 = lane & 31, hi = lane >> 5, wave = C.wave;
    float* park = (float*)(C.ws + WS_H2LO) + (size_t)C.gw * 4096 + lane;
    const float* lq = C.in[18];
    const float d1 = wave_sum(lq[lane] * lq[64 + lane]), d2 = wave_sum(lq[128 + lane] * lq[192 + lane]);
    const float lam_init = 0.2f;
    const float lam = expf(d1) - expf(d2) + lam_init;
    const float* sg = C.in[19];
    const unsigned lds0 = (unsigned)(uintptr_t)C.lds;
    const LASP char* ldsp = (const LASP char*)C.lds;
    constexpr int SLOT = 24576;
    const int krow = 8 * wave + (lane >> 3), kchunk = (lane & 7) ^ (lane >> 3);
    const int st0 = 4 * wave + (lane >> 5), st1 = st0 + 2;
    const int vrow = (lane & 31) >> 2, vch = lane & 3;
    const unsigned koffb = (unsigned)((krow * INC + kchunk * 8) * 2);
    const unsigned voffb0 = (unsigned)(((8 * (st0 >> 2) + vrow) * INC + 32 * (st0 & 3) + 8 * vch) * 2);
    const unsigned voffb1 = (unsigned)(((8 * (st1 >> 2) + vrow) * INC + 32 * (st1 & 3) + 8 * vch) * 2);
    const int koff0 = l31 * 128, kx = l31 & 7;
    const int vboff = 8192 + (4 * hi + ((lane & 15) >> 2)) * 64 + ((lane >> 4) & 1) * 32 + (lane & 3) * 8;
    const int vcu = (C.nblk % 8 == 0) ? (C.blk % 8) * (C.nblk / 8) + C.blk / 8 : C.blk;
    for (int idx = vcu; idx < 256; idx += C.nblk)
#pragma unroll 1
    for (int sub = 0; sub < 2; ++sub) {
        const int b = idx >> 4, hA = (idx >> 3) & 1, qb = idx & 7; const int hh = sub ? 3 - hA : hA;
        const int q0 = qb * 256 + wave * 32;
        const float slope2 = exp2f(-2.0f * (float)(hh + 1)) * LOG2E;
        const float qpos = (float)(q0 + l31 - 4 * hi);
        const bf16_t* qrow = u + (size_t)(b * SEQ + q0 + l31) * INC + QOFF + hh * 128;
        const bf16_t* kgb = u + (size_t)(b * SEQ) * INC + KOFF + hh * 128;
        const bf16_t* vgb = u + (size_t)(b * SEQ) * INC + VOFF + hh * 128;
        const int t0 = qb * 4;
#pragma unroll 1
        for (int c = 0; c < 2; ++c) {
            const bf16_t* kgc = kgb + c * 64;
#define ATT_DMA(t, sl) do { const size_t _o = (size_t)(t) * 64 * INC; const unsigned _b = lds0 + (unsigned)(sl) * SLOT; \
        glds16s(kgc + _o, koffb, (unsigned)__builtin_amdgcn_readfirstlane(_b + wave * 1024)); \
        glds16s(vgb + _o, voffb0, (unsigned)__builtin_amdgcn_readfirstlane(_b + 8192 + (2 * wave) * 1024)); \
        glds16s(vgb + _o, voffb1, (unsigned)__builtin_amdgcn_readfirstlane(_b + 8192 + (2 * wave + 1) * 1024)); } while (0)
#define ATT_WAITBAR() asm volatile("s_waitcnt vmcnt(0) lgkmcnt(0)\n\ts_barrier" ::: "memory")
#define ATT_QK(P0, P1, sl) do { const LASP char* Kb_ = ldsp + (sl) * SLOT + koff0; P0 = negm; P1 = negm; \
        _Pragma("unroll") for (int ks = 0; ks < 4; ++ks) { \
            const bf16x8 kf0_ = *(const LASP bf16x8*)(Kb_ + (((2 * ks + hi) ^ kx) * 16)); \
            const bf16x8 kf1_ = *(const LASP bf16x8*)(Kb_ + 4096 + (((2 * ks + hi) ^ kx) * 16)); \
            P0 = __builtin_amdgcn_mfma_f32_32x32x16_bf16(kf0_, qf[ks], P0, 0, 0, 0); P1 = __builtin_amdgcn_mfma_f32_32x32x16_bf16(kf1_, qf[ks], P1, 0, 0, 0); } } while (0)
#define ATT_SMPV(P0, P1, PN0, PN1, tt, sl) do { \
        const float a_ = qpos - (float)((tt) * 64); float rm = -1e30f; \
        _Pragma("unroll") for (int r = 0; r < 16; ++r) { const float x0 = a_ - (float)crow(r, 0); P0[r] = fmaf(fabsf(x0), -slope2, P0[r]); P1[r] = fmaf(fabsf(x0 - 32.0f), -slope2, P1[r]); rm = fmaxf(rm, fmaxf(P0[r], P1[r])); } \
        { auto rr = __builtin_amdgcn_permlane32_swap(__float_as_uint(rm), __float_as_uint(rm), false, false); rm = fmaxf(__uint_as_float(rr[0]), __uint_as_float(rr[1])); } \
        if (!__all(rm < mrel - 40.0f)) {        \
            mrel = fmaxf(mrel, rm); \
            if (__any(rm > 8.0f)) { const float dl = fmaxf(rm, 0.f); mhat += dl; mrel -= dl; \
                _Pragma("unroll") for (int r = 0; r < 16; ++r) { P0[r] -= dl; P1[r] -= dl; PN0[r] -= dl; PN1[r] -= dl; negm[r] = -mhat; } \
                const float f = exp2f(-dl); lsum *= f; \
                _Pragma("unroll") for (int eb = 0; eb < 4; ++eb) _Pragma("unroll") for (int r = 0; r < 16; ++r) o[eb][r] *= f; } \
            float ps = 0.f; \
            _Pragma("unroll") for (int r = 0; r < 16; ++r) { P0[r] = __builtin_amdgcn_exp2f(P0[r]); P1[r] = __builtin_amdgcn_exp2f(P1[r]); ps += P0[r] + P1[r]; } \
            lsum += ps; \
            bf16x8 pf[4]; \
            _Pragma("unroll") for (int s2 = 0; s2 < 2; ++s2) { \
                u32x4 w_; w_.x = cvtpk(P0[8 * s2 + 0], P0[8 * s2 + 1]); w_.y = cvtpk(P0[8 * s2 + 2], P0[8 * s2 + 3]); w_.z = cvtpk(P0[8 * s2 + 4], P0[8 * s2 + 5]); w_.w = cvtpk(P0[8 * s2 + 6], P0[8 * s2 + 7]); pf[s2] = __builtin_bit_cast(bf16x8, w_); \
                u32x4 v_; v_.x = cvtpk(P1[8 * s2 + 0], P1[8 * s2 + 1]); v_.y = cvtpk(P1[8 * s2 + 2], P1[8 * s2 + 3]); v_.z = cvtpk(P1[8 * s2 + 4], P1[8 * s2 + 5]); v_.w = cvtpk(P1[8 * s2 + 6], P1[8 * s2 + 7]); pf[2 + s2] = __builtin_bit_cast(bf16x8, v_); } \
            const LASP char* Vb_ = ldsp + (sl) * SLOT + vboff; \
            _Pragma("unroll") for (int eb = 0; eb < 4; ++eb) _Pragma("unroll") for (int s = 0; s < 4; ++s) { \
                const s16x4 lo_ = vtr(Vb_ + s * 4096 + eb * 512), h4_ = vtr(Vb_ + s * 4096 + 2048 + eb * 512); \
                const bf16x8 vf_ = (bf16x8){lo_[0], lo_[1], lo_[2], lo_[3], h4_[0], h4_[1], h4_[2], h4_[3]}; \
                o[eb] = __builtin_amdgcn_mfma_f32_32x32x16_bf16(vf_, pf[s], o[eb], 0, 0, 0); } \
        } } while (0)
            ATT_DMA(t0, 0);
            bf16x8 qf[4];
#pragma unroll
            for (int ks = 0; ks < 4; ++ks) qf[ks] = *(const bf16x8*)(qrow + c * 64 + 16 * ks + 8 * hi);
            f32x16 o[4];
#pragma unroll
            for (int eb = 0; eb < 4; ++eb)
#pragma unroll
                for (int r = 0; r < 16; ++r) o[eb][r] = 0.f;
            float mhat = 0.f, lsum = 0.f, mrel = -1e30f;
            f32x16 negm;
#pragma unroll
            for (int r = 0; r < 16; ++r) negm[r] = 0.f;
            f32x16 pA0, pA1, pB0, pB1;
            ATT_WAITBAR();
            ATT_DMA((t0 + 1) & 31, 1);
            ATT_QK(pA0, pA1, 0);
            int sl_cur = 0, sl_nxt = 1, sl_fill = 2;
#pragma unroll 1
            for (int i = 0; i < 32; i += 2) {
                ATT_WAITBAR();
                if (i + 2 < 32) ATT_DMA((t0 + i + 2) & 31, sl_fill);
                ATT_QK(pB0, pB1, sl_nxt);
                ATT_SMPV(pA0, pA1, pB0, pB1, (t0 + i) & 31, sl_cur);
                { const int t_ = sl_cur; sl_cur = sl_nxt; sl_nxt = sl_fill; sl_fill = t_; }
                ATT_WAITBAR();
                if (i + 3 < 32) ATT_DMA((t0 + i + 3) & 31, sl_fill);
                if (i + 2 < 32) ATT_QK(pA0, pA1, sl_nxt);
                ATT_SMPV(pB0, pB1, pA0, pA1, (t0 + i + 1) & 31, sl_cur);
                { const int t_ = sl_cur; sl_cur = sl_nxt; sl_nxt = sl_fill; sl_fill = t_; }
            }
#undef ATT_DMA
#undef ATT_QK
#undef ATT_SMPV
            { auto rr = __builtin_amdgcn_permlane32_swap(__float_as_uint(lsum), __float_as_uint(lsum), false, false); lsum = __uint_as_float(rr[0]) + __uint_as_float(rr[1]); }
            const float inv = 1.0f / lsum;
            float* pk = park; asm volatile("" : "+v"(pk));
            if (c == 0) {
#pragma unroll
                for (int eb = 0; eb < 4; ++eb)
#pragma unroll
                    for (int r = 0; r < 16; ++r) pk[(eb * 16 + r) * 64] = o[eb][r] * inv;
            } else {
                float ss = 0.f;
#pragma unroll
                for (int eb = 0; eb < 4; ++eb)
#pragma unroll
                    for (int r = 0; r < 16; ++r) { const float y = pk[(eb * 16 + r) * 64] - lam * (o[eb][r] * inv); o[eb][r] = y; ss += y * y; }
                { auto rr = __builtin_amdgcn_permlane32_swap(__float_as_uint(ss), __float_as_uint(ss), false, false); ss = __uint_as_float(rr[0]) + __uint_as_float(rr[1]); }
                const float rinv = 1.0f / sqrtf(ss * (1.0f / 128.0f) + EPS) * (1.0f - lam_init);
                bf16_t* orow = ycat + (size_t)(b * SEQ + q0 + l31) * D + 512 + hh * 128 + 4 * hi;
#pragma unroll
                for (int eb = 0; eb < 4; ++eb)
#pragma unroll
                    for (int g4 = 0; g4 < 4; ++g4) { const int e = 32 * eb + 8 * g4;
                        const f32x4 gg = *(const f32x4*)(sg + e + 4 * hi);
                        u32x2 w; w.x = cvtpk(o[eb][4 * g4] * rinv * gg.x, o[eb][4 * g4 + 1] * rinv * gg.y); w.y = cvtpk(o[eb][4 * g4 + 2] * rinv * gg.z, o[eb][4 * g4 + 3] * rinv * gg.w);
                        *(u32x2*)(orow + e) = w; }
            }
        }
    }
    ATT_WAITBAR();
#undef ATT_WAITBAR
}

__device__ __forceinline__ void phase_hy_pre_fast(Ctx& C) {
    const bf16_t* u = (const bf16_t*)(C.ws + WS_U); bf16_t* vpt = (bf16_t*)(C.ws + WS_VP); bf16_t* x0t = (bf16_t*)(C.ws + WS_X0C);
    const float* cw = C.in[7]; const float* cb = C.in[8];
    bf16_t* sv = (bf16_t*)C.lds; bf16_t* sx = sv + 64 * 72;
    const int tl = C.tid >> 3, c8 = C.tid & 7;
    for (int tile = C.blk; tile < NB * 32 * 8; tile += C.nblk) {
        const int cq = tile & 7, tq = (tile >> 3) & 31, b = tile >> 8;
        const int c0 = cq * 64 + c8 * 8, t = tq * 64 + tl; const size_t row = (size_t)b * SEQ + t;
        float r[3][8];
#pragma unroll
        for (int s = 0; s < 3; ++s) {
            const int ch = s * HW + c0;
            const u32x4 z = {0u, 0u, 0u, 0u};
            const u32x4 um = (t > 0) ? *(const u32x4*)(u + (row - 1) * INC + ch) : z, u0 = *(const u32x4*)(u + row * INC + ch), up = (t < SEQ - 1) ? *(const u32x4*)(u + (row + 1) * INC + ch) : z;
            f32x4 m0, m1, z0, z1, p0, p1; pg8::unpack8(um, m0, m1); pg8::unpack8(u0, z0, z1); pg8::unpack8(up, p0, p1);
            const f32x4 w00 = *(const f32x4*)(cw + ch), w01 = *(const f32x4*)(cw + ch + 4), w10 = *(const f32x4*)(cw + 3 * HW + ch), w11 = *(const f32x4*)(cw + 3 * HW + ch + 4);
            const f32x4 w20 = *(const f32x4*)(cw + 6 * HW + ch), w21 = *(const f32x4*)(cw + 6 * HW + ch + 4), bb0 = *(const f32x4*)(cb + ch), bb1 = *(const f32x4*)(cb + ch + 4);
            const f32x4 a0 = m0 * w00 + z0 * w10 + p0 * w20 + bb0, a1 = m1 * w01 + z1 * w11 + p1 * w21 + bb1;
#pragma unroll
            for (int i = 0; i < 4; ++i) { r[s][i] = a0[i]; r[s][4 + i] = a1[i]; }
        }
        __syncthreads();
#pragma unroll
        for (int i = 0; i < 8; ++i) { sx[(c8 * 8 + i) * 72 + tl] = (bf16_t)f2bf(r[0][i]); sv[(c8 * 8 + i) * 72 + tl] = (bf16_t)f2bf(r[2][i] * r[1][i]); }
        __syncthreads();
        { const int cl = C.tid >> 3, chk = C.tid & 7; const size_t o = ((size_t)(cq * 64 + cl) * NB + b) * SEQ + tq * 64 + chk * 8;
          *(u32x4*)(vpt + o) = *(const u32x4*)(sv + cl * 72 + chk * 8); *(u32x4*)(x0t + o) = *(const u32x4*)(sx + cl * 72 + chk * 8); }
    }
    __syncthreads();
}

__device__ __forceinline__ void phase_toeplitz(Ctx& C) {
    constexpr int VROW = 4096 + 16, FCOPY = 8192 + 32, FL = 16 * VROW;
    const bf16_t* vpt = (const bf16_t*)(C.ws + WS_VP); const bf16_t* x0t = (const bf16_t*)(C.ws + WS_X0C); bf16_t* yt = (bf16_t*)(C.ws + WS_YT);
    const float* kfc = (const float*)(C.ws + WS_KFC); const float* dsk = C.in[17];
    const int lane = C.lane, a = lane & 15, g = lane >> 4, wave = C.wave;
    const unsigned lds0 = (unsigned)(uintptr_t)C.lds;
    const LASP char* ldsp = (const LASP char*)C.lds;
    const int t0 = 256 * wave;
    const int c0 = 2048 - t0 + 8 * g - a;
    const LASP char* fbase = ldsp + FL + (c0 & 7) * FCOPY + 2 * (c0 & ~7);
    const LASP char* vbase = ldsp + a * VROW + 16 * g;
    for (int c = C.blk; c < HW; c += C.nblk) {
        asm volatile("s_waitcnt vmcnt(0) lgkmcnt(0)\n\ts_barrier" ::: "memory");
        { const char* src = (const char*)(vpt + (size_t)c * NB * SEQ) + lane * 16;
#pragma unroll
          for (int j = 0; j < 8; ++j) { const int p = wave * 8 + j;
              glds16(src + (size_t)p * 1024, (unsigned)__builtin_amdgcn_readfirstlane(lds0 + (p >> 2) * VROW + (p & 3) * 1024)); } }
        { const int q = C.tid; const float* kc = kfc + (size_t)c * 4096; float f[15];
#pragma unroll
          for (int i = 0; i < 15; ++i) { const int idx = 4096 - 8 * q - i; f[i] = (idx >= 1 && idx <= 4095) ? kc[idx] : 0.f; }
#pragma unroll
          for (int m = 0; m < 8; ++m) { u32x4 w; w.x = pk2(f[m], f[m + 1]); w.y = pk2(f[m + 2], f[m + 3]); w.z = pk2(f[m + 4], f[m + 5]); w.w = pk2(f[m + 6], f[m + 7]);
              *(LASP u32x4*)((LASP char*)C.lds + FL + m * FCOPY + q * 16) = w; } }
        asm volatile("s_waitcnt vmcnt(0) lgkmcnt(0)\n\ts_barrier" ::: "memory");
        f32x4 acc[16]; bf16x8 W[16];
#pragma unroll
        for (int r = 0; r < 16; ++r) { acc[r] = (f32x4){0.f, 0.f, 0.f, 0.f}; W[r] = *(const LASP bf16x8*)(fbase - 32 * r); }
#pragma unroll 1
        for (int ko = 0; ko < 8; ++ko) {
            const LASP char* fb = fbase + ko * 512; const LASP char* vb = vbase + ko * 512;
#pragma unroll
            for (int kk = 0; kk < 8; ++kk) {
                const bf16x8 Bf = *(const LASP bf16x8*)(vb + 64 * kk);
#pragma unroll
                for (int r = 0; r < 16; ++r) acc[r] = __builtin_amdgcn_mfma_f32_16x16x32_bf16(W[(r - 2 * kk) & 15], Bf, acc[r], 0, 0, 0);
                if (ko < 7 || kk < 7) { W[(-2 * kk - 2) & 15] = *(const LASP bf16x8*)(fb + 64 * kk + 64); W[(-2 * kk - 1) & 15] = *(const LASP bf16x8*)(fb + 64 * kk + 32); }
            }
        }
        const float dd = dsk[c];
#pragma unroll
        for (int r = 0; r < 16; ++r) { const int t = t0 + 16 * r + 4 * g; const size_t o = ((size_t)c * NB + a) * SEQ + t;
            const u32x2 vv = *(const LASP u32x2*)(ldsp + a * VROW + t * 2); const u32x2 xx = *(const u32x2*)(x0t + o);
            const float y0 = (acc[r][0] + bflo(vv.x) * dd) * bflo(xx.x), y1 = (acc[r][1] + bfhi(vv.x) * dd) * bfhi(xx.x);
            const float y2 = (acc[r][2] + bflo(vv.y) * dd) * bflo(xx.y), y3 = (acc[r][3] + bfhi(vv.y) * dd) * bfhi(xx.y);
            u32x2 w; w.x = pk2(y0, y1); w.y = pk2(y2, y3); *(u32x2*)(yt + o) = w; }
    }
    asm volatile("s_waitcnt vmcnt(0) lgkmcnt(0)\n\ts_barrier" ::: "memory");
}

__device__ __forceinline__ void phase_hy_post(Ctx& C) {
    const bf16_t* yt = (const bf16_t*)(C.ws + WS_YT); bf16_t* ycat = (bf16_t*)(C.ws + WS_YCAT);
    bf16_t* sy = (bf16_t*)C.lds;
    for (int tile = C.blk; tile < NB * 32 * 8; tile += C.nblk) {
        const int cq = tile & 7, tq = (tile >> 3) & 31, b = tile >> 8;
        __syncthreads();
        { const int cl = C.tid >> 3, chk = C.tid & 7; *(u32x4*)(sy + cl * 72 + chk * 8) = *(const u32x4*)(yt + ((size_t)(cq * 64 + cl) * NB + b) * SEQ + tq * 64 + chk * 8); }
        __syncthreads();
        { const int tl = C.tid >> 3, c8 = C.tid & 7; unsigned short e[8];
#pragma unroll
          for (int i = 0; i < 8; ++i) e[i] = sy[(c8 * 8 + i) * 72 + tl];
          u32x4 w; w.x = e[0] | ((unsigned)e[1] << 16); w.y = e[2] | ((unsigned)e[3] << 16); w.z = e[4] | ((unsigned)e[5] << 16); w.w = e[6] | ((unsigned)e[7] << 16);
          *(u32x4*)(ycat + ((size_t)b * SEQ + tq * 64 + tl) * D + cq * 64 + c8 * 8) = w; }
    }
    __syncthreads();
}

__device__ __forceinline__ void phase_router(Ctx& C) {
    const bf16_t* h2 = (const bf16_t*)(C.ws + WS_H); const bf16_t* h2lo = (const bf16_t*)(C.ws + WS_H2LO); const bf16_t* wrt = (const bf16_t*)(C.ws + WS_WRT);
    float* logits = (float*)(C.ws + WS_LOGITS);
    const int fr = C.lane & 15, fq = C.lane >> 4;
    for (int tile = C.gw; tile < T / 16; tile += C.ngw) {
        f32x4 acc[2]; acc[0] = (f32x4){0.f, 0.f, 0.f, 0.f}; acc[1] = acc[0];
        const bf16_t* ah = h2 + (size_t)(tile * 16 + fr) * D + fq * 8; const bf16_t* al = h2lo + (size_t)(tile * 16 + fr) * D + fq * 8;
        for (int k = 0; k < D; k += 32) {
            const bf16x8 a_h = *(const bf16x8*)(ah + k), a_l = *(const bf16x8*)(al + k);
#pragma unroll
            for (int n = 0; n < 2; ++n) { const bf16_t* bp = wrt + (size_t)(n * 16 + fr) * 2048 + fq * 8 + k;
                const bf16x8 b_h = *(const bf16x8*)(bp), b_l = *(const bf16x8*)(bp + 1024);
                acc[n] = __builtin_amdgcn_mfma_f32_16x16x32_bf16(b_h, a_h, acc[n], 0, 0, 0);
                acc[n] = __builtin_amdgcn_mfma_f32_16x16x32_bf16(b_h, a_l, acc[n], 0, 0, 0);
                acc[n] = __builtin_amdgcn_mfma_f32_16x16x32_bf16(b_l, a_h, acc[n], 0, 0, 0); }
        }
#pragma unroll
        for (int n = 0; n < 2; ++n) *(f32x4*)(logits + (size_t)(tile * 16 + fr) * NE + n * 16 + 4 * fq) = acc[n];
    }
}

__device__ __forceinline__ void phase_top4(Ctx& C) {
    const float* logits = (const float*)(C.ws + WS_LOGITS); int* tope = (int*)(C.ws + WS_TOPE); float* topw = (float*)(C.ws + WS_TOPW); int* blkcnt = (int*)(C.ws + WS_BLKCNT);
    int* hist = (int*)C.lds; const float* br = C.in[25];
    for (int vb = C.blk; vb < 256; vb += C.nblk) {
        __syncthreads();
        if (C.tid < NE) hist[C.tid] = 0;
        __syncthreads();
        if (C.tid < 128) {
            const int t = vb * 128 + C.tid;
            float v[32];
#pragma unroll
            for (int q = 0; q < 8; ++q) { const f32x4 x = *(const f32x4*)(logits + (size_t)t * NE + 4 * q), bb = *(const f32x4*)(br + 4 * q);
                v[4 * q] = x.x + bb.x; v[4 * q + 1] = x.y + bb.y; v[4 * q + 2] = x.z + bb.z; v[4 * q + 3] = x.w + bb.w; }
            float tv[4]; int ti[4];
#pragma unroll
            for (int k = 0; k < 4; ++k) {
                float best = -INFINITY; int bi = 0;
#pragma unroll
                for (int e = 0; e < 32; ++e) if (v[e] > best) { best = v[e]; bi = e; }
                tv[k] = best; ti[k] = bi;
#pragma unroll
                for (int e = 0; e < 32; ++e) v[e] = (e == bi) ? -INFINITY : v[e];
            }
            const float e0 = 1.0f, e1 = expf(tv[1] - tv[0]), e2 = expf(tv[2] - tv[0]), e3 = expf(tv[3] - tv[0]);
            const float inv = 1.0f / (e0 + e1 + e2 + e3);
            *(int4*)(tope + (size_t)t * 4) = make_int4(ti[0], ti[1], ti[2], ti[3]);
            *(f32x4*)(topw + (size_t)t * 4) = (f32x4){e0 * inv, e1 * inv, e2 * inv, e3 * inv};
#pragma unroll
            for (int k = 0; k < 4; ++k) atomicAdd(&hist[ti[k]], 1);
        }
        __syncthreads();
        if (C.tid < NE) blkcnt[vb * NE + C.tid] = hist[C.tid];
    }
    __syncthreads();
}

__device__ __forceinline__ void phase_rowlist(Ctx& C) {
    const int* tope = (const int*)(C.ws + WS_TOPE); const int* blkcnt = (const int*)(C.ws + WS_BLKCNT);
    int* rowpair = (int*)(C.ws + WS_ROWPAIR); int* tileexp = (int*)(C.ws + WS_TILEEXP); int* meta = (int*)(C.ws + WS_META);
    int* s_total = (int*)C.lds; int* s_base = s_total + 32; int* s_pstart = s_base + 32; int* s_e = s_pstart + 33;
    for (int vb = C.blk; vb < 256; vb += C.nblk) {
        __syncthreads();
        if (C.tid < NE) { int tot = 0, base = 0; for (int q = 0; q < 256; ++q) { const int c = blkcnt[q * NE + C.tid]; tot += c; if (q < vb) base += c; } s_total[C.tid] = tot; s_base[C.tid] = base; }
        s_e[C.tid] = tope[(size_t)vb * 512 + C.tid];
        __syncthreads();
        if (C.tid == 0) { int ps = 0; for (int e = 0; e < NE; ++e) { s_pstart[e] = ps; ps += ((s_total[e] + 255) / 256) * 256; } s_pstart[NE] = ps; }
        __syncthreads();
        { const int e = s_e[C.tid]; int rank = 0; for (int j = 0; j < C.tid; ++j) rank += (s_e[j] == e) ? 1 : 0;
          rowpair[s_pstart[e] + s_base[e] + rank] = vb * 512 + C.tid; }
        if (vb < NE) { const int e = vb; for (int r = s_pstart[e] + s_total[e] + C.tid; r < s_pstart[e + 1]; r += NTHREADS) rowpair[r] = -1; }
        if (vb == 0) {
            if (C.tid < NE) { for (int tl = s_pstart[C.tid] / 256; tl < s_pstart[C.tid + 1] / 256; ++tl) tileexp[tl] = C.tid; }
            if (C.tid == 0) meta[0] = s_pstart[NE] / 256;
        }
    }
    __syncthreads();
}


#define LDS3(C) ((PG8_LAS unsigned char*)(C).lds)
__device__ __forceinline__ void phase_inproj_fast(Ctx& C) {
    pg8::Gemm g{(const bf16_t*)(C.ws + WS_H), (const bf16_t*)(C.ws + WS_WIN), D, D, D, nullptr};
    pg8::StaticOrder S; S.init(T / 256, INC / 256, C.nblk, C.blk);
    pg8::EpiInproj E{(bf16_t*)(C.ws + WS_U), C.in[6]};
    pg8::gemm_phase<pg8::EpiInproj, pg8::StaticOrder, false>(LDS3(C), g, S, E);
}
__device__ __forceinline__ void phase_cat_fast(Ctx& C) {
    pg8::StaticOrder S; S.init(T / 256, D / 256, C.nblk, C.blk);
    { pg8::Gemm g{(const bf16_t*)(C.ws + WS_YCAT), (const bf16_t*)(C.ws + WS_WCAT), D, D, 512, nullptr};
      pg8::EpiCat<0> E{(bf16_t*)(C.ws + WS_MERGED), (const bf16_t*)(C.ws + WS_U)};
      pg8::gemm_phase<pg8::EpiCat<0>, pg8::StaticOrder, false>(LDS3(C), g, S, E); }
    { pg8::Gemm g{(const bf16_t*)(C.ws + WS_YCAT) + 512, (const bf16_t*)(C.ws + WS_WCAT) + 512, D, D, 512, nullptr};
      pg8::EpiCat<1> E{(bf16_t*)(C.ws + WS_MERGED), (const bf16_t*)(C.ws + WS_U)};
      pg8::gemm_phase<pg8::EpiCat<1>, pg8::StaticOrder, false>(LDS3(C), g, S, E); }
}
__device__ __forceinline__ void phase_mix_fast(Ctx& C) {
    pg8::Gemm g{(const bf16_t*)(C.ws + WS_MERGED), (const bf16_t*)(C.ws + WS_WMIX), D, D, D, nullptr};
    pg8::StaticOrder S; S.init(T / 256, D / 256, C.nblk, C.blk);
    pg8::EpiMix E{C.in[0], C.out, (const float*)(C.ws + WS_MOD)};
    pg8::gemm_phase<pg8::EpiMix, pg8::StaticOrder, false>(LDS3(C), g, S, E);
}
__device__ __forceinline__ void phase_gateup_fast(Ctx& C) {
    const int nmt = ((const int*)(C.ws + WS_META))[0];
    pg8::Gemm g{(const bf16_t*)(C.ws + WS_H), (const bf16_t*)(C.ws + WS_WGU), D, D, D, (const int*)(C.ws + WS_ROWPAIR)};
    pg8::MoeOrder S; S.b.init(nmt, 8, C.nblk, C.blk); S.tileexp = (const int*)(C.ws + WS_TILEEXP); S.nN = 8;
    pg8::EpiGateUp E{(bf16_t*)(C.ws + WS_ACT), C.in[27]};
    pg8::gemm_phase<pg8::EpiGateUp, pg8::MoeOrder, true>(LDS3(C), g, S, E);
}
__device__ __forceinline__ void phase_down_fast(Ctx& C) {
    const int nmt = ((const int*)(C.ws + WS_META))[0];
    pg8::Gemm g{(const bf16_t*)(C.ws + WS_ACT), (const bf16_t*)(C.ws + WS_WDN), D, D, D, nullptr};
    pg8::MoeOrder S; S.b.init(nmt, 4, C.nblk, C.blk); S.tileexp = (const int*)(C.ws + WS_TILEEXP); S.nN = 4;
    pg8::EpiDown E{(bf16_t*)(C.ws + WS_SLOTS), C.in[29], (const int*)(C.ws + WS_ROWPAIR), (const float*)(C.ws + WS_TOPW)};
    pg8::gemm_phase<pg8::EpiDown, pg8::MoeOrder, false>(LDS3(C), g, S, E);
}


#define XB_TMO      128
#define XB_XCNT(j)  (256  + 64 * (j))
#define XB_XSUB(j)  (1280 + 64 * (j))
#define XB_XGEN(j)  (2304 + 64 * (j))
#define XB_TOP      3328
#define XB_TOPGEN   3392
#define XCD_BAR_WORDS 3456
#define XB_SPIN_CAP (1u << 18)
#define XLAS __attribute__((address_space(3)))
__device__ __forceinline__ unsigned xb_ld(unsigned* p)              { return __hip_atomic_load(p, __ATOMIC_RELAXED, __HIP_MEMORY_SCOPE_AGENT); }
__device__ __forceinline__ unsigned xb_add(unsigned* p, unsigned v) { return __hip_atomic_fetch_add(p, v, __ATOMIC_RELAXED, __HIP_MEMORY_SCOPE_AGENT); }
__device__ __forceinline__ unsigned xb_xcc_id() { return (unsigned)__builtin_amdgcn_s_getreg((3 << 11) | 20) & 0xFu; }
#define XB_SPIN(cond, bar) do { unsigned _sp = 0; while (cond) { __builtin_amdgcn_s_sleep(1); \
    if ((++_sp & 255u) == 0u) { if (xb_ld(&(bar)[XB_TMO])) break; if (_sp > XB_SPIN_CAP) { atomicAdd(&(bar)[XB_TMO], 1u); break; } } } } while (0)
struct XcdBarrier { unsigned* bar; unsigned x; volatile XLAS unsigned* st; };
__device__ __forceinline__ XcdBarrier xcd_barrier_post(unsigned* bar, volatile XLAS unsigned* st) {
    XcdBarrier b; b.bar = bar; b.x = xb_xcc_id(); b.st = st;
    if (threadIdx.x == 0) (void)xb_add(&bar[XB_XCNT(b.x)], 1u);
    return b;
}
__device__ __forceinline__ void xcd_barrier_complete(unsigned* bar, unsigned x, unsigned& nloc, unsigned& nx) {
    const unsigned G = gridDim.x * gridDim.y * gridDim.z;
    unsigned sum, cnt, mine, sp = 0u;
    for (;;) {
        sum = 0u; cnt = 0u; mine = 0u;
#pragma unroll
        for (unsigned j = 0; j < 16; ++j) { const unsigned c = xb_ld(&bar[XB_XCNT(j)]); sum += c; cnt += (c > 0u) ? 1u : 0u; mine = (j == x) ? c : mine; }
        if (sum == G) break;
        __builtin_amdgcn_s_sleep(1);
        if ((++sp & 255u) == 0u) { if (xb_ld(&bar[XB_TMO])) break; if (sp > XB_SPIN_CAP) { atomicAdd(&bar[XB_TMO], 1u); break; } }
    }
    nloc = mine > 0u ? mine : 1u; nx = cnt > 0u ? cnt : 1u;
}
__device__ __forceinline__ void xcd_barrier(const XcdBarrier& b) {
    asm volatile("s_waitcnt vmcnt(0)" ::: "memory");
    __syncthreads();
    if (threadIdx.x == 0) {
        unsigned* bar = b.bar;
        __builtin_amdgcn_s_waitcnt(0);
        unsigned nloc = b.st[0], nx = b.st[1];
        if (nloc == 0u) { xcd_barrier_complete(bar, b.x, nloc, nx); b.st[0] = nloc; b.st[1] = nx; }
        const unsigned old = xb_add(&bar[XB_XSUB(b.x)], 1u);
        const unsigned gen = old / nloc;
        if (old + 1u == (gen + 1u) * nloc) {
            __builtin_amdgcn_fence(__ATOMIC_RELEASE, "agent");
            asm volatile("s_waitcnt vmcnt(0)" ::: "memory");
            const unsigned og = xb_add(&bar[XB_TOP], 1u);
            const unsigned tg = og / nx;
            if (og + 1u == (tg + 1u) * nx) xb_add(&bar[XB_TOPGEN], 1u);
            else XB_SPIN(xb_ld(&bar[XB_TOPGEN]) == tg, bar);
            __builtin_amdgcn_fence(__ATOMIC_ACQUIRE, "agent");
            xb_add(&bar[XB_XGEN(b.x)], 1u);
            asm volatile("s_waitcnt vmcnt(0)" ::: "memory");
        } else {
            XB_SPIN(xb_ld(&bar[XB_XGEN(b.x)]) == gen, bar);
            __builtin_amdgcn_fence(__ATOMIC_ACQUIRE, "agent");
            asm volatile("s_waitcnt vmcnt(0)" ::: "memory");
        }
    }
    __syncthreads();
}

constexpr int NPHASES = 15;
}

__global__ void __launch_bounds__(NTHREADS, 2) fwd_kernel(Params p) {
    extern __shared__ __attribute__((aligned(16))) unsigned char lds[];
    cg::grid_group grid = cg::this_grid();
    Ctx C;
#pragma unroll
    for (int i = 0; i < 31; ++i) C.in[i] = p.in[i];
    C.out = p.out; C.ws = p.ws; C.lds = lds;
    C.tid = threadIdx.x; C.lane = C.tid & 63; C.wave = __builtin_amdgcn_readfirstlane(C.tid >> 6);
    C.blk = blockIdx.x; C.nblk = gridDim.x; C.gw = C.blk * NWAVES + C.wave; C.ngw = C.nblk * NWAVES;
    const int lo = p.ph_lo, hi = p.ph_hi;
    volatile XLAS unsigned* misc = (volatile XLAS unsigned*)((XLAS unsigned char*)lds + (LDS_BYTES - 64));
    if (threadIdx.x < 16) misc[threadIdx.x] = 0u;
    __syncthreads();
    const XcdBarrier xbar = xcd_barrier_post((unsigned*)(p.ws + WS_CTL), misc);
#define GSYNC(k) do { xcd_barrier(xbar); } while (0)
    if (lo < 0) grid.sync();
#ifndef PHMASK
#define PHMASK 0xffff
#endif
#ifndef REPMASK
#define REPMASK 0
#endif
#define PH(k, body) do { if ((PHMASK >> (k)) & 1) { if (lo <= (k) && (k) < hi) { if ((REPMASK >> (k)) & 1) { body; GSYNC(1); } body; if ((k) + 1 < hi) GSYNC(k); } } } while (0)
#ifdef SYNCPROBE
    for (int i = 0; i < 20; ++i) GSYNC(1);
#endif
    PH(0, { phase_mod(C); phase_filters(C); });
    PH(1, { phase_weights(C); __syncthreads(); phase_norm1(C); });
#ifndef FASTMASK
#define FASTMASK 0xffff
#endif
#define FAST(k) ((FASTMASK >> (k)) & 1)
    PH(2, phase_inproj_fast(C));
    PH(3, phase_hy_pre_fast(C));
    PH(4, { phase_toeplitz(C); GSYNC(1); phase_hy_post(C); });
    PH(5, phase_attn_fast(C));
    PH(6, phase_cat_fast(C));
    PH(7, phase_mix_fast(C));
    PH(8, phase_norm2(C));
    PH(9, phase_router(C));
    PH(10, phase_top4(C));
    PH(11, phase_rowlist(C));
    PH(12, phase_gateup_fast(C));
    PH(13, phase_down_fast(C));
    PH(14, phase_final(C));
#undef PH
}

extern "C" void kernel_launch(void* const* d_in, const int* in_sizes, int n_in, void* d_out, int out_size, void* d_ws, size_t ws_size, hipStream_t stream) {
    static int grid = 0;
    if (grid == 0) {
        if (n_in != 31 || ws_size < WS_END) { fprintf(stderr, "kernel_launch: unexpected n_in %d or ws_size %zu\n", n_in, ws_size); grid = -1; return; }
        int dev = 0, cus = 0, per_cu = 0;
        hipGetDevice(&dev); hipDeviceGetAttribute(&cus, hipDeviceAttributeMultiprocessorCount, dev);
        hipFuncSetAttribute((const void*)fwd_kernel, hipFuncAttributeMaxDynamicSharedMemorySize, LDS_BYTES);
        hipOccupancyMaxActiveBlocksPerMultiprocessor(&per_cu, (const void*)fwd_kernel, NTHREADS, LDS_BYTES);
        if (per_cu < 1) { fprintf(stderr, "kernel_launch: occupancy query says %d blocks/CU\n", per_cu); per_cu = 1; }
        (void)hipGetLastError();
        grid = cus * 1;
        fprintf(stderr, "kernel_launch: cus %d per_cu %d grid %d\n", cus, per_cu, grid);
    }
    if (grid < 0) return;
    if (hipMemsetAsync((char*)d_ws + WS_CTL, 0, 65536, stream) != hipSuccess) { fprintf(stderr, "kernel_launch: memset failed\n"); return; }
    Params p{};
    for (int i = 0; i < 31; ++i) p.in[i] = (const float*)d_in[i];
    p.out = (float*)d_out; p.ws = (unsigned char*)d_ws; p.ph_lo = 0; p.ph_hi = NPHASES;
    void* args[] = {&p};
    hipError_t e = hipLaunchCooperativeKernel((const void*)fwd_kernel, dim3(grid), dim3(NTHREADS), args, LDS_BYTES, stream);
    if (e != hipSuccess) fprintf(stderr, "cooperative launch failed: %s (grid %d)\n", hipGetErrorString(e), grid);
}
```

```cpp
#include <hip/hip_runtime.h>
#include <hip/hip_cooperative_groups.h>
#include <cstdio>
#include <cstdint>
namespace cg = cooperative_groups;

namespace {
typedef unsigned short bf16_t;
typedef short bf16x8 __attribute__((ext_vector_type(8)));
typedef short s16x4 __attribute__((ext_vector_type(4)));
typedef float f32x4 __attribute__((ext_vector_type(4)));
typedef float f32x16 __attribute__((ext_vector_type(16)));
typedef unsigned u32x4 __attribute__((ext_vector_type(4)));
typedef unsigned u32x2 __attribute__((ext_vector_type(2)));

constexpr int D = 1024, NB = 16, SEQ = 2048, T = NB * SEQ, HW = 512, INC = 5120, NE = 32, FHID = 64;
constexpr int QOFF = 1536, KOFF = 2048, VOFF = 2560, GOFF = 3072;
constexpr int NTHREADS = 512, NWAVES = 8;
constexpr float EPS = 1e-5f;
constexpr float LOG2E = 1.4426950408889634f;
constexpr float QSCALE = 0.125f * 1.4426950408889634f;
constexpr size_t MiB = 1u << 20;
constexpr size_t WS_CTL = 0;
constexpr size_t WS_MOD = 1 * MiB;
constexpr size_t WS_META = 1 * MiB + 512 * 1024;
constexpr size_t WS_BLKCNT = WS_META + 4096;
constexpr size_t WS_TILEEXP = WS_BLKCNT + 256 * 32 * 4;
constexpr size_t WS_LOGITS = 2 * MiB;
constexpr size_t WS_TOPE = 6 * MiB;
constexpr size_t WS_TOPW = 6 * MiB + 512 * 1024;
constexpr size_t WS_ROWPAIR = 7 * MiB;
constexpr size_t WS_KFILT = 8 * MiB;
constexpr size_t WS_U = 16 * MiB;
constexpr size_t WS_ACT = WS_U;
constexpr size_t WS_H = 336 * MiB;
constexpr size_t WS_R1 = 400 * MiB;
constexpr size_t WS_YCAT = WS_R1;
constexpr size_t WS_MERGED = WS_R1 + 64 * MiB;
constexpr size_t WS_VP = WS_R1 + 128 * MiB;
constexpr size_t WS_X0C = WS_R1 + 160 * MiB;
constexpr size_t WS_VT = WS_R1 + 192 * MiB;
constexpr size_t WS_H2LO = WS_R1 + 224 * MiB;
constexpr size_t WS_SLOTS = WS_R1;
constexpr size_t WS_WIN = 688 * MiB;
constexpr size_t WS_WCAT = 698 * MiB;
constexpr size_t WS_WMIX = 700 * MiB;
constexpr size_t WS_WGU = 702 * MiB;
constexpr size_t WS_WDN = 830 * MiB;
constexpr size_t WS_WRT = 894 * MiB;
constexpr size_t WS_KFC = 896 * MiB;
constexpr size_t WS_END = 904 * MiB;
constexpr size_t WS_YT = WS_R1 + 192 * MiB;
constexpr int MAXROWS = 4 * T + NE * 256;
constexpr int LDS_BYTES = 147456;

struct Params { const float* in[31]; float* out; unsigned char* ws; int ph_lo, ph_hi; };

__device__ __forceinline__ unsigned f2bf(float f) { unsigned u = __float_as_uint(f); return (u + 0x7fffu + ((u >> 16) & 1u)) >> 16; }
__device__ __forceinline__ unsigned pk2(float lo, float hi) { return f2bf(lo) | (f2bf(hi) << 16); }
__device__ __forceinline__ float bf2f(unsigned h) { return __uint_as_float(h << 16); }
__device__ __forceinline__ float bflo(unsigned w) { return __uint_as_float(w << 16); }
__device__ __forceinline__ float bfhi(unsigned w) { return __uint_as_float(w & 0xffff0000u); }
__device__ __forceinline__ float wave_sum(float v) {
#pragma unroll
    for (int o = 1; o < 64; o <<= 1) v += __shfl_xor(v, o);
    return v;
}
__device__ __forceinline__ float sigmoidf_(float x) { return 1.0f / (1.0f + __expf(-x)); }
__device__ __forceinline__ int crow(int r, int hi) { return (r & 3) + 8 * (r >> 2) + 4 * hi; }
__device__ __forceinline__ int lane_id() { return (int)__builtin_amdgcn_mbcnt_hi(~0u, __builtin_amdgcn_mbcnt_lo(~0u, 0u)); }
__device__ __forceinline__ int fresh_lane() { int l = lane_id(); asm volatile("" : "+v"(l)); return l; }

struct Ctx {
    const float* in[31]; float* out; unsigned char* ws;
    int tid, lane, wave, gw, ngw, nblk, blk;
    unsigned char* lds;
};

struct WItem { const float* src; bf16_t* dst; int N; int sk; };
__device__ __forceinline__ WItem witem(const Ctx& C, int it) {
    constexpr int I_IN = (D / 64) * (INC / 64), I_HY = (HW / 64) * (D / 64), I_MIX = (D / 64) * (D / 64), I_GU1 = (D / 64) * (2 * D / 64), I_DN1 = (D / 64) * (D / 64);
    const float* W; int N, k0, n0, kd, nd, sk = -1; bf16_t* WT;
    int r = it;
    if (r < NE * I_GU1) { const int e = r / I_GU1, q = r % I_GU1; const int nb = 2 * D / 64; n0 = 64 * (q % nb); k0 = 64 * (q / nb);
        const int s = n0 / 1024, rem = n0 % 1024, j = rem / 128, i0 = rem % 128; nd = 256 * j + 128 * s + i0; kd = k0; N = 2 * D;
        W = C.in[26] + (size_t)e * D * 2 * D; WT = (bf16_t*)(C.ws + WS_WGU) + (size_t)e * 2 * D * D; }
    else if ((r -= NE * I_GU1) < NE * I_DN1) { const int e = r / I_DN1, q = r % I_DN1; const int nb = D / 64; n0 = 64 * (q % nb); k0 = 64 * (q / nb); nd = n0; kd = k0; N = D;
        W = C.in[28] + (size_t)e * D * D; WT = (bf16_t*)(C.ws + WS_WDN) + (size_t)e * D * D; }
    else if ((r -= NE * I_DN1) < I_IN) { const int nb = INC / 64; n0 = 64 * (r % nb); k0 = 64 * (r / nb); nd = n0; kd = k0; N = INC; W = C.in[5]; WT = (bf16_t*)(C.ws + WS_WIN);
        if (n0 >= GOFF) { const int rel = n0 - GOFF, sg_ = rel / 1024, rem = rel % 1024; nd = GOFF + 256 * (rem / 128) + 128 * sg_ + (rem % 128); } }
    else if ((r -= I_IN) < I_HY) { const int nb = D / 64; n0 = 64 * (r % nb); k0 = 64 * (r / nb); nd = n0; kd = k0; N = D; W = C.in[20]; WT = (bf16_t*)(C.ws + WS_WCAT); }
    else if ((r -= I_HY) < I_HY) { const int nb = D / 64; n0 = 64 * (r % nb); k0 = 64 * (r / nb); nd = n0; kd = 512 + k0; N = D; W = C.in[21]; WT = (bf16_t*)(C.ws + WS_WCAT); sk = k0; }
    else { r -= I_HY; const int nb = D / 64; n0 = 64 * (r % nb); k0 = 64 * (r / nb); nd = n0; kd = k0; N = D; W = C.in[22]; WT = (bf16_t*)(C.ws + WS_WMIX); }
    WItem w; w.N = N; w.sk = sk; w.src = W + (size_t)(k0 + (C.lane >> 4)) * N + n0 + 4 * (C.lane & 15); w.dst = WT + (size_t)(nd + (C.lane >> 3)) * D + kd + 8 * (C.lane & 7);
    return w;
}
__device__ __forceinline__ void phase_weights(Ctx& C) {
    float* scr = (float*)(C.lds + C.wave * 16640);
    constexpr int NITEMS = (D / 64) * (INC / 64) + 2 * (HW / 64) * (D / 64) + (D / 64) * (D / 64) + NE * (D / 64) * (2 * D / 64) + NE * (D / 64) * (D / 64);
    const int lane = C.lane;
    int it = C.gw;
    f32x4 v[16], vn[16];
    WItem cur;
    if (it < NITEMS) { cur = witem(C, it);
#pragma unroll
        for (int i = 0; i < 16; ++i) v[i] = *(const f32x4*)(cur.src + (size_t)(4 * i) * cur.N); }
    for (; it < NITEMS; it += C.ngw) {
        const bool more = it + C.ngw < NITEMS; WItem nx = cur;
        if (more) { nx = witem(C, it + C.ngw);
#pragma unroll
            for (int i = 0; i < 16; ++i) vn[i] = *(const f32x4*)(nx.src + (size_t)(4 * i) * nx.N); }
        if (cur.sk >= 0) {
#pragma unroll
            for (int i = 0; i < 16; ++i) v[i] = v[i] * (0.8f * C.in[19][(cur.sk + 4 * i + (lane >> 4)) & 127]); }
#pragma unroll
        for (int i = 0; i < 16; ++i) { float* d = scr + (4 * i + (lane >> 4)) * 65 + 4 * (lane & 15); d[0] = v[i].x; d[1] = v[i].y; d[2] = v[i].z; d[3] = v[i].w; }
        __builtin_amdgcn_s_waitcnt(0xc07f); asm volatile("" ::: "memory");
        const int c = lane & 7;
#pragma unroll
        for (int j = 0; j < 8; ++j) { const int n = (lane >> 3) + 8 * j; const float* s = scr + (8 * c) * 65 + n;
            u32x4 o; o.x = pk2(s[0 * 65], s[1 * 65]); o.y = pk2(s[2 * 65], s[3 * 65]); o.z = pk2(s[4 * 65], s[5 * 65]); o.w = pk2(s[6 * 65], s[7 * 65]);
            *(u32x4*)(cur.dst + (size_t)(8 * j) * D) = o; }
        __builtin_amdgcn_s_waitcnt(0xc07f); asm volatile("" ::: "memory");
        if (more) {
#pragma unroll
            for (int i = 0; i < 16; ++i) v[i] = vn[i]; }
        cur = nx;
    }
    bf16_t* wrt = (bf16_t*)(C.ws + WS_WRT);
    for (int i = C.blk * NTHREADS + C.tid; i < NE * D; i += C.nblk * NTHREADS) {
        const int e = i / D, k = i % D; const float w = C.in[24][(size_t)k * NE + e];
        const unsigned hi = f2bf(w); const float lo = w - bf2f(hi);
        wrt[(size_t)e * 2048 + k] = (bf16_t)hi; wrt[(size_t)e * 2048 + 1024 + k] = (bf16_t)f2bf(lo);
    }
}

__device__ __forceinline__ void phase_mod(Ctx& C) {
    float* sc = (float*)C.lds;
    float* part = sc + 16 * 1024;
    float* mod = (float*)(C.ws + WS_MOD);
    for (int vb = C.blk; vb < 256; vb += C.nblk) {
        const int j0 = vb * 24;
        __syncthreads();
        for (int i = C.tid; i < 16 * D; i += NTHREADS) { const float c = C.in[1][i]; sc[i] = c / (1.0f + expf(-c)); }
        __syncthreads();
        if (C.tid < 504) {
            const int jj = C.tid % 24, isub = C.tid / 24;
            float acc[16];
#pragma unroll
            for (int b = 0; b < 16; ++b) acc[b] = 0.f;
            const float* w = C.in[2] + j0 + jj;
#pragma unroll 7
            for (int i = isub; i < D; i += 21) { const float wv = w[(size_t)i * 6 * D];
#pragma unroll
                for (int b = 0; b < 16; ++b) acc[b] = fmaf(sc[b * D + i], wv, acc[b]); }
#pragma unroll
            for (int b = 0; b < 16; ++b) part[(isub * 16 + b) * 24 + jj] = acc[b];
        }
        __syncthreads();
        if (C.tid < 384) { const int b = C.tid / 24, jj = C.tid % 24; float a = C.in[3][j0 + jj];
            for (int q = 0; q < 21; ++q) a += part[(q * 16 + b) * 24 + jj];
            mod[b * 6 * D + j0 + jj] = a; }
    }
    __syncthreads();
}

__device__ __forceinline__ void phase_filters(Ctx& C) {
    float* sh = (float*)C.lds;
    float* h3t = sh + 8 * 160;
    float* kfc = (float*)(C.ws + WS_KFC);
    const float* w1 = C.in[9]; const float* b1 = C.in[10]; const float* w2 = C.in[11]; const float* b2 = C.in[12];
    const float* w3 = C.in[13]; const float* b3 = C.in[14]; const float* w4 = C.in[15]; const float* fq = C.in[16];
    const int pl = C.tid >> 6, j = C.tid & 63;
    float* z = sh + pl * 160; float* ha = z + 32; float* hb = ha + 64;
    for (int vb = C.blk; vb < SEQ / 8; vb += C.nblk) {
        const int pos = vb * 8 + pl;
        const float tt = (float)pos / (float)(SEQ - 1);
        const float w = 6.283185307179586f * (float)pos / (float)SEQ;
        __syncthreads();
        if (j < 17) {
            float v;
            if (j == 0) v = tt;
            else { const int i = (j - 1) & 7; const float fr = 1e-4f + (float)i * ((7.0f - 1e-4f) / 7.0f); v = (j <= 8) ? cosf(fr * w) : -sinf(fr * w); }
            z[j] = v;
        }
        __syncthreads();
        { float a = b1[j];
#pragma unroll
          for (int i = 0; i < 17; ++i) a = fmaf(z[i], w1[i * FHID + j], a); ha[j] = sinf(fq[j] * a); }
        __syncthreads();
        { float a = b2[j];
#pragma unroll 32
          for (int i = 0; i < FHID; ++i) a = fmaf(ha[i], w2[i * FHID + j], a); hb[j] = sinf(fq[j] * a); }
        __syncthreads();
        { float a = b3[j];
#pragma unroll 32
          for (int i = 0; i < FHID; ++i) a = fmaf(hb[i], w3[i * FHID + j], a); h3t[j * 8 + pl] = sinf(fq[j] * a); }
        __syncthreads();
        float af[8], ab[8];
#pragma unroll
        for (int p = 0; p < 8; ++p) { af[p] = 0.f; ab[p] = 0.f; }
#pragma unroll 16
        for (int i = 0; i < FHID; ++i) { const float wa = w4[i * 2 * HW + C.tid], wb = w4[i * 2 * HW + HW + C.tid];
            const f32x4 h0 = *(const f32x4*)(h3t + i * 8), h1 = *(const f32x4*)(h3t + i * 8 + 4);
#pragma unroll
            for (int p = 0; p < 4; ++p) { af[p] = fmaf(h0[p], wa, af[p]); af[4 + p] = fmaf(h1[p], wa, af[4 + p]); ab[p] = fmaf(h0[p], wb, ab[p]); ab[4 + p] = fmaf(h1[p], wb, ab[4 + p]); } }
        const float min_decay = logf(1e-2f) / 1.5f, max_decay = logf(1e-2f) / 0.3f;
        const int c = C.tid, pos0 = vb * 8;
        const float adelta = fabsf(min_decay + (float)c * ((max_decay - min_decay) / 511.0f));
#pragma unroll
        for (int p = 0; p < 8; ++p) { const float dec = expf(-((float)(pos0 + p) / (float)(SEQ - 1)) * adelta); af[p] *= dec; ab[p] *= dec; }
        float* dst = kfc + (size_t)c * 4096 + 2048 + pos0;
        *(f32x4*)dst = (f32x4){af[0], af[1], af[2], af[3]}; *(f32x4*)(dst + 4) = (f32x4){af[4], af[5], af[6], af[7]};
        float* dsb = kfc + (size_t)c * 4096 + 2048 - pos0;
#pragma unroll
        for (int p = 0; p < 8; ++p) if (pos0 + p >= 1) dsb[-p] = ab[p];
    }
    __syncthreads();
}

__device__ __forceinline__ void phase_norm1(Ctx& C) {
    const float* mod = (const float*)(C.ws + WS_MOD); bf16_t* h = (bf16_t*)(C.ws + WS_H);
    const float* g = C.in[4];
    for (int row = C.gw; row < T; row += C.ngw) {
        const int b = row / SEQ;
        const f32x4* xr = (const f32x4*)(C.in[0] + (size_t)row * D) + C.lane;
        f32x4 v[4]; float s = 0.f;
#pragma unroll
        for (int j = 0; j < 4; ++j) { v[j] = xr[64 * j]; s += (v[j].x * v[j].x + v[j].y * v[j].y) + (v[j].z * v[j].z + v[j].w * v[j].w); }
        const float rstd = 1.0f / sqrtf(wave_sum(s) * (1.0f / D) + EPS);
        const float* sh = mod + (size_t)b * 6 * D; const float* sc = sh + D;
        u32x2* o = (u32x2*)(h + (size_t)row * D) + C.lane;
#pragma unroll
        for (int j = 0; j < 4; ++j) { const int i0 = 4 * C.lane + 256 * j;
            const f32x4 gg = *(const f32x4*)(g + i0), s1 = *(const f32x4*)(sc + i0), s0 = *(const f32x4*)(sh + i0);
            f32x4 r; r.x = v[j].x * rstd * gg.x * (1.f + s1.x) + s0.x; r.y = v[j].y * rstd * gg.y * (1.f + s1.y) + s0.y;
            r.z = v[j].z * rstd * gg.z * (1.f + s1.z) + s0.z; r.w = v[j].w * rstd * gg.w * (1.f + s1.w) + s0.w;
            u32x2 w; w.x = pk2(r.x, r.y); w.y = pk2(r.z, r.w); o[64 * j] = w; }
    }
}

__device__ __forceinline__ void phase_final(Ctx& C) {
    const float* mod = (const float*)(C.ws + WS_MOD); const bf16_t* slots = (const bf16_t*)(C.ws + WS_SLOTS);
    const float* g = C.in[30];
    for (int row = C.gw; row < T; row += C.ngw) {
        const int b = row / SEQ;
        f32x4* xr = (f32x4*)(C.out + (size_t)row * D) + C.lane;
        const float* g2 = mod + (size_t)b * 6 * D + 5 * D;
        f32x4 v[4]; float s = 0.f;
#pragma unroll
        for (int j = 0; j < 4; ++j) { const int i0 = 4 * C.lane + 256 * j;
            f32x4 m = {0.f, 0.f, 0.f, 0.f};
#pragma unroll
            for (int k = 0; k < 4; ++k) { const u32x2 w = *(const u32x2*)(slots + ((size_t)row * 4 + k) * D + i0);
                m.x += bflo(w.x); m.y += bfhi(w.x); m.z += bflo(w.y); m.w += bfhi(w.y); }
            const f32x4 gg = *(const f32x4*)(g2 + i0);
            v[j] = xr[64 * j]; v[j].x += gg.x * m.x; v[j].y += gg.y * m.y; v[j].z += gg.z * m.z; v[j].w += gg.w * m.w;
            s += (v[j].x * v[j].x + v[j].y * v[j].y) + (v[j].z * v[j].z + v[j].w * v[j].w); }
        const float rstd = 1.0f / sqrtf(wave_sum(s) * (1.0f / D) + EPS);
#pragma unroll
        for (int j = 0; j < 4; ++j) { const int i0 = 4 * C.lane + 256 * j; const f32x4 gg = *(const f32x4*)(g + i0);
            f32x4 r; r.x = v[j].x * rstd * gg.x; r.y = v[j].y * rstd * gg.y; r.z = v[j].z * rstd * gg.z; r.w = v[j].w * rstd * gg.w; xr[64 * j] = r; }
    }
}

namespace pg8 {
#define PG8_LAS __attribute__((address_space(3)))
constexpr int BM = 256, BK = 64, HALF = 128, HTB = HALF * BK * 2, STAGE_BYTES = 8 * HTB, NXCD = 8, WGM = 8;
__device__ __forceinline__ int lds_byte(int r, int c) { const int st = (r >> 4) * 2 + (c >> 5), rr = r & 15, cc = c & 31, ob = rr * 64 + cc * 2; return st * 1024 + (ob ^ (((ob >> 9) & 1) << 5)); }
__device__ __forceinline__ void stage_rc(int b, int& R, int& C) { const int st = b / 1024, sb = b % 1024, swz = sb ^ (((sb >> 9) & 1) << 5); R = (st >> 1) * 16 + swz / 64; C = (st & 1) * 32 + (swz % 64) / 2; }
__device__ __forceinline__ int perm32(int rho) { const int n = rho >> 4, i = rho & 15; return 8 * (i >> 2) + 4 * n + (i & 3); }
struct Unit { int pm, pn; };
struct Gemm { const bf16_t* A; const bf16_t* Bt; int lda, ldb, K; const int* rowidx; };
struct StaticOrder {
    int nM, nN, nwg, G, c;
    __device__ void init(int nM_, int nN_, int G_, int c_) { nM = nM_; nN = nN_; nwg = nM * nN; G = G_; c = c_; }
    __device__ bool next(int i, Unit& u) const {
        const long L = (long)i * G + c; if (L >= nwg) return false;
        int wgid = (int)L; { const int q = nwg / NXCD, r = nwg % NXCD, xcd = wgid % NXCD, off = wgid / NXCD; wgid = (xcd < r ? xcd * (q + 1) : r * (q + 1) + (xcd - r) * q) + off; }
        const int nig = WGM * nN, gid = wgid / nig, fm = gid * WGM, gsz = (nM - fm) < WGM ? (nM - fm) : WGM;
        u.pm = fm + ((wgid % nig) % gsz); u.pn = (wgid % nig) / gsz; return true;
    }
};
struct MoeOrder {
    StaticOrder b; const int* tileexp; int nN;
    __device__ bool next(int i, Unit& u) const { if (!b.next(i, u)) return false; u.pn = tileexp[u.pm] * nN + u.pn; return true; }
};
__device__ __forceinline__ unsigned cvt_pk_bf16(float lo, float hi) { unsigned r; asm volatile("v_cvt_pk_bf16_f32 %0, %1, %2" : "=v"(r) : "v"(lo), "v"(hi)); return r; }

template <class Epi, class Sched, bool GATHER, bool MIDHOOK = false>
__device__ __forceinline__ void gemm_phase(PG8_LAS unsigned char* lds, const Gemm g, const Sched& S, const Epi& E, const int wid_) {
    const int wid = wid_, lane = fresh_lane(), tid = wid * 64 + lane, wr = wid >> 2, wc = wid & 3, fr = lane & 15, fq = lane >> 4;
    const int K = g.K, nt = K / BK;
    int RA[2]; unsigned cA2[2], voffB[2];
#pragma unroll
    for (int i = 0; i < 2; ++i) { int R, C; stage_rc(tid * 16 + i * 8192, R, C); const int Rb = Epi::PERM ? ((R & ~31) + perm32(R & 31)) : R;
        RA[i] = R; cA2[i] = (unsigned)C * 2u; voffB[i] = (unsigned)(Rb * g.ldb + C) * 2u; }
    const unsigned lda2 = (unsigned)g.lda * 2u;
    const size_t kstep = (size_t)(BK * 2);
    const size_t hstep = (size_t)HALF * g.ldb * 2;
    const size_t tstep = 2 * hstep;
    const unsigned ldsw = (unsigned)wid * 1024u;
    const int aoff = lds_byte(wr * 64 + fr, fq * 8), boff = lds_byte(wc * 32 + fr, fq * 8);
#define PG8_SA(b, h) (((b) * 2 + (h)) * HTB)
#define PG8_SB(b, h) ((4 + (b) * 2 + (h)) * HTB)
#define PG8_STAGE(bufoff, gbase, voff) do { _Pragma("unroll") for (int _i = 0; _i < 2; ++_i) \
        __builtin_amdgcn_global_load_lds((const unsigned*)((const char*)(gbase) + (voff)[_i]), (PG8_LAS unsigned*)(lds + (bufoff) + ldsw + _i * 8192), 16, 0, 0); } while (0)
#define PG8_AOFFS(dst, u_) do { _Pragma("unroll") for (int _h = 0; _h < 2; ++_h) _Pragma("unroll") for (int _i = 0; _i < 2; ++_i) { \
        int _row = (u_).pm * BM + _h * HALF + RA[_i]; if (GATHER) { const int _p = g.rowidx[_row]; _row = _p >= 0 ? (_p >> 2) : 0; } \
        dst[_h][_i] = (unsigned)_row * lda2 + cA2[_i]; } } while (0)
#define PG8_LDA(dst, b, h) do { _Pragma("unroll") for (int m = 0; m < 4; ++m) _Pragma("unroll") for (int k = 0; k < 2; ++k) dst[m][k] = *(const PG8_LAS bf16x8*)(lds + PG8_SA(b, h) + aoff + m * 2048 + k * 1024); } while (0)
#define PG8_LDB(dst, b, h) do { _Pragma("unroll") for (int n = 0; n < 2; ++n) _Pragma("unroll") for (int k = 0; k < 2; ++k) dst[n][k] = *(const PG8_LAS bf16x8*)(lds + PG8_SB(b, h) + boff + n * 2048 + k * 1024); } while (0)
#define PG8_MMA(ai, bj, At, Bt) do { __builtin_amdgcn_s_setprio(1); _Pragma("unroll") for (int m = 0; m < 4; ++m) _Pragma("unroll") for (int n = 0; n < 2; ++n) _Pragma("unroll") for (int k = 0; k < 2; ++k) \
        acc[ai][bj][m][n] = __builtin_amdgcn_mfma_f32_16x16x32_bf16(Bt[n][k], At[m][k], acc[ai][bj][m][n], 0, 0, 0); __builtin_amdgcn_s_setprio(0); } while (0)
#define PG8_WAIT_V(n) asm volatile("s_waitcnt vmcnt(" #n ")" ::: "memory")
#define PG8_WAIT_L(n) asm volatile("s_waitcnt lgkmcnt(" #n ")" ::: "memory")
#define PG8_BAR __builtin_amdgcn_s_barrier()
#define PG8_SCHED __builtin_amdgcn_sched_barrier(0)
    Unit cur, nxt; int ui = 0;
    if (!S.next(0, cur)) return;
    f32x4 acc[2][2][4][2];
#pragma unroll
    for (int a = 0; a < 2; ++a)
#pragma unroll
        for (int b = 0; b < 2; ++b)
#pragma unroll
            for (int m = 0; m < 4; ++m)
#pragma unroll
                for (int n = 0; n < 2; ++n) acc[a][b][m][n] = (f32x4){0.f, 0.f, 0.f, 0.f};
    bf16x8 At[4][2], B0[2][2], B1[2][2];
    unsigned cv[2][2], nv[2][2];
    PG8_AOFFS(cv, cur);
    const char* const Ab = (const char*)g.A;
    const char* cB = (const char*)g.Bt + (size_t)cur.pn * tstep;
    PG8_STAGE(PG8_SB(0, 0), cB, voffB); PG8_STAGE(PG8_SB(0, 1), cB + hstep, voffB); PG8_STAGE(PG8_SA(0, 0), Ab, cv[0]); PG8_STAGE(PG8_SA(0, 1), Ab, cv[1]);
    if (wr == 1) PG8_BAR;
    PG8_WAIT_V(2); PG8_BAR;
    PG8_STAGE(PG8_SB(1, 0), cB + kstep, voffB); PG8_STAGE(PG8_SA(1, 0), Ab + kstep, cv[0]); PG8_STAGE(PG8_SB(1, 1), cB + hstep + kstep, voffB);
    PG8_WAIT_V(6); PG8_BAR;
    for (;;) {
        const bool has_next = S.next(ui + 1, nxt);
        if (has_next) { PG8_AOFFS(nv, nxt); } else {
#pragma unroll
            for (int h = 0; h < 2; ++h)
#pragma unroll
                for (int i = 0; i < 2; ++i) nv[h][i] = cv[h][i]; }
        const char* nB = has_next ? (const char*)g.Bt + (size_t)nxt.pn * tstep : cB;
#define PG8_KSTEP(t) do { \
            const bool last = (t == nt - 2); \
            const char* a1 = Ab + (size_t)(t + 1) * kstep; \
            const char* a2 = last ? Ab : Ab + (size_t)(t + 2) * kstep; const char* b2 = last ? nB : cB + (size_t)(t + 2) * kstep; \
            const char* a3 = a2 + kstep; const char* b3 = b2 + kstep; \
            unsigned sv[2][2]; \
            _Pragma("unroll") for (int h = 0; h < 2; ++h) _Pragma("unroll") for (int i = 0; i < 2; ++i) sv[h][i] = last ? nv[h][i] : cv[h][i]; \
            PG8_LDB(B0, 0, 0); PG8_LDB(B1, 0, 1); PG8_SCHED; PG8_LDA(At, 0, 0); PG8_STAGE(PG8_SA(1, 1), a1, cv[1]); \
            PG8_WAIT_V(8); PG8_WAIT_L(0); PG8_BAR; PG8_MMA(0, 0, At, B0); PG8_MMA(0, 1, At, B1); PG8_BAR; PG8_SCHED; \
            PG8_LDA(At, 0, 1); PG8_STAGE(PG8_SB(0, 0), b2, voffB); PG8_STAGE(PG8_SB(0, 1), b2 + hstep, voffB); PG8_STAGE(PG8_SA(0, 0), a2, sv[0]); \
            PG8_WAIT_V(8); PG8_WAIT_L(0); PG8_BAR; PG8_MMA(1, 0, At, B0); PG8_MMA(1, 1, At, B1); PG8_BAR; PG8_SCHED; \
            PG8_LDB(B0, 1, 0); PG8_LDB(B1, 1, 1); PG8_SCHED; PG8_LDA(At, 1, 0); PG8_STAGE(PG8_SA(0, 1), a2, sv[1]); \
            PG8_WAIT_V(8); PG8_WAIT_L(0); PG8_BAR; PG8_MMA(0, 0, At, B0); PG8_MMA(0, 1, At, B1); PG8_BAR; PG8_SCHED; \
            PG8_LDA(At, 1, 1); PG8_STAGE(PG8_SB(1, 0), b3, voffB); PG8_STAGE(PG8_SB(1, 1), b3 + hstep, voffB); PG8_STAGE(PG8_SA(1, 0), a3, sv[0]); \
            PG8_WAIT_V(8); PG8_WAIT_L(0); PG8_BAR; PG8_MMA(1, 0, At, B0); PG8_MMA(1, 1, At, B1); PG8_BAR; PG8_SCHED; \
        } while (0)
        if constexpr (MIDHOOK) {
            for (int t = 0; t < nt / 2; t += 2) PG8_KSTEP(t);
            E.mid(acc, cur, wr, wc, fr, fq);
            for (int t = nt / 2; t < nt; t += 2) PG8_KSTEP(t);
        } else {
            for (int t = 0; t < nt; t += 2) PG8_KSTEP(t);
        }
#undef PG8_KSTEP
        if (wr == 0) PG8_BAR;
        E(acc, cur, wr, wc, fr, fq);
        if (!has_next) break;
#pragma unroll
        for (int a = 0; a < 2; ++a)
#pragma unroll
            for (int b = 0; b < 2; ++b)
#pragma unroll
                for (int m = 0; m < 4; ++m)
#pragma unroll
                    for (int n = 0; n < 2; ++n) acc[a][b][m][n] = (f32x4){0.f, 0.f, 0.f, 0.f};
        cur = nxt; cB = nB; ++ui;
#pragma unroll
        for (int h = 0; h < 2; ++h)
#pragma unroll
            for (int i = 0; i < 2; ++i) cv[h][i] = nv[h][i];
        if (wr == 1) PG8_BAR;
    }
    PG8_WAIT_V(0);
    PG8_BAR;
#undef PG8_SA
#undef PG8_SB
#undef PG8_STAGE
#undef PG8_AOFFS
#undef PG8_LDA
#undef PG8_LDB
#undef PG8_MMA
#undef PG8_WAIT_V
#undef PG8_WAIT_L
#undef PG8_BAR
#undef PG8_SCHED
}

__device__ __forceinline__ u32x4 pack8(const f32x4& v0, const f32x4& v1) { u32x4 w; w.x = cvt_pk_bf16(v0[0], v0[1]); w.y = cvt_pk_bf16(v0[2], v0[3]); w.z = cvt_pk_bf16(v1[0], v1[1]); w.w = cvt_pk_bf16(v1[2], v1[3]); return w; }
__device__ __forceinline__ void unpack8(const u32x4& w, f32x4& v0, f32x4& v1) { v0 = (f32x4){bflo(w.x), bfhi(w.x), bflo(w.y), bfhi(w.y)}; v1 = (f32x4){bflo(w.z), bfhi(w.z), bflo(w.w), bfhi(w.w)}; }
__device__ __forceinline__ float fsig(float x) { return __builtin_amdgcn_rcpf(1.0f + __builtin_amdgcn_exp2f(-LOG2E * x)); }

template <int MODE = 0> struct EpiInprojT {
    static constexpr bool PERM = true;
    bf16_t* U; const float* bias;
    __device__ __forceinline__ void operator()(const f32x4 (&acc)[2][2][4][2], const Unit& u, int wr, int wc, int fr, int fq) const {
        const int row0 = u.pm * BM + wr * 64 + fr, col0 = u.pn * BM + wc * 32 + 8 * fq; const float qs = (u.pn == 6 || u.pn == 7) ? QSCALE : 1.0f;
        if (u.pn >= 12) {
            const int c0 = 128 * (u.pn - 12) + wc * 32 + 8 * fq;
            f32x4 ba[2], bb[2];
#pragma unroll
            for (int n = 0; n < 2; ++n) { ba[n] = *(const f32x4*)(bias + GOFF + c0 + 4 * n); bb[n] = *(const f32x4*)(bias + GOFF + D + c0 + 4 * n); }
#pragma unroll
            for (int ai = 0; ai < 2; ++ai)
#pragma unroll
                for (int m = 0; m < 4; ++m) { bf16_t* rowp = U + (size_t)(row0 + ai * HALF + m * 16) * INC + GOFF + c0; f32x4 rr[2], sb[2];
#pragma unroll
                    for (int n = 0; n < 2; ++n) { const f32x4 a = acc[ai][0][m][n] + ba[n], b = acc[ai][1][m][n] + bb[n];
#pragma unroll
                        for (int i = 0; i < 4; ++i) { const float ea = __builtin_amdgcn_exp2f(-LOG2E * a[i]), eb = __builtin_amdgcn_exp2f(-LOG2E * b[i]); const float s2 = __builtin_amdgcn_rcpf(1.0f + eb);
                            sb[n][i] = s2; rr[n][i] = (1.0f + eb) * __builtin_amdgcn_rcpf(1.0f + ea); } }
                    const u32x4 wr_ = pack8(rr[0], rr[1]), ws_ = pack8(sb[0], sb[1]);
                    if (MODE == 0) { *(u32x4*)rowp = wr_; *(u32x4*)(rowp + D) = ws_; } else asm volatile("" :: "v"(wr_), "v"(ws_)); }
            return;
        }
        const bool sig = false;
        f32x4 bv[2][2];
#pragma unroll
        for (int bj = 0; bj < 2; ++bj)
#pragma unroll
            for (int n = 0; n < 2; ++n) bv[bj][n] = *(const f32x4*)(bias + col0 + bj * HALF + 4 * n);
#pragma unroll
        for (int ai = 0; ai < 2; ++ai)
#pragma unroll
            for (int m = 0; m < 4; ++m) { bf16_t* rowp = U + (size_t)(row0 + ai * HALF + m * 16) * INC + col0;
#pragma unroll
                for (int bj = 0; bj < 2; ++bj) { f32x4 v0 = (acc[ai][bj][m][0] + bv[bj][0]) * qs, v1 = (acc[ai][bj][m][1] + bv[bj][1]) * qs;
                    if (sig) {
#pragma unroll
                        for (int i = 0; i < 4; ++i) { v0[i] = fsig(v0[i]); v1[i] = fsig(v1[i]); } }
                    const u32x4 w_ = pack8(v0, v1);
                    if (MODE == 0) *(u32x4*)(rowp + bj * HALF) = w_; else asm volatile("" :: "v"(w_)); } }
    }
};
typedef EpiInprojT<0> EpiInproj;
template <int P> struct EpiCat {
    static constexpr bool PERM = true;
    bf16_t* Mg; const bf16_t* U;
    __device__ __forceinline__ void operator()(const f32x4 (&acc)[2][2][4][2], const Unit& u, int wr, int wc, int fr, int fq) const {
        const int row0 = u.pm * BM + wr * 64 + fr, col0 = u.pn * BM + wc * 32 + 8 * fq;
#pragma unroll
        for (int ai = 0; ai < 2; ++ai)
#pragma unroll
            for (int m = 0; m < 4; ++m) { const size_t row = (size_t)(row0 + ai * HALF + m * 16);
#pragma unroll
                for (int bj = 0; bj < 2; ++bj) { const u32x4 gw = *(const u32x4*)(U + row * INC + GOFF + P * D + col0 + bj * HALF);
                    f32x4 g0, g1; unpack8(gw, g0, g1); f32x4 v0 = acc[ai][bj][m][0] * g0, v1 = acc[ai][bj][m][1] * g1;
                    bf16_t* mp = Mg + row * D + col0 + bj * HALF;
                    if (P == 1) { const u32x4 tw = *(const u32x4*)mp; f32x4 t0, t1; unpack8(tw, t0, t1); v0 += t0; v1 += t1; }
                    *(u32x4*)mp = pack8(v0, v1); } }
    }
};
struct EpiCatR {
    static constexpr bool PERM = true;
    bf16_t* Mg; const bf16_t* U;
    __device__ __forceinline__ void mid(f32x4 (&acc)[2][2][4][2], const Unit& u, int wr, int wc, int fr, int fq) const {
        int row0 = u.pm * BM + wr * 64 + fr; asm volatile("" : "+v"(row0));
        const int col0 = u.pn * BM + wc * 32 + 8 * fq;
#pragma unroll
        for (int ai = 0; ai < 2; ++ai) { asm volatile("" ::: "memory");
#pragma unroll
            for (int m = 0; m < 4; ++m) { const size_t row = (size_t)(row0 + ai * HALF + m * 16);
#pragma unroll
                for (int bj = 0; bj < 2; ++bj) { const u32x4 gw1 = *(const u32x4*)(U + row * INC + GOFF + col0 + bj * HALF);
                    f32x4 a0, a1; unpack8(gw1, a0, a1); acc[ai][bj][m][0] *= a0; acc[ai][bj][m][1] *= a1; } } }
        asm volatile("" ::: "memory");
    }
    __device__ __forceinline__ void operator()(const f32x4 (&acc)[2][2][4][2], const Unit& u, int wr, int wc, int fr, int fq) const {
        const int row0 = u.pm * BM + wr * 64 + fr, col0 = u.pn * BM + wc * 32 + 8 * fq;
#pragma unroll
        for (int ai = 0; ai < 2; ++ai)
#pragma unroll
            for (int m = 0; m < 4; ++m) { const size_t row = (size_t)(row0 + ai * HALF + m * 16);
#pragma unroll
                for (int bj = 0; bj < 2; ++bj) { const u32x4 gw = *(const u32x4*)(U + row * INC + GOFF + D + col0 + bj * HALF);
                    f32x4 g0, g1; unpack8(gw, g0, g1);
                    *(u32x4*)(Mg + row * D + col0 + bj * HALF) = pack8(acc[ai][bj][m][0] * g0, acc[ai][bj][m][1] * g1); } }
    }
};
struct EpiMix {
    static constexpr bool PERM = false;
    const float* X; float* O; const float* mod; float* ssq;
    __device__ __forceinline__ void operator()(const f32x4 (&acc)[2][2][4][2], const Unit& u, int wr, int wc, int fr, int fq) const {
        const int row0 = u.pm * BM + wr * 64 + fr, col0 = u.pn * BM + wc * 32 + 4 * fq; const int b = (u.pm * BM) / SEQ;
        f32x4 gv[2][2];
#pragma unroll
        for (int bj = 0; bj < 2; ++bj)
#pragma unroll
            for (int n = 0; n < 2; ++n) gv[bj][n] = *(const f32x4*)(mod + (size_t)b * 6 * D + 2 * D + col0 + bj * HALF + n * 16);
#pragma unroll
        for (int ai = 0; ai < 2; ++ai)
#pragma unroll
            for (int m = 0; m < 4; ++m) { const size_t off = (size_t)(row0 + ai * HALF + m * 16) * D + col0; float sq = 0.f;
#pragma unroll
                for (int bj = 0; bj < 2; ++bj)
#pragma unroll
                    for (int n = 0; n < 2; ++n) { const f32x4 v = *(const f32x4*)(X + off + bj * HALF + n * 16) + gv[bj][n] * acc[ai][bj][m][n]; *(f32x4*)(O + off + bj * HALF + n * 16) = v;
                        sq += (v.x * v.x + v.y * v.y) + (v.z * v.z + v.w * v.w); }
                sq += __shfl_xor(sq, 16); sq += __shfl_xor(sq, 32);
                if (fq == 0) ssq[(size_t)(row0 + ai * HALF + m * 16) * 16 + u.pn * 4 + wc] = sq; }
    }
};
struct EpiGateUp {
    static constexpr bool PERM = true;
    bf16_t* Act; const float* bgu;
    __device__ __forceinline__ void operator()(const f32x4 (&acc)[2][2][4][2], const Unit& u, int wr, int wc, int fr, int fq) const {
        const int e = u.pn >> 3, j = u.pn & 7; const int row0 = u.pm * BM + wr * 64 + fr, col0 = 128 * j + wc * 32 + 8 * fq;
        f32x4 bg[2], bu[2];
#pragma unroll
        for (int n = 0; n < 2; ++n) { bg[n] = *(const f32x4*)(bgu + (size_t)e * 2 * D + col0 + 4 * n); bu[n] = *(const f32x4*)(bgu + (size_t)e * 2 * D + D + col0 + 4 * n); }
#pragma unroll
        for (int ai = 0; ai < 2; ++ai)
#pragma unroll
            for (int m = 0; m < 4; ++m) { f32x4 r[2];
#pragma unroll
                for (int n = 0; n < 2; ++n) { const f32x4 gt = acc[ai][0][m][n] + bg[n], up = acc[ai][1][m][n] + bu[n];
#pragma unroll
                    for (int i = 0; i < 4; ++i) { const float gg = fminf(gt[i], 7.0f), uu = fminf(fmaxf(up[i], -7.0f), 7.0f); r[n][i] = (uu + 1.0f) * (gg * fsig(1.702f * gg)); } }
                *(u32x4*)(Act + (size_t)(row0 + ai * HALF + m * 16) * D + col0) = pack8(r[0], r[1]); }
    }
};
struct EpiDown {
    static constexpr bool PERM = true;
    bf16_t* Slots; const float* bd; const int* rowpair; const float* topw;
    __device__ __forceinline__ void operator()(const f32x4 (&acc)[2][2][4][2], const Unit& u, int wr, int wc, int fr, int fq) const {
        const int e = u.pn >> 2, j = u.pn & 3; const int row0 = u.pm * BM + wr * 64 + fr, col0 = 256 * j + wc * 32 + 8 * fq;
        f32x4 bv[2][2];
#pragma unroll
        for (int bj = 0; bj < 2; ++bj)
#pragma unroll
            for (int n = 0; n < 2; ++n) bv[bj][n] = *(const f32x4*)(bd + (size_t)e * D + col0 + bj * HALF + 4 * n);
#pragma unroll
        for (int ai = 0; ai < 2; ++ai)
#pragma unroll
            for (int m = 0; m < 4; ++m) { const int p = rowpair[row0 + ai * HALF + m * 16];
                if (p >= 0) { const float w = topw[p];
#pragma unroll
                    for (int bj = 0; bj < 2; ++bj) { const f32x4 v0 = (acc[ai][bj][m][0] + bv[bj][0]) * w, v1 = (acc[ai][bj][m][1] + bv[bj][1]) * w;
                        *(u32x4*)(Slots + (size_t)p * D + col0 + bj * HALF) = pack8(v0, v1); } } }
    }
};
}

#define LASP __attribute__((address_space(3)))
__device__ __forceinline__ void glds16(const void* gsrc, unsigned lds_dst) { unsigned keep;
    asm volatile("s_mov_b32 %0, m0\n\ts_mov_b32 m0, %2\n\ts_nop 0\n\tglobal_load_lds_dwordx4 %1, off\n\ts_mov_b32 m0, %0" : "=&s"(keep) : "v"(gsrc), "s"(lds_dst) : "memory"); }
__device__ __forceinline__ void glds16s(const void* sbase, unsigned voff, unsigned lds_dst) { unsigned keep;
    asm volatile("s_nop 4\n\ts_mov_b32 %0, m0\n\ts_mov_b32 m0, %3\n\ts_nop 0\n\tglobal_load_lds_dwordx4 %1, %2\n\ts_mov_b32 m0, %0" : "=&s"(keep) : "v"(voff), "s"(sbase), "s"(lds_dst) : "memory"); }
typedef short v4i16_t __attribute__((ext_vector_type(4)));
__device__ __forceinline__ s16x4 vtr(const LASP char* p) { return __builtin_bit_cast(s16x4, __builtin_amdgcn_ds_read_tr16_b64_v4i16((LASP v4i16_t*)p)); }
typedef float f32x2_t __attribute__((ext_vector_type(2))); typedef __bf16 bf16x2_t __attribute__((ext_vector_type(2)));
__device__ __forceinline__ unsigned cvtpk(float lo, float hi) { f32x2_t v = {lo, hi}; bf16x2_t b = __builtin_convertvector(v, bf16x2_t); return __builtin_bit_cast(unsigned, b); }

__device__ __forceinline__ float max3f(float a, float b, float c) { float r; asm("v_max3_f32 %0, %1, %2, %3" : "=v"(r) : "v"(a), "v"(b), "v"(c)); return r; }
__device__ __forceinline__ float fadd_s(float a, float b) { float r; asm("v_add_f32_e32 %0, %1, %2" : "=v"(r) : "v"(a), "v"(b)); return r; }
__device__ __forceinline__ unsigned bfbits(float f) { return f2bf(f); }
__device__ __forceinline__ void phase_attn_fast(Ctx& C) {
    const bf16_t* u = (const bf16_t*)(C.ws + WS_U); bf16_t* ycat = (bf16_t*)(C.ws + WS_YCAT);
    const int wave = C.wave;
    const float* lq = C.in[18];
    float lam;
    { const int l_ = lane_id(); const float d1 = wave_sum(lq[l_] * lq[64 + l_]), d2 = wave_sum(lq[128 + l_] * lq[192 + l_]); lam = __builtin_bit_cast(float, __builtin_amdgcn_readfirstlane(__builtin_bit_cast(int, expf(d1) - expf(d2) + 0.2f))); }
    const unsigned lds0 = (unsigned)(uintptr_t)C.lds;
    const LASP char* ldsp = (const LASP char*)C.lds;
    constexpr int SLOT = 24576;
    const int vcu = (C.nblk % 8 == 0) ? (C.blk % 8) * (C.nblk / 8) + C.blk / 8 : C.blk;
    for (int idx = vcu; idx < 256; idx += C.nblk)
#pragma unroll 1
    for (int sub = 0; sub < 2; ++sub) {
        const int b = idx >> 4, hA = (idx >> 3) & 1, qb = idx & 7; const int hh = sub ? 3 - hA : hA;
        const int lane = fresh_lane();
        const int l31 = lane & 31, hi = lane >> 5;
        const int krow = 8 * wave + (lane >> 3), kchunk = (lane & 7) ^ (lane >> 3);
        const int st0 = 4 * wave + (lane >> 5), st1 = st0 + 2;
        const int vrow = (lane & 31) >> 2, vch = lane & 3;
        const unsigned koffb = (unsigned)((krow * INC + kchunk * 8) * 2);
        const unsigned voffb0 = (unsigned)(((8 * (st0 >> 2) + vrow) * INC + 32 * (st0 & 3) + 8 * vch) * 2);
        const unsigned voffb1 = (unsigned)(((8 * (st1 >> 2) + vrow) * INC + 32 * (st1 & 3) + 8 * vch) * 2);
        const int koff0 = l31 * 128, kx = l31 & 7;
        const int vboff = 8192 + (4 * hi + ((lane & 15) >> 2)) * 64 + ((lane >> 4) & 1) * 32 + (lane & 3) * 8;
        const unsigned hm0 = hi ? 0u : 0xffffffffu;
        const unsigned dkdk = hi ? 0u : bfbits((float)l31) * 0x10001u;
        const int q0 = qb * 256 + wave * 32;
        const float slope2 = exp2f(-2.0f * (float)(hh + 1)) * LOG2E;
        const unsigned SH = bfbits(slope2); const unsigned SL = bfbits(slope2 - bf2f(SH)); const unsigned SHSL = SH | (SL << 16);
        const float slope2q = bf2f(SH) + bf2f(SL);
        const unsigned kw0b = hi ? 0x3f803f80u : SHSL, kw1b = hi ? 0x00003f80u : SHSL, ksm = hi ? 0u : 0x80008000u;
        const unsigned qa0 = bfbits((float)q0) * 0x10001u, qa1 = bfbits((float)l31) * 0x10001u;
        const float qpos = (float)(q0 + l31 - 4 * hi);
        const bf16_t* qrow = u + (size_t)(b * SEQ + q0 + l31) * INC + QOFF + hh * 128;
        const bf16_t* kgb = u + (size_t)(b * SEQ) * INC + KOFF + hh * 128;
        const bf16_t* vgb = u + (size_t)(b * SEQ) * INC + VOFF + hh * 128;
        const int t0 = qb * 4, tdiag = q0 >> 6;
#pragma unroll 1
        for (int c = 0; c < 2; ++c) {
            const bf16_t* kgc = kgb + c * 64;
#define ATT_DMA(t, sl) do { const size_t _o = (size_t)(t) * 64 * INC; const unsigned _b = lds0 + (unsigned)(sl) * SLOT; \
        glds16s(kgc + _o, koffb, (unsigned)__builtin_amdgcn_readfirstlane(_b + wave * 1024)); \
        glds16s(vgb + _o, voffb0, (unsigned)__builtin_amdgcn_readfirstlane(_b + 8192 + (2 * wave) * 1024)); \
        glds16s(vgb + _o, voffb1, (unsigned)__builtin_amdgcn_readfirstlane(_b + 8192 + (2 * wave + 1) * 1024)); } while (0)
#define ATT_WAITBAR() asm volatile("s_waitcnt vmcnt(0) lgkmcnt(0)\n\ts_barrier" ::: "memory")
#define ATT_WAITBAR3() asm volatile("s_waitcnt vmcnt(3) lgkmcnt(0)\n\ts_barrier" ::: "memory")
#define ATT_SB() __builtin_amdgcn_sched_barrier(0)
#define ATT_QK(sl, tt) do { const LASP char* Kb_ = ldsp + (sl) * SLOT + koff0; \
        const int kvb_ = (tt) * 64; const bool diag_ = (tt) == tdiag; const bool before_ = kvb_ < q0; \
        const unsigned spos_ = before_ ? 0x80008000u : 0u, sneg_ = before_ ? 0u : 0x80008000u; \
        const unsigned dm_ = diag_ ? ~hm0 : 0xffffffffu; \
        const unsigned w0_ = (kw0b ^ (spos_ & ksm)) & dm_, w1_ = (kw1b ^ (spos_ & ksm)) & dm_, w3_ = (dkdk ^ (sneg_ & ksm)) & dm_; \
        const unsigned k0_ = ((bfbits((float)kvb_) * 0x10001u) ^ sneg_) & hm0 & dm_, k1_ = ((bfbits((float)(kvb_ + 32)) * 0x10001u) ^ sneg_) & hm0 & dm_; \
        const bf16x8 ka0_ = __builtin_bit_cast(bf16x8, (u32x4){w0_, w1_, k0_, w3_}), ka1_ = __builtin_bit_cast(bf16x8, (u32x4){w0_, w1_, k1_, w3_}); \
        P0 = __builtin_amdgcn_mfma_f32_32x32x16_bf16(ka0_, qaug, zero16, 0, 0, 0); P1 = __builtin_amdgcn_mfma_f32_32x32x16_bf16(ka1_, qaug, zero16, 0, 0, 0); \
        _Pragma("unroll") for (int ks = 0; ks < 4; ++ks) { \
            const bf16x8 kf0_ = *(const LASP bf16x8*)(Kb_ + (((2 * ks + hi) ^ kx) * 16)); \
            const bf16x8 kf1_ = *(const LASP bf16x8*)(Kb_ + 4096 + (((2 * ks + hi) ^ kx) * 16)); \
            const bf16x8 qf_ = *(const LASP bf16x8*)(qlds + ks * 1024); \
            P0 = __builtin_amdgcn_mfma_f32_32x32x16_bf16(kf0_, qf_, P0, 0, 0, 0); P1 = __builtin_amdgcn_mfma_f32_32x32x16_bf16(kf1_, qf_, P1, 0, 0, 0); } \
        asm volatile("s_nop 15\n\ts_nop 7" : "+v"(P0), "+v"(P1));     \
        ATT_SB(); } while (0)
#define ATT_SM(tt) do { \
        if ((tt) == tdiag) { const float a_ = qpos - (float)((tt) * 64); \
            _Pragma("unroll") for (int r = 0; r < 16; ++r) { const float x0 = a_ - (float)crow(r, 0); P0[r] = fmaf(fabsf(x0), -slope2q, P0[r]); P1[r] = fmaf(fabsf(x0 - 32.0f), -slope2q, P1[r]); } } \
        float rm_ = max3f(P0[0], P0[1], P1[0]); rm_ = max3f(rm_, P1[1], P0[2]); float rn_ = max3f(P0[3], P1[2], P1[3]); \
        _Pragma("unroll") for (int r = 4; r < 16; r += 2) { rm_ = max3f(rm_, P0[r], P0[r + 1]); rn_ = max3f(rn_, P1[r], P1[r + 1]); } \
        float rm; { const float rq_ = fmaxf(rm_, rn_); auto rr = __builtin_amdgcn_permlane32_swap(__float_as_uint(rq_), __float_as_uint(rq_), false, false); rm = max3f(__uint_as_float(rr[0]), __uint_as_float(rr[1]), -1e30f); } \
        live = !__all(rm < mrel - 40.0f);       \
        if (live) { \
            mrel = fmaxf(mrel, rm); \
            if (__any(rm > 8.0f)) { const float dl = fmaxf(rm, 0.f); mhat += dl; mrel -= dl; \
                _Pragma("unroll") for (int r = 0; r < 16; ++r) { P0[r] -= dl; P1[r] -= dl; } \
                { const unsigned mh_ = bfbits(mhat); const float r1_ = mhat - bf2f(mh_); const unsigned mm_ = bfbits(r1_); const unsigned ml_ = bfbits(r1_ - bf2f(mm_)); \
                  const unsigned a0_ = hi ? ((mh_ | (mm_ << 16)) ^ 0x80008000u) : qa0, a1_ = hi ? (ml_ ^ 0x8000u) : qa1; \
                  qaug = __builtin_bit_cast(bf16x8, (u32x4){a0_, a1_, hi ? 0u : SHSL, hi ? 0u : SHSL}); } \
                const float f = exp2f(-dl); lsum *= f; \
                _Pragma("unroll") for (int eb = 0; eb < 4; ++eb) _Pragma("unroll") for (int r = 0; r < 16; ++r) o[eb][r] *= f; } \
            _Pragma("unroll") for (int r = 0; r < 16; ++r) { P0[r] = __builtin_amdgcn_exp2f(P0[r]); P1[r] = __builtin_amdgcn_exp2f(P1[r]); } \
            asm volatile("s_nop 1" : "+v"(P0), "+v"(P1));     \
            float ps0 = fadd_s(P0[0], P1[0]), ps1 = fadd_s(P0[1], P1[1]); \
            _Pragma("unroll") for (int r = 2; r < 16; r += 2) { ps0 = fadd_s(ps0, P0[r]); ps1 = fadd_s(ps1, P0[r + 1]); ps0 = fadd_s(ps0, P1[r]); ps1 = fadd_s(ps1, P1[r + 1]); } \
            lsum += fadd_s(ps0, ps1); \
            _Pragma("unroll") for (int s2 = 0; s2 < 2; ++s2) { \
                u32x4 w_; w_.x = cvtpk(P0[8 * s2 + 0], P0[8 * s2 + 1]); w_.y = cvtpk(P0[8 * s2 + 2], P0[8 * s2 + 3]); w_.z = cvtpk(P0[8 * s2 + 4], P0[8 * s2 + 5]); w_.w = cvtpk(P0[8 * s2 + 6], P0[8 * s2 + 7]); pf[s2] = __builtin_bit_cast(bf16x8, w_); \
                u32x4 v_; v_.x = cvtpk(P1[8 * s2 + 0], P1[8 * s2 + 1]); v_.y = cvtpk(P1[8 * s2 + 2], P1[8 * s2 + 3]); v_.z = cvtpk(P1[8 * s2 + 4], P1[8 * s2 + 5]); v_.w = cvtpk(P1[8 * s2 + 6], P1[8 * s2 + 7]); pf[2 + s2] = __builtin_bit_cast(bf16x8, v_); } \
        } ATT_SB(); } while (0)
#define ATT_PV(sl) do { if (live) { const LASP char* Vb_ = ldsp + (sl) * SLOT + vboff; \
            _Pragma("unroll") for (int eb = 0; eb < 4; ++eb) _Pragma("unroll") for (int s = 0; s < 4; ++s) { \
                const s16x4 lo_ = vtr(Vb_ + s * 4096 + eb * 512), h4_ = vtr(Vb_ + s * 4096 + 2048 + eb * 512); \
                const bf16x8 vf_ = (bf16x8){lo_[0], lo_[1], lo_[2], lo_[3], h4_[0], h4_[1], h4_[2], h4_[3]}; \
                o[eb] = __builtin_amdgcn_mfma_f32_32x32x16_bf16(vf_, pf[s], o[eb], 0, 0, 0); } } ATT_SB(); } while (0)
            { bf16x8 qf_[4];
#pragma unroll
              for (int ks = 0; ks < 4; ++ks) qf_[ks] = *(const bf16x8*)(qrow + c * 64 + 16 * ks + 8 * hi);
#pragma unroll
              for (int ks = 0; ks < 4; ++ks) *(LASP bf16x8*)((LASP char*)C.lds + 4 * SLOT + wave * 4096 + ks * 1024 + lane * 16) = qf_[ks]; }
            asm volatile("s_waitcnt vmcnt(0)" ::: "memory");
            ATT_DMA(t0, 0); ATT_DMA((t0 + 1) & 31, 1);
            const LASP char* qlds = ldsp + 4 * SLOT + wave * 4096 + lane * 16;
            f32x16 o[4], zero16, P0, P1;
#pragma unroll
            for (int r = 0; r < 16; ++r) zero16[r] = 0.f;
#pragma unroll
            for (int eb = 0; eb < 4; ++eb)
#pragma unroll
                for (int r = 0; r < 16; ++r) o[eb][r] = 0.f;
            float mhat = 0.f, lsum = 0.f, mrel = -1e30f;
            bf16x8 qaug = __builtin_bit_cast(bf16x8, (u32x4){hi ? 0u : qa0, hi ? 0u : qa1, hi ? 0u : SHSL, hi ? 0u : SHSL});
            bf16x8 pf[4]; bool live = false;
            if (wave < 4) {
#pragma unroll 1
                for (int i = 0; i < 32; ++i) {
                    if (i + 1 < 32) ATT_WAITBAR3(); else ATT_WAITBAR();
                    if (i + 2 < 32) ATT_DMA((t0 + i + 2) & 31, (i + 2) & 3);
                    const int tt = (t0 + i) & 31;
                    ATT_QK(i & 3, tt); ATT_SM(tt); ATT_PV(i & 3);
                }
            } else {
#pragma unroll 1
                for (int i = 0; i < 32; ++i) {
                    if (i + 1 < 32) ATT_WAITBAR3(); else ATT_WAITBAR();
                    if (i + 2 < 32) ATT_DMA((t0 + i + 2) & 31, (i + 2) & 3);
                    const int tt = (t0 + i) & 31;
                    ATT_PV((i - 1) & 3); ATT_QK(i & 3, tt); ATT_SM(tt);
                }
                ATT_PV(31 & 3);
            }
#undef ATT_DMA
#undef ATT_QK
#undef ATT_SM
#undef ATT_PV
#undef ATT_SB
            { auto rr = __builtin_amdgcn_permlane32_swap(__float_as_uint(lsum), __float_as_uint(lsum), false, false); lsum = __uint_as_float(rr[0]) + __uint_as_float(rr[1]); }
            const float inv = 1.0f / lsum;
            float* pk = (float*)(C.ws + WS_H2LO) + (size_t)C.gw * 4096;
            pk += fresh_lane();
            if (c == 0) {
#pragma unroll
                for (int eb = 0; eb < 4; ++eb)
#pragma unroll
                    for (int r = 0; r < 16; ++r) pk[(eb * 16 + r) * 64] = o[eb][r] * inv;
            } else {
                float ss = 0.f;
#pragma unroll
                for (int eb = 0; eb < 4; ++eb)
#pragma unroll
                    for (int r = 0; r < 16; ++r) { const float y = pk[(eb * 16 + r) * 64] - lam * (o[eb][r] * inv); o[eb][r] = y; ss += y * y; }
                { auto rr = __builtin_amdgcn_permlane32_swap(__float_as_uint(ss), __float_as_uint(ss), false, false); ss = __uint_as_float(rr[0]) + __uint_as_float(rr[1]); }
                const float rinv = 1.0f / sqrtf(ss * (1.0f / 128.0f) + EPS);
                bf16_t* orow = ycat + (size_t)(b * SEQ + q0 + l31) * D + 512 + hh * 128 + 4 * hi;
#pragma unroll
                for (int eb = 0; eb < 4; ++eb)
#pragma unroll
                    for (int g4 = 0; g4 < 4; ++g4) { const int e = 32 * eb + 8 * g4;
                        u32x2 w; w.x = cvtpk(o[eb][4 * g4] * rinv, o[eb][4 * g4 + 1] * rinv); w.y = cvtpk(o[eb][4 * g4 + 2] * rinv, o[eb][4 * g4 + 3] * rinv);
                        *(u32x2*)(orow + e) = w; }
            }
        }
    }
    ATT_WAITBAR();
#undef ATT_WAITBAR
#undef ATT_WAITBAR3
}

__device__ __forceinline__ void phase_hy_pre_fast(Ctx& C) {
    const bf16_t* u = (const bf16_t*)(C.ws + WS_U); bf16_t* vpt = (bf16_t*)(C.ws + WS_VP); bf16_t* x0t = (bf16_t*)(C.ws + WS_X0C);
    const float* cw = C.in[7]; const float* cb = C.in[8];
    bf16_t* sv = (bf16_t*)C.lds; bf16_t* sx = sv + 64 * 72;
    const int tl = C.tid >> 3, c8 = C.tid & 7;
    for (int tile = C.blk; tile < NB * 32 * 8; tile += C.nblk) {
        const int cq = tile & 7, tq = (tile >> 3) & 31, b = tile >> 8;
        const int c0 = cq * 64 + c8 * 8, t = tq * 64 + tl; const size_t row = (size_t)b * SEQ + t;
        float r[3][8];
#pragma unroll
        for (int s = 0; s < 3; ++s) {
            const int ch = s * HW + c0;
            const u32x4 z = {0u, 0u, 0u, 0u};
            const u32x4 um = (t > 0) ? *(const u32x4*)(u + (row - 1) * INC + ch) : z, u0 = *(const u32x4*)(u + row * INC + ch), up = (t < SEQ - 1) ? *(const u32x4*)(u + (row + 1) * INC + ch) : z;
            f32x4 m0, m1, z0, z1, p0, p1; pg8::unpack8(um, m0, m1); pg8::unpack8(u0, z0, z1); pg8::unpack8(up, p0, p1);
            const f32x4 w00 = *(const f32x4*)(cw + ch), w01 = *(const f32x4*)(cw + ch + 4), w10 = *(const f32x4*)(cw + 3 * HW + ch), w11 = *(const f32x4*)(cw + 3 * HW + ch + 4);
            const f32x4 w20 = *(const f32x4*)(cw + 6 * HW + ch), w21 = *(const f32x4*)(cw + 6 * HW + ch + 4), bb0 = *(const f32x4*)(cb + ch), bb1 = *(const f32x4*)(cb + ch + 4);
            const f32x4 a0 = m0 * w00 + z0 * w10 + p0 * w20 + bb0, a1 = m1 * w01 + z1 * w11 + p1 * w21 + bb1;
#pragma unroll
            for (int i = 0; i < 4; ++i) { r[s][i] = a0[i]; r[s][4 + i] = a1[i]; }
        }
        __syncthreads();
#pragma unroll
        for (int i = 0; i < 8; ++i) { sx[(c8 * 8 + i) * 72 + tl] = (bf16_t)f2bf(r[0][i]); sv[(c8 * 8 + i) * 72 + tl] = (bf16_t)f2bf(r[2][i] * r[1][i]); }
        __syncthreads();
        { const int cl = C.tid >> 3, chk = C.tid & 7; const size_t o = ((size_t)(cq * 64 + cl) * NB + b) * SEQ + tq * 64 + chk * 8;
          *(u32x4*)(vpt + o) = *(const u32x4*)(sv + cl * 72 + chk * 8); *(u32x4*)(x0t + o) = *(const u32x4*)(sx + cl * 72 + chk * 8); }
    }
    __syncthreads();
}

__device__ __forceinline__ void phase_toeplitz(Ctx& C) {
    constexpr int VROW = 4096 + 16, FCOPY = 8192 + 32, FL = 16 * VROW;
    const bf16_t* vpt = (const bf16_t*)(C.ws + WS_VP); const bf16_t* x0t = (const bf16_t*)(C.ws + WS_X0C); bf16_t* yt = (bf16_t*)(C.ws + WS_YT);
    const float* kfc = (const float*)(C.ws + WS_KFC); const float* dsk = C.in[17];
    const int lane = C.lane, a = lane & 15, g = lane >> 4, wave = C.wave;
    const unsigned lds0 = (unsigned)(uintptr_t)C.lds;
    const LASP char* ldsp = (const LASP char*)C.lds;
    const int t0 = 256 * wave;
    const int c0 = 2048 - t0 + 8 * g - a;
    const LASP char* fbase = ldsp + FL + (c0 & 7) * FCOPY + 2 * (c0 & ~7);
    const LASP char* vbase = ldsp + a * VROW + 16 * g;
    for (int c = C.blk; c < HW; c += C.nblk) {
        asm volatile("s_waitcnt vmcnt(0) lgkmcnt(0)\n\ts_barrier" ::: "memory");
        { const char* src = (const char*)(vpt + (size_t)c * NB * SEQ) + lane * 16;
#pragma unroll
          for (int j = 0; j < 8; ++j) { const int p = wave * 8 + j;
              glds16(src + (size_t)p * 1024, (unsigned)__builtin_amdgcn_readfirstlane(lds0 + (p >> 2) * VROW + (p & 3) * 1024)); } }
        { const int q = C.tid; const float* kc = kfc + (size_t)c * 4096; float f[15];
#pragma unroll
          for (int i = 0; i < 15; ++i) { const int idx = 4096 - 8 * q - i; f[i] = (idx >= 1 && idx <= 4095) ? kc[idx] : 0.f; }
#pragma unroll
          for (int m = 0; m < 8; ++m) { u32x4 w; w.x = pk2(f[m], f[m + 1]); w.y = pk2(f[m + 2], f[m + 3]); w.z = pk2(f[m + 4], f[m + 5]); w.w = pk2(f[m + 6], f[m + 7]);
              *(LASP u32x4*)((LASP char*)C.lds + FL + m * FCOPY + q * 16) = w; } }
        asm volatile("s_waitcnt vmcnt(0) lgkmcnt(0)\n\ts_barrier" ::: "memory");
        f32x4 acc[16]; bf16x8 W[16];
#pragma unroll
        for (int r = 0; r < 16; ++r) { acc[r] = (f32x4){0.f, 0.f, 0.f, 0.f}; W[r] = *(const LASP bf16x8*)(fbase - 32 * r); }
#pragma unroll 1
        for (int ko = 0; ko < 8; ++ko) {
            const LASP char* fb = fbase + ko * 512; const LASP char* vb = vbase + ko * 512;
#pragma unroll
            for (int kk = 0; kk < 8; ++kk) {
                const bf16x8 Bf = *(const LASP bf16x8*)(vb + 64 * kk);
#pragma unroll
                for (int r = 0; r < 16; ++r) acc[r] = __builtin_amdgcn_mfma_f32_16x16x32_bf16(W[(r - 2 * kk) & 15], Bf, acc[r], 0, 0, 0);
                if (ko < 7 || kk < 7) { W[(-2 * kk - 2) & 15] = *(const LASP bf16x8*)(fb + 64 * kk + 64); W[(-2 * kk - 1) & 15] = *(const LASP bf16x8*)(fb + 64 * kk + 32); }
            }
        }
        const float dd = dsk[c];
#pragma unroll
        for (int r = 0; r < 16; ++r) { const int t = t0 + 16 * r + 4 * g; const size_t o = ((size_t)c * NB + a) * SEQ + t;
            const u32x2 vv = *(const LASP u32x2*)(ldsp + a * VROW + t * 2); const u32x2 xx = *(const u32x2*)(x0t + o);
            const float y0 = (acc[r][0] + bflo(vv.x) * dd) * bflo(xx.x), y1 = (acc[r][1] + bfhi(vv.x) * dd) * bfhi(xx.x);
            const float y2 = (acc[r][2] + bflo(vv.y) * dd) * bflo(xx.y), y3 = (acc[r][3] + bfhi(vv.y) * dd) * bfhi(xx.y);
            u32x2 w; w.x = pk2(y0, y1); w.y = pk2(y2, y3); *(u32x2*)(yt + o) = w; }
    }
    asm volatile("s_waitcnt vmcnt(0) lgkmcnt(0)\n\ts_barrier" ::: "memory");
}

__device__ __forceinline__ void phase_hy_post(Ctx& C) {
    const bf16_t* yt = (const bf16_t*)(C.ws + WS_YT); bf16_t* ycat = (bf16_t*)(C.ws + WS_YCAT);
    bf16_t* sy = (bf16_t*)C.lds;
    for (int tile = C.blk; tile < NB * 32 * 8; tile += C.nblk) {
        const int cq = tile & 7, tq = (tile >> 3) & 31, b = tile >> 8;
        __syncthreads();
        { const int cl = C.tid >> 3, chk = C.tid & 7; *(u32x4*)(sy + cl * 72 + chk * 8) = *(const u32x4*)(yt + ((size_t)(cq * 64 + cl) * NB + b) * SEQ + tq * 64 + chk * 8); }
        __syncthreads();
        { const int tl = C.tid >> 3, c8 = C.tid & 7; unsigned short e[8];
#pragma unroll
          for (int i = 0; i < 8; ++i) e[i] = sy[(c8 * 8 + i) * 72 + tl];
          u32x4 w; w.x = e[0] | ((unsigned)e[1] << 16); w.y = e[2] | ((unsigned)e[3] << 16); w.z = e[4] | ((unsigned)e[5] << 16); w.w = e[6] | ((unsigned)e[7] << 16);
          *(u32x4*)(ycat + ((size_t)b * SEQ + tq * 64 + tl) * D + cq * 64 + c8 * 8) = w; }
    }
    __syncthreads();
}

__device__ __forceinline__ void phase_route(Ctx& C) {
    const float* mod = (const float*)(C.ws + WS_MOD); const float* ssq = (const float*)(C.ws + WS_LOGITS); bf16_t* h2 = (bf16_t*)(C.ws + WS_H); const bf16_t* wrt = (const bf16_t*)(C.ws + WS_WRT);
    int* tope = (int*)(C.ws + WS_TOPE); float* topw = (float*)(C.ws + WS_TOPW); int* blkcnt = (int*)(C.ws + WS_BLKCNT);
    const float* g = C.in[23]; const float* br = C.in[25];
    int* hist = (int*)C.lds; float* slog = (float*)(C.lds + 1024) + C.wave * 512;
    const int lane = C.lane, tk = lane & 15, gq = lane >> 4;
    for (int vb = C.blk; vb < 256; vb += C.nblk) {
        __syncthreads();
        if (C.tid < NE) hist[C.tid] = 0;
        __syncthreads();
        const int tok = vb * 128 + C.wave * 16 + tk; const int b = tok / SEQ;
        float rstd;
        { const f32x4* sp = (const f32x4*)(ssq + (size_t)tok * 16); const f32x4 a0 = sp[0], a1 = sp[1], a2 = sp[2], a3 = sp[3];
          const float ss = ((a0.x + a0.y) + (a0.z + a0.w)) + ((a1.x + a1.y) + (a1.z + a1.w)) + ((a2.x + a2.y) + (a2.z + a2.w)) + ((a3.x + a3.y) + (a3.z + a3.w));
          rstd = 1.0f / sqrtf(ss * (1.0f / D) + EPS); }
        const float* xr = C.out + (size_t)tok * D + 8 * gq; const float* sh = mod + (size_t)b * 6 * D + 3 * D + 8 * gq; const float* sc = sh + D; const float* gg = g + 8 * gq;
        bf16_t* hr = h2 + (size_t)tok * D + 8 * gq;
        const bf16_t* wb = wrt + (size_t)tk * 2048 + 8 * gq;
        f32x4 acc[2]; acc[0] = (f32x4){0.f, 0.f, 0.f, 0.f}; acc[1] = acc[0];
#pragma unroll 2
        for (int k = 0; k < D; k += 32) {
            const f32x4 x0 = *(const f32x4*)(xr + k), x1v = *(const f32x4*)(xr + k + 4), g0 = *(const f32x4*)(gg + k), g1 = *(const f32x4*)(gg + k + 4);
            const f32x4 c0 = *(const f32x4*)(sc + k), c1 = *(const f32x4*)(sc + k + 4), s0 = *(const f32x4*)(sh + k), s1 = *(const f32x4*)(sh + k + 4);
            f32x4 h0, h1;
#pragma unroll
            for (int i = 0; i < 4; ++i) { h0[i] = x0[i] * rstd * g0[i] * (1.f + c0[i]) + s0[i]; h1[i] = x1v[i] * rstd * g1[i] * (1.f + c1[i]) + s1[i]; }
            u32x4 wh; wh.x = pk2(h0[0], h0[1]); wh.y = pk2(h0[2], h0[3]); wh.z = pk2(h1[0], h1[1]); wh.w = pk2(h1[2], h1[3]);
            *(u32x4*)(hr + k) = wh;
            u32x4 wl; wl.x = pk2(h0[0] - bflo(wh.x), h0[1] - bfhi(wh.x)); wl.y = pk2(h0[2] - bflo(wh.y), h0[3] - bfhi(wh.y)); wl.z = pk2(h1[0] - bflo(wh.z), h1[1] - bfhi(wh.z)); wl.w = pk2(h1[2] - bflo(wh.w), h1[3] - bfhi(wh.w));
            const bf16x8 a_h = __builtin_bit_cast(bf16x8, wh), a_l = __builtin_bit_cast(bf16x8, wl);
#pragma unroll
            for (int n = 0; n < 2; ++n) { const bf16_t* bp = wb + (size_t)n * 16 * 2048 + k;
                const bf16x8 b_h = *(const bf16x8*)(bp), b_l = *(const bf16x8*)(bp + 1024);
                acc[n] = __builtin_amdgcn_mfma_f32_16x16x32_bf16(b_h, a_h, acc[n], 0, 0, 0);
                acc[n] = __builtin_amdgcn_mfma_f32_16x16x32_bf16(b_h, a_l, acc[n], 0, 0, 0);
                acc[n] = __builtin_amdgcn_mfma_f32_16x16x32_bf16(b_l, a_h, acc[n], 0, 0, 0); }
        }
#pragma unroll
        for (int n = 0; n < 2; ++n) *(f32x4*)(slog + tk * 32 + n * 16 + 4 * gq) = acc[n];
        __builtin_amdgcn_s_waitcnt(0xc07f); asm volatile("" ::: "memory");
        if (lane < 16) {
            const int t = vb * 128 + C.wave * 16 + lane;
            float v[32];
#pragma unroll
            for (int q = 0; q < 8; ++q) { const f32x4 x = *(const f32x4*)(slog + lane * 32 + 4 * q), bb = *(const f32x4*)(br + 4 * q);
                v[4 * q] = x.x + bb.x; v[4 * q + 1] = x.y + bb.y; v[4 * q + 2] = x.z + bb.z; v[4 * q + 3] = x.w + bb.w; }
            float tv[4]; int ti[4];
#pragma unroll
            for (int k = 0; k < 4; ++k) {
                float best = -INFINITY; int bi = 0;
#pragma unroll
                for (int e = 0; e < 32; ++e) if (v[e] > best) { best = v[e]; bi = e; }
                tv[k] = best; ti[k] = bi;
#pragma unroll
                for (int e = 0; e < 32; ++e) v[e] = (e == bi) ? -INFINITY : v[e];
            }
            const float e0 = 1.0f, e1 = expf(tv[1] - tv[0]), e2 = expf(tv[2] - tv[0]), e3 = expf(tv[3] - tv[0]);
            const float inv = 1.0f / (e0 + e1 + e2 + e3);
            *(int4*)(tope + (size_t)t * 4) = make_int4(ti[0], ti[1], ti[2], ti[3]);
            *(f32x4*)(topw + (size_t)t * 4) = (f32x4){e0 * inv, e1 * inv, e2 * inv, e3 * inv};
#pragma unroll
            for (int k = 0; k < 4; ++k) atomicAdd(&hist[ti[k]], 1);
        }
        __syncthreads();
        if (C.tid < NE) blkcnt[vb * NE + C.tid] = hist[C.tid];
    }
    __syncthreads();
}

__device__ __forceinline__ void phase_rowlist(Ctx& C) {
    const int* tope = (const int*)(C.ws + WS_TOPE); const int* blkcnt = (const int*)(C.ws + WS_BLKCNT);
    int* rowpair = (int*)(C.ws + WS_ROWPAIR); int* tileexp = (int*)(C.ws + WS_TILEEXP); int* meta = (int*)(C.ws + WS_META);
    int* s_total = (int*)C.lds; int* s_base = s_total + 32; int* s_pstart = s_base + 32; int* s_e = s_pstart + 36; int* s_cnt = s_e + 512;
    for (int vb = C.blk; vb < 256; vb += C.nblk) {
        __syncthreads();
        { const int4* src = (const int4*)blkcnt; int4* dst = (int4*)s_cnt;
#pragma unroll
          for (int q = 0; q < 4; ++q) dst[q * NTHREADS + C.tid] = src[q * NTHREADS + C.tid]; }
        s_e[C.tid] = tope[(size_t)vb * 512 + C.tid];
        __syncthreads();
        if (C.tid < NE) { int tot = 0, base = 0;
#pragma unroll 8
            for (int q = 0; q < 256; ++q) { const int c = s_cnt[q * NE + C.tid]; tot += c; if (q < vb) base += c; } s_total[C.tid] = tot; s_base[C.tid] = base; }
        __syncthreads();
        if (C.tid == 0) { int ps = 0; for (int e = 0; e < NE; ++e) { s_pstart[e] = ps; ps += ((s_total[e] + 255) / 256) * 256; } s_pstart[NE] = ps; }
        __syncthreads();
        { const int e = s_e[C.tid]; int rank = 0; for (int j = 0; j < C.tid; ++j) rank += (s_e[j] == e) ? 1 : 0;
          rowpair[s_pstart[e] + s_base[e] + rank] = vb * 512 + C.tid; }
        if (vb < NE) { const int e = vb; for (int r = s_pstart[e] + s_total[e] + C.tid; r < s_pstart[e + 1]; r += NTHREADS) rowpair[r] = -1; }
        if (vb == 0) {
            if (C.tid < NE) { for (int tl = s_pstart[C.tid] / 256; tl < s_pstart[C.tid + 1] / 256; ++tl) tileexp[tl] = C.tid; }
            if (C.tid == 0) meta[0] = s_pstart[NE] / 256;
        }
    }
    __syncthreads();
}


#define LDS3(C) ((PG8_LAS unsigned char*)(C).lds)
__device__ __forceinline__ void phase_inproj_fast(Ctx& C) {
    pg8::Gemm g{(const bf16_t*)(C.ws + WS_H), (const bf16_t*)(C.ws + WS_WIN), D, D, D, nullptr};
    pg8::StaticOrder S; S.init(T / 256, INC / 256, C.nblk, C.blk);
    pg8::EpiInproj E{(bf16_t*)(C.ws + WS_U), C.in[6]};
    pg8::gemm_phase<pg8::EpiInproj, pg8::StaticOrder, false>(LDS3(C), g, S, E, C.wave);
}
#ifndef XVAR
#define XVAR 0
#endif
__device__ __forceinline__ void phase_probe_x(Ctx& C) {
#if XVAR == 1
    pg8::Gemm g{(const bf16_t*)(C.ws + WS_H), (const bf16_t*)(C.ws + WS_WIN), D, D, D, nullptr};
    pg8::StaticOrder S; S.init(T / 256, INC / 256, C.nblk, C.blk);
    pg8::EpiInprojT<1> E{(bf16_t*)(C.ws + WS_U), C.in[6]};
    pg8::gemm_phase<pg8::EpiInprojT<1>, pg8::StaticOrder, false>(LDS3(C), g, S, E, C.wave);
#endif
}
__device__ __forceinline__ void phase_cat_fast(Ctx& C) {
    pg8::StaticOrder S; S.init(T / 256, D / 256, C.nblk, C.blk);
    pg8::Gemm g{(const bf16_t*)(C.ws + WS_YCAT), (const bf16_t*)(C.ws + WS_WCAT), D, D, D, nullptr};
    pg8::EpiCatR E{(bf16_t*)(C.ws + WS_MERGED), (const bf16_t*)(C.ws + WS_U)};
    pg8::gemm_phase<pg8::EpiCatR, pg8::StaticOrder, false, true>(LDS3(C), g, S, E, C.wave);
}
__device__ __forceinline__ void phase_mix_fast(Ctx& C) {
    pg8::Gemm g{(const bf16_t*)(C.ws + WS_MERGED), (const bf16_t*)(C.ws + WS_WMIX), D, D, D, nullptr};
    pg8::StaticOrder S; S.init(T / 256, D / 256, C.nblk, C.blk);
    pg8::EpiMix E{C.in[0], C.out, (const float*)(C.ws + WS_MOD), (float*)(C.ws + WS_LOGITS)};
    pg8::gemm_phase<pg8::EpiMix, pg8::StaticOrder, false>(LDS3(C), g, S, E, C.wave);
}
__device__ __forceinline__ void phase_gateup_fast(Ctx& C) {
    const int nmt = ((const int*)(C.ws + WS_META))[0];
    pg8::Gemm g{(const bf16_t*)(C.ws + WS_H), (const bf16_t*)(C.ws + WS_WGU), D, D, D, (const int*)(C.ws + WS_ROWPAIR)};
    pg8::MoeOrder S; S.b.init(nmt, 8, C.nblk, C.blk); S.tileexp = (const int*)(C.ws + WS_TILEEXP); S.nN = 8;
    pg8::EpiGateUp E{(bf16_t*)(C.ws + WS_ACT), C.in[27]};
    pg8::gemm_phase<pg8::EpiGateUp, pg8::MoeOrder, true>(LDS3(C), g, S, E, C.wave);
}
__device__ __forceinline__ void phase_down_fast(Ctx& C) {
    const int nmt = ((const int*)(C.ws + WS_META))[0];
    pg8::Gemm g{(const bf16_t*)(C.ws + WS_ACT), (const bf16_t*)(C.ws + WS_WDN), D, D, D, nullptr};
    pg8::MoeOrder S; S.b.init(nmt, 4, C.nblk, C.blk); S.tileexp = (const int*)(C.ws + WS_TILEEXP); S.nN = 4;
    pg8::EpiDown E{(bf16_t*)(C.ws + WS_SLOTS), C.in[29], (const int*)(C.ws + WS_ROWPAIR), (const float*)(C.ws + WS_TOPW)};
    pg8::gemm_phase<pg8::EpiDown, pg8::MoeOrder, false>(LDS3(C), g, S, E, C.wave);
}


#define XB_TMO      128
#define XB_XCNT(j)  (256  + 64 * (j))
#define XB_XSUB(j)  (1280 + 64 * (j))
#define XB_XGEN(j)  (2304 + 64 * (j))
#define XB_TOP      3328
#define XB_TOPGEN   3392
#define XCD_BAR_WORDS 3456
#define XB_SPIN_CAP (1u << 18)
#define XLAS __attribute__((address_space(3)))
__device__ __forceinline__ unsigned xb_ld(unsigned* p)              { return __hip_atomic_load(p, __ATOMIC_RELAXED, __HIP_MEMORY_SCOPE_AGENT); }
__device__ __forceinline__ unsigned xb_add(unsigned* p, unsigned v) { return __hip_atomic_fetch_add(p, v, __ATOMIC_RELAXED, __HIP_MEMORY_SCOPE_AGENT); }
__device__ __forceinline__ unsigned xb_xcc_id() { return (unsigned)__builtin_amdgcn_s_getreg((3 << 11) | 20) & 0xFu; }
#define XB_SPIN(cond, bar) do { unsigned _sp = 0; while (cond) { __builtin_amdgcn_s_sleep(1); \
    if ((++_sp & 255u) == 0u) { if (xb_ld(&(bar)[XB_TMO])) break; if (_sp > XB_SPIN_CAP) { atomicAdd(&(bar)[XB_TMO], 1u); break; } } } } while (0)
struct XcdBarrier { unsigned* bar; unsigned x; volatile XLAS unsigned* st; };
__device__ __forceinline__ XcdBarrier xcd_barrier_post(unsigned* bar, volatile XLAS unsigned* st, bool leader) {
    XcdBarrier b; b.bar = bar; b.x = xb_xcc_id(); b.st = st;
    if (leader) (void)xb_add(&bar[XB_XCNT(b.x)], 1u);
    return b;
}
__device__ __forceinline__ void xcd_barrier_complete(unsigned* bar, unsigned x, unsigned& nloc, unsigned& nx) {
    const unsigned G = gridDim.x * gridDim.y * gridDim.z;
    unsigned sum, cnt, mine, sp = 0u;
    for (;;) {
        sum = 0u; cnt = 0u; mine = 0u;
#pragma unroll
        for (unsigned j = 0; j < 16; ++j) { const unsigned c = xb_ld(&bar[XB_XCNT(j)]); sum += c; cnt += (c > 0u) ? 1u : 0u; mine = (j == x) ? c : mine; }
        if (sum == G) break;
        __builtin_amdgcn_s_sleep(1);
        if ((++sp & 255u) == 0u) { if (xb_ld(&bar[XB_TMO])) break; if (sp > XB_SPIN_CAP) { atomicAdd(&bar[XB_TMO], 1u); break; } }
    }
    nloc = mine > 0u ? mine : 1u; nx = cnt > 0u ? cnt : 1u;
}
__device__ __forceinline__ void xcd_barrier(const XcdBarrier& b, int wave_) {
    asm volatile("s_waitcnt vmcnt(0)" ::: "memory");
    __syncthreads();
    if (wave_ == 0 && lane_id() == 0) {
        unsigned* bar = b.bar;
        __builtin_amdgcn_s_waitcnt(0);
        unsigned nloc = b.st[0], nx = b.st[1];
        if (nloc == 0u) { xcd_barrier_complete(bar, b.x, nloc, nx); b.st[0] = nloc; b.st[1] = nx; }
        const unsigned old = xb_add(&bar[XB_XSUB(b.x)], 1u);
        const unsigned gen = old / nloc;
        if (old + 1u == (gen + 1u) * nloc) {
            __builtin_amdgcn_fence(__ATOMIC_RELEASE, "agent");
            asm volatile("s_waitcnt vmcnt(0)" ::: "memory");
            const unsigned og = xb_add(&bar[XB_TOP], 1u);
            const unsigned tg = og / nx;
            if (og + 1u == (tg + 1u) * nx) xb_add(&bar[XB_TOPGEN], 1u);
            else XB_SPIN(xb_ld(&bar[XB_TOPGEN]) == tg, bar);
            __builtin_amdgcn_fence(__ATOMIC_ACQUIRE, "agent");
            xb_add(&bar[XB_XGEN(b.x)], 1u);
            asm volatile("s_waitcnt vmcnt(0)" ::: "memory");
        } else {
            XB_SPIN(xb_ld(&bar[XB_XGEN(b.x)]) == gen, bar);
            __builtin_amdgcn_fence(__ATOMIC_ACQUIRE, "agent");
            asm volatile("s_waitcnt vmcnt(0)" ::: "memory");
        }
    }
    __syncthreads();
}

constexpr int NPHASES = 13;
}

__global__ void __launch_bounds__(NTHREADS, 2) fwd_kernel(Params p) {
    extern __shared__ __attribute__((aligned(16))) unsigned char lds[];
    cg::grid_group grid = cg::this_grid();
    Ctx C;
#pragma unroll
    for (int i = 0; i < 31; ++i) C.in[i] = p.in[i];
    C.out = p.out; C.ws = p.ws; C.lds = lds;
    const int wave_s = __builtin_amdgcn_readfirstlane(threadIdx.x >> 6);
    C.lane = lane_id(); C.wave = wave_s; C.tid = wave_s * 64 + C.lane;
    C.blk = blockIdx.x; C.nblk = gridDim.x; C.gw = C.blk * NWAVES + C.wave; C.ngw = C.nblk * NWAVES;
    const int lo = p.ph_lo, hi = p.ph_hi;
    volatile XLAS unsigned* misc = (volatile XLAS unsigned*)((XLAS unsigned char*)lds + (LDS_BYTES - 64));
    if (C.tid < 16) misc[C.tid] = 0u;
    __syncthreads();
    const XcdBarrier xbar = xcd_barrier_post((unsigned*)(p.ws + WS_CTL), misc, C.tid == 0);
#define GSYNC(k) do { xcd_barrier(xbar, wave_s); } while (0)
    if (lo < 0) grid.sync();
#ifndef PHMASK
#define PHMASK 0xffff
#endif
#ifndef REPMASK
#define REPMASK 0
#endif
#ifndef PROBE_PHASE
#define PROBE_PHASE (-1)
#endif
    unsigned long long tp0 = 0, tp1 = 0;
#define PH(k, body) do { if ((PHMASK >> (k)) & 1) { if (lo <= (k) && (k) < hi) { if ((k) == PROBE_PHASE) tp0 = __builtin_amdgcn_s_memrealtime(); _Pragma("unroll 1") for (int rep_ = (REPMASK >> (k)) & 1; rep_ >= 0; --rep_) { { C.lane = fresh_lane(); C.wave = wave_s; C.tid = wave_s * 64 + C.lane; C.gw = C.blk * NWAVES + C.wave; } body; if (rep_ > 0 || (k) + 1 < hi) GSYNC(k); } if ((k) == PROBE_PHASE) tp1 = __builtin_amdgcn_s_memrealtime(); } } } while (0)
#ifdef SYNCPROBE
    for (int i = 0; i < 20; ++i) GSYNC(1);
#endif
    PH(0, { phase_mod(C); phase_filters(C); });
    PH(1, { phase_weights(C); __syncthreads(); phase_norm1(C); });
#ifndef FASTMASK
#define FASTMASK 0xffff
#endif
#define FAST(k) ((FASTMASK >> (k)) & 1)
    PH(2, phase_inproj_fast(C));
#if XVAR == 1
    PH(13, phase_probe_x(C));
#endif
    PH(3, phase_hy_pre_fast(C));
    PH(4, { phase_toeplitz(C); GSYNC(1); phase_hy_post(C); });
    PH(5, phase_attn_fast(C));
    PH(6, phase_cat_fast(C));
    PH(7, phase_mix_fast(C));
    PH(8, phase_route(C));
    PH(9, phase_rowlist(C));
    PH(10, phase_gateup_fast(C));
    PH(11, phase_down_fast(C));
    PH(12, phase_final(C));
#undef PH
    if (PROBE_PHASE >= 0 && C.blk == 0) { const unsigned long long te = __builtin_amdgcn_s_memrealtime(), span = 4ull * (tp1 - tp0); while (__builtin_amdgcn_s_memrealtime() - te < span) __builtin_amdgcn_s_sleep(8); }
}

extern "C" void kernel_launch(void* const* d_in, const int* in_sizes, int n_in, void* d_out, int out_size, void* d_ws, size_t ws_size, hipStream_t stream) {
    static int grid = 0;
    if (grid == 0) {
        if (n_in != 31 || ws_size < WS_END) { fprintf(stderr, "kernel_launch: unexpected n_in %d or ws_size %zu\n", n_in, ws_size); grid = -1; return; }
        int dev = 0, cus = 0, per_cu = 0;
        hipGetDevice(&dev); hipDeviceGetAttribute(&cus, hipDeviceAttributeMultiprocessorCount, dev);
        hipFuncSetAttribute((const void*)fwd_kernel, hipFuncAttributeMaxDynamicSharedMemorySize, LDS_BYTES);
        hipOccupancyMaxActiveBlocksPerMultiprocessor(&per_cu, (const void*)fwd_kernel, NTHREADS, LDS_BYTES);
        if (per_cu < 1) { fprintf(stderr, "kernel_launch: occupancy query says %d blocks/CU\n", per_cu); per_cu = 1; }
        (void)hipGetLastError();
        grid = cus * 1;
        fprintf(stderr, "kernel_launch: cus %d per_cu %d grid %d\n", cus, per_cu, grid);
    }
    if (grid < 0) return;
    if (hipMemsetAsync((char*)d_ws + WS_CTL, 0, 65536, stream) != hipSuccess) { fprintf(stderr, "kernel_launch: memset failed\n"); return; }
    Params p{};
    for (int i = 0; i < 31; ++i) p.in[i] = (const float*)d_in[i];
    p.out = (float*)d_out; p.ws = (unsigned char*)d_ws; p.ph_lo = 0; p.ph_hi = NPHASES + (XVAR ? 1 : 0);
    void* args[] = {&p};
    hipError_t e = hipLaunchCooperativeKernel((const void*)fwd_kernel, dim3(grid), dim3(NTHREADS), args, LDS_BYTES, stream);
    if (e != hipSuccess) fprintf(stderr, "cooperative launch failed: %s (grid %d)\n", hipGetErrorString(e), grid);
}
```

```cpp
#include <hip/hip_runtime.h>
#include <hip/hip_cooperative_groups.h>
#include <cstdio>
#include <cstdint>
namespace cg = cooperative_groups;

namespace {
typedef unsigned short bf16_t;
typedef short bf16x8 __attribute__((ext_vector_type(8)));
typedef short s16x4 __attribute__((ext_vector_type(4)));
typedef float f32x4 __attribute__((ext_vector_type(4)));
typedef float f32x16 __attribute__((ext_vector_type(16)));
typedef unsigned u32x4 __attribute__((ext_vector_type(4)));
typedef unsigned u32x2 __attribute__((ext_vector_type(2)));

constexpr int D = 1024, NB = 16, SEQ = 2048, T = NB * SEQ, HW = 512, INC = 5120, NE = 32, FHID = 64;
constexpr int QOFF = 1536, KOFF = 2048, VOFF = 2560, GOFF = 3072;
constexpr int NTHREADS = 512, NWAVES = 8;
constexpr float EPS = 1e-5f;
constexpr float LOG2E = 1.4426950408889634f;
constexpr float QSCALE = 0.125f * 1.4426950408889634f;
constexpr size_t MiB = 1u << 20;
constexpr size_t WS_CTL = 0;
constexpr size_t WS_MOD = 1 * MiB;
constexpr size_t WS_META = 1 * MiB + 512 * 1024;
constexpr size_t WS_BLKCNT = WS_META + 4096;
constexpr size_t WS_TILEEXP = WS_BLKCNT + 256 * 32 * 4;
constexpr size_t WS_LOGITS = 2 * MiB;
constexpr size_t WS_TOPE = 6 * MiB;
constexpr size_t WS_TOPW = 6 * MiB + 512 * 1024;
constexpr size_t WS_ROWPAIR = 7 * MiB;
constexpr size_t WS_KFILT = 8 * MiB;
constexpr size_t WS_U = 16 * MiB;
constexpr size_t WS_ACT = WS_U;
constexpr size_t WS_H = 336 * MiB;
constexpr size_t WS_R1 = 400 * MiB;
constexpr size_t WS_YCAT = WS_R1;
constexpr size_t WS_MERGED = WS_R1 + 64 * MiB;
constexpr size_t WS_VP = WS_R1 + 128 * MiB;
constexpr size_t WS_X0C = WS_R1 + 160 * MiB;
constexpr size_t WS_VT = WS_R1 + 192 * MiB;
constexpr size_t WS_H2LO = WS_R1 + 224 * MiB;
constexpr size_t WS_SLOTS = WS_R1;
constexpr size_t WS_WIN = 688 * MiB;
constexpr size_t WS_WCAT = 698 * MiB;
constexpr size_t WS_WMIX = 700 * MiB;
constexpr size_t WS_WGU = 702 * MiB;
constexpr size_t WS_WDN = 830 * MiB;
constexpr size_t WS_WRT = 894 * MiB;
constexpr size_t WS_KFC = 896 * MiB;
constexpr size_t WS_END = 904 * MiB;
constexpr size_t WS_YT = WS_R1 + 192 * MiB;
constexpr int MAXROWS = 4 * T + NE * 256;
constexpr int LDS_BYTES = 147456;

struct Params { const float* in[31]; float* out; unsigned char* ws; int ph_lo, ph_hi; };

__device__ __forceinline__ unsigned f2bf(float f) { unsigned u = __float_as_uint(f); return (u + 0x7fffu + ((u >> 16) & 1u)) >> 16; }
__device__ __forceinline__ unsigned pk2(float lo, float hi) { return f2bf(lo) | (f2bf(hi) << 16); }
__device__ __forceinline__ float bf2f(unsigned h) { return __uint_as_float(h << 16); }
__device__ __forceinline__ float bflo(unsigned w) { return __uint_as_float(w << 16); }
__device__ __forceinline__ float bfhi(unsigned w) { return __uint_as_float(w & 0xffff0000u); }
__device__ __forceinline__ float wave_sum(float v) {
#pragma unroll
    for (int o = 1; o < 64; o <<= 1) v += __shfl_xor(v, o);
    return v;
}
__device__ __forceinline__ float sigmoidf_(float x) { return 1.0f / (1.0f + __expf(-x)); }
__device__ __forceinline__ int crow(int r, int hi) { return (r & 3) + 8 * (r >> 2) + 4 * hi; }
__device__ __forceinline__ int lane_id() { return (int)__builtin_amdgcn_mbcnt_hi(~0u, __builtin_amdgcn_mbcnt_lo(~0u, 0u)); }
__device__ __forceinline__ int fresh_lane() { int l = lane_id(); asm volatile("" : "+v"(l)); return l; }

struct Ctx {
    const float* in[31]; float* out; unsigned char* ws;
    int tid, lane, wave, gw, ngw, nblk, blk;
    unsigned char* lds;
};

struct WItem { const float* src; bf16_t* dst; int N; int sk; };
__device__ __forceinline__ WItem witem(const Ctx& C, int it) {
    constexpr int I_IN = (D / 64) * (INC / 64), I_HY = (HW / 64) * (D / 64), I_MIX = (D / 64) * (D / 64), I_GU1 = (D / 64) * (2 * D / 64), I_DN1 = (D / 64) * (D / 64);
    const float* W; int N, k0, n0, kd, nd, sk = -1; bf16_t* WT;
    int r = it;
    if (r < NE * I_GU1) { const int e = r / I_GU1, q = r % I_GU1; const int nb = 2 * D / 64; n0 = 64 * (q % nb); k0 = 64 * (q / nb);
        const int s = n0 / 1024, rem = n0 % 1024, j = rem / 128, i0 = rem % 128; nd = 256 * j + 128 * s + i0; kd = k0; N = 2 * D;
        W = C.in[26] + (size_t)e * D * 2 * D; WT = (bf16_t*)(C.ws + WS_WGU) + (size_t)e * 2 * D * D; }
    else if ((r -= NE * I_GU1) < NE * I_DN1) { const int e = r / I_DN1, q = r % I_DN1; const int nb = D / 64; n0 = 64 * (q % nb); k0 = 64 * (q / nb); nd = n0; kd = k0; N = D;
        W = C.in[28] + (size_t)e * D * D; WT = (bf16_t*)(C.ws + WS_WDN) + (size_t)e * D * D; }
    else if ((r -= NE * I_DN1) < I_IN) { const int nb = INC / 64; n0 = 64 * (r % nb); k0 = 64 * (r / nb); nd = n0; kd = k0; N = INC; W = C.in[5]; WT = (bf16_t*)(C.ws + WS_WIN);
        if (n0 >= GOFF) { const int rel = n0 - GOFF, sg_ = rel / 1024, rem = rel % 1024; nd = GOFF + 256 * (rem / 128) + 128 * sg_ + (rem % 128); } }
    else if ((r -= I_IN) < I_HY) { const int nb = D / 64; n0 = 64 * (r % nb); k0 = 64 * (r / nb); nd = n0; kd = k0; N = D; W = C.in[20]; WT = (bf16_t*)(C.ws + WS_WCAT); }
    else if ((r -= I_HY) < I_HY) { const int nb = D / 64; n0 = 64 * (r % nb); k0 = 64 * (r / nb); nd = n0; kd = 512 + k0; N = D; W = C.in[21]; WT = (bf16_t*)(C.ws + WS_WCAT); sk = k0; }
    else { r -= I_HY; const int nb = D / 64; n0 = 64 * (r % nb); k0 = 64 * (r / nb); nd = n0; kd = k0; N = D; W = C.in[22]; WT = (bf16_t*)(C.ws + WS_WMIX); }
    WItem w; w.N = N; w.sk = sk; w.src = W + (size_t)(k0 + (C.lane >> 4)) * N + n0 + 4 * (C.lane & 15); w.dst = WT + (size_t)(nd + (C.lane >> 3)) * D + kd + 8 * (C.lane & 7);
    return w;
}
__device__ __forceinline__ void phase_weights(Ctx& C) {
    float* scr = (float*)(C.lds + C.wave * 16640);
    constexpr int NITEMS = (D / 64) * (INC / 64) + 2 * (HW / 64) * (D / 64) + (D / 64) * (D / 64) + NE * (D / 64) * (2 * D / 64) + NE * (D / 64) * (D / 64);
    const int lane = C.lane;
    int it = C.gw;
    f32x4 v[16], vn[16];
    WItem cur;
    if (it < NITEMS) { cur = witem(C, it);
#pragma unroll
        for (int i = 0; i < 16; ++i) v[i] = __builtin_nontemporal_load((const f32x4*)(cur.src + (size_t)(4 * i) * cur.N)); }
    for (; it < NITEMS; it += C.ngw) {
        const bool more = it + C.ngw < NITEMS; WItem nx = cur;
        if (more) { nx = witem(C, it + C.ngw);
#pragma unroll
            for (int i = 0; i < 16; ++i) vn[i] = __builtin_nontemporal_load((const f32x4*)(nx.src + (size_t)(4 * i) * nx.N)); }
        if (cur.sk >= 0) {
#pragma unroll
            for (int i = 0; i < 16; ++i) v[i] = v[i] * (0.8f * C.in[19][(cur.sk + 4 * i + (lane >> 4)) & 127]); }
#pragma unroll
        for (int i = 0; i < 16; ++i) { float* d = scr + (4 * i + (lane >> 4)) * 65 + 4 * (lane & 15); d[0] = v[i].x; d[1] = v[i].y; d[2] = v[i].z; d[3] = v[i].w; }
        __builtin_amdgcn_s_waitcnt(0xc07f); asm volatile("" ::: "memory");
        const int c = lane & 7;
#pragma unroll
        for (int j = 0; j < 8; ++j) { const int n = (lane >> 3) + 8 * j; const float* s = scr + (8 * c) * 65 + n;
            u32x4 o; o.x = pk2(s[0 * 65], s[1 * 65]); o.y = pk2(s[2 * 65], s[3 * 65]); o.z = pk2(s[4 * 65], s[5 * 65]); o.w = pk2(s[6 * 65], s[7 * 65]);
            __builtin_nontemporal_store(o, (u32x4*)(cur.dst + (size_t)(8 * j) * D)); }
        __builtin_amdgcn_s_waitcnt(0xc07f); asm volatile("" ::: "memory");
        if (more) {
#pragma unroll
            for (int i = 0; i < 16; ++i) v[i] = vn[i]; }
        cur = nx;
    }
    bf16_t* wrt = (bf16_t*)(C.ws + WS_WRT);
    for (int i = C.blk * NTHREADS + C.tid; i < NE * D; i += C.nblk * NTHREADS) {
        const int e = i / D, k = i % D; const float w = C.in[24][(size_t)k * NE + e];
        const unsigned hi = f2bf(w); const float lo = w - bf2f(hi);
        wrt[(size_t)e * 2048 + k] = (bf16_t)hi; wrt[(size_t)e * 2048 + 1024 + k] = (bf16_t)f2bf(lo);
    }
}

__device__ __forceinline__ void phase_mod(Ctx& C) {
    float* sc = (float*)C.lds;
    float* part = sc + 16 * 1024;
    float* mod = (float*)(C.ws + WS_MOD);
    for (int vb = C.blk; vb < 256; vb += C.nblk) {
        const int j0 = vb * 24;
        __syncthreads();
        for (int i = C.tid; i < 16 * D; i += NTHREADS) { const float c = C.in[1][i]; sc[i] = c / (1.0f + expf(-c)); }
        __syncthreads();
        if (C.tid < 504) {
            const int jj = C.tid % 24, isub = C.tid / 24;
            float acc[16];
#pragma unroll
            for (int b = 0; b < 16; ++b) acc[b] = 0.f;
            const float* w = C.in[2] + j0 + jj;
#pragma unroll 7
            for (int i = isub; i < D; i += 21) { const float wv = w[(size_t)i * 6 * D];
#pragma unroll
                for (int b = 0; b < 16; ++b) acc[b] = fmaf(sc[b * D + i], wv, acc[b]); }
#pragma unroll
            for (int b = 0; b < 16; ++b) part[(isub * 16 + b) * 24 + jj] = acc[b];
        }
        __syncthreads();
        if (C.tid < 384) { const int b = C.tid / 24, jj = C.tid % 24; float a = C.in[3][j0 + jj];
            for (int q = 0; q < 21; ++q) a += part[(q * 16 + b) * 24 + jj];
            mod[b * 6 * D + j0 + jj] = a; }
    }
    __syncthreads();
}

__device__ __forceinline__ void phase_filters(Ctx& C) {
    float* sh = (float*)C.lds;
    float* h3t = sh + 8 * 160;
    float* kfc = (float*)(C.ws + WS_KFC);
    const float* w1 = C.in[9]; const float* b1 = C.in[10]; const float* w2 = C.in[11]; const float* b2 = C.in[12];
    const float* w3 = C.in[13]; const float* b3 = C.in[14]; const float* w4 = C.in[15]; const float* fq = C.in[16];
    const int pl = C.tid >> 6, j = C.tid & 63;
    float* z = sh + pl * 160; float* ha = z + 32; float* hb = ha + 64;
    for (int vb = C.blk; vb < SEQ / 8; vb += C.nblk) {
        const int pos = vb * 8 + pl;
        const float tt = (float)pos / (float)(SEQ - 1);
        const float w = 6.283185307179586f * (float)pos / (float)SEQ;
        __syncthreads();
        if (j < 17) {
            float v;
            if (j == 0) v = tt;
            else { const int i = (j - 1) & 7; const float fr = 1e-4f + (float)i * ((7.0f - 1e-4f) / 7.0f); v = (j <= 8) ? cosf(fr * w) : -sinf(fr * w); }
            z[j] = v;
        }
        __syncthreads();
        { float a = b1[j];
#pragma unroll
          for (int i = 0; i < 17; ++i) a = fmaf(z[i], w1[i * FHID + j], a); ha[j] = sinf(fq[j] * a); }
        __syncthreads();
        { float a = b2[j];
#pragma unroll 32
          for (int i = 0; i < FHID; ++i) a = fmaf(ha[i], w2[i * FHID + j], a); hb[j] = sinf(fq[j] * a); }
        __syncthreads();
        { float a = b3[j];
#pragma unroll 32
          for (int i = 0; i < FHID; ++i) a = fmaf(hb[i], w3[i * FHID + j], a); h3t[j * 8 + pl] = sinf(fq[j] * a); }
        __syncthreads();
        float af[8], ab[8];
#pragma unroll
        for (int p = 0; p < 8; ++p) { af[p] = 0.f; ab[p] = 0.f; }
#pragma unroll 16
        for (int i = 0; i < FHID; ++i) { const float wa = w4[i * 2 * HW + C.tid], wb = w4[i * 2 * HW + HW + C.tid];
            const f32x4 h0 = *(const f32x4*)(h3t + i * 8), h1 = *(const f32x4*)(h3t + i * 8 + 4);
#pragma unroll
            for (int p = 0; p < 4; ++p) { af[p] = fmaf(h0[p], wa, af[p]); af[4 + p] = fmaf(h1[p], wa, af[4 + p]); ab[p] = fmaf(h0[p], wb, ab[p]); ab[4 + p] = fmaf(h1[p], wb, ab[4 + p]); } }
        const float min_decay = logf(1e-2f) / 1.5f, max_decay = logf(1e-2f) / 0.3f;
        const int c = C.tid, pos0 = vb * 8;
        const float adelta = fabsf(min_decay + (float)c * ((max_decay - min_decay) / 511.0f));
#pragma unroll
        for (int p = 0; p < 8; ++p) { const float dec = expf(-((float)(pos0 + p) / (float)(SEQ - 1)) * adelta); af[p] *= dec; ab[p] *= dec; }
        float* dst = kfc + (size_t)c * 4096 + 2048 + pos0;
        *(f32x4*)dst = (f32x4){af[0], af[1], af[2], af[3]}; *(f32x4*)(dst + 4) = (f32x4){af[4], af[5], af[6], af[7]};
        float* dsb = kfc + (size_t)c * 4096 + 2048 - pos0;
#pragma unroll
        for (int p = 0; p < 8; ++p) if (pos0 + p >= 1) dsb[-p] = ab[p];
    }
    __syncthreads();
}

__device__ __forceinline__ void phase_norm1(Ctx& C) {
    const float* mod = (const float*)(C.ws + WS_MOD); bf16_t* h = (bf16_t*)(C.ws + WS_H);
    const float* g = C.in[4];
    for (int row = C.gw; row < T; row += C.ngw) {
        const int b = row / SEQ;
        const f32x4* xr = (const f32x4*)(C.in[0] + (size_t)row * D) + C.lane;
        f32x4 v[4]; float s = 0.f;
#pragma unroll
        for (int j = 0; j < 4; ++j) { v[j] = __builtin_nontemporal_load(xr + 64 * j); s += (v[j].x * v[j].x + v[j].y * v[j].y) + (v[j].z * v[j].z + v[j].w * v[j].w); }
        const float rstd = 1.0f / sqrtf(wave_sum(s) * (1.0f / D) + EPS);
        const float* sh = mod + (size_t)b * 6 * D; const float* sc = sh + D;
        u32x2* o = (u32x2*)(h + (size_t)row * D) + C.lane;
#pragma unroll
        for (int j = 0; j < 4; ++j) { const int i0 = 4 * C.lane + 256 * j;
            const f32x4 gg = *(const f32x4*)(g + i0), s1 = *(const f32x4*)(sc + i0), s0 = *(const f32x4*)(sh + i0);
            f32x4 r; r.x = v[j].x * rstd * gg.x * (1.f + s1.x) + s0.x; r.y = v[j].y * rstd * gg.y * (1.f + s1.y) + s0.y;
            r.z = v[j].z * rstd * gg.z * (1.f + s1.z) + s0.z; r.w = v[j].w * rstd * gg.w * (1.f + s1.w) + s0.w;
            u32x2 w; w.x = pk2(r.x, r.y); w.y = pk2(r.z, r.w); o[64 * j] = w; }
    }
}

__device__ __forceinline__ void phase_final(Ctx& C) {
    const float* mod = (const float*)(C.ws + WS_MOD); const bf16_t* slots = (const bf16_t*)(C.ws + WS_SLOTS);
    const float* g = C.in[30];
    for (int row = C.gw; row < T; row += C.ngw) {
        const int b = row / SEQ;
        f32x4* xr = (f32x4*)(C.out + (size_t)row * D) + C.lane;
        const float* g2 = mod + (size_t)b * 6 * D + 5 * D;
        f32x4 v[4]; float s = 0.f;
#pragma unroll
        for (int j = 0; j < 4; ++j) { const int i0 = 4 * C.lane + 256 * j;
            f32x4 m = {0.f, 0.f, 0.f, 0.f};
#pragma unroll
            for (int k = 0; k < 4; ++k) { const u32x2 w = __builtin_nontemporal_load((const u32x2*)(slots + ((size_t)row * 4 + k) * D + i0));
                m.x += bflo(w.x); m.y += bfhi(w.x); m.z += bflo(w.y); m.w += bfhi(w.y); }
            const f32x4 gg = *(const f32x4*)(g2 + i0);
            v[j] = __builtin_nontemporal_load(xr + 64 * j); v[j].x += gg.x * m.x; v[j].y += gg.y * m.y; v[j].z += gg.z * m.z; v[j].w += gg.w * m.w;
            s += (v[j].x * v[j].x + v[j].y * v[j].y) + (v[j].z * v[j].z + v[j].w * v[j].w); }
        const float rstd = 1.0f / sqrtf(wave_sum(s) * (1.0f / D) + EPS);
#pragma unroll
        for (int j = 0; j < 4; ++j) { const int i0 = 4 * C.lane + 256 * j; const f32x4 gg = *(const f32x4*)(g + i0);
            f32x4 r; r.x = v[j].x * rstd * gg.x; r.y = v[j].y * rstd * gg.y; r.z = v[j].z * rstd * gg.z; r.w = v[j].w * rstd * gg.w; __builtin_nontemporal_store(r, xr + 64 * j); }
    }
}

namespace pg8 {
#define PG8_LAS __attribute__((address_space(3)))
constexpr int BM = 256, BK = 64, HALF = 128, HTB = HALF * BK * 2, STAGE_BYTES = 8 * HTB, NXCD = 8, WGM = 8;
__device__ __forceinline__ int lds_byte(int r, int c) { const int st = (r >> 4) * 2 + (c >> 5), rr = r & 15, cc = c & 31, ob = rr * 64 + cc * 2; return st * 1024 + (ob ^ (((ob >> 9) & 1) << 5)); }
__device__ __forceinline__ void stage_rc(int b, int& R, int& C) { const int st = b / 1024, sb = b % 1024, swz = sb ^ (((sb >> 9) & 1) << 5); R = (st >> 1) * 16 + swz / 64; C = (st & 1) * 32 + (swz % 64) / 2; }
__device__ __forceinline__ int perm32(int rho) { const int n = rho >> 4, i = rho & 15; return 8 * (i >> 2) + 4 * n + (i & 3); }
struct Unit { int pm, pn; };
struct Gemm { const bf16_t* A; const bf16_t* Bt; int lda, ldb, K; const int* rowidx; };
struct StaticOrder {
    int nM, nN, nwg, G, c;
    __device__ void init(int nM_, int nN_, int G_, int c_) { nM = nM_; nN = nN_; nwg = nM * nN; G = G_; c = c_; }
    __device__ bool next(int i, Unit& u) const {
        const long L = (long)i * G + c; if (L >= nwg) return false;
        int wgid = (int)L; { const int q = nwg / NXCD, r = nwg % NXCD, xcd = wgid % NXCD, off = wgid / NXCD; wgid = (xcd < r ? xcd * (q + 1) : r * (q + 1) + (xcd - r) * q) + off; }
        const int nig = WGM * nN, gid = wgid / nig, fm = gid * WGM, gsz = (nM - fm) < WGM ? (nM - fm) : WGM;
        u.pm = fm + ((wgid % nig) % gsz); u.pn = (wgid % nig) / gsz; return true;
    }
};
struct MoeOrder {
    StaticOrder b; const int* tileexp; int nN;
    __device__ bool next(int i, Unit& u) const { if (!b.next(i, u)) return false; u.pn = tileexp[u.pm] * nN + u.pn; return true; }
};
__device__ __forceinline__ unsigned cvt_pk_bf16(float lo, float hi) { unsigned r; asm volatile("v_cvt_pk_bf16_f32 %0, %1, %2" : "=v"(r) : "v"(lo), "v"(hi)); return r; }

template <class Epi, class Sched, bool GATHER, bool MIDHOOK = false>
__device__ __forceinline__ void gemm_phase(PG8_LAS unsigned char* lds, const Gemm g, const Sched& S, const Epi& E, const int wid_) {
    const int wid = wid_, lane = fresh_lane(), tid = wid * 64 + lane, wr = wid >> 2, wc = wid & 3, fr = lane & 15, fq = lane >> 4;
    const int K = g.K, nt = K / BK;
    int RA[2]; unsigned cA2[2], voffB[2];
#pragma unroll
    for (int i = 0; i < 2; ++i) { int R, C; stage_rc(tid * 16 + i * 8192, R, C); const int Rb = Epi::PERM ? ((R & ~31) + perm32(R & 31)) : R;
        RA[i] = R; cA2[i] = (unsigned)C * 2u; voffB[i] = (unsigned)(Rb * g.ldb + C) * 2u; }
    const unsigned lda2 = (unsigned)g.lda * 2u;
    const size_t kstep = (size_t)(BK * 2);
    const size_t hstep = (size_t)HALF * g.ldb * 2;
    const size_t tstep = 2 * hstep;
    const unsigned ldsw = (unsigned)wid * 1024u;
    const int aoff = lds_byte(wr * 64 + fr, fq * 8), boff = lds_byte(wc * 32 + fr, fq * 8);
#define PG8_SA(b, h) (((b) * 2 + (h)) * HTB)
#define PG8_SB(b, h) ((4 + (b) * 2 + (h)) * HTB)
#define PG8_STAGE(bufoff, gbase, voff) do { _Pragma("unroll") for (int _i = 0; _i < 2; ++_i) \
        __builtin_amdgcn_global_load_lds((const unsigned*)((const char*)(gbase) + (voff)[_i]), (PG8_LAS unsigned*)(lds + (bufoff) + ldsw + _i * 8192), 16, 0, 0); } while (0)
#define PG8_AOFFS(dst, u_) do { _Pragma("unroll") for (int _h = 0; _h < 2; ++_h) _Pragma("unroll") for (int _i = 0; _i < 2; ++_i) { \
        int _row = (u_).pm * BM + _h * HALF + RA[_i]; if (GATHER) { const int _p = g.rowidx[_row]; _row = _p >= 0 ? (_p >> 2) : 0; } \
        dst[_h][_i] = (unsigned)_row * lda2 + cA2[_i]; } } while (0)
#define PG8_LDA(dst, b, h) do { _Pragma("unroll") for (int m = 0; m < 4; ++m) _Pragma("unroll") for (int k = 0; k < 2; ++k) dst[m][k] = *(const PG8_LAS bf16x8*)(lds + PG8_SA(b, h) + aoff + m * 2048 + k * 1024); } while (0)
#define PG8_LDB(dst, b, h) do { _Pragma("unroll") for (int n = 0; n < 2; ++n) _Pragma("unroll") for (int k = 0; k < 2; ++k) dst[n][k] = *(const PG8_LAS bf16x8*)(lds + PG8_SB(b, h) + boff + n * 2048 + k * 1024); } while (0)
#define PG8_MMA(ai, bj, At, Bt) do { __builtin_amdgcn_s_setprio(1); _Pragma("unroll") for (int m = 0; m < 4; ++m) _Pragma("unroll") for (int n = 0; n < 2; ++n) _Pragma("unroll") for (int k = 0; k < 2; ++k) \
        acc[ai][bj][m][n] = __builtin_amdgcn_mfma_f32_16x16x32_bf16(Bt[n][k], At[m][k], acc[ai][bj][m][n], 0, 0, 0); __builtin_amdgcn_s_setprio(0); } while (0)
#define PG8_WAIT_V(n) asm volatile("s_waitcnt vmcnt(" #n ")" ::: "memory")
#define PG8_WAIT_L(n) asm volatile("s_waitcnt lgkmcnt(" #n ")" ::: "memory")
#define PG8_BAR __builtin_amdgcn_s_barrier()
#define PG8_SCHED __builtin_amdgcn_sched_barrier(0)
    Unit cur, nxt; int ui = 0;
    if (!S.next(0, cur)) return;
    f32x4 acc[2][2][4][2];
#pragma unroll
    for (int a = 0; a < 2; ++a)
#pragma unroll
        for (int b = 0; b < 2; ++b)
#pragma unroll
            for (int m = 0; m < 4; ++m)
#pragma unroll
                for (int n = 0; n < 2; ++n) acc[a][b][m][n] = (f32x4){0.f, 0.f, 0.f, 0.f};
    bf16x8 At[4][2], B0[2][2], B1[2][2];
    unsigned cv[2][2], nv[2][2];
    PG8_AOFFS(cv, cur);
    const char* const Ab = (const char*)g.A;
    const char* cB = (const char*)g.Bt + (size_t)cur.pn * tstep;
    PG8_STAGE(PG8_SB(0, 0), cB, voffB); PG8_STAGE(PG8_SB(0, 1), cB + hstep, voffB); PG8_STAGE(PG8_SA(0, 0), Ab, cv[0]); PG8_STAGE(PG8_SA(0, 1), Ab, cv[1]);
    if (wr == 1) PG8_BAR;
    PG8_WAIT_V(2); PG8_BAR;
    PG8_STAGE(PG8_SB(1, 0), cB + kstep, voffB); PG8_STAGE(PG8_SA(1, 0), Ab + kstep, cv[0]); PG8_STAGE(PG8_SB(1, 1), cB + hstep + kstep, voffB);
    PG8_WAIT_V(6); PG8_BAR;
    for (;;) {
        const bool has_next = S.next(ui + 1, nxt);
        if (has_next) { PG8_AOFFS(nv, nxt); } else {
#pragma unroll
            for (int h = 0; h < 2; ++h)
#pragma unroll
                for (int i = 0; i < 2; ++i) nv[h][i] = cv[h][i]; }
        const char* nB = has_next ? (const char*)g.Bt + (size_t)nxt.pn * tstep : cB;
#define PG8_KSTEP(t) do { \
            const bool last = (t == nt - 2); \
            const char* a1 = Ab + (size_t)(t + 1) * kstep; \
            const char* a2 = last ? Ab : Ab + (size_t)(t + 2) * kstep; const char* b2 = last ? nB : cB + (size_t)(t + 2) * kstep; \
            const char* a3 = a2 + kstep; const char* b3 = b2 + kstep; \
            unsigned sv[2][2]; \
            _Pragma("unroll") for (int h = 0; h < 2; ++h) _Pragma("unroll") for (int i = 0; i < 2; ++i) sv[h][i] = last ? nv[h][i] : cv[h][i]; \
            PG8_LDB(B0, 0, 0); PG8_LDB(B1, 0, 1); PG8_SCHED; PG8_LDA(At, 0, 0); PG8_STAGE(PG8_SA(1, 1), a1, cv[1]); \
            PG8_WAIT_V(8); PG8_WAIT_L(0); PG8_BAR; PG8_MMA(0, 0, At, B0); PG8_MMA(0, 1, At, B1); PG8_BAR; PG8_SCHED; \
            PG8_LDA(At, 0, 1); PG8_STAGE(PG8_SB(0, 0), b2, voffB); PG8_STAGE(PG8_SB(0, 1), b2 + hstep, voffB); PG8_STAGE(PG8_SA(0, 0), a2, sv[0]); \
            PG8_WAIT_V(8); PG8_WAIT_L(0); PG8_BAR; PG8_MMA(1, 0, At, B0); PG8_MMA(1, 1, At, B1); PG8_BAR; PG8_SCHED; \
            PG8_LDB(B0, 1, 0); PG8_LDB(B1, 1, 1); PG8_SCHED; PG8_LDA(At, 1, 0); PG8_STAGE(PG8_SA(0, 1), a2, sv[1]); \
            PG8_WAIT_V(8); PG8_WAIT_L(0); PG8_BAR; PG8_MMA(0, 0, At, B0); PG8_MMA(0, 1, At, B1); PG8_BAR; PG8_SCHED; \
            PG8_LDA(At, 1, 1); PG8_STAGE(PG8_SB(1, 0), b3, voffB); PG8_STAGE(PG8_SB(1, 1), b3 + hstep, voffB); PG8_STAGE(PG8_SA(1, 0), a3, sv[0]); \
            PG8_WAIT_V(8); PG8_WAIT_L(0); PG8_BAR; PG8_MMA(1, 0, At, B0); PG8_MMA(1, 1, At, B1); PG8_BAR; PG8_SCHED; \
        } while (0)
        if constexpr (MIDHOOK) {
            for (int t = 0; t < nt / 2; t += 2) PG8_KSTEP(t);
            E.mid(acc, cur, wr, wc, fr, fq);
            for (int t = nt / 2; t < nt; t += 2) PG8_KSTEP(t);
        } else {
            for (int t = 0; t < nt; t += 2) PG8_KSTEP(t);
        }
#undef PG8_KSTEP
        if (wr == 0) PG8_BAR;
        E(acc, cur, wr, wc, fr, fq);
        if (!has_next) break;
#pragma unroll
        for (int a = 0; a < 2; ++a)
#pragma unroll
            for (int b = 0; b < 2; ++b)
#pragma unroll
                for (int m = 0; m < 4; ++m)
#pragma unroll
                    for (int n = 0; n < 2; ++n) acc[a][b][m][n] = (f32x4){0.f, 0.f, 0.f, 0.f};
        cur = nxt; cB = nB; ++ui;
#pragma unroll
        for (int h = 0; h < 2; ++h)
#pragma unroll
            for (int i = 0; i < 2; ++i) cv[h][i] = nv[h][i];
        if (wr == 1) PG8_BAR;
    }
    PG8_WAIT_V(0);
    PG8_BAR;
#undef PG8_SA
#undef PG8_SB
#undef PG8_STAGE
#undef PG8_AOFFS
#undef PG8_LDA
#undef PG8_LDB
#undef PG8_MMA
#undef PG8_WAIT_V
#undef PG8_WAIT_L
#undef PG8_BAR
#undef PG8_SCHED
}

__device__ __forceinline__ u32x4 pack8(const f32x4& v0, const f32x4& v1) { u32x4 w; w.x = cvt_pk_bf16(v0[0], v0[1]); w.y = cvt_pk_bf16(v0[2], v0[3]); w.z = cvt_pk_bf16(v1[0], v1[1]); w.w = cvt_pk_bf16(v1[2], v1[3]); return w; }
__device__ __forceinline__ void unpack8(const u32x4& w, f32x4& v0, f32x4& v1) { v0 = (f32x4){bflo(w.x), bfhi(w.x), bflo(w.y), bfhi(w.y)}; v1 = (f32x4){bflo(w.z), bfhi(w.z), bflo(w.w), bfhi(w.w)}; }
__device__ __forceinline__ float fsig(float x) { return __builtin_amdgcn_rcpf(1.0f + __builtin_amdgcn_exp2f(-LOG2E * x)); }

template <int MODE = 0> struct EpiInprojT {
    static constexpr bool PERM = true;
    bf16_t* U; const float* bias;
    __device__ __forceinline__ void operator()(const f32x4 (&acc)[2][2][4][2], const Unit& u, int wr, int wc, int fr, int fq) const {
        const int row0 = u.pm * BM + wr * 64 + fr, col0 = u.pn * BM + wc * 32 + 8 * fq; const float qs = (u.pn == 6 || u.pn == 7) ? QSCALE : 1.0f;
        if (u.pn >= 12) {
            const int c0 = 128 * (u.pn - 12) + wc * 32 + 8 * fq;
            f32x4 ba[2], bb[2];
#pragma unroll
            for (int n = 0; n < 2; ++n) { ba[n] = *(const f32x4*)(bias + GOFF + c0 + 4 * n); bb[n] = *(const f32x4*)(bias + GOFF + D + c0 + 4 * n); }
#pragma unroll
            for (int ai = 0; ai < 2; ++ai)
#pragma unroll
                for (int m = 0; m < 4; ++m) { bf16_t* rowp = U + (size_t)(row0 + ai * HALF + m * 16) * INC + GOFF + c0; f32x4 rr[2], sb[2];
#pragma unroll
                    for (int n = 0; n < 2; ++n) { const f32x4 a = acc[ai][0][m][n] + ba[n], b = acc[ai][1][m][n] + bb[n];
#pragma unroll
                        for (int i = 0; i < 4; ++i) { const float ea = __builtin_amdgcn_exp2f(-LOG2E * a[i]), eb = __builtin_amdgcn_exp2f(-LOG2E * b[i]); const float s2 = __builtin_amdgcn_rcpf(1.0f + eb);
                            sb[n][i] = s2; rr[n][i] = (1.0f + eb) * __builtin_amdgcn_rcpf(1.0f + ea); } }
                    const u32x4 wr_ = pack8(rr[0], rr[1]), ws_ = pack8(sb[0], sb[1]);
                    if (MODE == 0) { *(u32x4*)rowp = wr_; *(u32x4*)(rowp + D) = ws_; } else asm volatile("" :: "v"(wr_), "v"(ws_)); }
            return;
        }
        const bool sig = false;
        f32x4 bv[2][2];
#pragma unroll
        for (int bj = 0; bj < 2; ++bj)
#pragma unroll
            for (int n = 0; n < 2; ++n) bv[bj][n] = *(const f32x4*)(bias + col0 + bj * HALF + 4 * n);
#pragma unroll
        for (int ai = 0; ai < 2; ++ai)
#pragma unroll
            for (int m = 0; m < 4; ++m) { bf16_t* rowp = U + (size_t)(row0 + ai * HALF + m * 16) * INC + col0;
#pragma unroll
                for (int bj = 0; bj < 2; ++bj) { f32x4 v0 = (acc[ai][bj][m][0] + bv[bj][0]) * qs, v1 = (acc[ai][bj][m][1] + bv[bj][1]) * qs;
                    if (sig) {
#pragma unroll
                        for (int i = 0; i < 4; ++i) { v0[i] = fsig(v0[i]); v1[i] = fsig(v1[i]); } }
                    const u32x4 w_ = pack8(v0, v1);
                    if (MODE == 0) *(u32x4*)(rowp + bj * HALF) = w_; else asm volatile("" :: "v"(w_)); } }
    }
};
typedef EpiInprojT<0> EpiInproj;
template <int P> struct EpiCat {
    static constexpr bool PERM = true;
    bf16_t* Mg; const bf16_t* U;
    __device__ __forceinline__ void operator()(const f32x4 (&acc)[2][2][4][2], const Unit& u, int wr, int wc, int fr, int fq) const {
        const int row0 = u.pm * BM + wr * 64 + fr, col0 = u.pn * BM + wc * 32 + 8 * fq;
#pragma unroll
        for (int ai = 0; ai < 2; ++ai)
#pragma unroll
            for (int m = 0; m < 4; ++m) { const size_t row = (size_t)(row0 + ai * HALF + m * 16);
#pragma unroll
                for (int bj = 0; bj < 2; ++bj) { const u32x4 gw = *(const u32x4*)(U + row * INC + GOFF + P * D + col0 + bj * HALF);
                    f32x4 g0, g1; unpack8(gw, g0, g1); f32x4 v0 = acc[ai][bj][m][0] * g0, v1 = acc[ai][bj][m][1] * g1;
                    bf16_t* mp = Mg + row * D + col0 + bj * HALF;
                    if (P == 1) { const u32x4 tw = *(const u32x4*)mp; f32x4 t0, t1; unpack8(tw, t0, t1); v0 += t0; v1 += t1; }
                    *(u32x4*)mp = pack8(v0, v1); } }
    }
};
struct EpiCatR {
    static constexpr bool PERM = true;
    bf16_t* Mg; const bf16_t* U;
    __device__ __forceinline__ void mid(f32x4 (&acc)[2][2][4][2], const Unit& u, int wr, int wc, int fr, int fq) const {
        int row0 = u.pm * BM + wr * 64 + fr; asm volatile("" : "+v"(row0));
        const int col0 = u.pn * BM + wc * 32 + 8 * fq;
#pragma unroll
        for (int ai = 0; ai < 2; ++ai) { asm volatile("" ::: "memory");
#pragma unroll
            for (int m = 0; m < 4; ++m) { const size_t row = (size_t)(row0 + ai * HALF + m * 16);
#pragma unroll
                for (int bj = 0; bj < 2; ++bj) { const u32x4 gw1 = *(const u32x4*)(U + row * INC + GOFF + col0 + bj * HALF);
                    f32x4 a0, a1; unpack8(gw1, a0, a1); acc[ai][bj][m][0] *= a0; acc[ai][bj][m][1] *= a1; } } }
        asm volatile("" ::: "memory");
    }
    __device__ __forceinline__ void operator()(const f32x4 (&acc)[2][2][4][2], const Unit& u, int wr, int wc, int fr, int fq) const {
        const int row0 = u.pm * BM + wr * 64 + fr, col0 = u.pn * BM + wc * 32 + 8 * fq;
#pragma unroll
        for (int ai = 0; ai < 2; ++ai)
#pragma unroll
            for (int m = 0; m < 4; ++m) { const size_t row = (size_t)(row0 + ai * HALF + m * 16);
#pragma unroll
                for (int bj = 0; bj < 2; ++bj) { const u32x4 gw = *(const u32x4*)(U + row * INC + GOFF + D + col0 + bj * HALF);
                    f32x4 g0, g1; unpack8(gw, g0, g1);
                    *(u32x4*)(Mg + row * D + col0 + bj * HALF) = pack8(acc[ai][bj][m][0] * g0, acc[ai][bj][m][1] * g1); } }
    }
};
struct EpiMix {
    static constexpr bool PERM = false;
    const float* X; float* O; const float* mod; float* ssq;
    __device__ __forceinline__ void operator()(const f32x4 (&acc)[2][2][4][2], const Unit& u, int wr, int wc, int fr, int fq) const {
        const int row0 = u.pm * BM + wr * 64 + fr, col0 = u.pn * BM + wc * 32 + 4 * fq; const int b = (u.pm * BM) / SEQ;
        f32x4 gv[2][2];
#pragma unroll
        for (int bj = 0; bj < 2; ++bj)
#pragma unroll
            for (int n = 0; n < 2; ++n) gv[bj][n] = *(const f32x4*)(mod + (size_t)b * 6 * D + 2 * D + col0 + bj * HALF + n * 16);
#pragma unroll
        for (int ai = 0; ai < 2; ++ai)
#pragma unroll
            for (int m = 0; m < 4; ++m) { const size_t off = (size_t)(row0 + ai * HALF + m * 16) * D + col0; float sq = 0.f;
#pragma unroll
                for (int bj = 0; bj < 2; ++bj)
#pragma unroll
                    for (int n = 0; n < 2; ++n) { const f32x4 v = *(const f32x4*)(X + off + bj * HALF + n * 16) + gv[bj][n] * acc[ai][bj][m][n]; *(f32x4*)(O + off + bj * HALF + n * 16) = v;
                        sq += (v.x * v.x + v.y * v.y) + (v.z * v.z + v.w * v.w); }
                sq += __shfl_xor(sq, 16); sq += __shfl_xor(sq, 32);
                if (fq == 0) ssq[(size_t)(row0 + ai * HALF + m * 16) * 16 + u.pn * 4 + wc] = sq; }
    }
};
struct EpiGateUp {
    static constexpr bool PERM = true;
    bf16_t* Act; const float* bgu;
    __device__ __forceinline__ void operator()(const f32x4 (&acc)[2][2][4][2], const Unit& u, int wr, int wc, int fr, int fq) const {
        const int e = u.pn >> 3, j = u.pn & 7; const int row0 = u.pm * BM + wr * 64 + fr, col0 = 128 * j + wc * 32 + 8 * fq;
        f32x4 bg[2], bu[2];
#pragma unroll
        for (int n = 0; n < 2; ++n) { bg[n] = *(const f32x4*)(bgu + (size_t)e * 2 * D + col0 + 4 * n); bu[n] = *(const f32x4*)(bgu + (size_t)e * 2 * D + D + col0 + 4 * n); }
#pragma unroll
        for (int ai = 0; ai < 2; ++ai)
#pragma unroll
            for (int m = 0; m < 4; ++m) { f32x4 r[2];
#pragma unroll
                for (int n = 0; n < 2; ++n) { const f32x4 gt = acc[ai][0][m][n] + bg[n], up = acc[ai][1][m][n] + bu[n];
#pragma unroll
                    for (int i = 0; i < 4; ++i) { const float gg = fminf(gt[i], 7.0f), uu = fminf(fmaxf(up[i], -7.0f), 7.0f); r[n][i] = (uu + 1.0f) * (gg * fsig(1.702f * gg)); } }
                *(u32x4*)(Act + (size_t)(row0 + ai * HALF + m * 16) * D + col0) = pack8(r[0], r[1]); }
    }
};
struct EpiDown {
    static constexpr bool PERM = true;
    bf16_t* Slots; const float* bd; const int* rowpair; const float* topw;
    __device__ __forceinline__ void operator()(const f32x4 (&acc)[2][2][4][2], const Unit& u, int wr, int wc, int fr, int fq) const {
        const int e = u.pn >> 2, j = u.pn & 3; const int row0 = u.pm * BM + wr * 64 + fr, col0 = 256 * j + wc * 32 + 8 * fq;
        f32x4 bv[2][2];
#pragma unroll
        for (int bj = 0; bj < 2; ++bj)
#pragma unroll
            for (int n = 0; n < 2; ++n) bv[bj][n] = *(const f32x4*)(bd + (size_t)e * D + col0 + bj * HALF + 4 * n);
#pragma unroll
        for (int ai = 0; ai < 2; ++ai)
#pragma unroll
            for (int m = 0; m < 4; ++m) { const int p = rowpair[row0 + ai * HALF + m * 16];
                if (p >= 0) { const float w = topw[p];
#pragma unroll
                    for (int bj = 0; bj < 2; ++bj) { const f32x4 v0 = (acc[ai][bj][m][0] + bv[bj][0]) * w, v1 = (acc[ai][bj][m][1] + bv[bj][1]) * w;
                        *(u32x4*)(Slots + (size_t)p * D + col0 + bj * HALF) = pack8(v0, v1); } } }
    }
};
}

#define LASP __attribute__((address_space(3)))
__device__ __forceinline__ void glds16(const void* gsrc, unsigned lds_dst) { unsigned keep;
    asm volatile("s_mov_b32 %0, m0\n\ts_mov_b32 m0, %2\n\ts_nop 0\n\tglobal_load_lds_dwordx4 %1, off\n\ts_mov_b32 m0, %0" : "=&s"(keep) : "v"(gsrc), "s"(lds_dst) : "memory"); }
__device__ __forceinline__ void glds16s(const void* sbase, unsigned voff, unsigned lds_dst) { unsigned keep;
    asm volatile("s_nop 4\n\ts_mov_b32 %0, m0\n\ts_mov_b32 m0, %3\n\ts_nop 0\n\tglobal_load_lds_dwordx4 %1, %2\n\ts_mov_b32 m0, %0" : "=&s"(keep) : "v"(voff), "s"(sbase), "s"(lds_dst) : "memory"); }
typedef short v4i16_t __attribute__((ext_vector_type(4)));
__device__ __forceinline__ s16x4 vtr(const LASP char* p) { return __builtin_bit_cast(s16x4, __builtin_amdgcn_ds_read_tr16_b64_v4i16((LASP v4i16_t*)p)); }
typedef float f32x2_t __attribute__((ext_vector_type(2))); typedef __bf16 bf16x2_t __attribute__((ext_vector_type(2)));
__device__ __forceinline__ unsigned cvtpk(float lo, float hi) { f32x2_t v = {lo, hi}; bf16x2_t b = __builtin_convertvector(v, bf16x2_t); return __builtin_bit_cast(unsigned, b); }

__device__ __forceinline__ float max3f(float a, float b, float c) { float r; asm("v_max3_f32 %0, %1, %2, %3" : "=v"(r) : "v"(a), "v"(b), "v"(c)); return r; }
__device__ __forceinline__ float fadd_s(float a, float b) { float r; asm("v_add_f32_e32 %0, %1, %2" : "=v"(r) : "v"(a), "v"(b)); return r; }
__device__ __forceinline__ unsigned bfbits(float f) { return f2bf(f); }
__device__ __forceinline__ void phase_attn_fast(Ctx& C) {
    const bf16_t* u = (const bf16_t*)(C.ws + WS_U); bf16_t* ycat = (bf16_t*)(C.ws + WS_YCAT);
    const int wave = C.wave;
    const float* lq = C.in[18];
    float lam;
    { const int l_ = lane_id(); const float d1 = wave_sum(lq[l_] * lq[64 + l_]), d2 = wave_sum(lq[128 + l_] * lq[192 + l_]); lam = __builtin_bit_cast(float, __builtin_amdgcn_readfirstlane(__builtin_bit_cast(int, expf(d1) - expf(d2) + 0.2f))); }
    const unsigned lds0 = (unsigned)(uintptr_t)C.lds;
    const LASP char* ldsp = (const LASP char*)C.lds;
    constexpr int SLOT = 24576;
    const int vcu = (C.nblk % 8 == 0) ? (C.blk % 8) * (C.nblk / 8) + C.blk / 8 : C.blk;
    for (int idx = vcu; idx < 256; idx += C.nblk)
#pragma unroll 1
    for (int sub = 0; sub < 2; ++sub) {
        const int b = idx >> 4, hA = (idx >> 3) & 1, qb = idx & 7; const int hh = sub ? 3 - hA : hA;
        const int lane = fresh_lane();
        const int l31 = lane & 31, hi = lane >> 5;
        const int krow = 8 * wave + (lane >> 3), kchunk = (lane & 7) ^ (lane >> 3);
        const int st0 = 4 * wave + (lane >> 5), st1 = st0 + 2;
        const int vrow = (lane & 31) >> 2, vch = lane & 3;
        const unsigned koffb = (unsigned)((krow * INC + kchunk * 8) * 2);
        const unsigned voffb0 = (unsigned)(((8 * (st0 >> 2) + vrow) * INC + 32 * (st0 & 3) + 8 * vch) * 2);
        const unsigned voffb1 = (unsigned)(((8 * (st1 >> 2) + vrow) * INC + 32 * (st1 & 3) + 8 * vch) * 2);
        const int koff0 = l31 * 128, kx = l31 & 7;
        const int vboff = 8192 + (4 * hi + ((lane & 15) >> 2)) * 64 + ((lane >> 4) & 1) * 32 + (lane & 3) * 8;
        const unsigned hm0 = hi ? 0u : 0xffffffffu;
        const unsigned dkdk = hi ? 0u : bfbits((float)l31) * 0x10001u;
        const int q0 = qb * 256 + wave * 32;
        const float slope2 = exp2f(-2.0f * (float)(hh + 1)) * LOG2E;
        const unsigned SH = bfbits(slope2); const unsigned SL = bfbits(slope2 - bf2f(SH)); const unsigned SHSL = SH | (SL << 16);
        const float slope2q = bf2f(SH) + bf2f(SL);
        const unsigned kw0b = hi ? 0x3f803f80u : SHSL, kw1b = hi ? 0x00003f80u : SHSL, ksm = hi ? 0u : 0x80008000u;
        const unsigned qa0 = bfbits((float)q0) * 0x10001u, qa1 = bfbits((float)l31) * 0x10001u;
        const float qpos = (float)(q0 + l31 - 4 * hi);
        const bf16_t* qrow = u + (size_t)(b * SEQ + q0 + l31) * INC + QOFF + hh * 128;
        const bf16_t* kgb = u + (size_t)(b * SEQ) * INC + KOFF + hh * 128;
        const bf16_t* vgb = u + (size_t)(b * SEQ) * INC + VOFF + hh * 128;
        const int t0 = qb * 4, tdiag = q0 >> 6;
#pragma unroll 1
        for (int c = 0; c < 2; ++c) {
            const bf16_t* kgc = kgb + c * 64;
#define ATT_DMA(t, sl) do { const size_t _o = (size_t)(t) * 64 * INC; const unsigned _b = lds0 + (unsigned)(sl) * SLOT; \
        glds16s(kgc + _o, koffb, (unsigned)__builtin_amdgcn_readfirstlane(_b + wave * 1024)); \
        glds16s(vgb + _o, voffb0, (unsigned)__builtin_amdgcn_readfirstlane(_b + 8192 + (2 * wave) * 1024)); \
        glds16s(vgb + _o, voffb1, (unsigned)__builtin_amdgcn_readfirstlane(_b + 8192 + (2 * wave + 1) * 1024)); } while (0)
#define ATT_WAITBAR() asm volatile("s_waitcnt vmcnt(0) lgkmcnt(0)\n\ts_barrier" ::: "memory")
#define ATT_WAITBAR3() asm volatile("s_waitcnt vmcnt(3) lgkmcnt(0)\n\ts_barrier" ::: "memory")
#define ATT_SB() __builtin_amdgcn_sched_barrier(0)
#define ATT_QK(sl, tt) do { const LASP char* Kb_ = ldsp + (sl) * SLOT + koff0; \
        const int kvb_ = (tt) * 64; const bool diag_ = (tt) == tdiag; const bool before_ = kvb_ < q0; \
        const unsigned spos_ = before_ ? 0x80008000u : 0u, sneg_ = before_ ? 0u : 0x80008000u; \
        const unsigned dm_ = diag_ ? ~hm0 : 0xffffffffu; \
        const unsigned w0_ = (kw0b ^ (spos_ & ksm)) & dm_, w1_ = (kw1b ^ (spos_ & ksm)) & dm_, w3_ = (dkdk ^ (sneg_ & ksm)) & dm_; \
        const unsigned k0_ = ((bfbits((float)kvb_) * 0x10001u) ^ sneg_) & hm0 & dm_, k1_ = ((bfbits((float)(kvb_ + 32)) * 0x10001u) ^ sneg_) & hm0 & dm_; \
        const bf16x8 ka0_ = __builtin_bit_cast(bf16x8, (u32x4){w0_, w1_, k0_, w3_}), ka1_ = __builtin_bit_cast(bf16x8, (u32x4){w0_, w1_, k1_, w3_}); \
        P0 = __builtin_amdgcn_mfma_f32_32x32x16_bf16(ka0_, qaug, zero16, 0, 0, 0); P1 = __builtin_amdgcn_mfma_f32_32x32x16_bf16(ka1_, qaug, zero16, 0, 0, 0); \
        _Pragma("unroll") for (int ks = 0; ks < 4; ++ks) { \
            const bf16x8 kf0_ = *(const LASP bf16x8*)(Kb_ + (((2 * ks + hi) ^ kx) * 16)); \
            const bf16x8 kf1_ = *(const LASP bf16x8*)(Kb_ + 4096 + (((2 * ks + hi) ^ kx) * 16)); \
            const bf16x8 qf_ = *(const LASP bf16x8*)(qlds + ks * 1024); \
            P0 = __builtin_amdgcn_mfma_f32_32x32x16_bf16(kf0_, qf_, P0, 0, 0, 0); P1 = __builtin_amdgcn_mfma_f32_32x32x16_bf16(kf1_, qf_, P1, 0, 0, 0); } \
        asm volatile("s_nop 15\n\ts_nop 7" : "+v"(P0), "+v"(P1));     \
        ATT_SB(); } while (0)
#define ATT_SM(tt) do { \
        if ((tt) == tdiag) { const float a_ = qpos - (float)((tt) * 64); \
            _Pragma("unroll") for (int r = 0; r < 16; ++r) { const float x0 = a_ - (float)crow(r, 0); P0[r] = fmaf(fabsf(x0), -slope2q, P0[r]); P1[r] = fmaf(fabsf(x0 - 32.0f), -slope2q, P1[r]); } } \
        float rm_ = max3f(P0[0], P0[1], P1[0]); rm_ = max3f(rm_, P1[1], P0[2]); float rn_ = max3f(P0[3], P1[2], P1[3]); \
        _Pragma("unroll") for (int r = 4; r < 16; r += 2) { rm_ = max3f(rm_, P0[r], P0[r + 1]); rn_ = max3f(rn_, P1[r], P1[r + 1]); } \
        float rm; { const float rq_ = fmaxf(rm_, rn_); auto rr = __builtin_amdgcn_permlane32_swap(__float_as_uint(rq_), __float_as_uint(rq_), false, false); rm = max3f(__uint_as_float(rr[0]), __uint_as_float(rr[1]), -1e30f); } \
        live = !__all(rm < mrel - 40.0f);       \
        if (live) { \
            mrel = fmaxf(mrel, rm); \
            if (__any(rm > 8.0f)) { const float dl = fmaxf(rm, 0.f); mhat += dl; mrel -= dl; \
                _Pragma("unroll") for (int r = 0; r < 16; ++r) { P0[r] -= dl; P1[r] -= dl; } \
                { const unsigned mh_ = bfbits(mhat); const float r1_ = mhat - bf2f(mh_); const unsigned mm_ = bfbits(r1_); const unsigned ml_ = bfbits(r1_ - bf2f(mm_)); \
                  const unsigned a0_ = hi ? ((mh_ | (mm_ << 16)) ^ 0x80008000u) : qa0, a1_ = hi ? (ml_ ^ 0x8000u) : qa1; \
                  qaug = __builtin_bit_cast(bf16x8, (u32x4){a0_, a1_, hi ? 0u : SHSL, hi ? 0u : SHSL}); } \
                const float f = exp2f(-dl); lsum *= f; \
                _Pragma("unroll") for (int eb = 0; eb < 4; ++eb) _Pragma("unroll") for (int r = 0; r < 16; ++r) o[eb][r] *= f; } \
            _Pragma("unroll") for (int r = 0; r < 16; ++r) { P0[r] = __builtin_amdgcn_exp2f(P0[r]); P1[r] = __builtin_amdgcn_exp2f(P1[r]); } \
            asm volatile("s_nop 1" : "+v"(P0), "+v"(P1));     \
            float ps0 = fadd_s(P0[0], P1[0]), ps1 = fadd_s(P0[1], P1[1]); \
            _Pragma("unroll") for (int r = 2; r < 16; r += 2) { ps0 = fadd_s(ps0, P0[r]); ps1 = fadd_s(ps1, P0[r + 1]); ps0 = fadd_s(ps0, P1[r]); ps1 = fadd_s(ps1, P1[r + 1]); } \
            lsum += fadd_s(ps0, ps1); \
            _Pragma("unroll") for (int s2 = 0; s2 < 2; ++s2) { \
                u32x4 w_; w_.x = cvtpk(P0[8 * s2 + 0], P0[8 * s2 + 1]); w_.y = cvtpk(P0[8 * s2 + 2], P0[8 * s2 + 3]); w_.z = cvtpk(P0[8 * s2 + 4], P0[8 * s2 + 5]); w_.w = cvtpk(P0[8 * s2 + 6], P0[8 * s2 + 7]); pf[s2] = __builtin_bit_cast(bf16x8, w_); \
                u32x4 v_; v_.x = cvtpk(P1[8 * s2 + 0], P1[8 * s2 + 1]); v_.y = cvtpk(P1[8 * s2 + 2], P1[8 * s2 + 3]); v_.z = cvtpk(P1[8 * s2 + 4], P1[8 * s2 + 5]); v_.w = cvtpk(P1[8 * s2 + 6], P1[8 * s2 + 7]); pf[2 + s2] = __builtin_bit_cast(bf16x8, v_); } \
        } ATT_SB(); } while (0)
#define ATT_PV(sl) do { if (live) { const LASP char* Vb_ = ldsp + (sl) * SLOT + vboff; \
            _Pragma("unroll") for (int eb = 0; eb < 4; ++eb) _Pragma("unroll") for (int s = 0; s < 4; ++s) { \
                const s16x4 lo_ = vtr(Vb_ + s * 4096 + eb * 512), h4_ = vtr(Vb_ + s * 4096 + 2048 + eb * 512); \
                const bf16x8 vf_ = (bf16x8){lo_[0], lo_[1], lo_[2], lo_[3], h4_[0], h4_[1], h4_[2], h4_[3]}; \
                o[eb] = __builtin_amdgcn_mfma_f32_32x32x16_bf16(vf_, pf[s], o[eb], 0, 0, 0); } } ATT_SB(); } while (0)
            { bf16x8 qf_[4];
#pragma unroll
              for (int ks = 0; ks < 4; ++ks) qf_[ks] = *(const bf16x8*)(qrow + c * 64 + 16 * ks + 8 * hi);
#pragma unroll
              for (int ks = 0; ks < 4; ++ks) *(LASP bf16x8*)((LASP char*)C.lds + 4 * SLOT + wave * 4096 + ks * 1024 + lane * 16) = qf_[ks]; }
            asm volatile("s_waitcnt vmcnt(0)" ::: "memory");
            ATT_DMA(t0, 0); ATT_DMA((t0 + 1) & 31, 1);
            const LASP char* qlds = ldsp + 4 * SLOT + wave * 4096 + lane * 16;
            f32x16 o[4], zero16, P0, P1;
#pragma unroll
            for (int r = 0; r < 16; ++r) zero16[r] = 0.f;
#pragma unroll
            for (int eb = 0; eb < 4; ++eb)
#pragma unroll
                for (int r = 0; r < 16; ++r) o[eb][r] = 0.f;
            float mhat = 0.f, lsum = 0.f, mrel = -1e30f;
            bf16x8 qaug = __builtin_bit_cast(bf16x8, (u32x4){hi ? 0u : qa0, hi ? 0u : qa1, hi ? 0u : SHSL, hi ? 0u : SHSL});
            bf16x8 pf[4]; bool live = false;
            if (wave < 4) {
#pragma unroll 1
                for (int i = 0; i < 32; ++i) {
                    if (i + 1 < 32) ATT_WAITBAR3(); else ATT_WAITBAR();
                    if (i + 2 < 32) ATT_DMA((t0 + i + 2) & 31, (i + 2) & 3);
                    const int tt = (t0 + i) & 31;
                    ATT_QK(i & 3, tt); ATT_SM(tt); ATT_PV(i & 3);
                }
            } else {
#pragma unroll 1
                for (int i = 0; i < 32; ++i) {
                    if (i + 1 < 32) ATT_WAITBAR3(); else ATT_WAITBAR();
                    if (i + 2 < 32) ATT_DMA((t0 + i + 2) & 31, (i + 2) & 3);
                    const int tt = (t0 + i) & 31;
                    ATT_PV((i - 1) & 3); ATT_QK(i & 3, tt); ATT_SM(tt);
                }
                ATT_PV(31 & 3);
            }
#undef ATT_DMA
#undef ATT_QK
#undef ATT_SM
#undef ATT_PV
#undef ATT_SB
            { auto rr = __builtin_amdgcn_permlane32_swap(__float_as_uint(lsum), __float_as_uint(lsum), false, false); lsum = __uint_as_float(rr[0]) + __uint_as_float(rr[1]); }
            const float inv = 1.0f / lsum;
            float* pk = (float*)(C.ws + WS_H2LO) + (size_t)C.gw * 4096;
            pk += fresh_lane();
            if (c == 0) {
#pragma unroll
                for (int eb = 0; eb < 4; ++eb)
#pragma unroll
                    for (int r = 0; r < 16; ++r) pk[(eb * 16 + r) * 64] = o[eb][r] * inv;
            } else {
                float ss = 0.f;
#pragma unroll
                for (int eb = 0; eb < 4; ++eb)
#pragma unroll
                    for (int r = 0; r < 16; ++r) { const float y = pk[(eb * 16 + r) * 64] - lam * (o[eb][r] * inv); o[eb][r] = y; ss += y * y; }
                { auto rr = __builtin_amdgcn_permlane32_swap(__float_as_uint(ss), __float_as_uint(ss), false, false); ss = __uint_as_float(rr[0]) + __uint_as_float(rr[1]); }
                const float rinv = 1.0f / sqrtf(ss * (1.0f / 128.0f) + EPS);
                bf16_t* orow = ycat + (size_t)(b * SEQ + q0 + l31) * D + 512 + hh * 128 + 4 * hi;
#pragma unroll
                for (int eb = 0; eb < 4; ++eb)
#pragma unroll
                    for (int g4 = 0; g4 < 4; ++g4) { const int e = 32 * eb + 8 * g4;
                        u32x2 w; w.x = cvtpk(o[eb][4 * g4] * rinv, o[eb][4 * g4 + 1] * rinv); w.y = cvtpk(o[eb][4 * g4 + 2] * rinv, o[eb][4 * g4 + 3] * rinv);
                        *(u32x2*)(orow + e) = w; }
            }
        }
    }
    ATT_WAITBAR();
#undef ATT_WAITBAR
#undef ATT_WAITBAR3
}

__device__ __forceinline__ void phase_hy_pre_fast(Ctx& C) {
    const bf16_t* u = (const bf16_t*)(C.ws + WS_U); bf16_t* vpt = (bf16_t*)(C.ws + WS_VP); bf16_t* x0t = (bf16_t*)(C.ws + WS_X0C);
    const float* cw = C.in[7]; const float* cb = C.in[8];
    bf16_t* sv = (bf16_t*)C.lds; bf16_t* sx = sv + 64 * 72;
    const int tl = C.tid >> 3, c8 = C.tid & 7;
    for (int tile = C.blk; tile < NB * 32 * 8; tile += C.nblk) {
        const int cq = tile & 7, tq = (tile >> 3) & 31, b = tile >> 8;
        const int c0 = cq * 64 + c8 * 8, t = tq * 64 + tl; const size_t row = (size_t)b * SEQ + t;
        float r[3][8];
#pragma unroll
        for (int s = 0; s < 3; ++s) {
            const int ch = s * HW + c0;
            const u32x4 z = {0u, 0u, 0u, 0u};
            const u32x4 um = (t > 0) ? *(const u32x4*)(u + (row - 1) * INC + ch) : z, u0 = *(const u32x4*)(u + row * INC + ch), up = (t < SEQ - 1) ? *(const u32x4*)(u + (row + 1) * INC + ch) : z;
            f32x4 m0, m1, z0, z1, p0, p1; pg8::unpack8(um, m0, m1); pg8::unpack8(u0, z0, z1); pg8::unpack8(up, p0, p1);
            const f32x4 w00 = *(const f32x4*)(cw + ch), w01 = *(const f32x4*)(cw + ch + 4), w10 = *(const f32x4*)(cw + 3 * HW + ch), w11 = *(const f32x4*)(cw + 3 * HW + ch + 4);
            const f32x4 w20 = *(const f32x4*)(cw + 6 * HW + ch), w21 = *(const f32x4*)(cw + 6 * HW + ch + 4), bb0 = *(const f32x4*)(cb + ch), bb1 = *(const f32x4*)(cb + ch + 4);
            const f32x4 a0 = m0 * w00 + z0 * w10 + p0 * w20 + bb0, a1 = m1 * w01 + z1 * w11 + p1 * w21 + bb1;
#pragma unroll
            for (int i = 0; i < 4; ++i) { r[s][i] = a0[i]; r[s][4 + i] = a1[i]; }
        }
        __syncthreads();
#pragma unroll
        for (int i = 0; i < 8; ++i) { sx[(c8 * 8 + i) * 72 + tl] = (bf16_t)f2bf(r[0][i]); sv[(c8 * 8 + i) * 72 + tl] = (bf16_t)f2bf(r[2][i] * r[1][i]); }
        __syncthreads();
        { const int cl = C.tid >> 3, chk = C.tid & 7; const size_t o = ((size_t)(cq * 64 + cl) * NB + b) * SEQ + tq * 64 + chk * 8;
          *(u32x4*)(vpt + o) = *(const u32x4*)(sv + cl * 72 + chk * 8); *(u32x4*)(x0t + o) = *(const u32x4*)(sx + cl * 72 + chk * 8); }
    }
    __syncthreads();
}

__device__ __forceinline__ void phase_toeplitz(Ctx& C) {
    constexpr int VROW = 4096 + 16, FCOPY = 8192 + 32, FL = 16 * VROW;
    const bf16_t* vpt = (const bf16_t*)(C.ws + WS_VP); const bf16_t* x0t = (const bf16_t*)(C.ws + WS_X0C); bf16_t* yt = (bf16_t*)(C.ws + WS_YT);
    const float* kfc = (const float*)(C.ws + WS_KFC); const float* dsk = C.in[17];
    const int lane = C.lane, a = lane & 15, g = lane >> 4, wave = C.wave;
    const unsigned lds0 = (unsigned)(uintptr_t)C.lds;
    const LASP char* ldsp = (const LASP char*)C.lds;
    const int t0 = 256 * wave;
    const int c0 = 2048 - t0 + 8 * g - a;
    const LASP char* fbase = ldsp + FL + (c0 & 7) * FCOPY + 2 * (c0 & ~7);
    const LASP char* vbase = ldsp + a * VROW + 16 * g;
    for (int c = C.blk; c < HW; c += C.nblk) {
        asm volatile("s_waitcnt vmcnt(0) lgkmcnt(0)\n\ts_barrier" ::: "memory");
        { const char* src = (const char*)(vpt + (size_t)c * NB * SEQ) + lane * 16;
#pragma unroll
          for (int j = 0; j < 8; ++j) { const int p = wave * 8 + j;
              glds16(src + (size_t)p * 1024, (unsigned)__builtin_amdgcn_readfirstlane(lds0 + (p >> 2) * VROW + (p & 3) * 1024)); } }
        { const int q = C.tid; const float* kc = kfc + (size_t)c * 4096; float f[15];
#pragma unroll
          for (int i = 0; i < 15; ++i) { const int idx = 4096 - 8 * q - i; f[i] = (idx >= 1 && idx <= 4095) ? kc[idx] : 0.f; }
#pragma unroll
          for (int m = 0; m < 8; ++m) { u32x4 w; w.x = pk2(f[m], f[m + 1]); w.y = pk2(f[m + 2], f[m + 3]); w.z = pk2(f[m + 4], f[m + 5]); w.w = pk2(f[m + 6], f[m + 7]);
              *(LASP u32x4*)((LASP char*)C.lds + FL + m * FCOPY + q * 16) = w; } }
        asm volatile("s_waitcnt vmcnt(0) lgkmcnt(0)\n\ts_barrier" ::: "memory");
        f32x4 acc[16]; bf16x8 W[16];
#pragma unroll
        for (int r = 0; r < 16; ++r) { acc[r] = (f32x4){0.f, 0.f, 0.f, 0.f}; W[r] = *(const LASP bf16x8*)(fbase - 32 * r); }
#pragma unroll 1
        for (int ko = 0; ko < 8; ++ko) {
            const LASP char* fb = fbase + ko * 512; const LASP char* vb = vbase + ko * 512;
#pragma unroll
            for (int kk = 0; kk < 8; ++kk) {
                const bf16x8 Bf = *(const LASP bf16x8*)(vb + 64 * kk);
#pragma unroll
                for (int r = 0; r < 16; ++r) acc[r] = __builtin_amdgcn_mfma_f32_16x16x32_bf16(W[(r - 2 * kk) & 15], Bf, acc[r], 0, 0, 0);
                if (ko < 7 || kk < 7) { W[(-2 * kk - 2) & 15] = *(const LASP bf16x8*)(fb + 64 * kk + 64); W[(-2 * kk - 1) & 15] = *(const LASP bf16x8*)(fb + 64 * kk + 32); }
            }
        }
        const float dd = dsk[c];
#pragma unroll
        for (int r = 0; r < 16; ++r) { const int t = t0 + 16 * r + 4 * g; const size_t o = ((size_t)c * NB + a) * SEQ + t;
            const u32x2 vv = *(const LASP u32x2*)(ldsp + a * VROW + t * 2); const u32x2 xx = *(const u32x2*)(x0t + o);
            const float y0 = (acc[r][0] + bflo(vv.x) * dd) * bflo(xx.x), y1 = (acc[r][1] + bfhi(vv.x) * dd) * bfhi(xx.x);
            const float y2 = (acc[r][2] + bflo(vv.y) * dd) * bflo(xx.y), y3 = (acc[r][3] + bfhi(vv.y) * dd) * bfhi(xx.y);
            u32x2 w; w.x = pk2(y0, y1); w.y = pk2(y2, y3); *(u32x2*)(yt + o) = w; }
    }
    asm volatile("s_waitcnt vmcnt(0) lgkmcnt(0)\n\ts_barrier" ::: "memory");
}

__device__ __forceinline__ void phase_hy_post(Ctx& C) {
    const bf16_t* yt = (const bf16_t*)(C.ws + WS_YT); bf16_t* ycat = (bf16_t*)(C.ws + WS_YCAT);
    bf16_t* sy = (bf16_t*)C.lds;
    for (int tile = C.blk; tile < NB * 32 * 8; tile += C.nblk) {
        const int cq = tile & 7, tq = (tile >> 3) & 31, b = tile >> 8;
        __syncthreads();
        { const int cl = C.tid >> 3, chk = C.tid & 7; *(u32x4*)(sy + cl * 72 + chk * 8) = *(const u32x4*)(yt + ((size_t)(cq * 64 + cl) * NB + b) * SEQ + tq * 64 + chk * 8); }
        __syncthreads();
        { const int tl = C.tid >> 3, c8 = C.tid & 7; unsigned short e[8];
#pragma unroll
          for (int i = 0; i < 8; ++i) e[i] = sy[(c8 * 8 + i) * 72 + tl];
          u32x4 w; w.x = e[0] | ((unsigned)e[1] << 16); w.y = e[2] | ((unsigned)e[3] << 16); w.z = e[4] | ((unsigned)e[5] << 16); w.w = e[6] | ((unsigned)e[7] << 16);
          *(u32x4*)(ycat + ((size_t)b * SEQ + tq * 64 + tl) * D + cq * 64 + c8 * 8) = w; }
    }
    __syncthreads();
}

__device__ __forceinline__ void phase_route(Ctx& C) {
    const float* mod = (const float*)(C.ws + WS_MOD); const float* ssq = (const float*)(C.ws + WS_LOGITS); bf16_t* h2 = (bf16_t*)(C.ws + WS_H); const bf16_t* wrt = (const bf16_t*)(C.ws + WS_WRT);
    int* tope = (int*)(C.ws + WS_TOPE); float* topw = (float*)(C.ws + WS_TOPW); int* blkcnt = (int*)(C.ws + WS_BLKCNT);
    const float* g = C.in[23]; const float* br = C.in[25];
    int* hist = (int*)C.lds; float* slog = (float*)(C.lds + 1024) + C.wave * 512;
    const int lane = C.lane, tk = lane & 15, gq = lane >> 4;
    for (int vb = C.blk; vb < 256; vb += C.nblk) {
        __syncthreads();
        if (C.tid < NE) hist[C.tid] = 0;
        __syncthreads();
        const int tok = vb * 128 + C.wave * 16 + tk; const int b = tok / SEQ;
        float rstd;
        { const f32x4* sp = (const f32x4*)(ssq + (size_t)tok * 16); const f32x4 a0 = sp[0], a1 = sp[1], a2 = sp[2], a3 = sp[3];
          const float ss = ((a0.x + a0.y) + (a0.z + a0.w)) + ((a1.x + a1.y) + (a1.z + a1.w)) + ((a2.x + a2.y) + (a2.z + a2.w)) + ((a3.x + a3.y) + (a3.z + a3.w));
          rstd = 1.0f / sqrtf(ss * (1.0f / D) + EPS); }
        const float* xr = C.out + (size_t)tok * D + 8 * gq; const float* sh = mod + (size_t)b * 6 * D + 3 * D + 8 * gq; const float* sc = sh + D; const float* gg = g + 8 * gq;
        bf16_t* hr = h2 + (size_t)tok * D + 8 * gq;
        const bf16_t* wb = wrt + (size_t)tk * 2048 + 8 * gq;
        f32x4 acc[2]; acc[0] = (f32x4){0.f, 0.f, 0.f, 0.f}; acc[1] = acc[0];
#pragma unroll 2
        for (int k = 0; k < D; k += 32) {
            const f32x4 x0 = *(const f32x4*)(xr + k), x1v = *(const f32x4*)(xr + k + 4), g0 = *(const f32x4*)(gg + k), g1 = *(const f32x4*)(gg + k + 4);
            const f32x4 c0 = *(const f32x4*)(sc + k), c1 = *(const f32x4*)(sc + k + 4), s0 = *(const f32x4*)(sh + k), s1 = *(const f32x4*)(sh + k + 4);
            f32x4 h0, h1;
#pragma unroll
            for (int i = 0; i < 4; ++i) { h0[i] = x0[i] * rstd * g0[i] * (1.f + c0[i]) + s0[i]; h1[i] = x1v[i] * rstd * g1[i] * (1.f + c1[i]) + s1[i]; }
            u32x4 wh; wh.x = pk2(h0[0], h0[1]); wh.y = pk2(h0[2], h0[3]); wh.z = pk2(h1[0], h1[1]); wh.w = pk2(h1[2], h1[3]);
            *(u32x4*)(hr + k) = wh;
            u32x4 wl; wl.x = pk2(h0[0] - bflo(wh.x), h0[1] - bfhi(wh.x)); wl.y = pk2(h0[2] - bflo(wh.y), h0[3] - bfhi(wh.y)); wl.z = pk2(h1[0] - bflo(wh.z), h1[1] - bfhi(wh.z)); wl.w = pk2(h1[2] - bflo(wh.w), h1[3] - bfhi(wh.w));
            const bf16x8 a_h = __builtin_bit_cast(bf16x8, wh), a_l = __builtin_bit_cast(bf16x8, wl);
#pragma unroll
            for (int n = 0; n < 2; ++n) { const bf16_t* bp = wb + (size_t)n * 16 * 2048 + k;
                const bf16x8 b_h = *(const bf16x8*)(bp), b_l = *(const bf16x8*)(bp + 1024);
                acc[n] = __builtin_amdgcn_mfma_f32_16x16x32_bf16(b_h, a_h, acc[n], 0, 0, 0);
                acc[n] = __builtin_amdgcn_mfma_f32_16x16x32_bf16(b_h, a_l, acc[n], 0, 0, 0);
                acc[n] = __builtin_amdgcn_mfma_f32_16x16x32_bf16(b_l, a_h, acc[n], 0, 0, 0); }
        }
#pragma unroll
        for (int n = 0; n < 2; ++n) *(f32x4*)(slog + tk * 32 + n * 16 + 4 * gq) = acc[n];
        __builtin_amdgcn_s_waitcnt(0xc07f); asm volatile("" ::: "memory");
        if (lane < 16) {
            const int t = vb * 128 + C.wave * 16 + lane;
            float v[32];
#pragma unroll
            for (int q = 0; q < 8; ++q) { const f32x4 x = *(const f32x4*)(slog + lane * 32 + 4 * q), bb = *(const f32x4*)(br + 4 * q);
                v[4 * q] = x.x + bb.x; v[4 * q + 1] = x.y + bb.y; v[4 * q + 2] = x.z + bb.z; v[4 * q + 3] = x.w + bb.w; }
            float tv[4]; int ti[4];
#pragma unroll
            for (int k = 0; k < 4; ++k) {
                float best = -INFINITY; int bi = 0;
#pragma unroll
                for (int e = 0; e < 32; ++e) if (v[e] > best) { best = v[e]; bi = e; }
                tv[k] = best; ti[k] = bi;
#pragma unroll
                for (int e = 0; e < 32; ++e) v[e] = (e == bi) ? -INFINITY : v[e];
            }
            const float e0 = 1.0f, e1 = expf(tv[1] - tv[0]), e2 = expf(tv[2] - tv[0]), e3 = expf(tv[3] - tv[0]);
            const float inv = 1.0f / (e0 + e1 + e2 + e3);
            *(int4*)(tope + (size_t)t * 4) = make_int4(ti[0], ti[1], ti[2], ti[3]);
            *(f32x4*)(topw + (size_t)t * 4) = (f32x4){e0 * inv, e1 * inv, e2 * inv, e3 * inv};
#pragma unroll
            for (int k = 0; k < 4; ++k) atomicAdd(&hist[ti[k]], 1);
        }
        __syncthreads();
        if (C.tid < NE) blkcnt[vb * NE + C.tid] = hist[C.tid];
    }
    __syncthreads();
}

__device__ __forceinline__ void phase_rowlist(Ctx& C) {
    const int* tope = (const int*)(C.ws + WS_TOPE); const int* blkcnt = (const int*)(C.ws + WS_BLKCNT);
    int* rowpair = (int*)(C.ws + WS_ROWPAIR); int* tileexp = (int*)(C.ws + WS_TILEEXP); int* meta = (int*)(C.ws + WS_META);
    int* s_total = (int*)C.lds; int* s_base = s_total + 32; int* s_pstart = s_base + 32; int* s_e = s_pstart + 36; int* s_cnt = s_e + 512;
    for (int vb = C.blk; vb < 256; vb += C.nblk) {
        __syncthreads();
        { const int4* src = (const int4*)blkcnt; int4* dst = (int4*)s_cnt;
#pragma unroll
          for (int q = 0; q < 4; ++q) dst[q * NTHREADS + C.tid] = src[q * NTHREADS + C.tid]; }
        s_e[C.tid] = tope[(size_t)vb * 512 + C.tid];
        __syncthreads();
        if (C.tid < NE) { int tot = 0, base = 0;
#pragma unroll 8
            for (int q = 0; q < 256; ++q) { const int c = s_cnt[q * NE + C.tid]; tot += c; if (q < vb) base += c; } s_total[C.tid] = tot; s_base[C.tid] = base; }
        __syncthreads();
        if (C.tid == 0) { int ps = 0; for (int e = 0; e < NE; ++e) { s_pstart[e] = ps; ps += ((s_total[e] + 255) / 256) * 256; } s_pstart[NE] = ps; }
        __syncthreads();
        { const int e = s_e[C.tid]; int rank = 0; for (int j = 0; j < C.tid; ++j) rank += (s_e[j] == e) ? 1 : 0;
          rowpair[s_pstart[e] + s_base[e] + rank] = vb * 512 + C.tid; }
        if (vb < NE) { const int e = vb; for (int r = s_pstart[e] + s_total[e] + C.tid; r < s_pstart[e + 1]; r += NTHREADS) rowpair[r] = -1; }
        if (vb == 0) {
            if (C.tid < NE) { for (int tl = s_pstart[C.tid] / 256; tl < s_pstart[C.tid + 1] / 256; ++tl) tileexp[tl] = C.tid; }
            if (C.tid == 0) meta[0] = s_pstart[NE] / 256;
        }
    }
    __syncthreads();
}


#define LDS3(C) ((PG8_LAS unsigned char*)(C).lds)
__device__ __forceinline__ void phase_inproj_fast(Ctx& C) {
    pg8::Gemm g{(const bf16_t*)(C.ws + WS_H), (const bf16_t*)(C.ws + WS_WIN), D, D, D, nullptr};
    pg8::StaticOrder S; S.init(T / 256, INC / 256, C.nblk, C.blk);
    pg8::EpiInproj E{(bf16_t*)(C.ws + WS_U), C.in[6]};
    pg8::gemm_phase<pg8::EpiInproj, pg8::StaticOrder, false>(LDS3(C), g, S, E, C.wave);
}
#ifndef XVAR
#define XVAR 0
#endif
__device__ __forceinline__ void phase_probe_x(Ctx& C) {
#if XVAR == 1
    pg8::Gemm g{(const bf16_t*)(C.ws + WS_H), (const bf16_t*)(C.ws + WS_WIN), D, D, D, nullptr};
    pg8::StaticOrder S; S.init(T / 256, INC / 256, C.nblk, C.blk);
    pg8::EpiInprojT<1> E{(bf16_t*)(C.ws + WS_U), C.in[6]};
    pg8::gemm_phase<pg8::EpiInprojT<1>, pg8::StaticOrder, false>(LDS3(C), g, S, E, C.wave);
#endif
}
__device__ __forceinline__ void phase_cat_fast(Ctx& C) {
    pg8::StaticOrder S; S.init(T / 256, D / 256, C.nblk, C.blk);
    pg8::Gemm g{(const bf16_t*)(C.ws + WS_YCAT), (const bf16_t*)(C.ws + WS_WCAT), D, D, D, nullptr};
    pg8::EpiCatR E{(bf16_t*)(C.ws + WS_MERGED), (const bf16_t*)(C.ws + WS_U)};
    pg8::gemm_phase<pg8::EpiCatR, pg8::StaticOrder, false, true>(LDS3(C), g, S, E, C.wave);
}
__device__ __forceinline__ void phase_mix_fast(Ctx& C) {
    pg8::Gemm g{(const bf16_t*)(C.ws + WS_MERGED), (const bf16_t*)(C.ws + WS_WMIX), D, D, D, nullptr};
    pg8::StaticOrder S; S.init(T / 256, D / 256, C.nblk, C.blk);
    pg8::EpiMix E{C.in[0], C.out, (const float*)(C.ws + WS_MOD), (float*)(C.ws + WS_LOGITS)};
    pg8::gemm_phase<pg8::EpiMix, pg8::StaticOrder, false>(LDS3(C), g, S, E, C.wave);
}
__device__ __forceinline__ void phase_gateup_fast(Ctx& C) {
    const int nmt = ((const int*)(C.ws + WS_META))[0];
    pg8::Gemm g{(const bf16_t*)(C.ws + WS_H), (const bf16_t*)(C.ws + WS_WGU), D, D, D, (const int*)(C.ws + WS_ROWPAIR)};
    pg8::MoeOrder S; S.b.init(nmt, 8, C.nblk, C.blk); S.tileexp = (const int*)(C.ws + WS_TILEEXP); S.nN = 8;
    pg8::EpiGateUp E{(bf16_t*)(C.ws + WS_ACT), C.in[27]};
    pg8::gemm_phase<pg8::EpiGateUp, pg8::MoeOrder, true>(LDS3(C), g, S, E, C.wave);
}
__device__ __forceinline__ void phase_down_fast(Ctx& C) {
    const int nmt = ((const int*)(C.ws + WS_META))[0];
    pg8::Gemm g{(const bf16_t*)(C.ws + WS_ACT), (const bf16_t*)(C.ws + WS_WDN), D, D, D, nullptr};
    pg8::MoeOrder S; S.b.init(nmt, 4, C.nblk, C.blk); S.tileexp = (const int*)(C.ws + WS_TILEEXP); S.nN = 4;
    pg8::EpiDown E{(bf16_t*)(C.ws + WS_SLOTS), C.in[29], (const int*)(C.ws + WS_ROWPAIR), (const float*)(C.ws + WS_TOPW)};
    pg8::gemm_phase<pg8::EpiDown, pg8::MoeOrder, false>(LDS3(C), g, S, E, C.wave);
}


#define XB_TMO      128
#define XB_XCNT(j)  (256  + 64 * (j))
#define XB_XSUB(j)  (1280 + 64 * (j))
#define XB_XGEN(j)  (2304 + 64 * (j))
#define XB_TOP      3328
#define XB_TOPGEN   3392
#define XCD_BAR_WORDS 3456
#define XB_SPIN_CAP (1u << 18)
#define XLAS __attribute__((address_space(3)))
__device__ __forceinline__ unsigned xb_ld(unsigned* p)              { return __hip_atomic_load(p, __ATOMIC_RELAXED, __HIP_MEMORY_SCOPE_AGENT); }
__device__ __forceinline__ unsigned xb_add(unsigned* p, unsigned v) { return __hip_atomic_fetch_add(p, v, __ATOMIC_RELAXED, __HIP_MEMORY_SCOPE_AGENT); }
__device__ __forceinline__ unsigned xb_xcc_id() { return (unsigned)__builtin_amdgcn_s_getreg((3 << 11) | 20) & 0xFu; }
#define XB_SPIN(cond, bar) do { unsigned _sp = 0; while (cond) { __builtin_amdgcn_s_sleep(1); \
    if ((++_sp & 255u) == 0u) { if (xb_ld(&(bar)[XB_TMO])) break; if (_sp > XB_SPIN_CAP) { atomicAdd(&(bar)[XB_TMO], 1u); break; } } } } while (0)
struct XcdBarrier { unsigned* bar; unsigned x; volatile XLAS unsigned* st; };
__device__ __forceinline__ XcdBarrier xcd_barrier_post(unsigned* bar, volatile XLAS unsigned* st, bool leader) {
    XcdBarrier b; b.bar = bar; b.x = xb_xcc_id(); b.st = st;
    if (leader) (void)xb_add(&bar[XB_XCNT(b.x)], 1u);
    return b;
}
__device__ __forceinline__ void xcd_barrier_complete(unsigned* bar, unsigned x, unsigned& nloc, unsigned& nx) {
    const unsigned G = gridDim.x * gridDim.y * gridDim.z;
    unsigned sum, cnt, mine, sp = 0u;
    for (;;) {
        sum = 0u; cnt = 0u; mine = 0u;
#pragma unroll
        for (unsigned j = 0; j < 16; ++j) { const unsigned c = xb_ld(&bar[XB_XCNT(j)]); sum += c; cnt += (c > 0u) ? 1u : 0u; mine = (j == x) ? c : mine; }
        if (sum == G) break;
        __builtin_amdgcn_s_sleep(1);
        if ((++sp & 255u) == 0u) { if (xb_ld(&bar[XB_TMO])) break; if (sp > XB_SPIN_CAP) { atomicAdd(&bar[XB_TMO], 1u); break; } }
    }
    nloc = mine > 0u ? mine : 1u; nx = cnt > 0u ? cnt : 1u;
}
__device__ __forceinline__ void xcd_barrier(const XcdBarrier& b, int wave_) {
    asm volatile("s_waitcnt vmcnt(0)" ::: "memory");
    __syncthreads();
    if (wave_ == 0 && lane_id() == 0) {
        unsigned* bar = b.bar;
        __builtin_amdgcn_s_waitcnt(0);
        unsigned nloc = b.st[0], nx = b.st[1];
        if (nloc == 0u) { xcd_barrier_complete(bar, b.x, nloc, nx); b.st[0] = nloc; b.st[1] = nx; }
        const unsigned old = xb_add(&bar[XB_XSUB(b.x)], 1u);
        const unsigned gen = old / nloc;
        if (old + 1u == (gen + 1u) * nloc) {
            __builtin_amdgcn_fence(__ATOMIC_RELEASE, "agent");
            asm volatile("s_waitcnt vmcnt(0)" ::: "memory");
            const unsigned og = xb_add(&bar[XB_TOP], 1u);
            const unsigned tg = og / nx;
            if (og + 1u == (tg + 1u) * nx) xb_add(&bar[XB_TOPGEN], 1u);
            else XB_SPIN(xb_ld(&bar[XB_TOPGEN]) == tg, bar);
            __builtin_amdgcn_fence(__ATOMIC_ACQUIRE, "agent");
            xb_add(&bar[XB_XGEN(b.x)], 1u);
            asm volatile("s_waitcnt vmcnt(0)" ::: "memory");
        } else {
            XB_SPIN(xb_ld(&bar[XB_XGEN(b.x)]) == gen, bar);
            __builtin_amdgcn_fence(__ATOMIC_ACQUIRE, "agent");
            asm volatile("s_waitcnt vmcnt(0)" ::: "memory");
        }
    }
    __syncthreads();
}

constexpr int NPHASES = 13;
}

__global__ void __launch_bounds__(NTHREADS, 2) fwd_kernel(Params p) {
    extern __shared__ __attribute__((aligned(16))) unsigned char lds[];
    cg::grid_group grid = cg::this_grid();
    Ctx C;
#pragma unroll
    for (int i = 0; i < 31; ++i) C.in[i] = p.in[i];
    C.out = p.out; C.ws = p.ws; C.lds = lds;
    const int wave_s = __builtin_amdgcn_readfirstlane(threadIdx.x >> 6);
    C.lane = lane_id(); C.wave = wave_s; C.tid = wave_s * 64 + C.lane;
    C.blk = blockIdx.x; C.nblk = gridDim.x; C.gw = C.blk * NWAVES + C.wave; C.ngw = C.nblk * NWAVES;
    const int lo = p.ph_lo, hi = p.ph_hi;
    volatile XLAS unsigned* misc = (volatile XLAS unsigned*)((XLAS unsigned char*)lds + (LDS_BYTES - 64));
    if (C.tid < 16) misc[C.tid] = 0u;
    __syncthreads();
    const XcdBarrier xbar = xcd_barrier_post((unsigned*)(p.ws + WS_CTL), misc, C.tid == 0);
#define GSYNC(k) do { xcd_barrier(xbar, wave_s); } while (0)
    if (lo < 0) grid.sync();
#ifndef PHMASK
#define PHMASK 0xffff
#endif
#ifndef REPMASK
#define REPMASK 0
#endif
#ifndef PROBE_PHASE
#define PROBE_PHASE (-1)
#endif
    unsigned long long tp0 = 0, tp1 = 0;
#define PH(k, body) do { if ((PHMASK >> (k)) & 1) { if (lo <= (k) && (k) < hi) { if ((k) == PROBE_PHASE) tp0 = __builtin_amdgcn_s_memrealtime(); _Pragma("unroll 1") for (int rep_ = (REPMASK >> (k)) & 1; rep_ >= 0; --rep_) { { C.lane = fresh_lane(); C.wave = wave_s; C.tid = wave_s * 64 + C.lane; C.gw = C.blk * NWAVES + C.wave; } body; if (rep_ > 0 || (k) + 1 < hi) GSYNC(k); } if ((k) == PROBE_PHASE) tp1 = __builtin_amdgcn_s_memrealtime(); } } } while (0)
#ifdef SYNCPROBE
    for (int i = 0; i < 20; ++i) GSYNC(1);
#endif
    PH(0, { phase_mod(C); phase_filters(C); });
    PH(1, { phase_weights(C); __syncthreads(); phase_norm1(C); });
#ifndef FASTMASK
#define FASTMASK 0xffff
#endif
#define FAST(k) ((FASTMASK >> (k)) & 1)
    PH(2, phase_inproj_fast(C));
#if XVAR == 1
    PH(13, phase_probe_x(C));
#endif
    PH(3, phase_hy_pre_fast(C));
    PH(4, { phase_toeplitz(C); GSYNC(1); phase_hy_post(C); });
    PH(5, phase_attn_fast(C));
    PH(6, phase_cat_fast(C));
    PH(7, phase_mix_fast(C));
    PH(8, phase_route(C));
    PH(9, phase_rowlist(C));
    PH(10, phase_gateup_fast(C));
    PH(11, phase_down_fast(C));
    PH(12, phase_final(C));
#undef PH
    if (PROBE_PHASE >= 0 && C.blk == 0) { const unsigned long long te = __builtin_amdgcn_s_memrealtime(), span = 4ull * (tp1 - tp0); while (__builtin_amdgcn_s_memrealtime() - te < span) __builtin_amdgcn_s_sleep(8); }
}

extern "C" void kernel_launch(void* const* d_in, const int* in_sizes, int n_in, void* d_out, int out_size, void* d_ws, size_t ws_size, hipStream_t stream) {
    static int grid = 0;
    if (grid == 0) {
        if (n_in != 31 || ws_size < WS_END) { fprintf(stderr, "kernel_launch: unexpected n_in %d or ws_size %zu\n", n_in, ws_size); grid = -1; return; }
        int dev = 0, cus = 0, per_cu = 0;
        hipGetDevice(&dev); hipDeviceGetAttribute(&cus, hipDeviceAttributeMultiprocessorCount, dev);
        hipFuncSetAttribute((const void*)fwd_kernel, hipFuncAttributeMaxDynamicSharedMemorySize, LDS_BYTES);
        hipOccupancyMaxActiveBlocksPerMultiprocessor(&per_cu, (const void*)fwd_kernel, NTHREADS, LDS_BYTES);
        if (per_cu < 1) { fprintf(stderr, "kernel_launch: occupancy query says %d blocks/CU\n", per_cu); per_cu = 1; }
        (void)hipGetLastError();
        grid = cus * 1;
        fprintf(stderr, "kernel_launch: cus %d per_cu %d grid %d\n", cus, per_cu, grid);
    }
    if (grid < 0) return;
    if (hipMemsetAsync((char*)d_ws + WS_CTL, 0, 65536, stream) != hipSuccess) { fprintf(stderr, "kernel_launch: memset failed\n"); return; }
    Params p{};
    for (int i = 0; i < 31; ++i) p.in[i] = (const float*)d_in[i];
    p.out = (float*)d_out; p.ws = (unsigned char*)d_ws; p.ph_lo = 0; p.ph_hi = NPHASES + (XVAR ? 1 : 0);
    void* args[] = {&p};
    hipError_t e = hipLaunchCooperativeKernel((const void*)fwd_kernel, dim3(grid), dim3(NTHREADS), args, LDS_BYTES, stream);
    if (e != hipSuccess) fprintf(stderr, "cooperative launch failed: %s (grid %d)\n", hipGetErrorString(e), grid);
}
```

```cpp
#include <hip/hip_runtime.h>
#include <hip/hip_cooperative_groups.h>
#include <cstdio>
#include <cstdint>
namespace cg = cooperative_groups;

namespace {
typedef unsigned short bf16_t;
typedef short bf16x8 __attribute__((ext_vector_type(8)));
typedef short s16x4 __attribute__((ext_vector_type(4)));
typedef float f32x4 __attribute__((ext_vector_type(4)));
typedef float f32x16 __attribute__((ext_vector_type(16)));
typedef unsigned u32x4 __attribute__((ext_vector_type(4)));
typedef unsigned u32x2 __attribute__((ext_vector_type(2)));

constexpr int D = 1024, NB = 16, SEQ = 2048, T = NB * SEQ, HW = 512, INC = 5120, NE = 32, FHID = 64;
constexpr int QOFF = 1536, KOFF = 2048, VOFF = 2560, GOFF = 3072;
constexpr int NTHREADS = 512, NWAVES = 8;
constexpr float EPS = 1e-5f;
constexpr float LOG2E = 1.4426950408889634f;
constexpr float QSCALE = 0.125f * 1.4426950408889634f;
constexpr size_t MiB = 1u << 20;
constexpr size_t WS_CTL = 0;
constexpr size_t WS_MOD = 1 * MiB;
constexpr size_t WS_META = 1 * MiB + 512 * 1024;
constexpr size_t WS_BLKCNT = WS_META + 4096;
constexpr size_t WS_TILEEXP = WS_BLKCNT + 256 * 32 * 4;
constexpr size_t WS_LOGITS = 2 * MiB;
constexpr size_t WS_TOPE = 6 * MiB;
constexpr size_t WS_TOPW = 6 * MiB + 512 * 1024;
constexpr size_t WS_ROWPAIR = 7 * MiB;
constexpr size_t WS_ROWW = 7 * MiB + 576 * 1024;
constexpr size_t WS_KFILT = 8 * MiB;
constexpr size_t WS_U = 16 * MiB;
constexpr size_t WS_ACT = WS_U;
constexpr size_t WS_H = 336 * MiB;
constexpr size_t WS_R1 = 400 * MiB;
constexpr size_t WS_YCAT = WS_R1;
constexpr size_t WS_MERGED = WS_R1 + 64 * MiB;
constexpr size_t WS_VP = WS_R1 + 128 * MiB;
constexpr size_t WS_X0C = WS_R1 + 160 * MiB;
constexpr size_t WS_VT = WS_R1 + 192 * MiB;
constexpr size_t WS_H2LO = WS_R1 + 224 * MiB;
constexpr size_t WS_SLOTS = WS_R1;
constexpr size_t WS_WIN = 688 * MiB;
constexpr size_t WS_WCAT = 698 * MiB;
constexpr size_t WS_WMIX = 700 * MiB;
constexpr size_t WS_WGU = 702 * MiB;
constexpr size_t WS_WDN = 830 * MiB;
constexpr size_t WS_WRT = 894 * MiB;
constexpr size_t WS_KFC = 896 * MiB;
constexpr size_t WS_END = 904 * MiB;
constexpr size_t WS_YT = WS_R1 + 192 * MiB;
constexpr int MAXROWS = 4 * T + NE * 256;
constexpr int LDS_BYTES = 147456;

struct Params { const float* in[31]; float* out; unsigned char* ws; int ph_lo, ph_hi; };

__device__ __forceinline__ unsigned f2bf(float f) { unsigned u = __float_as_uint(f); return (u + 0x7fffu + ((u >> 16) & 1u)) >> 16; }
__device__ __forceinline__ unsigned pk2(float lo, float hi) { return f2bf(lo) | (f2bf(hi) << 16); }
__device__ __forceinline__ float bf2f(unsigned h) { return __uint_as_float(h << 16); }
__device__ __forceinline__ float bflo(unsigned w) { return __uint_as_float(w << 16); }
__device__ __forceinline__ float bfhi(unsigned w) { return __uint_as_float(w & 0xffff0000u); }
__device__ __forceinline__ float wave_sum(float v) {
#pragma unroll
    for (int o = 1; o < 64; o <<= 1) v += __shfl_xor(v, o);
    return v;
}
__device__ __forceinline__ float sigmoidf_(float x) { return 1.0f / (1.0f + __expf(-x)); }
__device__ __forceinline__ int crow(int r, int hi) { return (r & 3) + 8 * (r >> 2) + 4 * hi; }
__device__ __forceinline__ int lane_id() { return (int)__builtin_amdgcn_mbcnt_hi(~0u, __builtin_amdgcn_mbcnt_lo(~0u, 0u)); }
__device__ __forceinline__ int fresh_lane() { int l = lane_id(); asm volatile("" : "+v"(l)); return l; }

struct Ctx {
    const float* in[31]; float* out; unsigned char* ws;
    int tid, lane, wave, gw, ngw, nblk, blk;
    unsigned char* lds;
};

struct WItem { const float* src; bf16_t* dst; int N; int sk; };
__device__ __forceinline__ WItem witem(const Ctx& C, int it) {
    constexpr int I_IN = (D / 64) * (INC / 64), I_HY = (HW / 64) * (D / 64), I_MIX = (D / 64) * (D / 64), I_GU1 = (D / 64) * (2 * D / 64), I_DN1 = (D / 64) * (D / 64);
    const float* W; int N, k0, n0, kd, nd, sk = -1; bf16_t* WT;
    int r = it;
    if (r < NE * I_GU1) { const int e = r / I_GU1, q = r % I_GU1; const int nb = 2 * D / 64; n0 = 64 * (q % nb); k0 = 64 * (q / nb);
        const int s = n0 / 1024, rem = n0 % 1024, j = rem / 128, i0 = rem % 128; nd = 256 * j + 128 * s + i0; kd = k0; N = 2 * D;
        W = C.in[26] + (size_t)e * D * 2 * D; WT = (bf16_t*)(C.ws + WS_WGU) + (size_t)e * 2 * D * D; }
    else if ((r -= NE * I_GU1) < NE * I_DN1) { const int e = r / I_DN1, q = r % I_DN1; const int nb = D / 64; n0 = 64 * (q % nb); k0 = 64 * (q / nb); nd = n0; kd = k0; N = D;
        W = C.in[28] + (size_t)e * D * D; WT = (bf16_t*)(C.ws + WS_WDN) + (size_t)e * D * D; }
    else if ((r -= NE * I_DN1) < I_IN) { const int nb = INC / 64; n0 = 64 * (r % nb); k0 = 64 * (r / nb); nd = n0; kd = k0; N = INC; W = C.in[5]; WT = (bf16_t*)(C.ws + WS_WIN);
        if (n0 >= GOFF) { const int rel = n0 - GOFF, sg_ = rel / 1024, rem = rel % 1024; nd = GOFF + 256 * (rem / 128) + 128 * sg_ + (rem % 128); } }
    else if ((r -= I_IN) < I_HY) { const int nb = D / 64; n0 = 64 * (r % nb); k0 = 64 * (r / nb); nd = n0; kd = k0; N = D; W = C.in[20]; WT = (bf16_t*)(C.ws + WS_WCAT); }
    else if ((r -= I_HY) < I_HY) { const int nb = D / 64; n0 = 64 * (r % nb); k0 = 64 * (r / nb); nd = n0; kd = 512 + k0; N = D; W = C.in[21]; WT = (bf16_t*)(C.ws + WS_WCAT); sk = k0; }
    else { r -= I_HY; const int nb = D / 64; n0 = 64 * (r % nb); k0 = 64 * (r / nb); nd = n0; kd = k0; N = D; W = C.in[22]; WT = (bf16_t*)(C.ws + WS_WMIX); }
    WItem w; w.N = N; w.sk = sk; w.src = W + (size_t)(k0 + (C.lane >> 4)) * N + n0 + 4 * (C.lane & 15); w.dst = WT + (size_t)(nd + (C.lane >> 3)) * D + kd + 8 * (C.lane & 7);
    return w;
}
__device__ __forceinline__ void phase_weights(Ctx& C) {
    float* scr = (float*)(C.lds + C.wave * 16640);
    constexpr int NITEMS = (D / 64) * (INC / 64) + 2 * (HW / 64) * (D / 64) + (D / 64) * (D / 64) + NE * (D / 64) * (2 * D / 64) + NE * (D / 64) * (D / 64);
    const int lane = C.lane;
    int it = C.gw;
    f32x4 v[16], vn[16];
    WItem cur;
    if (it < NITEMS) { cur = witem(C, it);
#pragma unroll
        for (int i = 0; i < 16; ++i) v[i] = __builtin_nontemporal_load((const f32x4*)(cur.src + (size_t)(4 * i) * cur.N)); }
    for (; it < NITEMS; it += C.ngw) {
        const bool more = it + C.ngw < NITEMS; WItem nx = cur;
        if (more) { nx = witem(C, it + C.ngw);
#pragma unroll
            for (int i = 0; i < 16; ++i) vn[i] = __builtin_nontemporal_load((const f32x4*)(nx.src + (size_t)(4 * i) * nx.N)); }
        if (cur.sk >= 0) {
#pragma unroll
            for (int i = 0; i < 16; ++i) v[i] = v[i] * (0.8f * C.in[19][(cur.sk + 4 * i + (lane >> 4)) & 127]); }
#pragma unroll
        for (int i = 0; i < 16; ++i) { float* d = scr + (4 * i + (lane >> 4)) * 65 + 4 * (lane & 15); d[0] = v[i].x; d[1] = v[i].y; d[2] = v[i].z; d[3] = v[i].w; }
        __builtin_amdgcn_s_waitcnt(0xc07f); asm volatile("" ::: "memory");
        const int c = lane & 7;
#pragma unroll
        for (int j = 0; j < 8; ++j) { const int n = (lane >> 3) + 8 * j; const float* s = scr + (8 * c) * 65 + n;
            u32x4 o; o.x = pk2(s[0 * 65], s[1 * 65]); o.y = pk2(s[2 * 65], s[3 * 65]); o.z = pk2(s[4 * 65], s[5 * 65]); o.w = pk2(s[6 * 65], s[7 * 65]);
            __builtin_nontemporal_store(o, (u32x4*)(cur.dst + (size_t)(8 * j) * D)); }
        __builtin_amdgcn_s_waitcnt(0xc07f); asm volatile("" ::: "memory");
        if (more) {
#pragma unroll
            for (int i = 0; i < 16; ++i) v[i] = vn[i]; }
        cur = nx;
    }
    bf16_t* wrt = (bf16_t*)(C.ws + WS_WRT);
    for (int i = C.blk * NTHREADS + C.tid; i < NE * D; i += C.nblk * NTHREADS) {
        const int e = i / D, k = i % D; const float w = C.in[24][(size_t)k * NE + e];
        const unsigned hi = f2bf(w); const float lo = w - bf2f(hi);
        wrt[(size_t)e * 2048 + k] = (bf16_t)hi; wrt[(size_t)e * 2048 + 1024 + k] = (bf16_t)f2bf(lo);
    }
}

__device__ __forceinline__ void phase_mod(Ctx& C) {
    float* sc = (float*)C.lds;
    float* part = sc + 16 * 1024;
    float* mod = (float*)(C.ws + WS_MOD);
    for (int vb = C.blk; vb < 256; vb += C.nblk) {
        const int j0 = vb * 24;
        __syncthreads();
        for (int i = C.tid; i < 16 * D; i += NTHREADS) { const float c = C.in[1][i]; sc[i] = c / (1.0f + expf(-c)); }
        __syncthreads();
        if (C.tid < 504) {
            const int jj = C.tid % 24, isub = C.tid / 24;
            float acc[16];
#pragma unroll
            for (int b = 0; b < 16; ++b) acc[b] = 0.f;
            const float* w = C.in[2] + j0 + jj;
#pragma unroll 7
            for (int i = isub; i < D; i += 21) { const float wv = w[(size_t)i * 6 * D];
#pragma unroll
                for (int b = 0; b < 16; ++b) acc[b] = fmaf(sc[b * D + i], wv, acc[b]); }
#pragma unroll
            for (int b = 0; b < 16; ++b) part[(isub * 16 + b) * 24 + jj] = acc[b];
        }
        __syncthreads();
        if (C.tid < 384) { const int b = C.tid / 24, jj = C.tid % 24; float a = C.in[3][j0 + jj];
            for (int q = 0; q < 21; ++q) a += part[(q * 16 + b) * 24 + jj];
            mod[b * 6 * D + j0 + jj] = a; }
    }
    __syncthreads();
}

__device__ __forceinline__ void phase_filters(Ctx& C) {
    float* sh = (float*)C.lds;
    float* h3t = sh + 8 * 160;
    float* kfc = (float*)(C.ws + WS_KFC);
    const float* w1 = C.in[9]; const float* b1 = C.in[10]; const float* w2 = C.in[11]; const float* b2 = C.in[12];
    const float* w3 = C.in[13]; const float* b3 = C.in[14]; const float* w4 = C.in[15]; const float* fq = C.in[16];
    const int pl = C.tid >> 6, j = C.tid & 63;
    float* z = sh + pl * 160; float* ha = z + 32; float* hb = ha + 64;
    for (int vb = C.blk; vb < SEQ / 8; vb += C.nblk) {
        const int pos = vb * 8 + pl;
        const float tt = (float)pos / (float)(SEQ - 1);
        const float w = 6.283185307179586f * (float)pos / (float)SEQ;
        __syncthreads();
        if (j < 17) {
            float v;
            if (j == 0) v = tt;
            else { const int i = (j - 1) & 7; const float fr = 1e-4f + (float)i * ((7.0f - 1e-4f) / 7.0f); v = (j <= 8) ? cosf(fr * w) : -sinf(fr * w); }
            z[j] = v;
        }
        __syncthreads();
        { float a = b1[j];
#pragma unroll
          for (int i = 0; i < 17; ++i) a = fmaf(z[i], w1[i * FHID + j], a); ha[j] = sinf(fq[j] * a); }
        __syncthreads();
        { float a = b2[j];
#pragma unroll 32
          for (int i = 0; i < FHID; ++i) a = fmaf(ha[i], w2[i * FHID + j], a); hb[j] = sinf(fq[j] * a); }
        __syncthreads();
        { float a = b3[j];
#pragma unroll 32
          for (int i = 0; i < FHID; ++i) a = fmaf(hb[i], w3[i * FHID + j], a); h3t[j * 8 + pl] = sinf(fq[j] * a); }
        __syncthreads();
        float af[8], ab[8];
#pragma unroll
        for (int p = 0; p < 8; ++p) { af[p] = 0.f; ab[p] = 0.f; }
#pragma unroll 16
        for (int i = 0; i < FHID; ++i) { const float wa = w4[i * 2 * HW + C.tid], wb = w4[i * 2 * HW + HW + C.tid];
            const f32x4 h0 = *(const f32x4*)(h3t + i * 8), h1 = *(const f32x4*)(h3t + i * 8 + 4);
#pragma unroll
            for (int p = 0; p < 4; ++p) { af[p] = fmaf(h0[p], wa, af[p]); af[4 + p] = fmaf(h1[p], wa, af[4 + p]); ab[p] = fmaf(h0[p], wb, ab[p]); ab[4 + p] = fmaf(h1[p], wb, ab[4 + p]); } }
        const float min_decay = logf(1e-2f) / 1.5f, max_decay = logf(1e-2f) / 0.3f;
        const int c = C.tid, pos0 = vb * 8;
        const float adelta = fabsf(min_decay + (float)c * ((max_decay - min_decay) / 511.0f));
#pragma unroll
        for (int p = 0; p < 8; ++p) { const float dec = expf(-((float)(pos0 + p) / (float)(SEQ - 1)) * adelta); af[p] *= dec; ab[p] *= dec; }
        float* dst = kfc + (size_t)c * 4096 + 2048 + pos0;
        *(f32x4*)dst = (f32x4){af[0], af[1], af[2], af[3]}; *(f32x4*)(dst + 4) = (f32x4){af[4], af[5], af[6], af[7]};
        float* dsb = kfc + (size_t)c * 4096 + 2048 - pos0;
#pragma unroll
        for (int p = 0; p < 8; ++p) if (pos0 + p >= 1) dsb[-p] = ab[p];
    }
    __syncthreads();
}

__device__ __forceinline__ void phase_norm1(Ctx& C) {
    const float* mod = (const float*)(C.ws + WS_MOD); bf16_t* h = (bf16_t*)(C.ws + WS_H);
    const float* g = C.in[4];
    for (int row = C.gw; row < T; row += C.ngw) {
        const int b = row / SEQ;
        const f32x4* xr = (const f32x4*)(C.in[0] + (size_t)row * D) + C.lane;
        f32x4 v[4]; float s = 0.f;
#pragma unroll
        for (int j = 0; j < 4; ++j) { v[j] = __builtin_nontemporal_load(xr + 64 * j); s += (v[j].x * v[j].x + v[j].y * v[j].y) + (v[j].z * v[j].z + v[j].w * v[j].w); }
        const float rstd = 1.0f / sqrtf(wave_sum(s) * (1.0f / D) + EPS);
        const float* sh = mod + (size_t)b * 6 * D; const float* sc = sh + D;
        u32x2* o = (u32x2*)(h + (size_t)row * D) + C.lane;
#pragma unroll
        for (int j = 0; j < 4; ++j) { const int i0 = 4 * C.lane + 256 * j;
            const f32x4 gg = *(const f32x4*)(g + i0), s1 = *(const f32x4*)(sc + i0), s0 = *(const f32x4*)(sh + i0);
            f32x4 r; r.x = v[j].x * rstd * gg.x * (1.f + s1.x) + s0.x; r.y = v[j].y * rstd * gg.y * (1.f + s1.y) + s0.y;
            r.z = v[j].z * rstd * gg.z * (1.f + s1.z) + s0.z; r.w = v[j].w * rstd * gg.w * (1.f + s1.w) + s0.w;
            u32x2 w; w.x = pk2(r.x, r.y); w.y = pk2(r.z, r.w); o[64 * j] = w; }
    }
}

__device__ __forceinline__ void phase_final(Ctx& C) {
    const float* mod = (const float*)(C.ws + WS_MOD); const bf16_t* slots = (const bf16_t*)(C.ws + WS_SLOTS); const int* rowinv = (const int*)(C.ws + WS_TOPE);
    const float* g = C.in[30];
    for (int row = C.gw; row < T; row += C.ngw) {
        const int b = row / SEQ;
        f32x4* xr = (f32x4*)(C.out + (size_t)row * D) + C.lane;
        const float* g2 = mod + (size_t)b * 6 * D + 5 * D;
        f32x4 v[4]; float s = 0.f; const int4 rr4 = *(const int4*)(rowinv + (size_t)row * 4); const int rk[4] = {rr4.x, rr4.y, rr4.z, rr4.w};
#pragma unroll
        for (int j = 0; j < 4; ++j) { const int i0 = 4 * C.lane + 256 * j;
            f32x4 m = {0.f, 0.f, 0.f, 0.f};
#pragma unroll
            for (int k = 0; k < 4; ++k) { const u32x2 w = __builtin_nontemporal_load((const u32x2*)(slots + (size_t)rk[k] * D + i0));
                m.x += bflo(w.x); m.y += bfhi(w.x); m.z += bflo(w.y); m.w += bfhi(w.y); }
            const f32x4 gg = *(const f32x4*)(g2 + i0);
            v[j] = __builtin_nontemporal_load(xr + 64 * j); v[j].x += gg.x * m.x; v[j].y += gg.y * m.y; v[j].z += gg.z * m.z; v[j].w += gg.w * m.w;
            s += (v[j].x * v[j].x + v[j].y * v[j].y) + (v[j].z * v[j].z + v[j].w * v[j].w); }
        const float rstd = 1.0f / sqrtf(wave_sum(s) * (1.0f / D) + EPS);
#pragma unroll
        for (int j = 0; j < 4; ++j) { const int i0 = 4 * C.lane + 256 * j; const f32x4 gg = *(const f32x4*)(g + i0);
            f32x4 r; r.x = v[j].x * rstd * gg.x; r.y = v[j].y * rstd * gg.y; r.z = v[j].z * rstd * gg.z; r.w = v[j].w * rstd * gg.w; __builtin_nontemporal_store(r, xr + 64 * j); }
    }
}

namespace pg8 {
#define PG8_LAS __attribute__((address_space(3)))
constexpr int BM = 256, BK = 64, HALF = 128, HTB = HALF * BK * 2, STAGE_BYTES = 8 * HTB, NXCD = 8, WGM = 8;
__device__ __forceinline__ int lds_byte(int r, int c) { const int st = (r >> 4) * 2 + (c >> 5), rr = r & 15, cc = c & 31, ob = rr * 64 + cc * 2; return st * 1024 + (ob ^ (((ob >> 9) & 1) << 5)); }
__device__ __forceinline__ void stage_rc(int b, int& R, int& C) { const int st = b / 1024, sb = b % 1024, swz = sb ^ (((sb >> 9) & 1) << 5); R = (st >> 1) * 16 + swz / 64; C = (st & 1) * 32 + (swz % 64) / 2; }
__device__ __forceinline__ int perm32(int rho) { const int n = rho >> 4, i = rho & 15; return 8 * (i >> 2) + 4 * n + (i & 3); }
struct Unit { int pm, pn; };
struct Gemm { const bf16_t* A; const bf16_t* Bt; int lda, ldb, K; const int* rowidx; };
struct StaticOrder {
    int nM, nN, nwg, G, c;
    __device__ void init(int nM_, int nN_, int G_, int c_) { nM = nM_; nN = nN_; nwg = nM * nN; G = G_; c = c_; }
    __device__ bool next(int i, Unit& u) const {
        const long L = (long)i * G + c; if (L >= nwg) return false;
        int wgid = (int)L; { const int q = nwg / NXCD, r = nwg % NXCD, xcd = wgid % NXCD, off = wgid / NXCD; wgid = (xcd < r ? xcd * (q + 1) : r * (q + 1) + (xcd - r) * q) + off; }
        const int nig = WGM * nN, gid = wgid / nig, fm = gid * WGM, gsz = (nM - fm) < WGM ? (nM - fm) : WGM;
        u.pm = fm + ((wgid % nig) % gsz); u.pn = (wgid % nig) / gsz; return true;
    }
};
struct MoeOrder {
    StaticOrder b; const int* tileexp; int nN;
    __device__ bool next(int i, Unit& u) const { if (!b.next(i, u)) return false; u.pn = tileexp[u.pm] * nN + u.pn; return true; }
};
__device__ __forceinline__ unsigned cvt_pk_bf16(float lo, float hi) { unsigned r; asm volatile("v_cvt_pk_bf16_f32 %0, %1, %2" : "=v"(r) : "v"(lo), "v"(hi)); return r; }

template <class Epi, class Sched, bool GATHER, bool MIDHOOK = false>
__device__ __forceinline__ void gemm_phase(PG8_LAS unsigned char* lds, const Gemm g, const Sched& S, const Epi& E, const int wid_) {
    const int wid = wid_, lane = fresh_lane(), tid = wid * 64 + lane, wr = wid >> 2, wc = wid & 3, fr = lane & 15, fq = lane >> 4;
    const int K = g.K, nt = K / BK;
    int RA[2]; unsigned cA2[2], voffB[2];
#pragma unroll
    for (int i = 0; i < 2; ++i) { int R, C; stage_rc(tid * 16 + i * 8192, R, C); const int Rb = Epi::PERM ? ((R & ~31) + perm32(R & 31)) : R;
        RA[i] = R; cA2[i] = (unsigned)C * 2u; voffB[i] = (unsigned)(Rb * g.ldb + C) * 2u; }
    const unsigned lda2 = (unsigned)g.lda * 2u;
    const size_t kstep = (size_t)(BK * 2);
    const size_t hstep = (size_t)HALF * g.ldb * 2;
    const size_t tstep = 2 * hstep;
    const unsigned ldsw = (unsigned)wid * 1024u;
    const int aoff = lds_byte(wr * 64 + fr, fq * 8), boff = lds_byte(wc * 32 + fr, fq * 8);
#define PG8_SA(b, h) (((b) * 2 + (h)) * HTB)
#define PG8_SB(b, h) ((4 + (b) * 2 + (h)) * HTB)
#define PG8_STAGE(bufoff, gbase, voff) do { _Pragma("unroll") for (int _i = 0; _i < 2; ++_i) \
        __builtin_amdgcn_global_load_lds((const unsigned*)((const char*)(gbase) + (voff)[_i]), (PG8_LAS unsigned*)(lds + (bufoff) + ldsw + _i * 8192), 16, 0, 0); } while (0)
#define PG8_AOFFS(dst, u_) do { _Pragma("unroll") for (int _h = 0; _h < 2; ++_h) _Pragma("unroll") for (int _i = 0; _i < 2; ++_i) { \
        int _row = (u_).pm * BM + _h * HALF + RA[_i]; if (GATHER) { const int _p = g.rowidx[_row]; _row = _p >= 0 ? (_p >> 2) : 0; } \
        dst[_h][_i] = (unsigned)_row * lda2 + cA2[_i]; } } while (0)
#define PG8_LDA(dst, b, h) do { _Pragma("unroll") for (int m = 0; m < 4; ++m) _Pragma("unroll") for (int k = 0; k < 2; ++k) dst[m][k] = *(const PG8_LAS bf16x8*)(lds + PG8_SA(b, h) + aoff + m * 2048 + k * 1024); } while (0)
#define PG8_LDB(dst, b, h) do { _Pragma("unroll") for (int n = 0; n < 2; ++n) _Pragma("unroll") for (int k = 0; k < 2; ++k) dst[n][k] = *(const PG8_LAS bf16x8*)(lds + PG8_SB(b, h) + boff + n * 2048 + k * 1024); } while (0)
#define PG8_MMA(ai, bj, At, Bt) do { __builtin_amdgcn_s_setprio(1); _Pragma("unroll") for (int m = 0; m < 4; ++m) _Pragma("unroll") for (int n = 0; n < 2; ++n) _Pragma("unroll") for (int k = 0; k < 2; ++k) \
        acc[ai][bj][m][n] = __builtin_amdgcn_mfma_f32_16x16x32_bf16(Bt[n][k], At[m][k], acc[ai][bj][m][n], 0, 0, 0); __builtin_amdgcn_s_setprio(0); } while (0)
#define PG8_WAIT_V(n) asm volatile("s_waitcnt vmcnt(" #n ")" ::: "memory")
#define PG8_WAIT_L(n) asm volatile("s_waitcnt lgkmcnt(" #n ")" ::: "memory")
#define PG8_BAR __builtin_amdgcn_s_barrier()
#define PG8_SCHED __builtin_amdgcn_sched_barrier(0)
    Unit cur, nxt; int ui = 0;
    if (!S.next(0, cur)) return;
    f32x4 acc[2][2][4][2];
#pragma unroll
    for (int a = 0; a < 2; ++a)
#pragma unroll
        for (int b = 0; b < 2; ++b)
#pragma unroll
            for (int m = 0; m < 4; ++m)
#pragma unroll
                for (int n = 0; n < 2; ++n) acc[a][b][m][n] = (f32x4){0.f, 0.f, 0.f, 0.f};
    bf16x8 At[4][2], B0[2][2], B1[2][2];
    unsigned cv[2][2], nv[2][2];
    PG8_AOFFS(cv, cur);
    const char* const Ab = (const char*)g.A;
    const char* cB = (const char*)g.Bt + (size_t)cur.pn * tstep;
    PG8_STAGE(PG8_SB(0, 0), cB, voffB); PG8_STAGE(PG8_SB(0, 1), cB + hstep, voffB); PG8_STAGE(PG8_SA(0, 0), Ab, cv[0]); PG8_STAGE(PG8_SA(0, 1), Ab, cv[1]);
    if (wr == 1) PG8_BAR;
    PG8_WAIT_V(2); PG8_BAR;
    PG8_STAGE(PG8_SB(1, 0), cB + kstep, voffB); PG8_STAGE(PG8_SA(1, 0), Ab + kstep, cv[0]); PG8_STAGE(PG8_SB(1, 1), cB + hstep + kstep, voffB);
    PG8_WAIT_V(6); PG8_BAR;
    for (;;) {
        const bool has_next = S.next(ui + 1, nxt);
        if (has_next) { PG8_AOFFS(nv, nxt); } else {
#pragma unroll
            for (int h = 0; h < 2; ++h)
#pragma unroll
                for (int i = 0; i < 2; ++i) nv[h][i] = cv[h][i]; }
        const char* nB = has_next ? (const char*)g.Bt + (size_t)nxt.pn * tstep : cB;
#define PG8_KSTEP(t) do { \
            const bool last = (t == nt - 2); \
            const char* a1 = Ab + (size_t)(t + 1) * kstep; \
            const char* a2 = last ? Ab : Ab + (size_t)(t + 2) * kstep; const char* b2 = last ? nB : cB + (size_t)(t + 2) * kstep; \
            const char* a3 = a2 + kstep; const char* b3 = b2 + kstep; \
            unsigned sv[2][2]; \
            _Pragma("unroll") for (int h = 0; h < 2; ++h) _Pragma("unroll") for (int i = 0; i < 2; ++i) sv[h][i] = last ? nv[h][i] : cv[h][i]; \
            PG8_LDB(B0, 0, 0); PG8_LDB(B1, 0, 1); PG8_SCHED; PG8_LDA(At, 0, 0); PG8_STAGE(PG8_SA(1, 1), a1, cv[1]); \
            PG8_WAIT_V(8); PG8_WAIT_L(0); PG8_BAR; PG8_MMA(0, 0, At, B0); PG8_MMA(0, 1, At, B1); PG8_BAR; PG8_SCHED; \
            PG8_LDA(At, 0, 1); PG8_STAGE(PG8_SB(0, 0), b2, voffB); PG8_STAGE(PG8_SB(0, 1), b2 + hstep, voffB); PG8_STAGE(PG8_SA(0, 0), a2, sv[0]); \
            PG8_WAIT_V(8); PG8_WAIT_L(0); PG8_BAR; PG8_MMA(1, 0, At, B0); PG8_MMA(1, 1, At, B1); PG8_BAR; PG8_SCHED; \
            PG8_LDB(B0, 1, 0); PG8_LDB(B1, 1, 1); PG8_SCHED; PG8_LDA(At, 1, 0); PG8_STAGE(PG8_SA(0, 1), a2, sv[1]); \
            PG8_WAIT_V(8); PG8_WAIT_L(0); PG8_BAR; PG8_MMA(0, 0, At, B0); PG8_MMA(0, 1, At, B1); PG8_BAR; PG8_SCHED; \
            PG8_LDA(At, 1, 1); PG8_STAGE(PG8_SB(1, 0), b3, voffB); PG8_STAGE(PG8_SB(1, 1), b3 + hstep, voffB); PG8_STAGE(PG8_SA(1, 0), a3, sv[0]); \
            PG8_WAIT_V(8); PG8_WAIT_L(0); PG8_BAR; PG8_MMA(1, 0, At, B0); PG8_MMA(1, 1, At, B1); PG8_BAR; PG8_SCHED; \
        } while (0)
        if constexpr (MIDHOOK) {
            for (int t = 0; t < nt / 2; t += 2) PG8_KSTEP(t);
            E.mid(acc, cur, wr, wc, fr, fq);
            for (int t = nt / 2; t < nt; t += 2) PG8_KSTEP(t);
        } else {
            for (int t = 0; t < nt; t += 2) PG8_KSTEP(t);
        }
#undef PG8_KSTEP
        if (wr == 0) PG8_BAR;
        E(acc, cur, wr, wc, fr, fq);
        if (!has_next) break;
#pragma unroll
        for (int a = 0; a < 2; ++a)
#pragma unroll
            for (int b = 0; b < 2; ++b)
#pragma unroll
                for (int m = 0; m < 4; ++m)
#pragma unroll
                    for (int n = 0; n < 2; ++n) acc[a][b][m][n] = (f32x4){0.f, 0.f, 0.f, 0.f};
        cur = nxt; cB = nB; ++ui;
#pragma unroll
        for (int h = 0; h < 2; ++h)
#pragma unroll
            for (int i = 0; i < 2; ++i) cv[h][i] = nv[h][i];
        if (wr == 1) PG8_BAR;
    }
    PG8_WAIT_V(0);
    PG8_BAR;
#undef PG8_SA
#undef PG8_SB
#undef PG8_STAGE
#undef PG8_AOFFS
#undef PG8_LDA
#undef PG8_LDB
#undef PG8_MMA
#undef PG8_WAIT_V
#undef PG8_WAIT_L
#undef PG8_BAR
#undef PG8_SCHED
}

__device__ __forceinline__ u32x4 pack8(const f32x4& v0, const f32x4& v1) { u32x4 w; w.x = cvt_pk_bf16(v0[0], v0[1]); w.y = cvt_pk_bf16(v0[2], v0[3]); w.z = cvt_pk_bf16(v1[0], v1[1]); w.w = cvt_pk_bf16(v1[2], v1[3]); return w; }
__device__ __forceinline__ void unpack8(const u32x4& w, f32x4& v0, f32x4& v1) { v0 = (f32x4){bflo(w.x), bfhi(w.x), bflo(w.y), bfhi(w.y)}; v1 = (f32x4){bflo(w.z), bfhi(w.z), bflo(w.w), bfhi(w.w)}; }
__device__ __forceinline__ float fsig(float x) { return __builtin_amdgcn_rcpf(1.0f + __builtin_amdgcn_exp2f(-LOG2E * x)); }

template <int MODE = 0> struct EpiInprojT {
    static constexpr bool PERM = true;
    bf16_t* U; const float* bias;
    __device__ __forceinline__ void operator()(const f32x4 (&acc)[2][2][4][2], const Unit& u, int wr, int wc, int fr, int fq) const {
        const int row0 = u.pm * BM + wr * 64 + fr, col0 = u.pn * BM + wc * 32 + 8 * fq; const float qs = (u.pn == 6 || u.pn == 7) ? QSCALE : 1.0f;
        if (u.pn >= 12) {
            const int c0 = 128 * (u.pn - 12) + wc * 32 + 8 * fq;
            f32x4 ba[2], bb[2];
#pragma unroll
            for (int n = 0; n < 2; ++n) { ba[n] = *(const f32x4*)(bias + GOFF + c0 + 4 * n); bb[n] = *(const f32x4*)(bias + GOFF + D + c0 + 4 * n); }
#pragma unroll
            for (int ai = 0; ai < 2; ++ai)
#pragma unroll
                for (int m = 0; m < 4; ++m) { bf16_t* rowp = U + (size_t)(row0 + ai * HALF + m * 16) * INC + GOFF + c0; f32x4 rr[2], sb[2];
#pragma unroll
                    for (int n = 0; n < 2; ++n) { const f32x4 a = acc[ai][0][m][n] + ba[n], b = acc[ai][1][m][n] + bb[n];
#pragma unroll
                        for (int i = 0; i < 4; ++i) { const float ea = __builtin_amdgcn_exp2f(-LOG2E * a[i]), eb = __builtin_amdgcn_exp2f(-LOG2E * b[i]); const float s2 = __builtin_amdgcn_rcpf(1.0f + eb);
                            sb[n][i] = s2; rr[n][i] = (1.0f + eb) * __builtin_amdgcn_rcpf(1.0f + ea); } }
                    const u32x4 wr_ = pack8(rr[0], rr[1]), ws_ = pack8(sb[0], sb[1]);
                    if (MODE == 0) { *(u32x4*)rowp = wr_; *(u32x4*)(rowp + D) = ws_; } else asm volatile("" :: "v"(wr_), "v"(ws_)); }
            return;
        }
        const bool sig = false;
        f32x4 bv[2][2];
#pragma unroll
        for (int bj = 0; bj < 2; ++bj)
#pragma unroll
            for (int n = 0; n < 2; ++n) bv[bj][n] = *(const f32x4*)(bias + col0 + bj * HALF + 4 * n);
#pragma unroll
        for (int ai = 0; ai < 2; ++ai)
#pragma unroll
            for (int m = 0; m < 4; ++m) { bf16_t* rowp = U + (size_t)(row0 + ai * HALF + m * 16) * INC + col0;
#pragma unroll
                for (int bj = 0; bj < 2; ++bj) { f32x4 v0 = (acc[ai][bj][m][0] + bv[bj][0]) * qs, v1 = (acc[ai][bj][m][1] + bv[bj][1]) * qs;
                    if (sig) {
#pragma unroll
                        for (int i = 0; i < 4; ++i) { v0[i] = fsig(v0[i]); v1[i] = fsig(v1[i]); } }
                    const u32x4 w_ = pack8(v0, v1);
                    if (MODE == 0) *(u32x4*)(rowp + bj * HALF) = w_; else asm volatile("" :: "v"(w_)); } }
    }
};
typedef EpiInprojT<0> EpiInproj;
template <int P> struct EpiCat {
    static constexpr bool PERM = true;
    bf16_t* Mg; const bf16_t* U;
    __device__ __forceinline__ void operator()(const f32x4 (&acc)[2][2][4][2], const Unit& u, int wr, int wc, int fr, int fq) const {
        const int row0 = u.pm * BM + wr * 64 + fr, col0 = u.pn * BM + wc * 32 + 8 * fq;
#pragma unroll
        for (int ai = 0; ai < 2; ++ai)
#pragma unroll
            for (int m = 0; m < 4; ++m) { const size_t row = (size_t)(row0 + ai * HALF + m * 16);
#pragma unroll
                for (int bj = 0; bj < 2; ++bj) { const u32x4 gw = *(const u32x4*)(U + row * INC + GOFF + P * D + col0 + bj * HALF);
                    f32x4 g0, g1; unpack8(gw, g0, g1); f32x4 v0 = acc[ai][bj][m][0] * g0, v1 = acc[ai][bj][m][1] * g1;
                    bf16_t* mp = Mg + row * D + col0 + bj * HALF;
                    if (P == 1) { const u32x4 tw = *(const u32x4*)mp; f32x4 t0, t1; unpack8(tw, t0, t1); v0 += t0; v1 += t1; }
                    *(u32x4*)mp = pack8(v0, v1); } }
    }
};
struct EpiCatR {
    static constexpr bool PERM = true;
    bf16_t* Mg; const bf16_t* U;
    __device__ __forceinline__ void mid(f32x4 (&acc)[2][2][4][2], const Unit& u, int wr, int wc, int fr, int fq) const {
        int row0 = u.pm * BM + wr * 64 + fr; asm volatile("" : "+v"(row0));
        const int col0 = u.pn * BM + wc * 32 + 8 * fq;
#pragma unroll
        for (int ai = 0; ai < 2; ++ai) { asm volatile("" ::: "memory");
#pragma unroll
            for (int m = 0; m < 4; ++m) { const size_t row = (size_t)(row0 + ai * HALF + m * 16);
#pragma unroll
                for (int bj = 0; bj < 2; ++bj) { const u32x4 gw1 = *(const u32x4*)(U + row * INC + GOFF + col0 + bj * HALF);
                    f32x4 a0, a1; unpack8(gw1, a0, a1); acc[ai][bj][m][0] *= a0; acc[ai][bj][m][1] *= a1; } } }
        asm volatile("" ::: "memory");
    }
    __device__ __forceinline__ void operator()(const f32x4 (&acc)[2][2][4][2], const Unit& u, int wr, int wc, int fr, int fq) const {
        const int row0 = u.pm * BM + wr * 64 + fr, col0 = u.pn * BM + wc * 32 + 8 * fq;
#pragma unroll
        for (int ai = 0; ai < 2; ++ai)
#pragma unroll
            for (int m = 0; m < 4; ++m) { const size_t row = (size_t)(row0 + ai * HALF + m * 16);
#pragma unroll
                for (int bj = 0; bj < 2; ++bj) { const u32x4 gw = *(const u32x4*)(U + row * INC + GOFF + D + col0 + bj * HALF);
                    f32x4 g0, g1; unpack8(gw, g0, g1);
                    *(u32x4*)(Mg + row * D + col0 + bj * HALF) = pack8(acc[ai][bj][m][0] * g0, acc[ai][bj][m][1] * g1); } }
    }
};
struct EpiMix {
    static constexpr bool PERM = false;
    const float* X; float* O; const float* mod; float* ssq;
    __device__ __forceinline__ void operator()(const f32x4 (&acc)[2][2][4][2], const Unit& u, int wr, int wc, int fr, int fq) const {
        const int row0 = u.pm * BM + wr * 64 + fr, col0 = u.pn * BM + wc * 32 + 4 * fq; const int b = (u.pm * BM) / SEQ;
        f32x4 gv[2][2];
#pragma unroll
        for (int bj = 0; bj < 2; ++bj)
#pragma unroll
            for (int n = 0; n < 2; ++n) gv[bj][n] = *(const f32x4*)(mod + (size_t)b * 6 * D + 2 * D + col0 + bj * HALF + n * 16);
#pragma unroll
        for (int ai = 0; ai < 2; ++ai)
#pragma unroll
            for (int m = 0; m < 4; ++m) { const size_t off = (size_t)(row0 + ai * HALF + m * 16) * D + col0; float sq = 0.f;
#pragma unroll
                for (int bj = 0; bj < 2; ++bj)
#pragma unroll
                    for (int n = 0; n < 2; ++n) { const f32x4 v = *(const f32x4*)(X + off + bj * HALF + n * 16) + gv[bj][n] * acc[ai][bj][m][n]; *(f32x4*)(O + off + bj * HALF + n * 16) = v;
                        sq += (v.x * v.x + v.y * v.y) + (v.z * v.z + v.w * v.w); }
                sq += __shfl_xor(sq, 16); sq += __shfl_xor(sq, 32);
                if (fq == 0) ssq[(size_t)(row0 + ai * HALF + m * 16) * 16 + u.pn * 4 + wc] = sq; }
    }
};
struct EpiGateUp {
    static constexpr bool PERM = true;
    bf16_t* Act; const float* bgu;
    __device__ __forceinline__ void operator()(const f32x4 (&acc)[2][2][4][2], const Unit& u, int wr, int wc, int fr, int fq) const {
        const int e = u.pn >> 3, j = u.pn & 7; const int row0 = u.pm * BM + wr * 64 + fr, col0 = 128 * j + wc * 32 + 8 * fq;
        f32x4 bg[2], bu[2];
#pragma unroll
        for (int n = 0; n < 2; ++n) { bg[n] = *(const f32x4*)(bgu + (size_t)e * 2 * D + col0 + 4 * n); bu[n] = *(const f32x4*)(bgu + (size_t)e * 2 * D + D + col0 + 4 * n); }
#pragma unroll
        for (int ai = 0; ai < 2; ++ai)
#pragma unroll
            for (int m = 0; m < 4; ++m) { f32x4 r[2];
#pragma unroll
                for (int n = 0; n < 2; ++n) { const f32x4 gt = acc[ai][0][m][n] + bg[n], up = acc[ai][1][m][n] + bu[n];
#pragma unroll
                    for (int i = 0; i < 4; ++i) { const float gg = fminf(gt[i], 7.0f), uu = fminf(fmaxf(up[i], -7.0f), 7.0f); r[n][i] = (uu + 1.0f) * (gg * fsig(1.702f * gg)); } }
                *(u32x4*)(Act + (size_t)(row0 + ai * HALF + m * 16) * D + col0) = pack8(r[0], r[1]); }
    }
};
struct EpiDown {
    static constexpr bool PERM = true;
    bf16_t* Slots; const float* bd; const float* roww;
    __device__ __forceinline__ void operator()(const f32x4 (&acc)[2][2][4][2], const Unit& u, int wr, int wc, int fr, int fq) const {
        const int e = u.pn >> 2, j = u.pn & 3; const int row0 = u.pm * BM + wr * 64 + fr, col0 = 256 * j + wc * 32 + 8 * fq;
        f32x4 bv[2][2];
#pragma unroll
        for (int bj = 0; bj < 2; ++bj)
#pragma unroll
            for (int n = 0; n < 2; ++n) bv[bj][n] = *(const f32x4*)(bd + (size_t)e * D + col0 + bj * HALF + 4 * n);
#pragma unroll
        for (int ai = 0; ai < 2; ++ai)
#pragma unroll
            for (int m = 0; m < 4; ++m) { const int row = row0 + ai * HALF + m * 16; const float w = roww[row];
#pragma unroll
                for (int bj = 0; bj < 2; ++bj) { const f32x4 v0 = (acc[ai][bj][m][0] + bv[bj][0]) * w, v1 = (acc[ai][bj][m][1] + bv[bj][1]) * w;
                    *(u32x4*)(Slots + (size_t)row * D + col0 + bj * HALF) = pack8(v0, v1); } }
    }
};
}

#define LASP __attribute__((address_space(3)))
__device__ __forceinline__ void glds16(const void* gsrc, unsigned lds_dst) { unsigned keep;
    asm volatile("s_mov_b32 %0, m0\n\ts_mov_b32 m0, %2\n\ts_nop 0\n\tglobal_load_lds_dwordx4 %1, off\n\ts_mov_b32 m0, %0" : "=&s"(keep) : "v"(gsrc), "s"(lds_dst) : "memory"); }
__device__ __forceinline__ void glds16s(const void* sbase, unsigned voff, unsigned lds_dst) { unsigned keep;
    asm volatile("s_nop 4\n\ts_mov_b32 %0, m0\n\ts_mov_b32 m0, %3\n\ts_nop 0\n\tglobal_load_lds_dwordx4 %1, %2\n\ts_mov_b32 m0, %0" : "=&s"(keep) : "v"(voff), "s"(sbase), "s"(lds_dst) : "memory"); }
typedef short v4i16_t __attribute__((ext_vector_type(4)));
__device__ __forceinline__ s16x4 vtr(const LASP char* p) { return __builtin_bit_cast(s16x4, __builtin_amdgcn_ds_read_tr16_b64_v4i16((LASP v4i16_t*)p)); }
typedef float f32x2_t __attribute__((ext_vector_type(2))); typedef __bf16 bf16x2_t __attribute__((ext_vector_type(2)));
__device__ __forceinline__ unsigned cvtpk(float lo, float hi) { f32x2_t v = {lo, hi}; bf16x2_t b = __builtin_convertvector(v, bf16x2_t); return __builtin_bit_cast(unsigned, b); }

__device__ __forceinline__ float max3f(float a, float b, float c) { float r; asm("v_max3_f32 %0, %1, %2, %3" : "=v"(r) : "v"(a), "v"(b), "v"(c)); return r; }
__device__ __forceinline__ float fadd_s(float a, float b) { float r; asm("v_add_f32_e32 %0, %1, %2" : "=v"(r) : "v"(a), "v"(b)); return r; }
__device__ __forceinline__ unsigned bfbits(float f) { return f2bf(f); }
__device__ __forceinline__ void phase_attn_fast(Ctx& C) {
    const bf16_t* u = (const bf16_t*)(C.ws + WS_U); bf16_t* ycat = (bf16_t*)(C.ws + WS_YCAT);
    const int wave = C.wave;
    const float* lq = C.in[18];
    float lam;
    { const int l_ = lane_id(); const float d1 = wave_sum(lq[l_] * lq[64 + l_]), d2 = wave_sum(lq[128 + l_] * lq[192 + l_]); lam = __builtin_bit_cast(float, __builtin_amdgcn_readfirstlane(__builtin_bit_cast(int, expf(d1) - expf(d2) + 0.2f))); }
    const unsigned lds0 = (unsigned)(uintptr_t)C.lds;
    const LASP char* ldsp = (const LASP char*)C.lds;
    constexpr int SLOT = 24576;
    const int vcu = (C.nblk % 8 == 0) ? (C.blk % 8) * (C.nblk / 8) + C.blk / 8 : C.blk;
    for (int idx = vcu; idx < 256; idx += C.nblk)
#pragma unroll 1
    for (int sub = 0; sub < 2; ++sub) {
        const int b = idx >> 4, hA = (idx >> 3) & 1, qb = idx & 7; const int hh = sub ? 3 - hA : hA;
        const int lane = fresh_lane();
        const int l31 = lane & 31, hi = lane >> 5;
        const int krow = 8 * wave + (lane >> 3), kchunk = (lane & 7) ^ (lane >> 3);
        const int st0 = 4 * wave + (lane >> 5), st1 = st0 + 2;
        const int vrow = (lane & 31) >> 2, vch = lane & 3;
        const unsigned koffb = (unsigned)((krow * INC + kchunk * 8) * 2);
        const unsigned voffb0 = (unsigned)(((8 * (st0 >> 2) + vrow) * INC + 32 * (st0 & 3) + 8 * vch) * 2);
        const unsigned voffb1 = (unsigned)(((8 * (st1 >> 2) + vrow) * INC + 32 * (st1 & 3) + 8 * vch) * 2);
        const int koff0 = l31 * 128, kx = l31 & 7;
        const int vboff = 8192 + (4 * hi + ((lane & 15) >> 2)) * 64 + ((lane >> 4) & 1) * 32 + (lane & 3) * 8;
        const unsigned hm0 = hi ? 0u : 0xffffffffu;
        const unsigned dkdk = hi ? 0u : bfbits((float)l31) * 0x10001u;
        const int q0 = qb * 256 + wave * 32;
        const float slope2 = exp2f(-2.0f * (float)(hh + 1)) * LOG2E;
        const unsigned SH = bfbits(slope2); const unsigned SL = bfbits(slope2 - bf2f(SH)); const unsigned SHSL = SH | (SL << 16);
        const float slope2q = bf2f(SH) + bf2f(SL);
        const unsigned kw0b = hi ? 0x3f803f80u : SHSL, kw1b = hi ? 0x00003f80u : SHSL, ksm = hi ? 0u : 0x80008000u;
        const unsigned qa0 = bfbits((float)q0) * 0x10001u, qa1 = bfbits((float)l31) * 0x10001u;
        const float qpos = (float)(q0 + l31 - 4 * hi);
        const bf16_t* qrow = u + (size_t)(b * SEQ + q0 + l31) * INC + QOFF + hh * 128;
        const bf16_t* kgb = u + (size_t)(b * SEQ) * INC + KOFF + hh * 128;
        const bf16_t* vgb = u + (size_t)(b * SEQ) * INC + VOFF + hh * 128;
        const int t0 = qb * 4, tdiag = q0 >> 6;
#pragma unroll 1
        for (int c = 0; c < 2; ++c) {
            const bf16_t* kgc = kgb + c * 64;
#define ATT_DMA(t, sl) do { const size_t _o = (size_t)(t) * 64 * INC; const unsigned _b = lds0 + (unsigned)(sl) * SLOT; \
        glds16s(kgc + _o, koffb, (unsigned)__builtin_amdgcn_readfirstlane(_b + wave * 1024)); \
        glds16s(vgb + _o, voffb0, (unsigned)__builtin_amdgcn_readfirstlane(_b + 8192 + (2 * wave) * 1024)); \
        glds16s(vgb + _o, voffb1, (unsigned)__builtin_amdgcn_readfirstlane(_b + 8192 + (2 * wave + 1) * 1024)); } while (0)
#define ATT_WAITBAR() asm volatile("s_waitcnt vmcnt(0) lgkmcnt(0)\n\ts_barrier" ::: "memory")
#define ATT_WAITBAR3() asm volatile("s_waitcnt vmcnt(3) lgkmcnt(0)\n\ts_barrier" ::: "memory")
#define ATT_SB() __builtin_amdgcn_sched_barrier(0)
#define ATT_QK(sl, tt) do { const LASP char* Kb_ = ldsp + (sl) * SLOT + koff0; \
        const int kvb_ = (tt) * 64; const bool diag_ = (tt) == tdiag; const bool before_ = kvb_ < q0; \
        const unsigned spos_ = before_ ? 0x80008000u : 0u, sneg_ = before_ ? 0u : 0x80008000u; \
        const unsigned dm_ = diag_ ? ~hm0 : 0xffffffffu; \
        const unsigned w0_ = (kw0b ^ (spos_ & ksm)) & dm_, w1_ = (kw1b ^ (spos_ & ksm)) & dm_, w3_ = (dkdk ^ (sneg_ & ksm)) & dm_; \
        const unsigned k0_ = ((bfbits((float)kvb_) * 0x10001u) ^ sneg_) & hm0 & dm_, k1_ = ((bfbits((float)(kvb_ + 32)) * 0x10001u) ^ sneg_) & hm0 & dm_; \
        const bf16x8 ka0_ = __builtin_bit_cast(bf16x8, (u32x4){w0_, w1_, k0_, w3_}), ka1_ = __builtin_bit_cast(bf16x8, (u32x4){w0_, w1_, k1_, w3_}); \
        P0 = __builtin_amdgcn_mfma_f32_32x32x16_bf16(ka0_, qaug, zero16, 0, 0, 0); P1 = __builtin_amdgcn_mfma_f32_32x32x16_bf16(ka1_, qaug, zero16, 0, 0, 0); \
        _Pragma("unroll") for (int ks = 0; ks < 4; ++ks) { \
            const bf16x8 kf0_ = *(const LASP bf16x8*)(Kb_ + (((2 * ks + hi) ^ kx) * 16)); \
            const bf16x8 kf1_ = *(const LASP bf16x8*)(Kb_ + 4096 + (((2 * ks + hi) ^ kx) * 16)); \
            const bf16x8 qf_ = *(const LASP bf16x8*)(qlds + ks * 1024); \
            P0 = __builtin_amdgcn_mfma_f32_32x32x16_bf16(kf0_, qf_, P0, 0, 0, 0); P1 = __builtin_amdgcn_mfma_f32_32x32x16_bf16(kf1_, qf_, P1, 0, 0, 0); } \
        asm volatile("s_nop 15\n\ts_nop 7" : "+v"(P0), "+v"(P1));     \
        ATT_SB(); } while (0)
#define ATT_SM(tt) do { \
        if ((tt) == tdiag) { const float a_ = qpos - (float)((tt) * 64); \
            _Pragma("unroll") for (int r = 0; r < 16; ++r) { const float x0 = a_ - (float)crow(r, 0); P0[r] = fmaf(fabsf(x0), -slope2q, P0[r]); P1[r] = fmaf(fabsf(x0 - 32.0f), -slope2q, P1[r]); } } \
        float rm_ = max3f(P0[0], P0[1], P1[0]); rm_ = max3f(rm_, P1[1], P0[2]); float rn_ = max3f(P0[3], P1[2], P1[3]); \
        _Pragma("unroll") for (int r = 4; r < 16; r += 2) { rm_ = max3f(rm_, P0[r], P0[r + 1]); rn_ = max3f(rn_, P1[r], P1[r + 1]); } \
        float rm; { const float rq_ = fmaxf(rm_, rn_); auto rr = __builtin_amdgcn_permlane32_swap(__float_as_uint(rq_), __float_as_uint(rq_), false, false); rm = max3f(__uint_as_float(rr[0]), __uint_as_float(rr[1]), -1e30f); } \
        live = !__all(rm < mrel - 40.0f);       \
        if (live) { \
            mrel = fmaxf(mrel, rm); \
            if (__any(rm > 8.0f)) { const float dl = fmaxf(rm, 0.f); mhat += dl; mrel -= dl; \
                _Pragma("unroll") for (int r = 0; r < 16; ++r) { P0[r] -= dl; P1[r] -= dl; } \
                { const unsigned mh_ = bfbits(mhat); const float r1_ = mhat - bf2f(mh_); const unsigned mm_ = bfbits(r1_); const unsigned ml_ = bfbits(r1_ - bf2f(mm_)); \
                  const unsigned a0_ = hi ? ((mh_ | (mm_ << 16)) ^ 0x80008000u) : qa0, a1_ = hi ? (ml_ ^ 0x8000u) : qa1; \
                  qaug = __builtin_bit_cast(bf16x8, (u32x4){a0_, a1_, hi ? 0u : SHSL, hi ? 0u : SHSL}); } \
                const float f = exp2f(-dl); lsum *= f; \
                _Pragma("unroll") for (int eb = 0; eb < 4; ++eb) _Pragma("unroll") for (int r = 0; r < 16; ++r) o[eb][r] *= f; } \
            _Pragma("unroll") for (int r = 0; r < 16; ++r) { P0[r] = __builtin_amdgcn_exp2f(P0[r]); P1[r] = __builtin_amdgcn_exp2f(P1[r]); } \
            asm volatile("s_nop 1" : "+v"(P0), "+v"(P1));     \
            float ps0 = fadd_s(P0[0], P1[0]), ps1 = fadd_s(P0[1], P1[1]); \
            _Pragma("unroll") for (int r = 2; r < 16; r += 2) { ps0 = fadd_s(ps0, P0[r]); ps1 = fadd_s(ps1, P0[r + 1]); ps0 = fadd_s(ps0, P1[r]); ps1 = fadd_s(ps1, P1[r + 1]); } \
            lsum += fadd_s(ps0, ps1); \
            _Pragma("unroll") for (int s2 = 0; s2 < 2; ++s2) { \
                u32x4 w_; w_.x = cvtpk(P0[8 * s2 + 0], P0[8 * s2 + 1]); w_.y = cvtpk(P0[8 * s2 + 2], P0[8 * s2 + 3]); w_.z = cvtpk(P0[8 * s2 + 4], P0[8 * s2 + 5]); w_.w = cvtpk(P0[8 * s2 + 6], P0[8 * s2 + 7]); pf[s2] = __builtin_bit_cast(bf16x8, w_); \
                u32x4 v_; v_.x = cvtpk(P1[8 * s2 + 0], P1[8 * s2 + 1]); v_.y = cvtpk(P1[8 * s2 + 2], P1[8 * s2 + 3]); v_.z = cvtpk(P1[8 * s2 + 4], P1[8 * s2 + 5]); v_.w = cvtpk(P1[8 * s2 + 6], P1[8 * s2 + 7]); pf[2 + s2] = __builtin_bit_cast(bf16x8, v_); } \
        } ATT_SB(); } while (0)
#define ATT_PV(sl) do { if (live) { const LASP char* Vb_ = ldsp + (sl) * SLOT + vboff; \
            _Pragma("unroll") for (int eb = 0; eb < 4; ++eb) _Pragma("unroll") for (int s = 0; s < 4; ++s) { \
                const s16x4 lo_ = vtr(Vb_ + s * 4096 + eb * 512), h4_ = vtr(Vb_ + s * 4096 + 2048 + eb * 512); \
                const bf16x8 vf_ = (bf16x8){lo_[0], lo_[1], lo_[2], lo_[3], h4_[0], h4_[1], h4_[2], h4_[3]}; \
                o[eb] = __builtin_amdgcn_mfma_f32_32x32x16_bf16(vf_, pf[s], o[eb], 0, 0, 0); } } ATT_SB(); } while (0)
            { bf16x8 qf_[4];
#pragma unroll
              for (int ks = 0; ks < 4; ++ks) qf_[ks] = *(const bf16x8*)(qrow + c * 64 + 16 * ks + 8 * hi);
#pragma unroll
              for (int ks = 0; ks < 4; ++ks) *(LASP bf16x8*)((LASP char*)C.lds + 4 * SLOT + wave * 4096 + ks * 1024 + lane * 16) = qf_[ks]; }
            asm volatile("s_waitcnt vmcnt(0)" ::: "memory");
            ATT_DMA(t0, 0); ATT_DMA((t0 + 1) & 31, 1);
            const LASP char* qlds = ldsp + 4 * SLOT + wave * 4096 + lane * 16;
            f32x16 o[4], zero16, P0, P1;
#pragma unroll
            for (int r = 0; r < 16; ++r) zero16[r] = 0.f;
#pragma unroll
            for (int eb = 0; eb < 4; ++eb)
#pragma unroll
                for (int r = 0; r < 16; ++r) o[eb][r] = 0.f;
            float mhat = 0.f, lsum = 0.f, mrel = -1e30f;
            bf16x8 qaug = __builtin_bit_cast(bf16x8, (u32x4){hi ? 0u : qa0, hi ? 0u : qa1, hi ? 0u : SHSL, hi ? 0u : SHSL});
            bf16x8 pf[4]; bool live = false;
            if (wave < 4) {
#pragma unroll 1
                for (int i = 0; i < 32; ++i) {
                    if (i + 1 < 32) ATT_WAITBAR3(); else ATT_WAITBAR();
                    if (i + 2 < 32) ATT_DMA((t0 + i + 2) & 31, (i + 2) & 3);
                    const int tt = (t0 + i) & 31;
                    ATT_QK(i & 3, tt); ATT_SM(tt); ATT_PV(i & 3);
                }
            } else {
#pragma unroll 1
                for (int i = 0; i < 32; ++i) {
                    if (i + 1 < 32) ATT_WAITBAR3(); else ATT_WAITBAR();
                    if (i + 2 < 32) ATT_DMA((t0 + i + 2) & 31, (i + 2) & 3);
                    const int tt = (t0 + i) & 31;
                    ATT_PV((i - 1) & 3); ATT_QK(i & 3, tt); ATT_SM(tt);
                }
                ATT_PV(31 & 3);
            }
#undef ATT_DMA
#undef ATT_QK
#undef ATT_SM
#undef ATT_PV
#undef ATT_SB
            { auto rr = __builtin_amdgcn_permlane32_swap(__float_as_uint(lsum), __float_as_uint(lsum), false, false); lsum = __uint_as_float(rr[0]) + __uint_as_float(rr[1]); }
            const float inv = 1.0f / lsum;
            float* pk = (float*)(C.ws + WS_H2LO) + (size_t)C.gw * 4096;
            pk += fresh_lane();
            if (c == 0) {
#pragma unroll
                for (int eb = 0; eb < 4; ++eb)
#pragma unroll
                    for (int r = 0; r < 16; ++r) pk[(eb * 16 + r) * 64] = o[eb][r] * inv;
            } else {
                float ss = 0.f;
#pragma unroll
                for (int eb = 0; eb < 4; ++eb)
#pragma unroll
                    for (int r = 0; r < 16; ++r) { const float y = pk[(eb * 16 + r) * 64] - lam * (o[eb][r] * inv); o[eb][r] = y; ss += y * y; }
                { auto rr = __builtin_amdgcn_permlane32_swap(__float_as_uint(ss), __float_as_uint(ss), false, false); ss = __uint_as_float(rr[0]) + __uint_as_float(rr[1]); }
                const float rinv = 1.0f / sqrtf(ss * (1.0f / 128.0f) + EPS);
                bf16_t* orow = ycat + (size_t)(b * SEQ + q0 + l31) * D + 512 + hh * 128 + 4 * hi;
#pragma unroll
                for (int eb = 0; eb < 4; ++eb)
#pragma unroll
                    for (int g4 = 0; g4 < 4; ++g4) { const int e = 32 * eb + 8 * g4;
                        u32x2 w; w.x = cvtpk(o[eb][4 * g4] * rinv, o[eb][4 * g4 + 1] * rinv); w.y = cvtpk(o[eb][4 * g4 + 2] * rinv, o[eb][4 * g4 + 3] * rinv);
                        *(u32x2*)(orow + e) = w; }
            }
        }
    }
    ATT_WAITBAR();
#undef ATT_WAITBAR
#undef ATT_WAITBAR3
}

#define LDS_BAR() asm volatile("s_waitcnt lgkmcnt(0)\n\ts_barrier" ::: "memory")
__device__ __forceinline__ void phase_hy_pre_fast(Ctx& C) {
    const bf16_t* u = (const bf16_t*)(C.ws + WS_U); bf16_t* vpt = (bf16_t*)(C.ws + WS_VP); bf16_t* x0t = (bf16_t*)(C.ws + WS_X0C);
    const float* cw = C.in[7]; const float* cb = C.in[8];
    bf16_t* sv = (bf16_t*)C.lds; bf16_t* sx = sv + 64 * 72 + 64;
    const int tl = C.tid >> 3, c8 = C.tid & 7;
    constexpr int NTILES = NB * 32 * 8;
#define HYP_LOAD(dst, tile_) do { const int cq_ = (tile_) & 7, tq_ = ((tile_) >> 3) & 31, b_ = (tile_) >> 8; const int c0_ = cq_ * 64 + c8 * 8, t_ = tq_ * 64 + tl; const size_t row_ = (size_t)b_ * SEQ + t_; \
        const u32x4 z_ = {0u, 0u, 0u, 0u}; \
        _Pragma("unroll") for (int s_ = 0; s_ < 3; ++s_) { const int ch_ = s_ * HW + c0_; \
            dst[s_][0] = (t_ > 0) ? *(const u32x4*)(u + (row_ - 1) * INC + ch_) : z_; dst[s_][1] = *(const u32x4*)(u + row_ * INC + ch_); dst[s_][2] = (t_ < SEQ - 1) ? *(const u32x4*)(u + (row_ + 1) * INC + ch_) : z_; } } while (0)
    u32x4 cur[3][3], nxt[3][3];
    int tile = C.blk;
    if (tile < NTILES) HYP_LOAD(cur, tile);
    for (; tile < NTILES; tile += C.nblk) {
        const bool more = tile + C.nblk < NTILES;
        if (more) HYP_LOAD(nxt, tile + C.nblk);
        const int cq = tile & 7, tq = (tile >> 3) & 31, b = tile >> 8;
        const int c0 = cq * 64 + c8 * 8;
        float r[3][8];
#pragma unroll
        for (int s = 0; s < 3; ++s) {
            const int ch = s * HW + c0;
            f32x4 m0, m1, z0, z1, p0, p1; pg8::unpack8(cur[s][0], m0, m1); pg8::unpack8(cur[s][1], z0, z1); pg8::unpack8(cur[s][2], p0, p1);
            const f32x4 w00 = *(const f32x4*)(cw + ch), w01 = *(const f32x4*)(cw + ch + 4), w10 = *(const f32x4*)(cw + 3 * HW + ch), w11 = *(const f32x4*)(cw + 3 * HW + ch + 4);
            const f32x4 w20 = *(const f32x4*)(cw + 6 * HW + ch), w21 = *(const f32x4*)(cw + 6 * HW + ch + 4), bb0 = *(const f32x4*)(cb + ch), bb1 = *(const f32x4*)(cb + ch + 4);
            const f32x4 a0 = m0 * w00 + z0 * w10 + p0 * w20 + bb0, a1 = m1 * w01 + z1 * w11 + p1 * w21 + bb1;
#pragma unroll
            for (int i = 0; i < 4; ++i) { r[s][i] = a0[i]; r[s][4 + i] = a1[i]; }
        }
        LDS_BAR();
#pragma unroll
        for (int i = 0; i < 8; ++i) { sx[(c8 * 8 + i) * 72 + c8 * 8 + tl] = (bf16_t)f2bf(r[0][i]); sv[(c8 * 8 + i) * 72 + c8 * 8 + tl] = (bf16_t)f2bf(r[2][i] * r[1][i]); }
        LDS_BAR();
        { const int cl = C.tid >> 3, chk = C.tid & 7; const size_t o = ((size_t)(cq * 64 + cl) * NB + b) * SEQ + tq * 64 + chk * 8;
          *(u32x4*)(vpt + o) = *(const u32x4*)(sv + cl * 72 + (cl >> 3) * 8 + chk * 8); *(u32x4*)(x0t + o) = *(const u32x4*)(sx + cl * 72 + (cl >> 3) * 8 + chk * 8); }
        if (more) {
#pragma unroll
            for (int s = 0; s < 3; ++s)
#pragma unroll
                for (int q = 0; q < 3; ++q) cur[s][q] = nxt[s][q]; }
    }
#undef HYP_LOAD
    __syncthreads();
}

__device__ __forceinline__ void phase_toeplitz(Ctx& C) {
    constexpr int VROW = 4096 + 16, FCOPY = 8192 + 32, FL = 16 * VROW;
    const bf16_t* vpt = (const bf16_t*)(C.ws + WS_VP); const bf16_t* x0t = (const bf16_t*)(C.ws + WS_X0C); bf16_t* yt = (bf16_t*)(C.ws + WS_YT);
    const float* kfc = (const float*)(C.ws + WS_KFC); const float* dsk = C.in[17];
    const int lane = C.lane, a = lane & 15, g = lane >> 4, wave = C.wave;
    const unsigned lds0 = (unsigned)(uintptr_t)C.lds;
    const LASP char* ldsp = (const LASP char*)C.lds;
    const int t0 = 256 * wave;
    const int c0 = 2048 - t0 + 8 * g - a;
    const LASP char* fbase = ldsp + FL + (c0 & 7) * FCOPY + 2 * (c0 & ~7);
    const LASP char* vbase = ldsp + a * VROW + 16 * g;
    for (int c = C.blk; c < HW; c += C.nblk) {
        asm volatile("s_waitcnt vmcnt(0) lgkmcnt(0)\n\ts_barrier" ::: "memory");
        { const char* src = (const char*)(vpt + (size_t)c * NB * SEQ) + lane * 16;
#pragma unroll
          for (int j = 0; j < 8; ++j) { const int p = wave * 8 + j;
              glds16(src + (size_t)p * 1024, (unsigned)__builtin_amdgcn_readfirstlane(lds0 + (p >> 2) * VROW + (p & 3) * 1024)); } }
        { const int q = C.tid; const float* kc = kfc + (size_t)c * 4096; float f[15];
#pragma unroll
          for (int i = 0; i < 15; ++i) { const int idx = 4096 - 8 * q - i; f[i] = (idx >= 1 && idx <= 4095) ? kc[idx] : 0.f; }
#pragma unroll
          for (int m = 0; m < 8; ++m) { u32x4 w; w.x = pk2(f[m], f[m + 1]); w.y = pk2(f[m + 2], f[m + 3]); w.z = pk2(f[m + 4], f[m + 5]); w.w = pk2(f[m + 6], f[m + 7]);
              *(LASP u32x4*)((LASP char*)C.lds + FL + m * FCOPY + q * 16) = w; } }
        asm volatile("s_waitcnt vmcnt(0) lgkmcnt(0)\n\ts_barrier" ::: "memory");
        f32x4 acc[16]; bf16x8 W[16];
#pragma unroll
        for (int r = 0; r < 16; ++r) { acc[r] = (f32x4){0.f, 0.f, 0.f, 0.f}; W[r] = *(const LASP bf16x8*)(fbase - 32 * r); }
#pragma unroll 1
        for (int ko = 0; ko < 8; ++ko) {
            const LASP char* fb = fbase + ko * 512; const LASP char* vb = vbase + ko * 512;
#pragma unroll
            for (int kk = 0; kk < 8; ++kk) {
                const bf16x8 Bf = *(const LASP bf16x8*)(vb + 64 * kk);
#pragma unroll
                for (int r = 0; r < 16; ++r) acc[r] = __builtin_amdgcn_mfma_f32_16x16x32_bf16(W[(r - 2 * kk) & 15], Bf, acc[r], 0, 0, 0);
                if (ko < 7 || kk < 7) { W[(-2 * kk - 2) & 15] = *(const LASP bf16x8*)(fb + 64 * kk + 64); W[(-2 * kk - 1) & 15] = *(const LASP bf16x8*)(fb + 64 * kk + 32); }
            }
        }
        const float dd = dsk[c];
#pragma unroll
        for (int r = 0; r < 16; ++r) { const int t = t0 + 16 * r + 4 * g; const size_t o = ((size_t)c * NB + a) * SEQ + t;
            const u32x2 vv = *(const LASP u32x2*)(ldsp + a * VROW + t * 2); const u32x2 xx = *(const u32x2*)(x0t + o);
            const float y0 = (acc[r][0] + bflo(vv.x) * dd) * bflo(xx.x), y1 = (acc[r][1] + bfhi(vv.x) * dd) * bfhi(xx.x);
            const float y2 = (acc[r][2] + bflo(vv.y) * dd) * bflo(xx.y), y3 = (acc[r][3] + bfhi(vv.y) * dd) * bfhi(xx.y);
            u32x2 w; w.x = pk2(y0, y1); w.y = pk2(y2, y3); *(u32x2*)(yt + o) = w; }
    }
    asm volatile("s_waitcnt vmcnt(0) lgkmcnt(0)\n\ts_barrier" ::: "memory");
}

__device__ __forceinline__ void phase_hy_post(Ctx& C) {
    const bf16_t* yt = (const bf16_t*)(C.ws + WS_YT); bf16_t* ycat = (bf16_t*)(C.ws + WS_YCAT);
    bf16_t* sy = (bf16_t*)C.lds;
    constexpr int NTILES = NB * 32 * 8;
    const int cl = C.tid >> 3, chk = C.tid & 7, tl = C.tid >> 3, c8 = C.tid & 7;
#define HYQ_LOAD(tile_) (*(const u32x4*)(yt + ((size_t)(((tile_) & 7) * 64 + cl) * NB + ((tile_) >> 8)) * SEQ + (((tile_) >> 3) & 31) * 64 + chk * 8))
    int tile = C.blk; u32x4 cur = {0u, 0u, 0u, 0u}, nxt = cur;
    if (tile < NTILES) cur = HYQ_LOAD(tile);
    for (; tile < NTILES; tile += C.nblk) {
        const bool more = tile + C.nblk < NTILES;
        if (more) nxt = HYQ_LOAD(tile + C.nblk);
        const int cq = tile & 7, tq = (tile >> 3) & 31, b = tile >> 8;
        LDS_BAR();
        *(u32x4*)(sy + cl * 72 + (cl >> 3) * 8 + chk * 8) = cur;
        LDS_BAR();
        { unsigned short e[8];
#pragma unroll
          for (int i = 0; i < 8; ++i) e[i] = sy[(c8 * 8 + i) * 72 + c8 * 8 + tl];
          u32x4 w; w.x = e[0] | ((unsigned)e[1] << 16); w.y = e[2] | ((unsigned)e[3] << 16); w.z = e[4] | ((unsigned)e[5] << 16); w.w = e[6] | ((unsigned)e[7] << 16);
          *(u32x4*)(ycat + ((size_t)b * SEQ + tq * 64 + tl) * D + cq * 64 + c8 * 8) = w; }
        cur = nxt;
    }
#undef HYQ_LOAD
    __syncthreads();
}

__device__ __forceinline__ void phase_route(Ctx& C) {
    const float* mod = (const float*)(C.ws + WS_MOD); const float* ssq = (const float*)(C.ws + WS_LOGITS); bf16_t* h2 = (bf16_t*)(C.ws + WS_H); const bf16_t* wrt = (const bf16_t*)(C.ws + WS_WRT);
    int* tope = (int*)(C.ws + WS_TOPE); float* topw = (float*)(C.ws + WS_TOPW); int* blkcnt = (int*)(C.ws + WS_BLKCNT);
    const float* g = C.in[23]; const float* br = C.in[25];
    int* hist = (int*)C.lds; float* slog = (float*)(C.lds + 1024) + C.wave * 512;
    const int lane = C.lane, tk = lane & 15, gq = lane >> 4;
    for (int vb = C.blk; vb < 256; vb += C.nblk) {
        __syncthreads();
        if (C.tid < NE) hist[C.tid] = 0;
        __syncthreads();
        const int tok = vb * 128 + C.wave * 16 + tk; const int b = tok / SEQ;
        float rstd;
        { const f32x4* sp = (const f32x4*)(ssq + (size_t)tok * 16); const f32x4 a0 = sp[0], a1 = sp[1], a2 = sp[2], a3 = sp[3];
          const float ss = ((a0.x + a0.y) + (a0.z + a0.w)) + ((a1.x + a1.y) + (a1.z + a1.w)) + ((a2.x + a2.y) + (a2.z + a2.w)) + ((a3.x + a3.y) + (a3.z + a3.w));
          rstd = 1.0f / sqrtf(ss * (1.0f / D) + EPS); }
        const float* xr = C.out + (size_t)tok * D + 8 * gq; const float* sh = mod + (size_t)b * 6 * D + 3 * D + 8 * gq; const float* sc = sh + D; const float* gg = g + 8 * gq;
        bf16_t* hr = h2 + (size_t)tok * D + 8 * gq;
        const bf16_t* wb = wrt + (size_t)tk * 2048 + 8 * gq;
        f32x4 acc[2]; acc[0] = (f32x4){0.f, 0.f, 0.f, 0.f}; acc[1] = acc[0];
#pragma unroll 2
        for (int k = 0; k < D; k += 32) {
            const f32x4 x0 = *(const f32x4*)(xr + k), x1v = *(const f32x4*)(xr + k + 4), g0 = *(const f32x4*)(gg + k), g1 = *(const f32x4*)(gg + k + 4);
            const f32x4 c0 = *(const f32x4*)(sc + k), c1 = *(const f32x4*)(sc + k + 4), s0 = *(const f32x4*)(sh + k), s1 = *(const f32x4*)(sh + k + 4);
            f32x4 h0, h1;
#pragma unroll
            for (int i = 0; i < 4; ++i) { h0[i] = x0[i] * rstd * g0[i] * (1.f + c0[i]) + s0[i]; h1[i] = x1v[i] * rstd * g1[i] * (1.f + c1[i]) + s1[i]; }
            u32x4 wh; wh.x = pk2(h0[0], h0[1]); wh.y = pk2(h0[2], h0[3]); wh.z = pk2(h1[0], h1[1]); wh.w = pk2(h1[2], h1[3]);
            *(u32x4*)(hr + k) = wh;
            u32x4 wl; wl.x = pk2(h0[0] - bflo(wh.x), h0[1] - bfhi(wh.x)); wl.y = pk2(h0[2] - bflo(wh.y), h0[3] - bfhi(wh.y)); wl.z = pk2(h1[0] - bflo(wh.z), h1[1] - bfhi(wh.z)); wl.w = pk2(h1[2] - bflo(wh.w), h1[3] - bfhi(wh.w));
            const bf16x8 a_h = __builtin_bit_cast(bf16x8, wh), a_l = __builtin_bit_cast(bf16x8, wl);
#pragma unroll
            for (int n = 0; n < 2; ++n) { const bf16_t* bp = wb + (size_t)n * 16 * 2048 + k;
                const bf16x8 b_h = *(const bf16x8*)(bp), b_l = *(const bf16x8*)(bp + 1024);
                acc[n] = __builtin_amdgcn_mfma_f32_16x16x32_bf16(b_h, a_h, acc[n], 0, 0, 0);
                acc[n] = __builtin_amdgcn_mfma_f32_16x16x32_bf16(b_h, a_l, acc[n], 0, 0, 0);
                acc[n] = __builtin_amdgcn_mfma_f32_16x16x32_bf16(b_l, a_h, acc[n], 0, 0, 0); }
        }
#pragma unroll
        for (int n = 0; n < 2; ++n) *(f32x4*)(slog + tk * 32 + n * 16 + 4 * gq) = acc[n];
        __builtin_amdgcn_s_waitcnt(0xc07f); asm volatile("" ::: "memory");
        if (lane < 16) {
            const int t = vb * 128 + C.wave * 16 + lane;
            float v[32];
#pragma unroll
            for (int q = 0; q < 8; ++q) { const f32x4 x = *(const f32x4*)(slog + lane * 32 + 4 * q), bb = *(const f32x4*)(br + 4 * q);
                v[4 * q] = x.x + bb.x; v[4 * q + 1] = x.y + bb.y; v[4 * q + 2] = x.z + bb.z; v[4 * q + 3] = x.w + bb.w; }
            float tv[4]; int ti[4];
#pragma unroll
            for (int k = 0; k < 4; ++k) {
                float best = -INFINITY; int bi = 0;
#pragma unroll
                for (int e = 0; e < 32; ++e) if (v[e] > best) { best = v[e]; bi = e; }
                tv[k] = best; ti[k] = bi;
#pragma unroll
                for (int e = 0; e < 32; ++e) v[e] = (e == bi) ? -INFINITY : v[e];
            }
            const float e0 = 1.0f, e1 = expf(tv[1] - tv[0]), e2 = expf(tv[2] - tv[0]), e3 = expf(tv[3] - tv[0]);
            const float inv = 1.0f / (e0 + e1 + e2 + e3);
            *(int4*)(tope + (size_t)t * 4) = make_int4(ti[0], ti[1], ti[2], ti[3]);
            *(f32x4*)(topw + (size_t)t * 4) = (f32x4){e0 * inv, e1 * inv, e2 * inv, e3 * inv};
#pragma unroll
            for (int k = 0; k < 4; ++k) atomicAdd(&hist[ti[k]], 1);
        }
        __syncthreads();
        if (C.tid < NE) blkcnt[vb * NE + C.tid] = hist[C.tid];
    }
    __syncthreads();
}

__device__ __forceinline__ void phase_rowlist(Ctx& C) {
    const int* tope = (const int*)(C.ws + WS_TOPE); const int* blkcnt = (const int*)(C.ws + WS_BLKCNT);
    int* rowpair = (int*)(C.ws + WS_ROWPAIR); int* tileexp = (int*)(C.ws + WS_TILEEXP); int* meta = (int*)(C.ws + WS_META);
    float* roww = (float*)(C.ws + WS_ROWW); const float* topw = (const float*)(C.ws + WS_TOPW); int* rowinv = (int*)(C.ws + WS_TOPE);
    int* s_total = (int*)C.lds; int* s_base = s_total + 32; int* s_pstart = s_base + 32; int* s_e = s_pstart + 36; int* s_cnt = s_e + 512;
    for (int vb = C.blk; vb < 256; vb += C.nblk) {
        __syncthreads();
        { const int4* src = (const int4*)blkcnt; int4* dst = (int4*)s_cnt;
#pragma unroll
          for (int q = 0; q < 4; ++q) dst[q * NTHREADS + C.tid] = src[q * NTHREADS + C.tid]; }
        s_e[C.tid] = tope[(size_t)vb * 512 + C.tid];
        __syncthreads();
        if (C.tid < NE) { int tot = 0, base = 0;
#pragma unroll 8
            for (int q = 0; q < 256; ++q) { const int c = s_cnt[q * NE + C.tid]; tot += c; if (q < vb) base += c; } s_total[C.tid] = tot; s_base[C.tid] = base; }
        __syncthreads();
        if (C.tid == 0) { int ps = 0; for (int e = 0; e < NE; ++e) { s_pstart[e] = ps; ps += ((s_total[e] + 255) / 256) * 256; } s_pstart[NE] = ps; }
        __syncthreads();
        { const int e = s_e[C.tid]; int rank = 0; for (int j = 0; j < C.tid; ++j) rank += (s_e[j] == e) ? 1 : 0;
          rowpair[s_pstart[e] + s_base[e] + rank] = vb * 512 + C.tid; roww[s_pstart[e] + s_base[e] + rank] = topw[vb * 512 + C.tid]; rowinv[vb * 512 + C.tid] = s_pstart[e] + s_base[e] + rank; }
        if (vb < NE) { const int e = vb; for (int r = s_pstart[e] + s_total[e] + C.tid; r < s_pstart[e + 1]; r += NTHREADS) { rowpair[r] = -1; roww[r] = 0.f; } }
        if (vb == 0) {
            if (C.tid < NE) { for (int tl = s_pstart[C.tid] / 256; tl < s_pstart[C.tid + 1] / 256; ++tl) tileexp[tl] = C.tid; }
            if (C.tid == 0) meta[0] = s_pstart[NE] / 256;
        }
    }
    __syncthreads();
}


#define LDS3(C) ((PG8_LAS unsigned char*)(C).lds)
__device__ __forceinline__ void phase_inproj_fast(Ctx& C) {
    pg8::Gemm g{(const bf16_t*)(C.ws + WS_H), (const bf16_t*)(C.ws + WS_WIN), D, D, D, nullptr};
    pg8::StaticOrder S; S.init(T / 256, INC / 256, C.nblk, C.blk);
    pg8::EpiInproj E{(bf16_t*)(C.ws + WS_U), C.in[6]};
    pg8::gemm_phase<pg8::EpiInproj, pg8::StaticOrder, false>(LDS3(C), g, S, E, C.wave);
}
#ifndef XVAR
#define XVAR 0
#endif
__device__ __forceinline__ void phase_probe_x(Ctx& C) {
#if XVAR == 1
    pg8::Gemm g{(const bf16_t*)(C.ws + WS_H), (const bf16_t*)(C.ws + WS_WIN), D, D, D, nullptr};
    pg8::StaticOrder S; S.init(T / 256, INC / 256, C.nblk, C.blk);
    pg8::EpiInprojT<1> E{(bf16_t*)(C.ws + WS_U), C.in[6]};
    pg8::gemm_phase<pg8::EpiInprojT<1>, pg8::StaticOrder, false>(LDS3(C), g, S, E, C.wave);
#endif
}
__device__ __forceinline__ void phase_cat_fast(Ctx& C) {
    pg8::StaticOrder S; S.init(T / 256, D / 256, C.nblk, C.blk);
    pg8::Gemm g{(const bf16_t*)(C.ws + WS_YCAT), (const bf16_t*)(C.ws + WS_WCAT), D, D, D, nullptr};
    pg8::EpiCatR E{(bf16_t*)(C.ws + WS_MERGED), (const bf16_t*)(C.ws + WS_U)};
    pg8::gemm_phase<pg8::EpiCatR, pg8::StaticOrder, false, true>(LDS3(C), g, S, E, C.wave);
}
__device__ __forceinline__ void phase_mix_fast(Ctx& C) {
    pg8::Gemm g{(const bf16_t*)(C.ws + WS_MERGED), (const bf16_t*)(C.ws + WS_WMIX), D, D, D, nullptr};
    pg8::StaticOrder S; S.init(T / 256, D / 256, C.nblk, C.blk);
    pg8::EpiMix E{C.in[0], C.out, (const float*)(C.ws + WS_MOD), (float*)(C.ws + WS_LOGITS)};
    pg8::gemm_phase<pg8::EpiMix, pg8::StaticOrder, false>(LDS3(C), g, S, E, C.wave);
}
__device__ __forceinline__ void phase_gateup_fast(Ctx& C) {
    const int nmt = ((const int*)(C.ws + WS_META))[0];
    pg8::Gemm g{(const bf16_t*)(C.ws + WS_H), (const bf16_t*)(C.ws + WS_WGU), D, D, D, (const int*)(C.ws + WS_ROWPAIR)};
    pg8::MoeOrder S; S.b.init(nmt, 8, C.nblk, C.blk); S.tileexp = (const int*)(C.ws + WS_TILEEXP); S.nN = 8;
    pg8::EpiGateUp E{(bf16_t*)(C.ws + WS_ACT), C.in[27]};
    pg8::gemm_phase<pg8::EpiGateUp, pg8::MoeOrder, true>(LDS3(C), g, S, E, C.wave);
}
__device__ __forceinline__ void phase_down_fast(Ctx& C) {
    const int nmt = ((const int*)(C.ws + WS_META))[0];
    pg8::Gemm g{(const bf16_t*)(C.ws + WS_ACT), (const bf16_t*)(C.ws + WS_WDN), D, D, D, nullptr};
    pg8::MoeOrder S; S.b.init(nmt, 4, C.nblk, C.blk); S.tileexp = (const int*)(C.ws + WS_TILEEXP); S.nN = 4;
    pg8::EpiDown E{(bf16_t*)(C.ws + WS_SLOTS), C.in[29], (const float*)(C.ws + WS_ROWW)};
    pg8::gemm_phase<pg8::EpiDown, pg8::MoeOrder, false>(LDS3(C), g, S, E, C.wave);
}


#define XB_TMO      128
#define XB_XCNT(j)  (256  + 64 * (j))
#define XB_XSUB(j)  (1280 + 64 * (j))
#define XB_XGEN(j)  (2304 + 64 * (j))
#define XB_TOP      3328
#define XB_TOPGEN   3392
#define XCD_BAR_WORDS 3456
#define XB_SPIN_CAP (1u << 18)
#define XLAS __attribute__((address_space(3)))
__device__ __forceinline__ unsigned xb_ld(unsigned* p)              { return __hip_atomic_load(p, __ATOMIC_RELAXED, __HIP_MEMORY_SCOPE_AGENT); }
__device__ __forceinline__ unsigned xb_add(unsigned* p, unsigned v) { return __hip_atomic_fetch_add(p, v, __ATOMIC_RELAXED, __HIP_MEMORY_SCOPE_AGENT); }
__device__ __forceinline__ unsigned xb_xcc_id() { return (unsigned)__builtin_amdgcn_s_getreg((3 << 11) | 20) & 0xFu; }
#define XB_SPIN(cond, bar) do { unsigned _sp = 0; while (cond) { __builtin_amdgcn_s_sleep(1); \
    if ((++_sp & 255u) == 0u) { if (xb_ld(&(bar)[XB_TMO])) break; if (_sp > XB_SPIN_CAP) { atomicAdd(&(bar)[XB_TMO], 1u); break; } } } } while (0)
struct XcdBarrier { unsigned* bar; unsigned x; volatile XLAS unsigned* st; };
__device__ __forceinline__ XcdBarrier xcd_barrier_post(unsigned* bar, volatile XLAS unsigned* st, bool leader) {
    XcdBarrier b; b.bar = bar; b.x = xb_xcc_id(); b.st = st;
    if (leader) (void)xb_add(&bar[XB_XCNT(b.x)], 1u);
    return b;
}
__device__ __forceinline__ void xcd_barrier_complete(unsigned* bar, unsigned x, unsigned& nloc, unsigned& nx) {
    const unsigned G = gridDim.x * gridDim.y * gridDim.z;
    unsigned sum, cnt, mine, sp = 0u;
    for (;;) {
        sum = 0u; cnt = 0u; mine = 0u;
#pragma unroll
        for (unsigned j = 0; j < 16; ++j) { const unsigned c = xb_ld(&bar[XB_XCNT(j)]); sum += c; cnt += (c > 0u) ? 1u : 0u; mine = (j == x) ? c : mine; }
        if (sum == G) break;
        __builtin_amdgcn_s_sleep(1);
        if ((++sp & 255u) == 0u) { if (xb_ld(&bar[XB_TMO])) break; if (sp > XB_SPIN_CAP) { atomicAdd(&bar[XB_TMO], 1u); break; } }
    }
    nloc = mine > 0u ? mine : 1u; nx = cnt > 0u ? cnt : 1u;
}
__device__ __forceinline__ void xcd_barrier(const XcdBarrier& b, int wave_) {
    asm volatile("s_waitcnt vmcnt(0)" ::: "memory");
    __syncthreads();
    if (wave_ == 0 && lane_id() == 0) {
        unsigned* bar = b.bar;
        __builtin_amdgcn_s_waitcnt(0);
        unsigned nloc = b.st[0], nx = b.st[1];
        if (nloc == 0u) { xcd_barrier_complete(bar, b.x, nloc, nx); b.st[0] = nloc; b.st[1] = nx; }
        const unsigned old = xb_add(&bar[XB_XSUB(b.x)], 1u);
        const unsigned gen = old / nloc;
        if (old + 1u == (gen + 1u) * nloc) {
            __builtin_amdgcn_fence(__ATOMIC_RELEASE, "agent");
            asm volatile("s_waitcnt vmcnt(0)" ::: "memory");
            const unsigned og = xb_add(&bar[XB_TOP], 1u);
            const unsigned tg = og / nx;
            if (og + 1u == (tg + 1u) * nx) xb_add(&bar[XB_TOPGEN], 1u);
            else XB_SPIN(xb_ld(&bar[XB_TOPGEN]) == tg, bar);
            __builtin_amdgcn_fence(__ATOMIC_ACQUIRE, "agent");
            xb_add(&bar[XB_XGEN(b.x)], 1u);
            asm volatile("s_waitcnt vmcnt(0)" ::: "memory");
        } else {
            XB_SPIN(xb_ld(&bar[XB_XGEN(b.x)]) == gen, bar);
            __builtin_amdgcn_fence(__ATOMIC_ACQUIRE, "agent");
            asm volatile("s_waitcnt vmcnt(0)" ::: "memory");
        }
    }
    __syncthreads();
}

constexpr int NPHASES = 13;
}

__global__ void __launch_bounds__(NTHREADS, 2) fwd_kernel(Params p) {
    extern __shared__ __attribute__((aligned(16))) unsigned char lds[];
    cg::grid_group grid = cg::this_grid();
    Ctx C;
#pragma unroll
    for (int i = 0; i < 31; ++i) C.in[i] = p.in[i];
    C.out = p.out; C.ws = p.ws; C.lds = lds;
    const int wave_s = __builtin_amdgcn_readfirstlane(threadIdx.x >> 6);
    C.lane = lane_id(); C.wave = wave_s; C.tid = wave_s * 64 + C.lane;
    C.blk = blockIdx.x; C.nblk = gridDim.x; C.gw = C.blk * NWAVES + C.wave; C.ngw = C.nblk * NWAVES;
    const int lo = p.ph_lo, hi = p.ph_hi;
    volatile XLAS unsigned* misc = (volatile XLAS unsigned*)((XLAS unsigned char*)lds + (LDS_BYTES - 64));
    if (C.tid < 16) misc[C.tid] = 0u;
    __syncthreads();
    const XcdBarrier xbar = xcd_barrier_post((unsigned*)(p.ws + WS_CTL), misc, C.tid == 0);
#define GSYNC(k) do { xcd_barrier(xbar, wave_s); } while (0)
    if (lo < 0) grid.sync();
#ifndef PHMASK
#define PHMASK 0xffff
#endif
#ifndef REPMASK
#define REPMASK 0
#endif
#ifndef PROBE_PHASE
#define PROBE_PHASE (-1)
#endif
    unsigned long long tp0 = 0, tp1 = 0;
#define PH(k, body) do { if ((PHMASK >> (k)) & 1) { if (lo <= (k) && (k) < hi) { if ((k) == PROBE_PHASE) tp0 = __builtin_amdgcn_s_memrealtime(); _Pragma("unroll 1") for (int rep_ = (REPMASK >> (k)) & 1; rep_ >= 0; --rep_) { { C.lane = fresh_lane(); C.wave = wave_s; C.tid = wave_s * 64 + C.lane; C.gw = C.blk * NWAVES + C.wave; } body; if (rep_ > 0 || (k) + 1 < hi) GSYNC(k); } if ((k) == PROBE_PHASE) tp1 = __builtin_amdgcn_s_memrealtime(); } } } while (0)
#ifdef SYNCPROBE
    for (int i = 0; i < 20; ++i) GSYNC(1);
#endif
    PH(0, { phase_mod(C); phase_filters(C); });
    PH(1, { phase_weights(C); __syncthreads(); phase_norm1(C); });
#ifndef FASTMASK
#define FASTMASK 0xffff
#endif
#define FAST(k) ((FASTMASK >> (k)) & 1)
    PH(2, phase_inproj_fast(C));
#if XVAR == 1
    PH(13, phase_probe_x(C));
#endif
    PH(3, phase_hy_pre_fast(C));
    PH(4, { phase_toeplitz(C); GSYNC(1); phase_hy_post(C); });
    PH(5, phase_attn_fast(C));
    PH(6, phase_cat_fast(C));
    PH(7, phase_mix_fast(C));
    PH(8, phase_route(C));
    PH(9, phase_rowlist(C));
    PH(10, phase_gateup_fast(C));
    PH(11, phase_down_fast(C));
    PH(12, phase_final(C));
#undef PH
    if (PROBE_PHASE >= 0 && C.blk == 0) { const unsigned long long te = __builtin_amdgcn_s_memrealtime(), span = 4ull * (tp1 - tp0); while (__builtin_amdgcn_s_memrealtime() - te < span) __builtin_amdgcn_s_sleep(8); }
}

extern "C" void kernel_launch(void* const* d_in, const int* in_sizes, int n_in, void* d_out, int out_size, void* d_ws, size_t ws_size, hipStream_t stream) {
    static int grid = 0;
    if (grid == 0) {
        if (n_in != 31 || ws_size < WS_END) { fprintf(stderr, "kernel_launch: unexpected n_in %d or ws_size %zu\n", n_in, ws_size); grid = -1; return; }
        int dev = 0, cus = 0, per_cu = 0;
        hipGetDevice(&dev); hipDeviceGetAttribute(&cus, hipDeviceAttributeMultiprocessorCount, dev);
        hipFuncSetAttribute((const void*)fwd_kernel, hipFuncAttributeMaxDynamicSharedMemorySize, LDS_BYTES);
        hipOccupancyMaxActiveBlocksPerMultiprocessor(&per_cu, (const void*)fwd_kernel, NTHREADS, LDS_BYTES);
        if (per_cu < 1) { fprintf(stderr, "kernel_launch: occupancy query says %d blocks/CU\n", per_cu); per_cu = 1; }
        (void)hipGetLastError();
        grid = cus * 1;
        fprintf(stderr, "kernel_launch: cus %d per_cu %d grid %d\n", cus, per_cu, grid);
    }
    if (grid < 0) return;
    if (hipMemsetAsync((char*)d_ws + WS_CTL, 0, 65536, stream) != hipSuccess) { fprintf(stderr, "kernel_launch: memset failed\n"); return; }
    Params p{};
    for (int i = 0; i < 31; ++i) p.in[i] = (const float*)d_in[i];
    p.out = (float*)d_out; p.ws = (unsigned char*)d_ws; p.ph_lo = 0; p.ph_hi = NPHASES + (XVAR ? 1 : 0);
    void* args[] = {&p};
    hipError_t e = hipLaunchCooperativeKernel((const void*)fwd_kernel, dim3(grid), dim3(NTHREADS), args, LDS_BYTES, stream);
    if (e != hipSuccess) fprintf(stderr, "cooperative launch failed: %s (grid %d)\n", hipGetErrorString(e), grid);
}
```

```cpp
#include <hip/hip_runtime.h>
#include <hip/hip_cooperative_groups.h>
#include <cstdio>
#include <cstdint>
namespace cg = cooperative_groups;

namespace {
typedef unsigned short bf16_t;
typedef short bf16x8 __attribute__((ext_vector_type(8)));
typedef short s16x4 __attribute__((ext_vector_type(4)));
typedef float f32x4 __attribute__((ext_vector_type(4)));
typedef float f32x16 __attribute__((ext_vector_type(16)));
typedef unsigned u32x4 __attribute__((ext_vector_type(4)));
typedef unsigned u32x2 __attribute__((ext_vector_type(2)));

constexpr int D = 1024, NB = 16, SEQ = 2048, T = NB * SEQ, HW = 512, INC = 5120, NE = 32, FHID = 64;
constexpr int QOFF = 1536, KOFF = 2048, VOFF = 2560, GOFF = 3072;
constexpr int NTHREADS = 512, NWAVES = 8;
constexpr float EPS = 1e-5f;
constexpr float LOG2E = 1.4426950408889634f;
constexpr float QSCALE = 0.125f * 1.4426950408889634f;
constexpr size_t MiB = 1u << 20;
constexpr size_t WS_CTL = 0;
constexpr size_t WS_MOD = 1 * MiB;
constexpr size_t WS_META = 1 * MiB + 512 * 1024;
constexpr size_t WS_BLKCNT = WS_META + 4096;
constexpr size_t WS_TILEEXP = WS_BLKCNT + 256 * 32 * 4;
constexpr size_t WS_LOGITS = 2 * MiB;
constexpr size_t WS_TOPE = 6 * MiB;
constexpr size_t WS_TOPW = 6 * MiB + 512 * 1024;
constexpr size_t WS_ROWPAIR = 7 * MiB;
constexpr size_t WS_ROWW = 7 * MiB + 576 * 1024;
constexpr size_t WS_KFILT = 8 * MiB;
constexpr size_t WS_U = 16 * MiB;
constexpr size_t WS_ACT = WS_U;
constexpr size_t WS_H = 336 * MiB;
constexpr size_t WS_R1 = 400 * MiB;
constexpr size_t WS_YCAT = WS_R1;
constexpr size_t WS_MERGED = WS_R1 + 64 * MiB;
constexpr size_t WS_VP = WS_R1 + 128 * MiB;
constexpr size_t WS_X0C = WS_R1 + 160 * MiB;
constexpr size_t WS_VT = WS_R1 + 192 * MiB;
constexpr size_t WS_H2LO = WS_R1 + 224 * MiB;
constexpr size_t WS_SLOTS = WS_R1;
constexpr size_t WS_WIN = 688 * MiB;
constexpr size_t WS_WCAT = 698 * MiB;
constexpr size_t WS_WMIX = 700 * MiB;
constexpr size_t WS_WGU = 702 * MiB;
constexpr size_t WS_WDN = 830 * MiB;
constexpr size_t WS_WRT = 894 * MiB;
constexpr size_t WS_KFC = 896 * MiB;
constexpr size_t WS_X1 = 904 * MiB;
constexpr size_t WS_END = 968 * MiB;
constexpr size_t WS_YT = WS_R1 + 192 * MiB;
constexpr int MAXROWS = 4 * T + NE * 256;
constexpr int LDS_BYTES = 147456;

struct Params { const float* in[31]; float* out; unsigned char* ws; int ph_lo, ph_hi; };

__device__ __forceinline__ unsigned f2bf(float f) { unsigned u = __float_as_uint(f); return (u + 0x7fffu + ((u >> 16) & 1u)) >> 16; }
__device__ __forceinline__ unsigned pk2(float lo, float hi) { return f2bf(lo) | (f2bf(hi) << 16); }
__device__ __forceinline__ float bf2f(unsigned h) { return __uint_as_float(h << 16); }
__device__ __forceinline__ float bflo(unsigned w) { return __uint_as_float(w << 16); }
__device__ __forceinline__ float bfhi(unsigned w) { return __uint_as_float(w & 0xffff0000u); }
__device__ __forceinline__ float wave_sum(float v) {
#pragma unroll
    for (int o = 1; o < 64; o <<= 1) v += __shfl_xor(v, o);
    return v;
}
__device__ __forceinline__ float sigmoidf_(float x) { return 1.0f / (1.0f + __expf(-x)); }
__device__ __forceinline__ int crow(int r, int hi) { return (r & 3) + 8 * (r >> 2) + 4 * hi; }
__device__ __forceinline__ int lane_id() { return (int)__builtin_amdgcn_mbcnt_hi(~0u, __builtin_amdgcn_mbcnt_lo(~0u, 0u)); }
__device__ __forceinline__ int fresh_lane() { int l = lane_id(); asm volatile("" : "+v"(l)); return l; }

struct Ctx {
    const float* in[31]; float* out; unsigned char* ws;
    int tid, lane, wave, gw, ngw, nblk, blk;
    unsigned char* lds;
};

struct WItem { const float* src; bf16_t* dst; int N; int sk; };
__device__ __forceinline__ WItem witem(const Ctx& C, int it) {
    constexpr int I_IN = (D / 64) * (INC / 64), I_HY = (HW / 64) * (D / 64), I_MIX = (D / 64) * (D / 64), I_GU1 = (D / 64) * (2 * D / 64), I_DN1 = (D / 64) * (D / 64);
    const float* W; int N, k0, n0, kd, nd, sk = -1; bf16_t* WT;
    int r = it;
    if (r < NE * I_GU1) { const int e = r / I_GU1, q = r % I_GU1; const int nb = 2 * D / 64; n0 = 64 * (q % nb); k0 = 64 * (q / nb);
        const int s = n0 / 1024, rem = n0 % 1024, j = rem / 128, i0 = rem % 128; nd = 256 * j + 128 * s + i0; kd = k0; N = 2 * D;
        W = C.in[26] + (size_t)e * D * 2 * D; WT = (bf16_t*)(C.ws + WS_WGU) + (size_t)e * 2 * D * D; }
    else if ((r -= NE * I_GU1) < NE * I_DN1) { const int e = r / I_DN1, q = r % I_DN1; const int nb = D / 64; n0 = 64 * (q % nb); k0 = 64 * (q / nb); nd = n0; kd = k0; N = D;
        W = C.in[28] + (size_t)e * D * D; WT = (bf16_t*)(C.ws + WS_WDN) + (size_t)e * D * D; }
    else if ((r -= NE * I_DN1) < I_IN) { const int nb = INC / 64; n0 = 64 * (r % nb); k0 = 64 * (r / nb); nd = n0; kd = k0; N = INC; W = C.in[5]; WT = (bf16_t*)(C.ws + WS_WIN);
        if (n0 >= GOFF) { const int rel = n0 - GOFF, sg_ = rel / 1024, rem = rel % 1024; nd = GOFF + 256 * (rem / 128) + 128 * sg_ + (rem % 128); } }
    else if ((r -= I_IN) < I_HY) { const int nb = D / 64; n0 = 64 * (r % nb); k0 = 64 * (r / nb); nd = n0; kd = k0; N = D; W = C.in[20]; WT = (bf16_t*)(C.ws + WS_WCAT); }
    else if ((r -= I_HY) < I_HY) { const int nb = D / 64; n0 = 64 * (r % nb); k0 = 64 * (r / nb); nd = n0; kd = 512 + k0; N = D; W = C.in[21]; WT = (bf16_t*)(C.ws + WS_WCAT); sk = k0; }
    else { r -= I_HY; const int nb = D / 64; n0 = 64 * (r % nb); k0 = 64 * (r / nb); nd = n0; kd = k0; N = D; W = C.in[22]; WT = (bf16_t*)(C.ws + WS_WMIX); }
    WItem w; w.N = N; w.sk = sk; w.src = W + (size_t)(k0 + (C.lane >> 4)) * N + n0 + 4 * (C.lane & 15); w.dst = WT + (size_t)(nd + (C.lane >> 3)) * D + kd + 8 * (C.lane & 7);
    return w;
}
__device__ __forceinline__ void phase_weights(Ctx& C) {
    float* scr = (float*)(C.lds + C.wave * 16640);
    constexpr int NITEMS = (D / 64) * (INC / 64) + 2 * (HW / 64) * (D / 64) + (D / 64) * (D / 64) + NE * (D / 64) * (2 * D / 64) + NE * (D / 64) * (D / 64);
    const int lane = C.lane;
    int it = C.gw;
    f32x4 v[16], vn[16];
    WItem cur;
    if (it < NITEMS) { cur = witem(C, it);
#pragma unroll
        for (int i = 0; i < 16; ++i) v[i] = __builtin_nontemporal_load((const f32x4*)(cur.src + (size_t)(4 * i) * cur.N)); }
    for (; it < NITEMS; it += C.ngw) {
        const bool more = it + C.ngw < NITEMS; WItem nx = cur;
        if (more) { nx = witem(C, it + C.ngw);
#pragma unroll
            for (int i = 0; i < 16; ++i) vn[i] = __builtin_nontemporal_load((const f32x4*)(nx.src + (size_t)(4 * i) * nx.N)); }
        if (cur.sk >= 0) {
#pragma unroll
            for (int i = 0; i < 16; ++i) v[i] = v[i] * (0.8f * C.in[19][(cur.sk + 4 * i + (lane >> 4)) & 127]); }
#pragma unroll
        for (int i = 0; i < 16; ++i) { float* d = scr + (4 * i + (lane >> 4)) * 65 + 4 * (lane & 15); d[0] = v[i].x; d[1] = v[i].y; d[2] = v[i].z; d[3] = v[i].w; }
        __builtin_amdgcn_s_waitcnt(0xc07f); asm volatile("" ::: "memory");
        const int c = lane & 7;
#pragma unroll
        for (int j = 0; j < 8; ++j) { const int n = (lane >> 3) + 8 * j; const float* s = scr + (8 * c) * 65 + n;
            u32x4 o; o.x = pk2(s[0 * 65], s[1 * 65]); o.y = pk2(s[2 * 65], s[3 * 65]); o.z = pk2(s[4 * 65], s[5 * 65]); o.w = pk2(s[6 * 65], s[7 * 65]);
            __builtin_nontemporal_store(o, (u32x4*)(cur.dst + (size_t)(8 * j) * D)); }
        __builtin_amdgcn_s_waitcnt(0xc07f); asm volatile("" ::: "memory");
        if (more) {
#pragma unroll
            for (int i = 0; i < 16; ++i) v[i] = vn[i]; }
        cur = nx;
    }
    bf16_t* wrt = (bf16_t*)(C.ws + WS_WRT);
    for (int i = C.blk * NTHREADS + C.tid; i < NE * D; i += C.nblk * NTHREADS) {
        const int e = i / D, k = i % D; const float w = C.in[24][(size_t)k * NE + e];
        const unsigned hi = f2bf(w); const float lo = w - bf2f(hi);
        wrt[(size_t)e * 2048 + k] = (bf16_t)hi; wrt[(size_t)e * 2048 + 1024 + k] = (bf16_t)f2bf(lo);
    }
}

__device__ __forceinline__ void phase_mod(Ctx& C) {
    float* sc = (float*)C.lds;
    float* part = sc + 16 * 1024;
    float* mod = (float*)(C.ws + WS_MOD);
    for (int vb = C.blk; vb < 256; vb += C.nblk) {
        const int j0 = vb * 24;
        __syncthreads();
        for (int i = C.tid; i < 16 * D; i += NTHREADS) { const float c = C.in[1][i]; sc[i] = c / (1.0f + expf(-c)); }
        __syncthreads();
        if (C.tid < 504) {
            const int jj = C.tid % 24, isub = C.tid / 24;
            float acc[16];
#pragma unroll
            for (int b = 0; b < 16; ++b) acc[b] = 0.f;
            const float* w = C.in[2] + j0 + jj;
#pragma unroll 7
            for (int i = isub; i < D; i += 21) { const float wv = w[(size_t)i * 6 * D];
#pragma unroll
                for (int b = 0; b < 16; ++b) acc[b] = fmaf(sc[b * D + i], wv, acc[b]); }
#pragma unroll
            for (int b = 0; b < 16; ++b) part[(isub * 16 + b) * 24 + jj] = acc[b];
        }
        __syncthreads();
        if (C.tid < 384) { const int b = C.tid / 24, jj = C.tid % 24; float a = C.in[3][j0 + jj];
            for (int q = 0; q < 21; ++q) a += part[(q * 16 + b) * 24 + jj];
            mod[b * 6 * D + j0 + jj] = a; }
    }
    __syncthreads();
}

__device__ __forceinline__ void phase_filters(Ctx& C) {
    float* sh = (float*)C.lds;
    float* h3t = sh + 8 * 160;
    float* kfc = (float*)(C.ws + WS_KFC);
    const float* w1 = C.in[9]; const float* b1 = C.in[10]; const float* w2 = C.in[11]; const float* b2 = C.in[12];
    const float* w3 = C.in[13]; const float* b3 = C.in[14]; const float* w4 = C.in[15]; const float* fq = C.in[16];
    const int pl = C.tid >> 6, j = C.tid & 63;
    float* z = sh + pl * 160; float* ha = z + 32; float* hb = ha + 64;
    for (int vb = C.blk; vb < SEQ / 8; vb += C.nblk) {
        const int pos = vb * 8 + pl;
        const float tt = (float)pos / (float)(SEQ - 1);
        const float w = 6.283185307179586f * (float)pos / (float)SEQ;
        __syncthreads();
        if (j < 17) {
            float v;
            if (j == 0) v = tt;
            else { const int i = (j - 1) & 7; const float fr = 1e-4f + (float)i * ((7.0f - 1e-4f) / 7.0f); v = (j <= 8) ? cosf(fr * w) : -sinf(fr * w); }
            z[j] = v;
        }
        __syncthreads();
        { float a = b1[j];
#pragma unroll
          for (int i = 0; i < 17; ++i) a = fmaf(z[i], w1[i * FHID + j], a); ha[j] = sinf(fq[j] * a); }
        __syncthreads();
        { float a = b2[j];
#pragma unroll 32
          for (int i = 0; i < FHID; ++i) a = fmaf(ha[i], w2[i * FHID + j], a); hb[j] = sinf(fq[j] * a); }
        __syncthreads();
        { float a = b3[j];
#pragma unroll 32
          for (int i = 0; i < FHID; ++i) a = fmaf(hb[i], w3[i * FHID + j], a); h3t[j * 8 + pl] = sinf(fq[j] * a); }
        __syncthreads();
        float af[8], ab[8];
#pragma unroll
        for (int p = 0; p < 8; ++p) { af[p] = 0.f; ab[p] = 0.f; }
#pragma unroll 16
        for (int i = 0; i < FHID; ++i) { const float wa = w4[i * 2 * HW + C.tid], wb = w4[i * 2 * HW + HW + C.tid];
            const f32x4 h0 = *(const f32x4*)(h3t + i * 8), h1 = *(const f32x4*)(h3t + i * 8 + 4);
#pragma unroll
            for (int p = 0; p < 4; ++p) { af[p] = fmaf(h0[p], wa, af[p]); af[4 + p] = fmaf(h1[p], wa, af[4 + p]); ab[p] = fmaf(h0[p], wb, ab[p]); ab[4 + p] = fmaf(h1[p], wb, ab[4 + p]); } }
        const float min_decay = logf(1e-2f) / 1.5f, max_decay = logf(1e-2f) / 0.3f;
        const int c = C.tid, pos0 = vb * 8;
        const float adelta = fabsf(min_decay + (float)c * ((max_decay - min_decay) / 511.0f));
#pragma unroll
        for (int p = 0; p < 8; ++p) { const float dec = expf(-((float)(pos0 + p) / (float)(SEQ - 1)) * adelta); af[p] *= dec; ab[p] *= dec; }
        float* dst = kfc + (size_t)c * 4096 + 2048 + pos0;
        *(f32x4*)dst = (f32x4){af[0], af[1], af[2], af[3]}; *(f32x4*)(dst + 4) = (f32x4){af[4], af[5], af[6], af[7]};
        float* dsb = kfc + (size_t)c * 4096 + 2048 - pos0;
#pragma unroll
        for (int p = 0; p < 8; ++p) if (pos0 + p >= 1) dsb[-p] = ab[p];
    }
    __syncthreads();
}

__device__ __forceinline__ void phase_norm1(Ctx& C) {
    const float* mod = (const float*)(C.ws + WS_MOD); bf16_t* h = (bf16_t*)(C.ws + WS_H);
    const float* g = C.in[4];
    for (int row = C.gw; row < T; row += C.ngw) {
        const int b = row / SEQ;
        const f32x4* xr = (const f32x4*)(C.in[0] + (size_t)row * D) + C.lane;
        f32x4 v[4]; float s = 0.f;
#pragma unroll
        for (int j = 0; j < 4; ++j) { v[j] = __builtin_nontemporal_load(xr + 64 * j); s += (v[j].x * v[j].x + v[j].y * v[j].y) + (v[j].z * v[j].z + v[j].w * v[j].w); }
        const float rstd = 1.0f / sqrtf(wave_sum(s) * (1.0f / D) + EPS);
        const float* sh = mod + (size_t)b * 6 * D; const float* sc = sh + D;
        u32x2* o = (u32x2*)(h + (size_t)row * D) + C.lane;
#pragma unroll
        for (int j = 0; j < 4; ++j) { const int i0 = 4 * C.lane + 256 * j;
            const f32x4 gg = *(const f32x4*)(g + i0), s1 = *(const f32x4*)(sc + i0), s0 = *(const f32x4*)(sh + i0);
            f32x4 r; r.x = v[j].x * rstd * gg.x * (1.f + s1.x) + s0.x; r.y = v[j].y * rstd * gg.y * (1.f + s1.y) + s0.y;
            r.z = v[j].z * rstd * gg.z * (1.f + s1.z) + s0.z; r.w = v[j].w * rstd * gg.w * (1.f + s1.w) + s0.w;
            u32x2 w; w.x = pk2(r.x, r.y); w.y = pk2(r.z, r.w); o[64 * j] = w; }
    }
}

__device__ __forceinline__ void phase_final(Ctx& C) {
    const float* mod = (const float*)(C.ws + WS_MOD); const bf16_t* slots = (const bf16_t*)(C.ws + WS_SLOTS); const int* rowinv = (const int*)(C.ws + WS_TOPE);
    const bf16_t* x1 = (const bf16_t*)(C.ws + WS_X1);
    const float* g = C.in[30];
    for (int row = C.gw; row < T; row += C.ngw) {
        const int b = row / SEQ;
        f32x4* xr = (f32x4*)(C.out + (size_t)row * D) + C.lane;
        const float* g2 = mod + (size_t)b * 6 * D + 5 * D;
        f32x4 v[4]; float s = 0.f; const int4 rr4 = *(const int4*)(rowinv + (size_t)row * 4); const int rk[4] = {rr4.x, rr4.y, rr4.z, rr4.w};
#pragma unroll
        for (int j = 0; j < 4; ++j) { const int i0 = 4 * C.lane + 256 * j;
            f32x4 m = {0.f, 0.f, 0.f, 0.f};
#pragma unroll
            for (int k = 0; k < 4; ++k) { const u32x2 w = __builtin_nontemporal_load((const u32x2*)(slots + (size_t)rk[k] * D + i0));
                m.x += bflo(w.x); m.y += bfhi(w.x); m.z += bflo(w.y); m.w += bfhi(w.y); }
            const f32x4 gg = *(const f32x4*)(g2 + i0);
            const u32x2 xw = __builtin_nontemporal_load((const u32x2*)(x1 + (size_t)row * D + i0));
            v[j].x = bflo(xw.x) + gg.x * m.x; v[j].y = bfhi(xw.x) + gg.y * m.y; v[j].z = bflo(xw.y) + gg.z * m.z; v[j].w = bfhi(xw.y) + gg.w * m.w;
            s += (v[j].x * v[j].x + v[j].y * v[j].y) + (v[j].z * v[j].z + v[j].w * v[j].w); }
        const float rstd = 1.0f / sqrtf(wave_sum(s) * (1.0f / D) + EPS);
#pragma unroll
        for (int j = 0; j < 4; ++j) { const int i0 = 4 * C.lane + 256 * j; const f32x4 gg = *(const f32x4*)(g + i0);
            f32x4 r; r.x = v[j].x * rstd * gg.x; r.y = v[j].y * rstd * gg.y; r.z = v[j].z * rstd * gg.z; r.w = v[j].w * rstd * gg.w; __builtin_nontemporal_store(r, xr + 64 * j); }
    }
}

namespace pg8 {
#define PG8_LAS __attribute__((address_space(3)))
constexpr int BM = 256, BK = 64, HALF = 128, HTB = HALF * BK * 2, STAGE_BYTES = 8 * HTB, NXCD = 8, WGM = 8;
__device__ __forceinline__ int lds_byte(int r, int c) { const int st = (r >> 4) * 2 + (c >> 5), rr = r & 15, cc = c & 31, ob = rr * 64 + cc * 2; return st * 1024 + (ob ^ (((ob >> 9) & 1) << 5)); }
__device__ __forceinline__ void stage_rc(int b, int& R, int& C) { const int st = b / 1024, sb = b % 1024, swz = sb ^ (((sb >> 9) & 1) << 5); R = (st >> 1) * 16 + swz / 64; C = (st & 1) * 32 + (swz % 64) / 2; }
__device__ __forceinline__ int perm32(int rho) { const int n = rho >> 4, i = rho & 15; return 8 * (i >> 2) + 4 * n + (i & 3); }
struct Unit { int pm, pn; };
struct Gemm { const bf16_t* A; const bf16_t* Bt; int lda, ldb, K; const int* rowidx; };
struct StaticOrder {
    int nM, nN, nwg, G, c;
    __device__ void init(int nM_, int nN_, int G_, int c_) { nM = nM_; nN = nN_; nwg = nM * nN; G = G_; c = c_; }
    __device__ bool next(int i, Unit& u) const {
        const long L = (long)i * G + c; if (L >= nwg) return false;
        int wgid = (int)L; { const int q = nwg / NXCD, r = nwg % NXCD, xcd = wgid % NXCD, off = wgid / NXCD; wgid = (xcd < r ? xcd * (q + 1) : r * (q + 1) + (xcd - r) * q) + off; }
        const int nig = WGM * nN, gid = wgid / nig, fm = gid * WGM, gsz = (nM - fm) < WGM ? (nM - fm) : WGM;
        u.pm = fm + ((wgid % nig) % gsz); u.pn = (wgid % nig) / gsz; return true;
    }
};
struct MoeOrder {
    StaticOrder b; const PG8_LAS int* tileexp; int nN;
    __device__ bool next(int i, Unit& u) const { if (!b.next(i, u)) return false; u.pn = tileexp[u.pm] * nN + u.pn; return true; }
};
__device__ __forceinline__ unsigned cvt_pk_bf16(float lo, float hi) { unsigned r; asm volatile("v_cvt_pk_bf16_f32 %0, %1, %2" : "=v"(r) : "v"(lo), "v"(hi)); return r; }

template <class Epi, class Sched, bool GATHER, bool MIDHOOK = false>
__device__ __forceinline__ void gemm_phase(PG8_LAS unsigned char* lds, const Gemm g, const Sched& S, const Epi& E, const int wid_) {
    const int wid = wid_, lane = fresh_lane(), tid = wid * 64 + lane, wr = wid >> 2, wc = wid & 3, fr = lane & 15, fq = lane >> 4;
    const int K = g.K, nt = K / BK;
    int RA[2]; unsigned cA2[2], voffB[2];
#pragma unroll
    for (int i = 0; i < 2; ++i) { int R, C; stage_rc(tid * 16 + i * 8192, R, C); const int Rb = Epi::PERM ? ((R & ~31) + perm32(R & 31)) : R;
        RA[i] = R; cA2[i] = (unsigned)C * 2u; voffB[i] = (unsigned)(Rb * g.ldb + C) * 2u; }
    const unsigned lda2 = (unsigned)g.lda * 2u;
    const size_t kstep = (size_t)(BK * 2);
    const size_t hstep = (size_t)HALF * g.ldb * 2;
    const size_t tstep = 2 * hstep;
    const unsigned ldsw = (unsigned)wid * 1024u;
    const int aoff = lds_byte(wr * 64 + fr, fq * 8), boff = lds_byte(wc * 32 + fr, fq * 8);
#define PG8_SA(b, h) (((b) * 2 + (h)) * HTB)
#define PG8_SB(b, h) ((4 + (b) * 2 + (h)) * HTB)
#define PG8_STAGE(bufoff, gbase, voff) do { _Pragma("unroll") for (int _i = 0; _i < 2; ++_i) \
        __builtin_amdgcn_global_load_lds((const unsigned*)((const char*)(gbase) + (voff)[_i]), (PG8_LAS unsigned*)(lds + (bufoff) + ldsw + _i * 8192), 16, 0, 0); } while (0)
#define PG8_AOFFS(dst, u_) do { _Pragma("unroll") for (int _h = 0; _h < 2; ++_h) _Pragma("unroll") for (int _i = 0; _i < 2; ++_i) { \
        int _row = (u_).pm * BM + _h * HALF + RA[_i]; if (GATHER) { const int _p = g.rowidx[_row]; _row = _p >= 0 ? (_p >> 2) : 0; } \
        dst[_h][_i] = (unsigned)_row * lda2 + cA2[_i]; } } while (0)
      \
#define PG8_AOFFS_RAW(dst, u_) do { _Pragma("unroll") for (int _h = 0; _h < 2; ++_h) _Pragma("unroll") for (int _i = 0; _i < 2; ++_i) { \
        const int _row = (u_).pm * BM + _h * HALF + RA[_i]; dst[_h][_i] = GATHER ? (unsigned)g.rowidx[_row] : (unsigned)_row; } } while (0)
#define PG8_AOFFS_FIN(dst) do { _Pragma("unroll") for (int _h = 0; _h < 2; ++_h) _Pragma("unroll") for (int _i = 0; _i < 2; ++_i) { \
        int _row = (int)dst[_h][_i]; if (GATHER) _row = _row >= 0 ? (_row >> 2) : 0; dst[_h][_i] = (unsigned)_row * lda2 + cA2[_i]; } } while (0)
#define PG8_LDA(dst, b, h) do { _Pragma("unroll") for (int m = 0; m < 4; ++m) _Pragma("unroll") for (int k = 0; k < 2; ++k) dst[m][k] = *(const PG8_LAS bf16x8*)(lds + PG8_SA(b, h) + aoff + m * 2048 + k * 1024); } while (0)
#define PG8_LDB(dst, b, h) do { _Pragma("unroll") for (int n = 0; n < 2; ++n) _Pragma("unroll") for (int k = 0; k < 2; ++k) dst[n][k] = *(const PG8_LAS bf16x8*)(lds + PG8_SB(b, h) + boff + n * 2048 + k * 1024); } while (0)
#define PG8_MMA(ai, bj, At, Bt) do { __builtin_amdgcn_s_setprio(1); _Pragma("unroll") for (int m = 0; m < 4; ++m) _Pragma("unroll") for (int n = 0; n < 2; ++n) _Pragma("unroll") for (int k = 0; k < 2; ++k) \
        acc[ai][bj][m][n] = __builtin_amdgcn_mfma_f32_16x16x32_bf16(Bt[n][k], At[m][k], acc[ai][bj][m][n], 0, 0, 0); __builtin_amdgcn_s_setprio(0); } while (0)
#define PG8_WAIT_V(n) asm volatile("s_waitcnt vmcnt(" #n ")" ::: "memory")
#define PG8_WAIT_L(n) asm volatile("s_waitcnt lgkmcnt(" #n ")" ::: "memory")
#define PG8_BAR __builtin_amdgcn_s_barrier()
#define PG8_SCHED __builtin_amdgcn_sched_barrier(0)
    Unit cur, nxt; int ui = 0;
    if (!S.next(0, cur)) return;
    f32x4 acc[2][2][4][2];
#pragma unroll
    for (int a = 0; a < 2; ++a)
#pragma unroll
        for (int b = 0; b < 2; ++b)
#pragma unroll
            for (int m = 0; m < 4; ++m)
#pragma unroll
                for (int n = 0; n < 2; ++n) acc[a][b][m][n] = (f32x4){0.f, 0.f, 0.f, 0.f};
    bf16x8 At[4][2], B0[2][2], B1[2][2];
    unsigned cv[2][2], nv[2][2];
    PG8_AOFFS(cv, cur);
    const char* const Ab = (const char*)g.A;
    const char* cB = (const char*)g.Bt + (size_t)cur.pn * tstep;
    PG8_STAGE(PG8_SB(0, 0), cB, voffB); PG8_STAGE(PG8_SB(0, 1), cB + hstep, voffB); PG8_STAGE(PG8_SA(0, 0), Ab, cv[0]); PG8_STAGE(PG8_SA(0, 1), Ab, cv[1]);
    if (wr == 1) PG8_BAR;
    PG8_WAIT_V(2); PG8_BAR;
    PG8_STAGE(PG8_SB(1, 0), cB + kstep, voffB); PG8_STAGE(PG8_SA(1, 0), Ab + kstep, cv[0]); PG8_STAGE(PG8_SB(1, 1), cB + hstep + kstep, voffB);
    PG8_WAIT_V(6); PG8_BAR;
    for (;;) {
        const bool has_next = S.next(ui + 1, nxt);
        if (has_next) { if constexpr (GATHER) { PG8_AOFFS_RAW(nv, nxt); } else { PG8_AOFFS(nv, nxt); } } else {
#pragma unroll
            for (int h = 0; h < 2; ++h)
#pragma unroll
                for (int i = 0; i < 2; ++i) nv[h][i] = cv[h][i]; }
        const char* nB = has_next ? (const char*)g.Bt + (size_t)nxt.pn * tstep : cB;
#define PG8_KSTEP(t) do { \
            const bool last = (t == nt - 2); \
            const char* a1 = Ab + (size_t)(t + 1) * kstep; \
            const char* a2 = last ? Ab : Ab + (size_t)(t + 2) * kstep; const char* b2 = last ? nB : cB + (size_t)(t + 2) * kstep; \
            const char* a3 = a2 + kstep; const char* b3 = b2 + kstep; \
            unsigned sv[2][2]; \
            if constexpr (GATHER) { \
                _Pragma("unroll") for (int h = 0; h < 2; ++h) _Pragma("unroll") for (int i = 0; i < 2; ++i) sv[h][i] = cv[h][i]; \
                if (last) { asm volatile("" : "+v"(nv[0][0]), "+v"(nv[0][1]), "+v"(nv[1][0]), "+v"(nv[1][1])); if (has_next) PG8_AOFFS_FIN(nv); _Pragma("unroll") for (int h = 0; h < 2; ++h) _Pragma("unroll") for (int i = 0; i < 2; ++i) sv[h][i] = nv[h][i]; } \
            } else { _Pragma("unroll") for (int h = 0; h < 2; ++h) _Pragma("unroll") for (int i = 0; i < 2; ++i) sv[h][i] = last ? nv[h][i] : cv[h][i]; } \
            PG8_LDB(B0, 0, 0); PG8_LDB(B1, 0, 1); PG8_SCHED; PG8_LDA(At, 0, 0); PG8_STAGE(PG8_SA(1, 1), a1, cv[1]); \
            PG8_WAIT_V(8); PG8_WAIT_L(0); PG8_BAR; PG8_MMA(0, 0, At, B0); PG8_MMA(0, 1, At, B1); PG8_BAR; PG8_SCHED; \
            PG8_LDA(At, 0, 1); PG8_STAGE(PG8_SB(0, 0), b2, voffB); PG8_STAGE(PG8_SB(0, 1), b2 + hstep, voffB); PG8_STAGE(PG8_SA(0, 0), a2, sv[0]); \
            PG8_WAIT_V(8); PG8_WAIT_L(0); PG8_BAR; PG8_MMA(1, 0, At, B0); PG8_MMA(1, 1, At, B1); PG8_BAR; PG8_SCHED; \
            PG8_LDB(B0, 1, 0); PG8_LDB(B1, 1, 1); PG8_SCHED; PG8_LDA(At, 1, 0); PG8_STAGE(PG8_SA(0, 1), a2, sv[1]); \
            PG8_WAIT_V(8); PG8_WAIT_L(0); PG8_BAR; PG8_MMA(0, 0, At, B0); PG8_MMA(0, 1, At, B1); PG8_BAR; PG8_SCHED; \
            PG8_LDA(At, 1, 1); PG8_STAGE(PG8_SB(1, 0), b3, voffB); PG8_STAGE(PG8_SB(1, 1), b3 + hstep, voffB); PG8_STAGE(PG8_SA(1, 0), a3, sv[0]); \
            PG8_WAIT_V(8); PG8_WAIT_L(0); PG8_BAR; PG8_MMA(1, 0, At, B0); PG8_MMA(1, 1, At, B1); PG8_BAR; PG8_SCHED; \
        } while (0)
        if constexpr (MIDHOOK) {
            for (int t = 0; t < nt / 2; t += 2) PG8_KSTEP(t);
            E.mid(acc, cur, wr, wc, fr, fq);
            for (int t = nt / 2; t < nt; t += 2) PG8_KSTEP(t);
        } else {
            for (int t = 0; t < nt; t += 2) PG8_KSTEP(t);
        }
#undef PG8_KSTEP
        if (wr == 0) PG8_BAR;
        E(acc, cur, wr, wc, fr, fq);
        if (!has_next) break;
#pragma unroll
        for (int a = 0; a < 2; ++a)
#pragma unroll
            for (int b = 0; b < 2; ++b)
#pragma unroll
                for (int m = 0; m < 4; ++m)
#pragma unroll
                    for (int n = 0; n < 2; ++n) acc[a][b][m][n] = (f32x4){0.f, 0.f, 0.f, 0.f};
        cur = nxt; cB = nB; ++ui;
#pragma unroll
        for (int h = 0; h < 2; ++h)
#pragma unroll
            for (int i = 0; i < 2; ++i) cv[h][i] = nv[h][i];
        if (wr == 1) PG8_BAR;
    }
    PG8_WAIT_V(0);
    PG8_BAR;
#undef PG8_SA
#undef PG8_SB
#undef PG8_STAGE
#undef PG8_AOFFS
#undef PG8_AOFFS_RAW
#undef PG8_AOFFS_FIN
#undef PG8_LDA
#undef PG8_LDB
#undef PG8_MMA
#undef PG8_WAIT_V
#undef PG8_WAIT_L
#undef PG8_BAR
#undef PG8_SCHED
}

__device__ __forceinline__ u32x4 pack8(const f32x4& v0, const f32x4& v1) { u32x4 w; w.x = cvt_pk_bf16(v0[0], v0[1]); w.y = cvt_pk_bf16(v0[2], v0[3]); w.z = cvt_pk_bf16(v1[0], v1[1]); w.w = cvt_pk_bf16(v1[2], v1[3]); return w; }
__device__ __forceinline__ void unpack8(const u32x4& w, f32x4& v0, f32x4& v1) { v0 = (f32x4){bflo(w.x), bfhi(w.x), bflo(w.y), bfhi(w.y)}; v1 = (f32x4){bflo(w.z), bfhi(w.z), bflo(w.w), bfhi(w.w)}; }
__device__ __forceinline__ float fsig(float x) { return __builtin_amdgcn_rcpf(1.0f + __builtin_amdgcn_exp2f(-LOG2E * x)); }

template <int MODE = 0> struct EpiInprojT {
    static constexpr bool PERM = true;
    bf16_t* U; const float* bias;
    __device__ __forceinline__ void operator()(const f32x4 (&acc)[2][2][4][2], const Unit& u, int wr, int wc, int fr, int fq) const {
        if (MODE == 2) { _Pragma("unroll") for (int a_ = 0; a_ < 2; ++a_) _Pragma("unroll") for (int b_ = 0; b_ < 2; ++b_) _Pragma("unroll") for (int m_ = 0; m_ < 4; ++m_) _Pragma("unroll") for (int n_ = 0; n_ < 2; ++n_) asm volatile("" :: "v"(acc[a_][b_][m_][n_])); return; }
        const int row0 = u.pm * BM + wr * 64 + fr, col0 = u.pn * BM + wc * 32 + 8 * fq; const float qs = (u.pn == 6 || u.pn == 7) ? QSCALE : 1.0f;
        if (u.pn >= 12) {
            const int c0 = 128 * (u.pn - 12) + wc * 32 + 8 * fq;
            f32x4 ba[2], bb[2];
#pragma unroll
            for (int n = 0; n < 2; ++n) { ba[n] = *(const f32x4*)(bias + GOFF + c0 + 4 * n); bb[n] = *(const f32x4*)(bias + GOFF + D + c0 + 4 * n); }
#pragma unroll
            for (int ai = 0; ai < 2; ++ai)
#pragma unroll
                for (int m = 0; m < 4; ++m) { bf16_t* rowp = U + (size_t)(row0 + ai * HALF + m * 16) * INC + GOFF + c0; f32x4 rr[2], sb[2];
#pragma unroll
                    for (int n = 0; n < 2; ++n) { const f32x4 a = acc[ai][0][m][n] + ba[n], b = acc[ai][1][m][n] + bb[n];
#pragma unroll
                        for (int i = 0; i < 4; ++i) { const float ea = __builtin_amdgcn_exp2f(-LOG2E * a[i]), eb = __builtin_amdgcn_exp2f(-LOG2E * b[i]); const float s2 = __builtin_amdgcn_rcpf(1.0f + eb);
                            sb[n][i] = s2; rr[n][i] = (1.0f + eb) * __builtin_amdgcn_rcpf(1.0f + ea); } }
                    const u32x4 wr_ = pack8(rr[0], rr[1]), ws_ = pack8(sb[0], sb[1]);
                    if (MODE == 0) { *(u32x4*)rowp = wr_; *(u32x4*)(rowp + D) = ws_; } else asm volatile("" :: "v"(wr_), "v"(ws_)); }
            return;
        }
        const bool sig = false;
        f32x4 bv[2][2];
#pragma unroll
        for (int bj = 0; bj < 2; ++bj)
#pragma unroll
            for (int n = 0; n < 2; ++n) bv[bj][n] = *(const f32x4*)(bias + col0 + bj * HALF + 4 * n);
#pragma unroll
        for (int ai = 0; ai < 2; ++ai)
#pragma unroll
            for (int m = 0; m < 4; ++m) { bf16_t* rowp = U + (size_t)(row0 + ai * HALF + m * 16) * INC + col0;
#pragma unroll
                for (int bj = 0; bj < 2; ++bj) { f32x4 v0 = (acc[ai][bj][m][0] + bv[bj][0]) * qs, v1 = (acc[ai][bj][m][1] + bv[bj][1]) * qs;
                    if (sig) {
#pragma unroll
                        for (int i = 0; i < 4; ++i) { v0[i] = fsig(v0[i]); v1[i] = fsig(v1[i]); } }
                    const u32x4 w_ = pack8(v0, v1);
                    if (MODE == 0) *(u32x4*)(rowp + bj * HALF) = w_; else asm volatile("" :: "v"(w_)); } }
    }
};
typedef EpiInprojT<0> EpiInproj;
template <int P> struct EpiCat {
    static constexpr bool PERM = true;
    bf16_t* Mg; const bf16_t* U;
    __device__ __forceinline__ void operator()(const f32x4 (&acc)[2][2][4][2], const Unit& u, int wr, int wc, int fr, int fq) const {
        const int row0 = u.pm * BM + wr * 64 + fr, col0 = u.pn * BM + wc * 32 + 8 * fq;
#pragma unroll
        for (int ai = 0; ai < 2; ++ai)
#pragma unroll
            for (int m = 0; m < 4; ++m) { const size_t row = (size_t)(row0 + ai * HALF + m * 16);
#pragma unroll
                for (int bj = 0; bj < 2; ++bj) { const u32x4 gw = *(const u32x4*)(U + row * INC + GOFF + P * D + col0 + bj * HALF);
                    f32x4 g0, g1; unpack8(gw, g0, g1); f32x4 v0 = acc[ai][bj][m][0] * g0, v1 = acc[ai][bj][m][1] * g1;
                    bf16_t* mp = Mg + row * D + col0 + bj * HALF;
                    if (P == 1) { const u32x4 tw = *(const u32x4*)mp; f32x4 t0, t1; unpack8(tw, t0, t1); v0 += t0; v1 += t1; }
                    *(u32x4*)mp = pack8(v0, v1); } }
    }
};
struct EpiCatR {
    static constexpr bool PERM = true;
    bf16_t* Mg; const bf16_t* U;
    __device__ __forceinline__ void mid(f32x4 (&acc)[2][2][4][2], const Unit& u, int wr, int wc, int fr, int fq) const {
        int row0 = u.pm * BM + wr * 64 + fr; asm volatile("" : "+v"(row0));
        const int col0 = u.pn * BM + wc * 32 + 8 * fq;
#pragma unroll
        for (int ai = 0; ai < 2; ++ai) { asm volatile("" ::: "memory");
#pragma unroll
            for (int m = 0; m < 4; ++m) { const size_t row = (size_t)(row0 + ai * HALF + m * 16);
#pragma unroll
                for (int bj = 0; bj < 2; ++bj) { const u32x4 gw1 = *(const u32x4*)(U + row * INC + GOFF + col0 + bj * HALF);
                    f32x4 a0, a1; unpack8(gw1, a0, a1); acc[ai][bj][m][0] *= a0; acc[ai][bj][m][1] *= a1; } } }
        asm volatile("" ::: "memory");
    }
    __device__ __forceinline__ void operator()(const f32x4 (&acc)[2][2][4][2], const Unit& u, int wr, int wc, int fr, int fq) const {
        const int row0 = u.pm * BM + wr * 64 + fr, col0 = u.pn * BM + wc * 32 + 8 * fq;
#pragma unroll
        for (int ai = 0; ai < 2; ++ai)
#pragma unroll
            for (int m = 0; m < 4; ++m) { const size_t row = (size_t)(row0 + ai * HALF + m * 16);
#pragma unroll
                for (int bj = 0; bj < 2; ++bj) { const u32x4 gw = *(const u32x4*)(U + row * INC + GOFF + D + col0 + bj * HALF);
                    f32x4 g0, g1; unpack8(gw, g0, g1);
                    *(u32x4*)(Mg + row * D + col0 + bj * HALF) = pack8(acc[ai][bj][m][0] * g0, acc[ai][bj][m][1] * g1); } }
    }
};
struct EpiMix {
    static constexpr bool PERM = true;
    const float* X; bf16_t* O; const float* mod; float* ssq;
    __device__ __forceinline__ void operator()(const f32x4 (&acc)[2][2][4][2], const Unit& u, int wr, int wc, int fr, int fq) const {
        const int row0 = u.pm * BM + wr * 64 + fr, col0 = u.pn * BM + wc * 32 + 8 * fq; const int b = (u.pm * BM) / SEQ;
        f32x4 gv[2][2];
#pragma unroll
        for (int bj = 0; bj < 2; ++bj)
#pragma unroll
            for (int n = 0; n < 2; ++n) gv[bj][n] = *(const f32x4*)(mod + (size_t)b * 6 * D + 2 * D + col0 + bj * HALF + 4 * n);
#pragma unroll
        for (int ai = 0; ai < 2; ++ai)
#pragma unroll
            for (int m = 0; m < 4; ++m) { const size_t off = (size_t)(row0 + ai * HALF + m * 16) * D + col0; float sq = 0.f;
#pragma unroll
                for (int bj = 0; bj < 2; ++bj) { f32x4 v[2];
#pragma unroll
                    for (int n = 0; n < 2; ++n) { v[n] = *(const f32x4*)(X + off + bj * HALF + 4 * n) + gv[bj][n] * acc[ai][bj][m][n]; }
                    const u32x4 w = pack8(v[0], v[1]); *(u32x4*)(O + off + bj * HALF) = w;
                    f32x4 r0, r1; unpack8(w, r0, r1);
                    sq += ((r0.x * r0.x + r0.y * r0.y) + (r0.z * r0.z + r0.w * r0.w)) + ((r1.x * r1.x + r1.y * r1.y) + (r1.z * r1.z + r1.w * r1.w)); }
                sq += __shfl_xor(sq, 16); sq += __shfl_xor(sq, 32);
                if (fq == 0) ssq[(size_t)(row0 + ai * HALF + m * 16) * 16 + u.pn * 4 + wc] = sq; }
    }
};
struct EpiGateUp {
    static constexpr bool PERM = true;
    bf16_t* Act; const float* bgu;
    __device__ __forceinline__ void operator()(const f32x4 (&acc)[2][2][4][2], const Unit& u, int wr, int wc, int fr, int fq) const {
        const int e = u.pn >> 3, j = u.pn & 7; const int row0 = u.pm * BM + wr * 64 + fr, col0 = 128 * j + wc * 32 + 8 * fq;
        f32x4 bg[2], bu[2];
#pragma unroll
        for (int n = 0; n < 2; ++n) { bg[n] = *(const f32x4*)(bgu + (size_t)e * 2 * D + col0 + 4 * n); bu[n] = *(const f32x4*)(bgu + (size_t)e * 2 * D + D + col0 + 4 * n); }
#pragma unroll
        for (int ai = 0; ai < 2; ++ai)
#pragma unroll
            for (int m = 0; m < 4; ++m) { f32x4 r[2];
#pragma unroll
                for (int n = 0; n < 2; ++n) { const f32x4 gt = acc[ai][0][m][n] + bg[n], up = acc[ai][1][m][n] + bu[n];
#pragma unroll
                    for (int i = 0; i < 4; ++i) { const float gg = fminf(gt[i], 7.0f), uu = fminf(fmaxf(up[i], -7.0f), 7.0f); r[n][i] = (uu + 1.0f) * (gg * fsig(1.702f * gg)); } }
                *(u32x4*)(Act + (size_t)(row0 + ai * HALF + m * 16) * D + col0) = pack8(r[0], r[1]); }
    }
};
struct EpiDown {
    static constexpr bool PERM = true;
    bf16_t* Slots; const float* bd; const float* roww;
    __device__ __forceinline__ void operator()(const f32x4 (&acc)[2][2][4][2], const Unit& u, int wr, int wc, int fr, int fq) const {
        const int e = u.pn >> 2, j = u.pn & 3; const int row0 = u.pm * BM + wr * 64 + fr, col0 = 256 * j + wc * 32 + 8 * fq;
        f32x4 bv[2][2];
#pragma unroll
        for (int bj = 0; bj < 2; ++bj)
#pragma unroll
            for (int n = 0; n < 2; ++n) bv[bj][n] = *(const f32x4*)(bd + (size_t)e * D + col0 + bj * HALF + 4 * n);
#pragma unroll
        for (int ai = 0; ai < 2; ++ai)
#pragma unroll
            for (int m = 0; m < 4; ++m) { const int row = row0 + ai * HALF + m * 16; const float w = roww[row];
#pragma unroll
                for (int bj = 0; bj < 2; ++bj) { const f32x4 v0 = (acc[ai][bj][m][0] + bv[bj][0]) * w, v1 = (acc[ai][bj][m][1] + bv[bj][1]) * w;
                    *(u32x4*)(Slots + (size_t)row * D + col0 + bj * HALF) = pack8(v0, v1); } }
    }
};
}

#define LASP __attribute__((address_space(3)))
__device__ __forceinline__ void glds16(const void* gsrc, unsigned lds_dst) { unsigned keep;
    asm volatile("s_mov_b32 %0, m0\n\ts_mov_b32 m0, %2\n\ts_nop 0\n\tglobal_load_lds_dwordx4 %1, off\n\ts_mov_b32 m0, %0" : "=&s"(keep) : "v"(gsrc), "s"(lds_dst) : "memory"); }
__device__ __forceinline__ void glds16s(const void* sbase, unsigned voff, unsigned lds_dst) { unsigned keep;
    asm volatile("s_nop 4\n\ts_mov_b32 %0, m0\n\ts_mov_b32 m0, %3\n\ts_nop 0\n\tglobal_load_lds_dwordx4 %1, %2\n\ts_mov_b32 m0, %0" : "=&s"(keep) : "v"(voff), "s"(sbase), "s"(lds_dst) : "memory"); }
typedef short v4i16_t __attribute__((ext_vector_type(4)));
__device__ __forceinline__ s16x4 vtr(const LASP char* p) { return __builtin_bit_cast(s16x4, __builtin_amdgcn_ds_read_tr16_b64_v4i16((LASP v4i16_t*)p)); }
typedef float f32x2_t __attribute__((ext_vector_type(2))); typedef __bf16 bf16x2_t __attribute__((ext_vector_type(2)));
__device__ __forceinline__ unsigned cvtpk(float lo, float hi) { f32x2_t v = {lo, hi}; bf16x2_t b = __builtin_convertvector(v, bf16x2_t); return __builtin_bit_cast(unsigned, b); }

__device__ __forceinline__ float max3f(float a, float b, float c) { float r; asm("v_max3_f32 %0, %1, %2, %3" : "=v"(r) : "v"(a), "v"(b), "v"(c)); return r; }
__device__ __forceinline__ float fadd_s(float a, float b) { float r; asm("v_add_f32_e32 %0, %1, %2" : "=v"(r) : "v"(a), "v"(b)); return r; }
__device__ __forceinline__ unsigned bfbits(float f) { return f2bf(f); }
__device__ __forceinline__ void phase_attn_fast(Ctx& C) {
    const bf16_t* u = (const bf16_t*)(C.ws + WS_U); bf16_t* ycat = (bf16_t*)(C.ws + WS_YCAT);
    const int wave = C.wave;
    const float* lq = C.in[18];
    float lam;
    { const int l_ = lane_id(); const float d1 = wave_sum(lq[l_] * lq[64 + l_]), d2 = wave_sum(lq[128 + l_] * lq[192 + l_]); lam = __builtin_bit_cast(float, __builtin_amdgcn_readfirstlane(__builtin_bit_cast(int, expf(d1) - expf(d2) + 0.2f))); }
    const unsigned lds0 = (unsigned)(uintptr_t)C.lds;
    const LASP char* ldsp = (const LASP char*)C.lds;
    constexpr int SLOT = 24576;
    const int vcu = (C.nblk % 8 == 0) ? (C.blk % 8) * (C.nblk / 8) + C.blk / 8 : C.blk;
    for (int idx = vcu; idx < 256; idx += C.nblk)
#pragma unroll 1
    for (int sub = 0; sub < 2; ++sub) {
        const int b = idx >> 4, hA = (idx >> 3) & 1, qb = idx & 7; const int hh = sub ? 3 - hA : hA;
        const int lane = fresh_lane();
        const int l31 = lane & 31, hi = lane >> 5;
        const int krow = 8 * wave + (lane >> 3), kchunk = (lane & 7) ^ (lane >> 3);
        const int st0 = 4 * wave + (lane >> 5), st1 = st0 + 2;
        const int vrow = (lane & 31) >> 2, vch = lane & 3;
        const unsigned koffb = (unsigned)((krow * INC + kchunk * 8) * 2);
        const unsigned voffb0 = (unsigned)(((8 * (st0 >> 2) + vrow) * INC + 32 * (st0 & 3) + 8 * vch) * 2);
        const unsigned voffb1 = (unsigned)(((8 * (st1 >> 2) + vrow) * INC + 32 * (st1 & 3) + 8 * vch) * 2);
        const int koff0 = l31 * 128, kx = l31 & 7;
        const int vboff = 8192 + (4 * hi + ((lane & 15) >> 2)) * 64 + ((lane >> 4) & 1) * 32 + (lane & 3) * 8;
        const unsigned hm0 = hi ? 0u : 0xffffffffu;
        const unsigned dkdk = hi ? 0u : bfbits((float)l31) * 0x10001u;
        const int q0 = qb * 256 + wave * 32;
        const float slope2 = exp2f(-2.0f * (float)(hh + 1)) * LOG2E;
        const unsigned SH = bfbits(slope2); const unsigned SL = bfbits(slope2 - bf2f(SH)); const unsigned SHSL = SH | (SL << 16);
        const float slope2q = bf2f(SH) + bf2f(SL);
        const unsigned kw0b = hi ? 0x3f803f80u : SHSL, kw1b = hi ? 0x00003f80u : SHSL, ksm = hi ? 0u : 0x80008000u;
        const unsigned qa0 = bfbits((float)q0) * 0x10001u, qa1 = bfbits((float)l31) * 0x10001u;
        const float qpos = (float)(q0 + l31 - 4 * hi);
        const bf16_t* qrow = u + (size_t)(b * SEQ + q0 + l31) * INC + QOFF + hh * 128;
        const bf16_t* kgb = u + (size_t)(b * SEQ) * INC + KOFF + hh * 128;
        const bf16_t* vgb = u + (size_t)(b * SEQ) * INC + VOFF + hh * 128;
        const int t0 = qb * 4, tdiag = q0 >> 6;
#pragma unroll 1
        for (int c = 0; c < 2; ++c) {
            const bf16_t* kgc = kgb + c * 64;
#define ATT_DMA(t, sl) do { const size_t _o = (size_t)(t) * 64 * INC; const unsigned _b = lds0 + (unsigned)(sl) * SLOT; \
        glds16s(kgc + _o, koffb, (unsigned)__builtin_amdgcn_readfirstlane(_b + wave * 1024)); \
        glds16s(vgb + _o, voffb0, (unsigned)__builtin_amdgcn_readfirstlane(_b + 8192 + (2 * wave) * 1024)); \
        glds16s(vgb + _o, voffb1, (unsigned)__builtin_amdgcn_readfirstlane(_b + 8192 + (2 * wave + 1) * 1024)); } while (0)
#define ATT_WAITBAR() asm volatile("s_waitcnt vmcnt(0) lgkmcnt(0)\n\ts_barrier" ::: "memory")
#define ATT_WAITBAR3() asm volatile("s_waitcnt vmcnt(3) lgkmcnt(0)\n\ts_barrier" ::: "memory")
#define ATT_SB() __builtin_amdgcn_sched_barrier(0)
#define ATT_QK(sl, tt) do { const LASP char* Kb_ = ldsp + (sl) * SLOT + koff0; \
        const int kvb_ = (tt) * 64; const bool diag_ = (tt) == tdiag; const bool before_ = kvb_ < q0; \
        const unsigned spos_ = before_ ? 0x80008000u : 0u, sneg_ = before_ ? 0u : 0x80008000u; \
        const unsigned dm_ = diag_ ? ~hm0 : 0xffffffffu; \
        const unsigned w0_ = (kw0b ^ (spos_ & ksm)) & dm_, w1_ = (kw1b ^ (spos_ & ksm)) & dm_, w3_ = (dkdk ^ (sneg_ & ksm)) & dm_; \
        const unsigned k0_ = ((bfbits((float)kvb_) * 0x10001u) ^ sneg_) & hm0 & dm_, k1_ = ((bfbits((float)(kvb_ + 32)) * 0x10001u) ^ sneg_) & hm0 & dm_; \
        const bf16x8 ka0_ = __builtin_bit_cast(bf16x8, (u32x4){w0_, w1_, k0_, w3_}), ka1_ = __builtin_bit_cast(bf16x8, (u32x4){w0_, w1_, k1_, w3_}); \
        P0 = __builtin_amdgcn_mfma_f32_32x32x16_bf16(ka0_, qaug, zero16, 0, 0, 0); P1 = __builtin_amdgcn_mfma_f32_32x32x16_bf16(ka1_, qaug, zero16, 0, 0, 0); \
        _Pragma("unroll") for (int ks = 0; ks < 4; ++ks) { \
            const bf16x8 kf0_ = *(const LASP bf16x8*)(Kb_ + (((2 * ks + hi) ^ kx) * 16)); \
            const bf16x8 kf1_ = *(const LASP bf16x8*)(Kb_ + 4096 + (((2 * ks + hi) ^ kx) * 16)); \
            const bf16x8 qf_ = *(const LASP bf16x8*)(qlds + ks * 1024); \
            P0 = __builtin_amdgcn_mfma_f32_32x32x16_bf16(kf0_, qf_, P0, 0, 0, 0); P1 = __builtin_amdgcn_mfma_f32_32x32x16_bf16(kf1_, qf_, P1, 0, 0, 0); } \
        asm volatile("s_nop 15\n\ts_nop 7" : "+v"(P0), "+v"(P1));     \
        ATT_SB(); } while (0)
#define ATT_SM(tt) do { \
        if ((tt) == tdiag) { const float a_ = qpos - (float)((tt) * 64); \
            _Pragma("unroll") for (int r = 0; r < 16; ++r) { const float x0 = a_ - (float)crow(r, 0); P0[r] = fmaf(fabsf(x0), -slope2q, P0[r]); P1[r] = fmaf(fabsf(x0 - 32.0f), -slope2q, P1[r]); } } \
        float rm_ = max3f(P0[0], P0[1], P1[0]); rm_ = max3f(rm_, P1[1], P0[2]); float rn_ = max3f(P0[3], P1[2], P1[3]); \
        _Pragma("unroll") for (int r = 4; r < 16; r += 2) { rm_ = max3f(rm_, P0[r], P0[r + 1]); rn_ = max3f(rn_, P1[r], P1[r + 1]); } \
        float rm; { const float rq_ = fmaxf(rm_, rn_); auto rr = __builtin_amdgcn_permlane32_swap(__float_as_uint(rq_), __float_as_uint(rq_), false, false); rm = max3f(__uint_as_float(rr[0]), __uint_as_float(rr[1]), -1e30f); } \
        live = !__all(rm < mrel - 40.0f);       \
        if (live) { \
            mrel = fmaxf(mrel, rm); \
            if (__any(rm > 8.0f)) { const float dl = fmaxf(rm, 0.f); mhat += dl; mrel -= dl; \
                _Pragma("unroll") for (int r = 0; r < 16; ++r) { P0[r] -= dl; P1[r] -= dl; } \
                { const unsigned mh_ = bfbits(mhat); const float r1_ = mhat - bf2f(mh_); const unsigned mm_ = bfbits(r1_); const unsigned ml_ = bfbits(r1_ - bf2f(mm_)); \
                  const unsigned a0_ = hi ? ((mh_ | (mm_ << 16)) ^ 0x80008000u) : qa0, a1_ = hi ? (ml_ ^ 0x8000u) : qa1; \
                  qaug = __builtin_bit_cast(bf16x8, (u32x4){a0_, a1_, hi ? 0u : SHSL, hi ? 0u : SHSL}); } \
                const float f = exp2f(-dl); lsum *= f; \
                _Pragma("unroll") for (int eb = 0; eb < 4; ++eb) _Pragma("unroll") for (int r = 0; r < 16; ++r) o[eb][r] *= f; } \
            _Pragma("unroll") for (int r = 0; r < 16; ++r) { P0[r] = __builtin_amdgcn_exp2f(P0[r]); P1[r] = __builtin_amdgcn_exp2f(P1[r]); } \
            asm volatile("s_nop 1" : "+v"(P0), "+v"(P1));     \
            float ps0 = fadd_s(P0[0], P1[0]), ps1 = fadd_s(P0[1], P1[1]); \
            _Pragma("unroll") for (int r = 2; r < 16; r += 2) { ps0 = fadd_s(ps0, P0[r]); ps1 = fadd_s(ps1, P0[r + 1]); ps0 = fadd_s(ps0, P1[r]); ps1 = fadd_s(ps1, P1[r + 1]); } \
            lsum += fadd_s(ps0, ps1); \
            _Pragma("unroll") for (int s2 = 0; s2 < 2; ++s2) { \
                u32x4 w_; w_.x = cvtpk(P0[8 * s2 + 0], P0[8 * s2 + 1]); w_.y = cvtpk(P0[8 * s2 + 2], P0[8 * s2 + 3]); w_.z = cvtpk(P0[8 * s2 + 4], P0[8 * s2 + 5]); w_.w = cvtpk(P0[8 * s2 + 6], P0[8 * s2 + 7]); pf[s2] = __builtin_bit_cast(bf16x8, w_); \
                u32x4 v_; v_.x = cvtpk(P1[8 * s2 + 0], P1[8 * s2 + 1]); v_.y = cvtpk(P1[8 * s2 + 2], P1[8 * s2 + 3]); v_.z = cvtpk(P1[8 * s2 + 4], P1[8 * s2 + 5]); v_.w = cvtpk(P1[8 * s2 + 6], P1[8 * s2 + 7]); pf[2 + s2] = __builtin_bit_cast(bf16x8, v_); } \
        } ATT_SB(); } while (0)
#define ATT_PV(sl) do { if (live) { const LASP char* Vb_ = ldsp + (sl) * SLOT + vboff; \
            _Pragma("unroll") for (int eb = 0; eb < 4; ++eb) _Pragma("unroll") for (int s = 0; s < 4; ++s) { \
                const s16x4 lo_ = vtr(Vb_ + s * 4096 + eb * 512), h4_ = vtr(Vb_ + s * 4096 + 2048 + eb * 512); \
                const bf16x8 vf_ = (bf16x8){lo_[0], lo_[1], lo_[2], lo_[3], h4_[0], h4_[1], h4_[2], h4_[3]}; \
                o[eb] = __builtin_amdgcn_mfma_f32_32x32x16_bf16(vf_, pf[s], o[eb], 0, 0, 0); } } ATT_SB(); } while (0)
            { bf16x8 qf_[4];
#pragma unroll
              for (int ks = 0; ks < 4; ++ks) qf_[ks] = *(const bf16x8*)(qrow + c * 64 + 16 * ks + 8 * hi);
#pragma unroll
              for (int ks = 0; ks < 4; ++ks) *(LASP bf16x8*)((LASP char*)C.lds + 4 * SLOT + wave * 4096 + ks * 1024 + lane * 16) = qf_[ks]; }
            asm volatile("s_waitcnt vmcnt(0)" ::: "memory");
            ATT_DMA(t0, 0); ATT_DMA((t0 + 1) & 31, 1);
            const LASP char* qlds = ldsp + 4 * SLOT + wave * 4096 + lane * 16;
            f32x16 o[4], zero16, P0, P1;
#pragma unroll
            for (int r = 0; r < 16; ++r) zero16[r] = 0.f;
#pragma unroll
            for (int eb = 0; eb < 4; ++eb)
#pragma unroll
                for (int r = 0; r < 16; ++r) o[eb][r] = 0.f;
            float mhat = 0.f, lsum = 0.f, mrel = -1e30f;
            bf16x8 qaug = __builtin_bit_cast(bf16x8, (u32x4){hi ? 0u : qa0, hi ? 0u : qa1, hi ? 0u : SHSL, hi ? 0u : SHSL});
            bf16x8 pf[4]; bool live = false;
            if (wave < 4) {
#pragma unroll 1
                for (int i = 0; i < 32; ++i) {
                    if (i + 1 < 32) ATT_WAITBAR3(); else ATT_WAITBAR();
                    if (i + 2 < 32) ATT_DMA((t0 + i + 2) & 31, (i + 2) & 3);
                    const int tt = (t0 + i) & 31;
                    ATT_QK(i & 3, tt); ATT_SM(tt); ATT_PV(i & 3);
                }
            } else {
#pragma unroll 1
                for (int i = 0; i < 32; ++i) {
                    if (i + 1 < 32) ATT_WAITBAR3(); else ATT_WAITBAR();
                    if (i + 2 < 32) ATT_DMA((t0 + i + 2) & 31, (i + 2) & 3);
                    const int tt = (t0 + i) & 31;
                    ATT_PV((i - 1) & 3); ATT_QK(i & 3, tt); ATT_SM(tt);
                }
                ATT_PV(31 & 3);
            }
#undef ATT_DMA
#undef ATT_QK
#undef ATT_SM
#undef ATT_PV
#undef ATT_SB
            { auto rr = __builtin_amdgcn_permlane32_swap(__float_as_uint(lsum), __float_as_uint(lsum), false, false); lsum = __uint_as_float(rr[0]) + __uint_as_float(rr[1]); }
            const float inv = 1.0f / lsum;
            float* pk = (float*)(C.ws + WS_H2LO) + (size_t)C.gw * 4096;
            pk += fresh_lane();
            if (c == 0) {
#pragma unroll
                for (int eb = 0; eb < 4; ++eb)
#pragma unroll
                    for (int r = 0; r < 16; ++r) pk[(eb * 16 + r) * 64] = o[eb][r] * inv;
            } else {
                float ss = 0.f;
#pragma unroll
                for (int eb = 0; eb < 4; ++eb)
#pragma unroll
                    for (int r = 0; r < 16; ++r) { const float y = pk[(eb * 16 + r) * 64] - lam * (o[eb][r] * inv); o[eb][r] = y; ss += y * y; }
                { auto rr = __builtin_amdgcn_permlane32_swap(__float_as_uint(ss), __float_as_uint(ss), false, false); ss = __uint_as_float(rr[0]) + __uint_as_float(rr[1]); }
                const float rinv = 1.0f / sqrtf(ss * (1.0f / 128.0f) + EPS);
                bf16_t* orow = ycat + (size_t)(b * SEQ + q0 + l31) * D + 512 + hh * 128 + 4 * hi;
#pragma unroll
                for (int eb = 0; eb < 4; ++eb)
#pragma unroll
                    for (int g4 = 0; g4 < 4; ++g4) { const int e = 32 * eb + 8 * g4;
                        u32x2 w; w.x = cvtpk(o[eb][4 * g4] * rinv, o[eb][4 * g4 + 1] * rinv); w.y = cvtpk(o[eb][4 * g4 + 2] * rinv, o[eb][4 * g4 + 3] * rinv);
                        *(u32x2*)(orow + e) = w; }
            }
        }
    }
    ATT_WAITBAR();
#undef ATT_WAITBAR
#undef ATT_WAITBAR3
}

#define LDS_BAR() asm volatile("s_waitcnt lgkmcnt(0)\n\ts_barrier" ::: "memory")
__device__ __forceinline__ void phase_hy_pre_fast(Ctx& C) {
    const bf16_t* u = (const bf16_t*)(C.ws + WS_U); bf16_t* vpt = (bf16_t*)(C.ws + WS_VP); bf16_t* x0t = (bf16_t*)(C.ws + WS_X0C);
    const float* cw = C.in[7]; const float* cb = C.in[8];
    bf16_t* sv = (bf16_t*)C.lds; bf16_t* sx = sv + 64 * 72 + 64;
    const int tl = C.tid >> 3, c8 = C.tid & 7;
    constexpr int NTILES = NB * 32 * 8;
#define HYP_LOAD(dst, tile_) do { const int cq_ = (tile_) & 7, tq_ = ((tile_) >> 3) & 31, b_ = (tile_) >> 8; const int c0_ = cq_ * 64 + c8 * 8, t_ = tq_ * 64 + tl; const size_t row_ = (size_t)b_ * SEQ + t_; \
        const u32x4 z_ = {0u, 0u, 0u, 0u}; \
        _Pragma("unroll") for (int s_ = 0; s_ < 3; ++s_) { const int ch_ = s_ * HW + c0_; \
            dst[s_][0] = (t_ > 0) ? *(const u32x4*)(u + (row_ - 1) * INC + ch_) : z_; dst[s_][1] = *(const u32x4*)(u + row_ * INC + ch_); dst[s_][2] = (t_ < SEQ - 1) ? *(const u32x4*)(u + (row_ + 1) * INC + ch_) : z_; } } while (0)
    u32x4 cur[3][3], nxt[3][3];
    int tile = C.blk;
    if (tile < NTILES) HYP_LOAD(cur, tile);
    for (; tile < NTILES; tile += C.nblk) {
        const bool more = tile + C.nblk < NTILES;
        if (more) HYP_LOAD(nxt, tile + C.nblk);
        const int cq = tile & 7, tq = (tile >> 3) & 31, b = tile >> 8;
        const int c0 = cq * 64 + c8 * 8;
        float r[3][8];
#pragma unroll
        for (int s = 0; s < 3; ++s) {
            const int ch = s * HW + c0;
            f32x4 m0, m1, z0, z1, p0, p1; pg8::unpack8(cur[s][0], m0, m1); pg8::unpack8(cur[s][1], z0, z1); pg8::unpack8(cur[s][2], p0, p1);
            const f32x4 w00 = *(const f32x4*)(cw + ch), w01 = *(const f32x4*)(cw + ch + 4), w10 = *(const f32x4*)(cw + 3 * HW + ch), w11 = *(const f32x4*)(cw + 3 * HW + ch + 4);
            const f32x4 w20 = *(const f32x4*)(cw + 6 * HW + ch), w21 = *(const f32x4*)(cw + 6 * HW + ch + 4), bb0 = *(const f32x4*)(cb + ch), bb1 = *(const f32x4*)(cb + ch + 4);
            const f32x4 a0 = m0 * w00 + z0 * w10 + p0 * w20 + bb0, a1 = m1 * w01 + z1 * w11 + p1 * w21 + bb1;
#pragma unroll
            for (int i = 0; i < 4; ++i) { r[s][i] = a0[i]; r[s][4 + i] = a1[i]; }
        }
        LDS_BAR();
#pragma unroll
        for (int i = 0; i < 8; ++i) { sx[(c8 * 8 + i) * 72 + c8 * 8 + tl] = (bf16_t)f2bf(r[0][i]); sv[(c8 * 8 + i) * 72 + c8 * 8 + tl] = (bf16_t)f2bf(r[2][i] * r[1][i]); }
        LDS_BAR();
        { const int cl = C.tid >> 3, chk = C.tid & 7; const size_t o = ((size_t)(cq * 64 + cl) * NB + b) * SEQ + tq * 64 + chk * 8;
          *(u32x4*)(vpt + o) = *(const u32x4*)(sv + cl * 72 + (cl >> 3) * 8 + chk * 8); *(u32x4*)(x0t + o) = *(const u32x4*)(sx + cl * 72 + (cl >> 3) * 8 + chk * 8); }
        if (more) {
#pragma unroll
            for (int s = 0; s < 3; ++s)
#pragma unroll
                for (int q = 0; q < 3; ++q) cur[s][q] = nxt[s][q]; }
    }
#undef HYP_LOAD
    __syncthreads();
}

__device__ __forceinline__ void phase_toeplitz(Ctx& C) {
    constexpr int VROW = 4096 + 16, FCOPY = 8192 + 32, FL = 16 * VROW;
    const bf16_t* vpt = (const bf16_t*)(C.ws + WS_VP); const bf16_t* x0t = (const bf16_t*)(C.ws + WS_X0C); bf16_t* yt = (bf16_t*)(C.ws + WS_YT);
    const float* kfc = (const float*)(C.ws + WS_KFC); const float* dsk = C.in[17];
    const int lane = C.lane, a = lane & 15, g = lane >> 4, wave = C.wave;
    const unsigned lds0 = (unsigned)(uintptr_t)C.lds;
    const LASP char* ldsp = (const LASP char*)C.lds;
    const int t0 = 256 * wave;
    const int c0 = 2048 - t0 + 8 * g - a;
    const LASP char* fbase = ldsp + FL + (c0 & 7) * FCOPY + 2 * (c0 & ~7);
    const LASP char* vbase = ldsp + a * VROW + 16 * g;
    for (int c = C.blk; c < HW; c += C.nblk) {
        asm volatile("s_waitcnt vmcnt(0) lgkmcnt(0)\n\ts_barrier" ::: "memory");
        { const char* src = (const char*)(vpt + (size_t)c * NB * SEQ) + lane * 16;
#pragma unroll
          for (int j = 0; j < 8; ++j) { const int p = wave * 8 + j;
              glds16(src + (size_t)p * 1024, (unsigned)__builtin_amdgcn_readfirstlane(lds0 + (p >> 2) * VROW + (p & 3) * 1024)); } }
        { const int q = C.tid; const float* kc = kfc + (size_t)c * 4096; float f[15];
#pragma unroll
          for (int i = 0; i < 15; ++i) { const int idx = 4096 - 8 * q - i; f[i] = (idx >= 1 && idx <= 4095) ? kc[idx] : 0.f; }
#pragma unroll
          for (int m = 0; m < 8; ++m) { u32x4 w; w.x = pk2(f[m], f[m + 1]); w.y = pk2(f[m + 2], f[m + 3]); w.z = pk2(f[m + 4], f[m + 5]); w.w = pk2(f[m + 6], f[m + 7]);
              *(LASP u32x4*)((LASP char*)C.lds + FL + m * FCOPY + q * 16) = w; } }
        asm volatile("s_waitcnt vmcnt(0) lgkmcnt(0)\n\ts_barrier" ::: "memory");
        f32x4 acc[16]; bf16x8 W[16];
#pragma unroll
        for (int r = 0; r < 16; ++r) { acc[r] = (f32x4){0.f, 0.f, 0.f, 0.f}; W[r] = *(const LASP bf16x8*)(fbase - 32 * r); }
#pragma unroll 1
        for (int ko = 0; ko < 8; ++ko) {
            const LASP char* fb = fbase + ko * 512; const LASP char* vb = vbase + ko * 512;
#pragma unroll
            for (int kk = 0; kk < 8; ++kk) {
                const bf16x8 Bf = *(const LASP bf16x8*)(vb + 64 * kk);
#pragma unroll
                for (int r = 0; r < 16; ++r) acc[r] = __builtin_amdgcn_mfma_f32_16x16x32_bf16(W[(r - 2 * kk) & 15], Bf, acc[r], 0, 0, 0);
                if (ko < 7 || kk < 7) { W[(-2 * kk - 2) & 15] = *(const LASP bf16x8*)(fb + 64 * kk + 64); W[(-2 * kk - 1) & 15] = *(const LASP bf16x8*)(fb + 64 * kk + 32); }
            }
        }
        const float dd = dsk[c];
#pragma unroll
        for (int r = 0; r < 16; ++r) { const int t = t0 + 16 * r + 4 * g; const size_t o = ((size_t)c * NB + a) * SEQ + t;
            const u32x2 vv = *(const LASP u32x2*)(ldsp + a * VROW + t * 2); const u32x2 xx = *(const u32x2*)(x0t + o);
            const float y0 = (acc[r][0] + bflo(vv.x) * dd) * bflo(xx.x), y1 = (acc[r][1] + bfhi(vv.x) * dd) * bfhi(xx.x);
            const float y2 = (acc[r][2] + bflo(vv.y) * dd) * bflo(xx.y), y3 = (acc[r][3] + bfhi(vv.y) * dd) * bfhi(xx.y);
            u32x2 w; w.x = pk2(y0, y1); w.y = pk2(y2, y3); *(u32x2*)(yt + o) = w; }
    }
    asm volatile("s_waitcnt vmcnt(0) lgkmcnt(0)\n\ts_barrier" ::: "memory");
}

__device__ __forceinline__ void phase_hy_post(Ctx& C) {
    const bf16_t* yt = (const bf16_t*)(C.ws + WS_YT); bf16_t* ycat = (bf16_t*)(C.ws + WS_YCAT);
    bf16_t* sy = (bf16_t*)C.lds;
    constexpr int NTILES = NB * 32 * 8;
    const int cl = C.tid >> 3, chk = C.tid & 7, tl = C.tid >> 3, c8 = C.tid & 7;
#define HYQ_LOAD(tile_) (*(const u32x4*)(yt + ((size_t)(((tile_) & 7) * 64 + cl) * NB + ((tile_) >> 8)) * SEQ + (((tile_) >> 3) & 31) * 64 + chk * 8))
    int tile = C.blk; u32x4 cur = {0u, 0u, 0u, 0u}, nxt = cur;
    if (tile < NTILES) cur = HYQ_LOAD(tile);
    for (; tile < NTILES; tile += C.nblk) {
        const bool more = tile + C.nblk < NTILES;
        if (more) nxt = HYQ_LOAD(tile + C.nblk);
        const int cq = tile & 7, tq = (tile >> 3) & 31, b = tile >> 8;
        LDS_BAR();
        *(u32x4*)(sy + cl * 72 + (cl >> 3) * 8 + chk * 8) = cur;
        LDS_BAR();
        { unsigned short e[8];
#pragma unroll
          for (int i = 0; i < 8; ++i) e[i] = sy[(c8 * 8 + i) * 72 + c8 * 8 + tl];
          u32x4 w; w.x = e[0] | ((unsigned)e[1] << 16); w.y = e[2] | ((unsigned)e[3] << 16); w.z = e[4] | ((unsigned)e[5] << 16); w.w = e[6] | ((unsigned)e[7] << 16);
          *(u32x4*)(ycat + ((size_t)b * SEQ + tq * 64 + tl) * D + cq * 64 + c8 * 8) = w; }
        cur = nxt;
    }
#undef HYQ_LOAD
    __syncthreads();
}

__device__ __forceinline__ void phase_route(Ctx& C) {
    const float* mod = (const float*)(C.ws + WS_MOD); const float* ssq = (const float*)(C.ws + WS_LOGITS); bf16_t* h2 = (bf16_t*)(C.ws + WS_H); const bf16_t* wrt = (const bf16_t*)(C.ws + WS_WRT);
    int* tope = (int*)(C.ws + WS_TOPE); float* topw = (float*)(C.ws + WS_TOPW); int* blkcnt = (int*)(C.ws + WS_BLKCNT);
    const float* g = C.in[23]; const float* br = C.in[25];
    int* hist = (int*)C.lds; float* slog = (float*)(C.lds + 1024) + C.wave * 512;
    const int lane = C.lane, tk = lane & 15, gq = lane >> 4;
    for (int vb = C.blk; vb < 256; vb += C.nblk) {
        __syncthreads();
        if (C.tid < NE) hist[C.tid] = 0;
        __syncthreads();
        const int tok = vb * 128 + C.wave * 16 + tk; const int b = tok / SEQ;
        float rstd;
        { const f32x4* sp = (const f32x4*)(ssq + (size_t)tok * 16); const f32x4 a0 = sp[0], a1 = sp[1], a2 = sp[2], a3 = sp[3];
          const float ss = ((a0.x + a0.y) + (a0.z + a0.w)) + ((a1.x + a1.y) + (a1.z + a1.w)) + ((a2.x + a2.y) + (a2.z + a2.w)) + ((a3.x + a3.y) + (a3.z + a3.w));
          rstd = 1.0f / sqrtf(ss * (1.0f / D) + EPS); }
        const bf16_t* xr = (const bf16_t*)(C.ws + WS_X1) + (size_t)tok * D + 8 * gq; const float* sh = mod + (size_t)b * 6 * D + 3 * D + 8 * gq; const float* sc = sh + D; const float* gg = g + 8 * gq;
        bf16_t* hr = h2 + (size_t)tok * D + 8 * gq;
        const bf16_t* wb = wrt + (size_t)tk * 2048 + 8 * gq;
        f32x4 acc[2]; acc[0] = (f32x4){0.f, 0.f, 0.f, 0.f}; acc[1] = acc[0];
#pragma unroll 2
        for (int k = 0; k < D; k += 32) {
            f32x4 x0, x1v; { const u32x4 xw = *(const u32x4*)(xr + k); pg8::unpack8(xw, x0, x1v); } const f32x4 g0 = *(const f32x4*)(gg + k), g1 = *(const f32x4*)(gg + k + 4);
            const f32x4 c0 = *(const f32x4*)(sc + k), c1 = *(const f32x4*)(sc + k + 4), s0 = *(const f32x4*)(sh + k), s1 = *(const f32x4*)(sh + k + 4);
            f32x4 h0, h1;
#pragma unroll
            for (int i = 0; i < 4; ++i) { h0[i] = x0[i] * rstd * g0[i] * (1.f + c0[i]) + s0[i]; h1[i] = x1v[i] * rstd * g1[i] * (1.f + c1[i]) + s1[i]; }
            u32x4 wh; wh.x = pk2(h0[0], h0[1]); wh.y = pk2(h0[2], h0[3]); wh.z = pk2(h1[0], h1[1]); wh.w = pk2(h1[2], h1[3]);
            *(u32x4*)(hr + k) = wh;
            u32x4 wl; wl.x = pk2(h0[0] - bflo(wh.x), h0[1] - bfhi(wh.x)); wl.y = pk2(h0[2] - bflo(wh.y), h0[3] - bfhi(wh.y)); wl.z = pk2(h1[0] - bflo(wh.z), h1[1] - bfhi(wh.z)); wl.w = pk2(h1[2] - bflo(wh.w), h1[3] - bfhi(wh.w));
            const bf16x8 a_h = __builtin_bit_cast(bf16x8, wh), a_l = __builtin_bit_cast(bf16x8, wl);
#pragma unroll
            for (int n = 0; n < 2; ++n) { const bf16_t* bp = wb + (size_t)n * 16 * 2048 + k;
                const bf16x8 b_h = *(const bf16x8*)(bp), b_l = *(const bf16x8*)(bp + 1024);
                acc[n] = __builtin_amdgcn_mfma_f32_16x16x32_bf16(b_h, a_h, acc[n], 0, 0, 0);
                acc[n] = __builtin_amdgcn_mfma_f32_16x16x32_bf16(b_h, a_l, acc[n], 0, 0, 0);
                acc[n] = __builtin_amdgcn_mfma_f32_16x16x32_bf16(b_l, a_h, acc[n], 0, 0, 0); }
        }
#pragma unroll
        for (int n = 0; n < 2; ++n) *(f32x4*)(slog + tk * 32 + n * 16 + 4 * gq) = acc[n];
        __builtin_amdgcn_s_waitcnt(0xc07f); asm volatile("" ::: "memory");
        if (lane < 16) {
            const int t = vb * 128 + C.wave * 16 + lane;
            float v[32];
#pragma unroll
            for (int q = 0; q < 8; ++q) { const f32x4 x = *(const f32x4*)(slog + lane * 32 + 4 * q), bb = *(const f32x4*)(br + 4 * q);
                v[4 * q] = x.x + bb.x; v[4 * q + 1] = x.y + bb.y; v[4 * q + 2] = x.z + bb.z; v[4 * q + 3] = x.w + bb.w; }
            float tv[4]; int ti[4];
#pragma unroll
            for (int k = 0; k < 4; ++k) {
                float best = -INFINITY; int bi = 0;
#pragma unroll
                for (int e = 0; e < 32; ++e) if (v[e] > best) { best = v[e]; bi = e; }
                tv[k] = best; ti[k] = bi;
#pragma unroll
                for (int e = 0; e < 32; ++e) v[e] = (e == bi) ? -INFINITY : v[e];
            }
            const float e0 = 1.0f, e1 = expf(tv[1] - tv[0]), e2 = expf(tv[2] - tv[0]), e3 = expf(tv[3] - tv[0]);
            const float inv = 1.0f / (e0 + e1 + e2 + e3);
            *(int4*)(tope + (size_t)t * 4) = make_int4(ti[0], ti[1], ti[2], ti[3]);
            *(f32x4*)(topw + (size_t)t * 4) = (f32x4){e0 * inv, e1 * inv, e2 * inv, e3 * inv};
#pragma unroll
            for (int k = 0; k < 4; ++k) atomicAdd(&hist[ti[k]], 1);
        }
        __syncthreads();
        if (C.tid < NE) blkcnt[vb * NE + C.tid] = hist[C.tid];
    }
    __syncthreads();
}

__device__ __forceinline__ void phase_rowlist(Ctx& C) {
    const int* tope = (const int*)(C.ws + WS_TOPE); const int* blkcnt = (const int*)(C.ws + WS_BLKCNT);
    int* rowpair = (int*)(C.ws + WS_ROWPAIR); int* tileexp = (int*)(C.ws + WS_TILEEXP); int* meta = (int*)(C.ws + WS_META);
    float* roww = (float*)(C.ws + WS_ROWW); const float* topw = (const float*)(C.ws + WS_TOPW); int* rowinv = (int*)(C.ws + WS_TOPE);
    int* s_total = (int*)C.lds; int* s_base = s_total + 32; int* s_pstart = s_base + 32; int* s_e = s_pstart + 36; int* s_cnt = s_e + 512;
    for (int vb = C.blk; vb < 256; vb += C.nblk) {
        __syncthreads();
        { const int4* src = (const int4*)blkcnt; int4* dst = (int4*)s_cnt;
#pragma unroll
          for (int q = 0; q < 4; ++q) dst[q * NTHREADS + C.tid] = src[q * NTHREADS + C.tid]; }
        s_e[C.tid] = tope[(size_t)vb * 512 + C.tid];
        __syncthreads();
        if (C.tid < NE) { int tot = 0, base = 0;
#pragma unroll 8
            for (int q = 0; q < 256; ++q) { const int c = s_cnt[q * NE + C.tid]; tot += c; if (q < vb) base += c; } s_total[C.tid] = tot; s_base[C.tid] = base; }
        __syncthreads();
        if (C.tid == 0) { int ps = 0; for (int e = 0; e < NE; ++e) { s_pstart[e] = ps; ps += ((s_total[e] + 255) / 256) * 256; } s_pstart[NE] = ps; }
        __syncthreads();
        { const int e = s_e[C.tid]; int rank = 0; for (int j = 0; j < C.tid; ++j) rank += (s_e[j] == e) ? 1 : 0;
          rowpair[s_pstart[e] + s_base[e] + rank] = vb * 512 + C.tid; roww[s_pstart[e] + s_base[e] + rank] = topw[vb * 512 + C.tid]; rowinv[vb * 512 + C.tid] = s_pstart[e] + s_base[e] + rank; }
        if (vb < NE) { const int e = vb; for (int r = s_pstart[e] + s_total[e] + C.tid; r < s_pstart[e + 1]; r += NTHREADS) { rowpair[r] = -1; roww[r] = 0.f; } }
        if (vb == 0) {
            if (C.tid < NE) { for (int tl = s_pstart[C.tid] / 256; tl < s_pstart[C.tid + 1] / 256; ++tl) tileexp[tl] = C.tid; }
            if (C.tid == 0) meta[0] = s_pstart[NE] / 256;
        }
    }
    __syncthreads();
}


#define LDS3(C) ((PG8_LAS unsigned char*)(C).lds)
__device__ __forceinline__ void phase_inproj_fast(Ctx& C) {
    pg8::Gemm g{(const bf16_t*)(C.ws + WS_H), (const bf16_t*)(C.ws + WS_WIN), D, D, D, nullptr};
    pg8::StaticOrder S; S.init(T / 256, INC / 256, C.nblk, C.blk);
    pg8::EpiInproj E{(bf16_t*)(C.ws + WS_U), C.in[6]};
    pg8::gemm_phase<pg8::EpiInproj, pg8::StaticOrder, false>(LDS3(C), g, S, E, C.wave);
}
#ifndef XVAR
#define XVAR 0
#endif
__device__ __forceinline__ void phase_probe_x(Ctx& C) {
#if XVAR == 1 || XVAR == 2
    pg8::Gemm g{(const bf16_t*)(C.ws + WS_H), (const bf16_t*)(C.ws + WS_WIN), D, D, D, nullptr};
    pg8::StaticOrder S; S.init(T / 256, INC / 256, C.nblk, C.blk);
    pg8::EpiInprojT<XVAR> E{(bf16_t*)(C.ws + WS_U), C.in[6]};
    pg8::gemm_phase<pg8::EpiInprojT<XVAR>, pg8::StaticOrder, false>(LDS3(C), g, S, E, C.wave);
#endif
}
__device__ __forceinline__ void phase_cat_fast(Ctx& C) {
    pg8::StaticOrder S; S.init(T / 256, D / 256, C.nblk, C.blk);
    pg8::Gemm g{(const bf16_t*)(C.ws + WS_YCAT), (const bf16_t*)(C.ws + WS_WCAT), D, D, D, nullptr};
    pg8::EpiCatR E{(bf16_t*)(C.ws + WS_MERGED), (const bf16_t*)(C.ws + WS_U)};
    pg8::gemm_phase<pg8::EpiCatR, pg8::StaticOrder, false, true>(LDS3(C), g, S, E, C.wave);
}
__device__ __forceinline__ void phase_mix_fast(Ctx& C) {
    pg8::Gemm g{(const bf16_t*)(C.ws + WS_MERGED), (const bf16_t*)(C.ws + WS_WMIX), D, D, D, nullptr};
    pg8::StaticOrder S; S.init(T / 256, D / 256, C.nblk, C.blk);
    pg8::EpiMix E{C.in[0], (bf16_t*)(C.ws + WS_X1), (const float*)(C.ws + WS_MOD), (float*)(C.ws + WS_LOGITS)};
    pg8::gemm_phase<pg8::EpiMix, pg8::StaticOrder, false>(LDS3(C), g, S, E, C.wave);
}
__device__ __forceinline__ void phase_gateup_fast(Ctx& C) {
    const int nmt = ((const int*)(C.ws + WS_META))[0];
    pg8::Gemm g{(const bf16_t*)(C.ws + WS_H), (const bf16_t*)(C.ws + WS_WGU), D, D, D, (const int*)(C.ws + WS_ROWPAIR)};
    { PG8_LAS int* te = (PG8_LAS int*)(LDS3(C) + 131072); const int* tg = (const int*)(C.ws + WS_TILEEXP); for (int i = C.tid; i < nmt; i += NTHREADS) te[i] = tg[i]; __syncthreads(); }
    pg8::MoeOrder S; S.b.init(nmt, 8, C.nblk, C.blk); S.tileexp = (const PG8_LAS int*)(LDS3(C) + 131072); S.nN = 8;
    pg8::EpiGateUp E{(bf16_t*)(C.ws + WS_ACT), C.in[27]};
    pg8::gemm_phase<pg8::EpiGateUp, pg8::MoeOrder, true>(LDS3(C), g, S, E, C.wave);
}
__device__ __forceinline__ void phase_down_fast(Ctx& C) {
    const int nmt = ((const int*)(C.ws + WS_META))[0];
    pg8::Gemm g{(const bf16_t*)(C.ws + WS_ACT), (const bf16_t*)(C.ws + WS_WDN), D, D, D, nullptr};
    { PG8_LAS int* te = (PG8_LAS int*)(LDS3(C) + 131072); const int* tg = (const int*)(C.ws + WS_TILEEXP); for (int i = C.tid; i < nmt; i += NTHREADS) te[i] = tg[i]; __syncthreads(); }
    pg8::MoeOrder S; S.b.init(nmt, 4, C.nblk, C.blk); S.tileexp = (const PG8_LAS int*)(LDS3(C) + 131072); S.nN = 4;
    pg8::EpiDown E{(bf16_t*)(C.ws + WS_SLOTS), C.in[29], (const float*)(C.ws + WS_ROWW)};
    pg8::gemm_phase<pg8::EpiDown, pg8::MoeOrder, false>(LDS3(C), g, S, E, C.wave);
}


#define XB_TMO      128
#define XB_XCNT(j)  (256  + 64 * (j))
#define XB_XSUB(j)  (1280 + 64 * (j))
#define XB_XGEN(j)  (2304 + 64 * (j))
#define XB_TOP      3328
#define XB_TOPGEN   3392
#define XCD_BAR_WORDS 3456
#define XB_SPIN_CAP (1u << 18)
#define XLAS __attribute__((address_space(3)))
__device__ __forceinline__ unsigned xb_ld(unsigned* p)              { return __hip_atomic_load(p, __ATOMIC_RELAXED, __HIP_MEMORY_SCOPE_AGENT); }
__device__ __forceinline__ unsigned xb_add(unsigned* p, unsigned v) { return __hip_atomic_fetch_add(p, v, __ATOMIC_RELAXED, __HIP_MEMORY_SCOPE_AGENT); }
__device__ __forceinline__ unsigned xb_xcc_id() { return (unsigned)__builtin_amdgcn_s_getreg((3 << 11) | 20) & 0xFu; }
#define XB_SPIN(cond, bar) do { unsigned _sp = 0; while (cond) { __builtin_amdgcn_s_sleep(1); \
    if ((++_sp & 255u) == 0u) { if (xb_ld(&(bar)[XB_TMO])) break; if (_sp > XB_SPIN_CAP) { atomicAdd(&(bar)[XB_TMO], 1u); break; } } } } while (0)
struct XcdBarrier { unsigned* bar; unsigned x; volatile XLAS unsigned* st; };
__device__ __forceinline__ XcdBarrier xcd_barrier_post(unsigned* bar, volatile XLAS unsigned* st, bool leader) {
    XcdBarrier b; b.bar = bar; b.x = xb_xcc_id(); b.st = st;
    if (leader) (void)xb_add(&bar[XB_XCNT(b.x)], 1u);
    return b;
}
__device__ __forceinline__ void xcd_barrier_complete(unsigned* bar, unsigned x, unsigned& nloc, unsigned& nx) {
    const unsigned G = gridDim.x * gridDim.y * gridDim.z;
    unsigned sum, cnt, mine, sp = 0u;
    for (;;) {
        sum = 0u; cnt = 0u; mine = 0u;
#pragma unroll
        for (unsigned j = 0; j < 16; ++j) { const unsigned c = xb_ld(&bar[XB_XCNT(j)]); sum += c; cnt += (c > 0u) ? 1u : 0u; mine = (j == x) ? c : mine; }
        if (sum == G) break;
        __builtin_amdgcn_s_sleep(1);
        if ((++sp & 255u) == 0u) { if (xb_ld(&bar[XB_TMO])) break; if (sp > XB_SPIN_CAP) { atomicAdd(&bar[XB_TMO], 1u); break; } }
    }
    nloc = mine > 0u ? mine : 1u; nx = cnt > 0u ? cnt : 1u;
}
__device__ __forceinline__ void xcd_barrier(const XcdBarrier& b, int wave_) {
    asm volatile("s_waitcnt vmcnt(0)" ::: "memory");
    __syncthreads();
    if (wave_ == 0 && lane_id() == 0) {
        unsigned* bar = b.bar;
        __builtin_amdgcn_s_waitcnt(0);
        unsigned nloc = b.st[0], nx = b.st[1];
        if (nloc == 0u) { xcd_barrier_complete(bar, b.x, nloc, nx); b.st[0] = nloc; b.st[1] = nx; }
        const unsigned old = xb_add(&bar[XB_XSUB(b.x)], 1u);
        const unsigned gen = old / nloc;
        if (old + 1u == (gen + 1u) * nloc) {
            __builtin_amdgcn_fence(__ATOMIC_RELEASE, "agent");
            asm volatile("s_waitcnt vmcnt(0)" ::: "memory");
            const unsigned og = xb_add(&bar[XB_TOP], 1u);
            const unsigned tg = og / nx;
            if (og + 1u == (tg + 1u) * nx) xb_add(&bar[XB_TOPGEN], 1u);
            else XB_SPIN(xb_ld(&bar[XB_TOPGEN]) == tg, bar);
            __builtin_amdgcn_fence(__ATOMIC_ACQUIRE, "agent");
            xb_add(&bar[XB_XGEN(b.x)], 1u);
            asm volatile("s_waitcnt vmcnt(0)" ::: "memory");
        } else {
            XB_SPIN(xb_ld(&bar[XB_XGEN(b.x)]) == gen, bar);
            __builtin_amdgcn_fence(__ATOMIC_ACQUIRE, "agent");
            asm volatile("s_waitcnt vmcnt(0)" ::: "memory");
        }
    }
    __syncthreads();
}

constexpr int NPHASES = 13;
}

__global__ void __launch_bounds__(NTHREADS, 2) fwd_kernel(Params p) {
    extern __shared__ __attribute__((aligned(16))) unsigned char lds[];
    cg::grid_group grid = cg::this_grid();
    Ctx C;
#pragma unroll
    for (int i = 0; i < 31; ++i) C.in[i] = p.in[i];
    C.out = p.out; C.ws = p.ws; C.lds = lds;
    const int wave_s = __builtin_amdgcn_readfirstlane(threadIdx.x >> 6);
    C.lane = lane_id(); C.wave = wave_s; C.tid = wave_s * 64 + C.lane;
    C.blk = blockIdx.x; C.nblk = gridDim.x; C.gw = C.blk * NWAVES + C.wave; C.ngw = C.nblk * NWAVES;
    const int lo = p.ph_lo, hi = p.ph_hi;
    volatile XLAS unsigned* misc = (volatile XLAS unsigned*)((XLAS unsigned char*)lds + (LDS_BYTES - 64));
    if (C.tid < 16) misc[C.tid] = 0u;
    __syncthreads();
    const XcdBarrier xbar = xcd_barrier_post((unsigned*)(p.ws + WS_CTL), misc, C.tid == 0);
#define GSYNC(k) do { xcd_barrier(xbar, wave_s); } while (0)
    if (lo < 0) grid.sync();
#ifndef PHMASK
#define PHMASK 0xffff
#endif
#ifndef REPMASK
#define REPMASK 0
#endif
#ifndef PROBE_PHASE
#define PROBE_PHASE (-1)
#endif
    unsigned long long tp0 = 0, tp1 = 0;
#define PH(k, body) do { if ((PHMASK >> (k)) & 1) { if (lo <= (k) && (k) < hi) { if ((k) == PROBE_PHASE) tp0 = __builtin_amdgcn_s_memrealtime(); _Pragma("unroll 1") for (int rep_ = (REPMASK >> (k)) & 1; rep_ >= 0; --rep_) { { C.lane = fresh_lane(); C.wave = wave_s; C.tid = wave_s * 64 + C.lane; C.gw = C.blk * NWAVES + C.wave; } body; if (rep_ > 0 || (k) + 1 < hi) GSYNC(k); } if ((k) == PROBE_PHASE) tp1 = __builtin_amdgcn_s_memrealtime(); } } } while (0)
#ifdef SYNCPROBE
    for (int i = 0; i < 20; ++i) GSYNC(1);
#endif
    PH(0, { phase_mod(C); phase_filters(C); });
    PH(1, { phase_weights(C); __syncthreads(); phase_norm1(C); });
#ifndef FASTMASK
#define FASTMASK 0xffff
#endif
#define FAST(k) ((FASTMASK >> (k)) & 1)
    PH(2, phase_inproj_fast(C));
#if XVAR == 1 || XVAR == 2
    PH(13, phase_probe_x(C));
#endif
    PH(3, phase_hy_pre_fast(C));
    PH(4, { phase_toeplitz(C); GSYNC(1); phase_hy_post(C); });
    PH(5, phase_attn_fast(C));
    PH(6, phase_cat_fast(C));
    PH(7, phase_mix_fast(C));
    PH(8, phase_route(C));
    PH(9, phase_rowlist(C));
    PH(10, phase_gateup_fast(C));
    PH(11, phase_down_fast(C));
    PH(12, phase_final(C));
#undef PH
    if (PROBE_PHASE >= 0 && C.blk == 0) { const unsigned long long te = __builtin_amdgcn_s_memrealtime(), span = 4ull * (tp1 - tp0); while (__builtin_amdgcn_s_memrealtime() - te < span) __builtin_amdgcn_s_sleep(8); }
}

extern "C" void kernel_launch(void* const* d_in, const int* in_sizes, int n_in, void* d_out, int out_size, void* d_ws, size_t ws_size, hipStream_t stream) {
    static int grid = 0;
    if (grid == 0) {
        if (n_in != 31 || ws_size < WS_END) { fprintf(stderr, "kernel_launch: unexpected n_in %d or ws_size %zu\n", n_in, ws_size); grid = -1; return; }
        int dev = 0, cus = 0, per_cu = 0;
        hipGetDevice(&dev); hipDeviceGetAttribute(&cus, hipDeviceAttributeMultiprocessorCount, dev);
        hipFuncSetAttribute((const void*)fwd_kernel, hipFuncAttributeMaxDynamicSharedMemorySize, LDS_BYTES);
        hipOccupancyMaxActiveBlocksPerMultiprocessor(&per_cu, (const void*)fwd_kernel, NTHREADS, LDS_BYTES);
        if (per_cu < 1) { fprintf(stderr, "kernel_launch: occupancy query says %d blocks/CU\n", per_cu); per_cu = 1; }
        (void)hipGetLastError();
        grid = cus * 1;
        fprintf(stderr, "kernel_launch: cus %d per_cu %d grid %d\n", cus, per_cu, grid);
    }
    if (grid < 0) return;
    if (hipMemsetAsync((char*)d_ws + WS_CTL, 0, 65536, stream) != hipSuccess) { fprintf(stderr, "kernel_launch: memset failed\n"); return; }
    Params p{};
    for (int i = 0; i < 31; ++i) p.in[i] = (const float*)d_in[i];
    p.out = (float*)d_out; p.ws = (unsigned char*)d_ws; p.ph_lo = 0; p.ph_hi = NPHASES + (XVAR ? 1 : 0);
    void* args[] = {&p};
    hipError_t e = hipLaunchCooperativeKernel((const void*)fwd_kernel, dim3(grid), dim3(NTHREADS), args, LDS_BYTES, stream);
    if (e != hipSuccess) fprintf(stderr, "cooperative launch failed: %s (grid %d)\n", hipGetErrorString(e), grid);
}
```

```cpp
#include <hip/hip_runtime.h>
#include <hip/hip_cooperative_groups.h>
#include <cstdio>
#include <cstdint>
namespace cg = cooperative_groups;

namespace {
typedef unsigned short bf16_t;
typedef short bf16x8 __attribute__((ext_vector_type(8)));
typedef short s16x4 __attribute__((ext_vector_type(4)));
typedef float f32x4 __attribute__((ext_vector_type(4)));
typedef float f32x16 __attribute__((ext_vector_type(16)));
typedef unsigned u32x4 __attribute__((ext_vector_type(4)));
typedef unsigned u32x2 __attribute__((ext_vector_type(2)));

constexpr int D = 1024, NB = 16, SEQ = 2048, T = NB * SEQ, HW = 512, INC = 5120, NE = 32, FHID = 64;
constexpr int QOFF = 1536, KOFF = 2048, VOFF = 2560, GOFF = 3072;
constexpr int NTHREADS = 512, NWAVES = 8;
constexpr float EPS = 1e-5f;
constexpr float LOG2E = 1.4426950408889634f;
constexpr float QSCALE = 0.125f * 1.4426950408889634f;
constexpr size_t MiB = 1u << 20;
constexpr size_t WS_CTL = 0;
constexpr size_t WS_MOD = 1 * MiB;
constexpr size_t WS_META = 1 * MiB + 512 * 1024;
constexpr size_t WS_BLKCNT = WS_META + 4096;
constexpr size_t WS_TILEEXP = WS_BLKCNT + 256 * 32 * 4;
constexpr size_t WS_LOGITS = 2 * MiB;
constexpr size_t WS_TOPE = 6 * MiB;
constexpr size_t WS_TOPW = 6 * MiB + 512 * 1024;
constexpr size_t WS_ROWPAIR = 7 * MiB;
constexpr size_t WS_ROWW = 7 * MiB + 576 * 1024;
constexpr size_t WS_KFILT = 8 * MiB;
constexpr size_t WS_U = 16 * MiB;
constexpr size_t WS_ACT = WS_U;
constexpr size_t WS_H = 336 * MiB;
constexpr size_t WS_R1 = 400 * MiB;
constexpr size_t WS_YCAT = WS_R1;
constexpr size_t WS_MERGED = WS_R1 + 64 * MiB;
constexpr size_t WS_VP = WS_R1 + 128 * MiB;
constexpr size_t WS_X0C = WS_R1 + 160 * MiB;
constexpr size_t WS_VT = WS_R1 + 192 * MiB;
constexpr size_t WS_H2LO = WS_R1 + 224 * MiB;
constexpr size_t WS_SLOTS = WS_R1;
constexpr size_t WS_WIN = 688 * MiB;
constexpr size_t WS_WCAT = 698 * MiB;
constexpr size_t WS_WMIX = 700 * MiB;
constexpr size_t WS_WGU = 702 * MiB;
constexpr size_t WS_WDN = 830 * MiB;
constexpr size_t WS_WRT = 894 * MiB;
constexpr size_t WS_KFC = 896 * MiB;
constexpr size_t WS_X1 = 904 * MiB;
constexpr size_t WS_END = 968 * MiB;
constexpr size_t WS_YT = WS_R1 + 192 * MiB;
constexpr int MAXROWS = 4 * T + NE * 256;
constexpr int LDS_BYTES = 163840;

struct Params { const float* in[31]; float* out; unsigned char* ws; int ph_lo, ph_hi; };

__device__ __forceinline__ unsigned f2bf(float f) { unsigned u = __float_as_uint(f); return (u + 0x7fffu + ((u >> 16) & 1u)) >> 16; }
__device__ __forceinline__ unsigned pk2(float lo, float hi) { return f2bf(lo) | (f2bf(hi) << 16); }
__device__ __forceinline__ float bf2f(unsigned h) { return __uint_as_float(h << 16); }
__device__ __forceinline__ float bflo(unsigned w) { return __uint_as_float(w << 16); }
__device__ __forceinline__ float bfhi(unsigned w) { return __uint_as_float(w & 0xffff0000u); }
__device__ __forceinline__ float wave_sum(float v) {
#pragma unroll
    for (int o = 1; o < 64; o <<= 1) v += __shfl_xor(v, o);
    return v;
}
__device__ __forceinline__ float sigmoidf_(float x) { return 1.0f / (1.0f + __expf(-x)); }
typedef float f32x2_t __attribute__((ext_vector_type(2))); typedef __bf16 bf16x2_t __attribute__((ext_vector_type(2)));
__device__ __forceinline__ unsigned cvtpk(float lo, float hi) { f32x2_t v = {lo, hi}; bf16x2_t b = __builtin_convertvector(v, bf16x2_t); return __builtin_bit_cast(unsigned, b); }
__device__ __forceinline__ int crow(int r, int hi) { return (r & 3) + 8 * (r >> 2) + 4 * hi; }
__device__ __forceinline__ int lane_id() { return (int)__builtin_amdgcn_mbcnt_hi(~0u, __builtin_amdgcn_mbcnt_lo(~0u, 0u)); }
__device__ __forceinline__ int fresh_lane() { int l = lane_id(); asm volatile("" : "+v"(l)); return l; }

struct Ctx {
    const float* in[31]; float* out; unsigned char* ws;
    int tid, lane, wave, gw, ngw, nblk, blk;
    unsigned char* lds;
};

struct WItem { const float* src; bf16_t* dst; int N; int sk; };
__device__ __forceinline__ WItem witem(const Ctx& C, int it) {
    constexpr int I_IN = (D / 64) * (INC / 64), I_HY = (HW / 64) * (D / 64), I_MIX = (D / 64) * (D / 64), I_GU1 = (D / 64) * (2 * D / 64), I_DN1 = (D / 64) * (D / 64);
    const float* W; int N, k0, n0, kd, nd, sk = -1; bf16_t* WT;
    int r = it;
    if (r < NE * I_GU1) { const int e = r / I_GU1, q = r % I_GU1; const int nb = 2 * D / 64; n0 = 64 * (q % nb); k0 = 64 * (q / nb);
        const int s = n0 / 1024, rem = n0 % 1024, j = rem / 128, i0 = rem % 128; nd = 256 * j + 128 * s + i0; kd = k0; N = 2 * D;
        W = C.in[26] + (size_t)e * D * 2 * D; WT = (bf16_t*)(C.ws + WS_WGU) + (size_t)e * 2 * D * D; }
    else if ((r -= NE * I_GU1) < NE * I_DN1) { const int e = r / I_DN1, q = r % I_DN1; const int nb = D / 64; n0 = 64 * (q % nb); k0 = 64 * (q / nb); nd = n0; kd = k0; N = D;
        W = C.in[28] + (size_t)e * D * D; WT = (bf16_t*)(C.ws + WS_WDN) + (size_t)e * D * D; }
    else if ((r -= NE * I_DN1) < I_IN) { const int nb = INC / 64; n0 = 64 * (r % nb); k0 = 64 * (r / nb); nd = n0; kd = k0; N = INC; W = C.in[5]; WT = (bf16_t*)(C.ws + WS_WIN);
        if (n0 >= GOFF) { const int rel = n0 - GOFF, sg_ = rel / 1024, rem = rel % 1024; nd = GOFF + 256 * (rem / 128) + 128 * sg_ + (rem % 128); } }
    else if ((r -= I_IN) < I_HY) { const int nb = D / 64; n0 = 64 * (r % nb); k0 = 64 * (r / nb); nd = n0; kd = k0; N = D; W = C.in[20]; WT = (bf16_t*)(C.ws + WS_WCAT); }
    else if ((r -= I_HY) < I_HY) { const int nb = D / 64; n0 = 64 * (r % nb); k0 = 64 * (r / nb); nd = n0; kd = 512 + k0; N = D; W = C.in[21]; WT = (bf16_t*)(C.ws + WS_WCAT); sk = k0; }
    else { r -= I_HY; const int nb = D / 64; n0 = 64 * (r % nb); k0 = 64 * (r / nb); nd = n0; kd = k0; N = D; W = C.in[22]; WT = (bf16_t*)(C.ws + WS_WMIX); }
    WItem w; w.N = N; w.sk = sk; w.src = W + (size_t)(k0 + (C.lane >> 4)) * N + n0 + 4 * (C.lane & 15); w.dst = WT + (size_t)(nd + (C.lane >> 3)) * D + kd + 8 * (C.lane & 7);
    return w;
}
__device__ __forceinline__ void phase_weights(Ctx& C) {
    float* scr = (float*)(C.lds + C.wave * 16640);
    constexpr int NITEMS = (D / 64) * (INC / 64) + 2 * (HW / 64) * (D / 64) + (D / 64) * (D / 64) + NE * (D / 64) * (2 * D / 64) + NE * (D / 64) * (D / 64);
    const int lane = C.lane;
    int it = C.gw;
    f32x4 v[16], vn[16];
    WItem cur;
    if (it < NITEMS) { cur = witem(C, it);
#pragma unroll
        for (int i = 0; i < 16; ++i) v[i] = __builtin_nontemporal_load((const f32x4*)(cur.src + (size_t)(4 * i) * cur.N)); }
    for (; it < NITEMS; it += C.ngw) {
        const bool more = it + C.ngw < NITEMS; WItem nx = cur;
        if (more) { nx = witem(C, it + C.ngw);
#pragma unroll
            for (int i = 0; i < 16; ++i) vn[i] = __builtin_nontemporal_load((const f32x4*)(nx.src + (size_t)(4 * i) * nx.N)); }
        if (cur.sk >= 0) {
#pragma unroll
            for (int i = 0; i < 16; ++i) v[i] = v[i] * (0.8f * C.in[19][(cur.sk + 4 * i + (lane >> 4)) & 127]); }
#pragma unroll
        for (int i = 0; i < 16; ++i) { float* d = scr + (4 * i + (lane >> 4)) * 65 + 4 * (lane & 15); d[0] = v[i].x; d[1] = v[i].y; d[2] = v[i].z; d[3] = v[i].w; }
        __builtin_amdgcn_s_waitcnt(0xc07f); asm volatile("" ::: "memory");
        const int c = lane & 7;
#pragma unroll
        for (int j = 0; j < 8; ++j) { const int n = (lane >> 3) + 8 * j; const float* s = scr + (8 * c) * 65 + n;
            u32x4 o; o.x = pk2(s[0 * 65], s[1 * 65]); o.y = pk2(s[2 * 65], s[3 * 65]); o.z = pk2(s[4 * 65], s[5 * 65]); o.w = pk2(s[6 * 65], s[7 * 65]);
            __builtin_nontemporal_store(o, (u32x4*)(cur.dst + (size_t)(8 * j) * D)); }
        __builtin_amdgcn_s_waitcnt(0xc07f); asm volatile("" ::: "memory");
        if (more) {
#pragma unroll
            for (int i = 0; i < 16; ++i) v[i] = vn[i]; }
        cur = nx;
    }
    bf16_t* wrt = (bf16_t*)(C.ws + WS_WRT);
    for (int i = C.blk * NTHREADS + C.tid; i < NE * D; i += C.nblk * NTHREADS) {
        const int e = i / D, k = i % D; const float w = C.in[24][(size_t)k * NE + e];
        const unsigned hi = f2bf(w); const float lo = w - bf2f(hi);
        wrt[(size_t)e * 2048 + k] = (bf16_t)hi; wrt[(size_t)e * 2048 + 1024 + k] = (bf16_t)f2bf(lo);
    }
}

__device__ __forceinline__ void phase_mod(Ctx& C) {
    float* sc = (float*)C.lds;
    float* part = sc + 16 * 1024;
    float* mod = (float*)(C.ws + WS_MOD);
    for (int vb = C.blk; vb < 256; vb += C.nblk) {
        const int j0 = vb * 24;
        __syncthreads();
        for (int i = C.tid; i < 16 * D; i += NTHREADS) { const float c = C.in[1][i]; sc[i] = c / (1.0f + expf(-c)); }
        __syncthreads();
        if (C.tid < 504) {
            const int jj = C.tid % 24, isub = C.tid / 24;
            float acc[16];
#pragma unroll
            for (int b = 0; b < 16; ++b) acc[b] = 0.f;
            const float* w = C.in[2] + j0 + jj;
#pragma unroll 7
            for (int i = isub; i < D; i += 21) { const float wv = w[(size_t)i * 6 * D];
#pragma unroll
                for (int b = 0; b < 16; ++b) acc[b] = fmaf(sc[b * D + i], wv, acc[b]); }
#pragma unroll
            for (int b = 0; b < 16; ++b) part[(isub * 16 + b) * 24 + jj] = acc[b];
        }
        __syncthreads();
        if (C.tid < 384) { const int b = C.tid / 24, jj = C.tid % 24; float a = C.in[3][j0 + jj];
            for (int q = 0; q < 21; ++q) a += part[(q * 16 + b) * 24 + jj];
            mod[b * 6 * D + j0 + jj] = a;
            { const int j = j0 + jj; if (j >= 4 * D && j < 5 * D) mod[16 * 6 * D + b * D + (j - 4 * D)] = C.in[23][j - 4 * D] * (1.0f + a); } }
    }
    __syncthreads();
}

__device__ __forceinline__ void phase_filters(Ctx& C) {
    float* sh = (float*)C.lds;
    float* h3t = sh + 8 * 160;
    float* kfc = (float*)(C.ws + WS_KFC);
    const float* w1 = C.in[9]; const float* b1 = C.in[10]; const float* w2 = C.in[11]; const float* b2 = C.in[12];
    const float* w3 = C.in[13]; const float* b3 = C.in[14]; const float* w4 = C.in[15]; const float* fq = C.in[16];
    const int pl = C.tid >> 6, j = C.tid & 63;
    float* z = sh + pl * 160; float* ha = z + 32; float* hb = ha + 64;
    for (int vb = C.blk; vb < SEQ / 8; vb += C.nblk) {
        const int pos = vb * 8 + pl;
        const float tt = (float)pos / (float)(SEQ - 1);
        const float w = 6.283185307179586f * (float)pos / (float)SEQ;
        __syncthreads();
        if (j < 17) {
            float v;
            if (j == 0) v = tt;
            else { const int i = (j - 1) & 7; const float fr = 1e-4f + (float)i * ((7.0f - 1e-4f) / 7.0f); v = (j <= 8) ? cosf(fr * w) : -sinf(fr * w); }
            z[j] = v;
        }
        __syncthreads();
        { float a = b1[j];
#pragma unroll
          for (int i = 0; i < 17; ++i) a = fmaf(z[i], w1[i * FHID + j], a); ha[j] = sinf(fq[j] * a); }
        __syncthreads();
        { float a = b2[j];
#pragma unroll 32
          for (int i = 0; i < FHID; ++i) a = fmaf(ha[i], w2[i * FHID + j], a); hb[j] = sinf(fq[j] * a); }
        __syncthreads();
        { float a = b3[j];
#pragma unroll 32
          for (int i = 0; i < FHID; ++i) a = fmaf(hb[i], w3[i * FHID + j], a); h3t[j * 8 + pl] = sinf(fq[j] * a); }
        __syncthreads();
        float af[8], ab[8];
#pragma unroll
        for (int p = 0; p < 8; ++p) { af[p] = 0.f; ab[p] = 0.f; }
#pragma unroll 16
        for (int i = 0; i < FHID; ++i) { const float wa = w4[i * 2 * HW + C.tid], wb = w4[i * 2 * HW + HW + C.tid];
            const f32x4 h0 = *(const f32x4*)(h3t + i * 8), h1 = *(const f32x4*)(h3t + i * 8 + 4);
#pragma unroll
            for (int p = 0; p < 4; ++p) { af[p] = fmaf(h0[p], wa, af[p]); af[4 + p] = fmaf(h1[p], wa, af[4 + p]); ab[p] = fmaf(h0[p], wb, ab[p]); ab[4 + p] = fmaf(h1[p], wb, ab[4 + p]); } }
        const float min_decay = logf(1e-2f) / 1.5f, max_decay = logf(1e-2f) / 0.3f;
        const int c = C.tid, pos0 = vb * 8;
        const float adelta = fabsf(min_decay + (float)c * ((max_decay - min_decay) / 511.0f));
#pragma unroll
        for (int p = 0; p < 8; ++p) { const float dec = expf(-((float)(pos0 + p) / (float)(SEQ - 1)) * adelta); af[p] *= dec; ab[p] *= dec; }
        float* dst = kfc + (size_t)c * 4096 + 2048 + pos0;
        *(f32x4*)dst = (f32x4){af[0], af[1], af[2], af[3]}; *(f32x4*)(dst + 4) = (f32x4){af[4], af[5], af[6], af[7]};
        float* dsb = kfc + (size_t)c * 4096 + 2048 - pos0;
#pragma unroll
        for (int p = 0; p < 8; ++p) if (pos0 + p >= 1) dsb[-p] = ab[p];
    }
    __syncthreads();
}

__device__ __forceinline__ void phase_norm1(Ctx& C) {
    const float* mod = (const float*)(C.ws + WS_MOD); bf16_t* h = (bf16_t*)(C.ws + WS_H);
    const float* g = C.in[4];
    for (int row = C.gw; row < T; row += C.ngw) {
        const int b = row / SEQ;
        const f32x4* xr = (const f32x4*)(C.in[0] + (size_t)row * D) + C.lane;
        f32x4 v[4]; float s = 0.f;
#pragma unroll
        for (int j = 0; j < 4; ++j) { v[j] = __builtin_nontemporal_load(xr + 64 * j); s += (v[j].x * v[j].x + v[j].y * v[j].y) + (v[j].z * v[j].z + v[j].w * v[j].w); }
        const float rstd = 1.0f / sqrtf(wave_sum(s) * (1.0f / D) + EPS);
        const float* sh = mod + (size_t)b * 6 * D; const float* sc = sh + D;
        u32x2* o = (u32x2*)(h + (size_t)row * D) + C.lane;
#pragma unroll
        for (int j = 0; j < 4; ++j) { const int i0 = 4 * C.lane + 256 * j;
            const f32x4 gg = *(const f32x4*)(g + i0), s1 = *(const f32x4*)(sc + i0), s0 = *(const f32x4*)(sh + i0);
            f32x4 r; r.x = v[j].x * rstd * gg.x * (1.f + s1.x) + s0.x; r.y = v[j].y * rstd * gg.y * (1.f + s1.y) + s0.y;
            r.z = v[j].z * rstd * gg.z * (1.f + s1.z) + s0.z; r.w = v[j].w * rstd * gg.w * (1.f + s1.w) + s0.w;
            u32x2 w; w.x = pk2(r.x, r.y); w.y = pk2(r.z, r.w); o[64 * j] = w; }
    }
}

__device__ __forceinline__ void phase_final(Ctx& C) {
    const float* mod = (const float*)(C.ws + WS_MOD); const bf16_t* slots = (const bf16_t*)(C.ws + WS_SLOTS); const int* rowinv = (const int*)(C.ws + WS_TOPE);
    const bf16_t* x1 = (const bf16_t*)(C.ws + WS_X1);
    const float* g = C.in[30];
    for (int row = C.gw; row < T; row += C.ngw) {
        const int b = row / SEQ;
        f32x4* xr = (f32x4*)(C.out + (size_t)row * D) + C.lane;
        const float* g2 = mod + (size_t)b * 6 * D + 5 * D;
        f32x4 v[4]; float s = 0.f; const int4 rr4 = *(const int4*)(rowinv + (size_t)row * 4); const int rk[4] = {rr4.x, rr4.y, rr4.z, rr4.w};
#pragma unroll
        for (int j = 0; j < 4; ++j) { const int i0 = 4 * C.lane + 256 * j;
            f32x4 m = {0.f, 0.f, 0.f, 0.f};
#pragma unroll
            for (int k = 0; k < 4; ++k) { const u32x2 w = __builtin_nontemporal_load((const u32x2*)(slots + (size_t)rk[k] * D + i0));
                m.x += bflo(w.x); m.y += bfhi(w.x); m.z += bflo(w.y); m.w += bfhi(w.y); }
            const f32x4 gg = *(const f32x4*)(g2 + i0);
            const u32x2 xw = __builtin_nontemporal_load((const u32x2*)(x1 + (size_t)row * D + i0));
            v[j].x = bflo(xw.x) + gg.x * m.x; v[j].y = bfhi(xw.x) + gg.y * m.y; v[j].z = bflo(xw.y) + gg.z * m.z; v[j].w = bfhi(xw.y) + gg.w * m.w;
            s += (v[j].x * v[j].x + v[j].y * v[j].y) + (v[j].z * v[j].z + v[j].w * v[j].w); }
        const float rstd = 1.0f / sqrtf(wave_sum(s) * (1.0f / D) + EPS);
#pragma unroll
        for (int j = 0; j < 4; ++j) { const int i0 = 4 * C.lane + 256 * j; const f32x4 gg = *(const f32x4*)(g + i0);
            f32x4 r; r.x = v[j].x * rstd * gg.x; r.y = v[j].y * rstd * gg.y; r.z = v[j].z * rstd * gg.z; r.w = v[j].w * rstd * gg.w; __builtin_nontemporal_store(r, xr + 64 * j); }
    }
}

namespace pg8 {
#define PG8_LAS __attribute__((address_space(3)))
constexpr int BM = 256, BK = 64, HALF = 128, HTB = HALF * BK * 2, STAGE_BYTES = 8 * HTB, NXCD = 8, WGM = 8;
__device__ __forceinline__ int lds_byte(int r, int c) { const int st = (r >> 4) * 2 + (c >> 5), rr = r & 15, cc = c & 31, ob = rr * 64 + cc * 2; return st * 1024 + (ob ^ (((ob >> 9) & 1) << 5)); }
__device__ __forceinline__ void stage_rc(int b, int& R, int& C) { const int st = b / 1024, sb = b % 1024, swz = sb ^ (((sb >> 9) & 1) << 5); R = (st >> 1) * 16 + swz / 64; C = (st & 1) * 32 + (swz % 64) / 2; }
__device__ __forceinline__ int perm32(int rho) { const int n = rho >> 4, i = rho & 15; return 8 * (i >> 2) + 4 * n + (i & 3); }
struct Unit { int pm, pn; };
struct Gemm { const bf16_t* A; const bf16_t* Bt; int lda, ldb, K; const int* rowidx; };
struct StaticOrder {
    int nM, nN, nwg, G, c;
    __device__ void init(int nM_, int nN_, int G_, int c_) { nM = nM_; nN = nN_; nwg = nM * nN; G = G_; c = c_; }
    __device__ bool next(int i, Unit& u) const {
        const long L = (long)i * G + c; if (L >= nwg) return false;
        int wgid = (int)L; { const int q = nwg / NXCD, r = nwg % NXCD, xcd = wgid % NXCD, off = wgid / NXCD; wgid = (xcd < r ? xcd * (q + 1) : r * (q + 1) + (xcd - r) * q) + off; }
        const int nig = WGM * nN, gid = wgid / nig, fm = gid * WGM, gsz = (nM - fm) < WGM ? (nM - fm) : WGM;
        u.pm = fm + ((wgid % nig) % gsz); u.pn = (wgid % nig) / gsz; return true;
    }
};
struct MoeOrder {
    StaticOrder b; const PG8_LAS int* tileexp; int nN;
    __device__ bool next(int i, Unit& u) const { if (!b.next(i, u)) return false; u.pn = tileexp[u.pm] * nN + u.pn; return true; }
};
__device__ __forceinline__ unsigned cvt_pk_bf16(float lo, float hi) { unsigned r; asm volatile("v_cvt_pk_bf16_f32 %0, %1, %2" : "=v"(r) : "v"(lo), "v"(hi)); return r; }

template <class Epi, class Sched, bool GATHER, bool MIDHOOK = false>
__device__ __forceinline__ void gemm_phase(PG8_LAS unsigned char* lds, const Gemm g, const Sched& S, const Epi& E, const int wid_) {
    const int wid = wid_, lane = fresh_lane(), tid = wid * 64 + lane, wr = wid >> 2, wc = wid & 3, fr = lane & 15, fq = lane >> 4;
    const int K = g.K, nt = K / BK;
    int RA[2]; unsigned cA2[2], voffB[2];
#pragma unroll
    for (int i = 0; i < 2; ++i) { int R, C; stage_rc(tid * 16 + i * 8192, R, C); const int Rb = Epi::PERM ? ((R & ~31) + perm32(R & 31)) : R;
        RA[i] = R; cA2[i] = (unsigned)C * 2u; voffB[i] = (unsigned)(Rb * g.ldb + C) * 2u; }
    const unsigned lda2 = (unsigned)g.lda * 2u;
    const size_t kstep = (size_t)(BK * 2);
    const size_t hstep = (size_t)HALF * g.ldb * 2;
    const size_t tstep = 2 * hstep;
    const unsigned ldsw = (unsigned)wid * 1024u;
    const int aoff = lds_byte(wr * 64 + fr, fq * 8), boff = lds_byte(wc * 32 + fr, fq * 8);
#define PG8_SA(b, h) (((b) * 2 + (h)) * HTB)
#define PG8_SB(b, h) ((4 + (b) * 2 + (h)) * HTB)
#define PG8_STAGE(bufoff, gbase, voff) do { _Pragma("unroll") for (int _i = 0; _i < 2; ++_i) \
        __builtin_amdgcn_global_load_lds((const unsigned*)((const char*)(gbase) + (voff)[_i]), (PG8_LAS unsigned*)(lds + (bufoff) + ldsw + _i * 8192), 16, 0, 0); } while (0)
#define PG8_AOFFS(dst, u_) do { _Pragma("unroll") for (int _h = 0; _h < 2; ++_h) _Pragma("unroll") for (int _i = 0; _i < 2; ++_i) { \
        int _row = (u_).pm * BM + _h * HALF + RA[_i]; if (GATHER) { const int _p = g.rowidx[_row]; _row = _p >= 0 ? (_p >> 2) : 0; } \
        dst[_h][_i] = (unsigned)_row * lda2 + cA2[_i]; } } while (0)
      \
#define PG8_AOFFS_RAW(dst, u_) do { _Pragma("unroll") for (int _h = 0; _h < 2; ++_h) _Pragma("unroll") for (int _i = 0; _i < 2; ++_i) { \
        const int _row = (u_).pm * BM + _h * HALF + RA[_i]; dst[_h][_i] = GATHER ? (unsigned)g.rowidx[_row] : (unsigned)_row; } } while (0)
#define PG8_AOFFS_FIN(dst) do { _Pragma("unroll") for (int _h = 0; _h < 2; ++_h) _Pragma("unroll") for (int _i = 0; _i < 2; ++_i) { \
        int _row = (int)dst[_h][_i]; if (GATHER) _row = _row >= 0 ? (_row >> 2) : 0; dst[_h][_i] = (unsigned)_row * lda2 + cA2[_i]; } } while (0)
#define PG8_LDA(dst, b, h) do { _Pragma("unroll") for (int m = 0; m < 4; ++m) _Pragma("unroll") for (int k = 0; k < 2; ++k) dst[m][k] = *(const PG8_LAS bf16x8*)(lds + PG8_SA(b, h) + aoff + m * 2048 + k * 1024); } while (0)
#define PG8_LDB(dst, b, h) do { _Pragma("unroll") for (int n = 0; n < 2; ++n) _Pragma("unroll") for (int k = 0; k < 2; ++k) dst[n][k] = *(const PG8_LAS bf16x8*)(lds + PG8_SB(b, h) + boff + n * 2048 + k * 1024); } while (0)
#define PG8_MMA(ai, bj, At, Bt) do { __builtin_amdgcn_s_setprio(1); _Pragma("unroll") for (int m = 0; m < 4; ++m) _Pragma("unroll") for (int n = 0; n < 2; ++n) _Pragma("unroll") for (int k = 0; k < 2; ++k) \
        acc[ai][bj][m][n] = __builtin_amdgcn_mfma_f32_16x16x32_bf16(Bt[n][k], At[m][k], acc[ai][bj][m][n], 0, 0, 0); __builtin_amdgcn_s_setprio(0); } while (0)
#define PG8_WAIT_V(n) asm volatile("s_waitcnt vmcnt(" #n ")" ::: "memory")
#define PG8_WAIT_L(n) asm volatile("s_waitcnt lgkmcnt(" #n ")" ::: "memory")
#define PG8_BAR __builtin_amdgcn_s_barrier()
#define PG8_SCHED __builtin_amdgcn_sched_barrier(0)
    Unit cur, nxt; int ui = 0;
    if (!S.next(0, cur)) return;
    f32x4 acc[2][2][4][2];
#pragma unroll
    for (int a = 0; a < 2; ++a)
#pragma unroll
        for (int b = 0; b < 2; ++b)
#pragma unroll
            for (int m = 0; m < 4; ++m)
#pragma unroll
                for (int n = 0; n < 2; ++n) acc[a][b][m][n] = (f32x4){0.f, 0.f, 0.f, 0.f};
    bf16x8 At[4][2], B0[2][2], B1[2][2];
    unsigned cv[2][2], nv[2][2];
    PG8_AOFFS(cv, cur);
    const char* const Ab = (const char*)g.A;
    const char* cB = (const char*)g.Bt + (size_t)cur.pn * tstep;
    PG8_STAGE(PG8_SB(0, 0), cB, voffB); PG8_STAGE(PG8_SB(0, 1), cB + hstep, voffB); PG8_STAGE(PG8_SA(0, 0), Ab, cv[0]); PG8_STAGE(PG8_SA(0, 1), Ab, cv[1]);
    if (wr == 1) PG8_BAR;
    PG8_WAIT_V(2); PG8_BAR;
    PG8_STAGE(PG8_SB(1, 0), cB + kstep, voffB); PG8_STAGE(PG8_SA(1, 0), Ab + kstep, cv[0]); PG8_STAGE(PG8_SB(1, 1), cB + hstep + kstep, voffB);
    PG8_WAIT_V(6); PG8_BAR;
    for (;;) {
        const bool has_next = S.next(ui + 1, nxt);
        if (has_next) { if constexpr (GATHER) { PG8_AOFFS_RAW(nv, nxt); } else { PG8_AOFFS(nv, nxt); } } else {
#pragma unroll
            for (int h = 0; h < 2; ++h)
#pragma unroll
                for (int i = 0; i < 2; ++i) nv[h][i] = cv[h][i]; }
        const char* nB = has_next ? (const char*)g.Bt + (size_t)nxt.pn * tstep : cB;
#define PG8_KSTEP(t) do { \
            const bool last = (t == nt - 2); \
            const char* a1 = Ab + (size_t)(t + 1) * kstep; \
            const char* a2 = last ? Ab : Ab + (size_t)(t + 2) * kstep; const char* b2 = last ? nB : cB + (size_t)(t + 2) * kstep; \
            const char* a3 = a2 + kstep; const char* b3 = b2 + kstep; \
            unsigned sv[2][2]; \
            if constexpr (GATHER) { \
                _Pragma("unroll") for (int h = 0; h < 2; ++h) _Pragma("unroll") for (int i = 0; i < 2; ++i) sv[h][i] = cv[h][i]; \
                if (last) { asm volatile("" : "+v"(nv[0][0]), "+v"(nv[0][1]), "+v"(nv[1][0]), "+v"(nv[1][1])); if (has_next) PG8_AOFFS_FIN(nv); _Pragma("unroll") for (int h = 0; h < 2; ++h) _Pragma("unroll") for (int i = 0; i < 2; ++i) sv[h][i] = nv[h][i]; } \
            } else { _Pragma("unroll") for (int h = 0; h < 2; ++h) _Pragma("unroll") for (int i = 0; i < 2; ++i) sv[h][i] = last ? nv[h][i] : cv[h][i]; } \
            PG8_LDB(B0, 0, 0); PG8_LDB(B1, 0, 1); PG8_SCHED; PG8_LDA(At, 0, 0); PG8_STAGE(PG8_SA(1, 1), a1, cv[1]); \
            PG8_WAIT_V(8); PG8_WAIT_L(0); PG8_BAR; PG8_MMA(0, 0, At, B0); PG8_MMA(0, 1, At, B1); PG8_BAR; PG8_SCHED; \
            PG8_LDA(At, 0, 1); PG8_STAGE(PG8_SB(0, 0), b2, voffB); PG8_STAGE(PG8_SB(0, 1), b2 + hstep, voffB); PG8_STAGE(PG8_SA(0, 0), a2, sv[0]); \
            PG8_WAIT_V(8); PG8_WAIT_L(0); PG8_BAR; PG8_MMA(1, 0, At, B0); PG8_MMA(1, 1, At, B1); PG8_BAR; PG8_SCHED; \
            PG8_LDB(B0, 1, 0); PG8_LDB(B1, 1, 1); PG8_SCHED; PG8_LDA(At, 1, 0); PG8_STAGE(PG8_SA(0, 1), a2, sv[1]); \
            PG8_WAIT_V(8); PG8_WAIT_L(0); PG8_BAR; PG8_MMA(0, 0, At, B0); PG8_MMA(0, 1, At, B1); PG8_BAR; PG8_SCHED; \
            PG8_LDA(At, 1, 1); PG8_STAGE(PG8_SB(1, 0), b3, voffB); PG8_STAGE(PG8_SB(1, 1), b3 + hstep, voffB); PG8_STAGE(PG8_SA(1, 0), a3, sv[0]); \
            PG8_WAIT_V(8); PG8_WAIT_L(0); PG8_BAR; PG8_MMA(1, 0, At, B0); PG8_MMA(1, 1, At, B1); PG8_BAR; PG8_SCHED; \
        } while (0)
        if constexpr (MIDHOOK) {
            for (int t = 0; t < nt / 2; t += 2) PG8_KSTEP(t);
            E.mid(acc, cur, wr, wc, fr, fq);
            for (int t = nt / 2; t < nt; t += 2) PG8_KSTEP(t);
        } else {
            for (int t = 0; t < nt; t += 2) PG8_KSTEP(t);
        }
#undef PG8_KSTEP
        if (wr == 0) PG8_BAR;
        E(acc, cur, wr, wc, fr, fq);
        if (!has_next) break;
#pragma unroll
        for (int a = 0; a < 2; ++a)
#pragma unroll
            for (int b = 0; b < 2; ++b)
#pragma unroll
                for (int m = 0; m < 4; ++m)
#pragma unroll
                    for (int n = 0; n < 2; ++n) acc[a][b][m][n] = (f32x4){0.f, 0.f, 0.f, 0.f};
        cur = nxt; cB = nB; ++ui;
#pragma unroll
        for (int h = 0; h < 2; ++h)
#pragma unroll
            for (int i = 0; i < 2; ++i) cv[h][i] = nv[h][i];
        if (wr == 1) PG8_BAR;
    }
    PG8_WAIT_V(0);
    PG8_BAR;
#undef PG8_SA
#undef PG8_SB
#undef PG8_STAGE
#undef PG8_AOFFS
#undef PG8_AOFFS_RAW
#undef PG8_AOFFS_FIN
#undef PG8_LDA
#undef PG8_LDB
#undef PG8_MMA
#undef PG8_WAIT_V
#undef PG8_WAIT_L
#undef PG8_BAR
#undef PG8_SCHED
}

__device__ __forceinline__ u32x4 pack8(const f32x4& v0, const f32x4& v1) { u32x4 w; w.x = cvt_pk_bf16(v0[0], v0[1]); w.y = cvt_pk_bf16(v0[2], v0[3]); w.z = cvt_pk_bf16(v1[0], v1[1]); w.w = cvt_pk_bf16(v1[2], v1[3]); return w; }
__device__ __forceinline__ void unpack8(const u32x4& w, f32x4& v0, f32x4& v1) { v0 = (f32x4){bflo(w.x), bfhi(w.x), bflo(w.y), bfhi(w.y)}; v1 = (f32x4){bflo(w.z), bfhi(w.z), bflo(w.w), bfhi(w.w)}; }
__device__ __forceinline__ float fsig(float x) { return __builtin_amdgcn_rcpf(1.0f + __builtin_amdgcn_exp2f(-LOG2E * x)); }

template <int MODE = 0> struct EpiInprojT {
    static constexpr bool PERM = true;
    bf16_t* U; const float* bias;
    __device__ __forceinline__ void operator()(const f32x4 (&acc)[2][2][4][2], const Unit& u, int wr, int wc, int fr, int fq) const {
        if (MODE == 2) { _Pragma("unroll") for (int a_ = 0; a_ < 2; ++a_) _Pragma("unroll") for (int b_ = 0; b_ < 2; ++b_) _Pragma("unroll") for (int m_ = 0; m_ < 4; ++m_) _Pragma("unroll") for (int n_ = 0; n_ < 2; ++n_) asm volatile("" :: "v"(acc[a_][b_][m_][n_])); return; }
        const int row0 = u.pm * BM + wr * 64 + fr, col0 = u.pn * BM + wc * 32 + 8 * fq; const float qs = (u.pn == 6 || u.pn == 7) ? QSCALE : 1.0f;
        if (u.pn >= 12) {
            const int c0 = 128 * (u.pn - 12) + wc * 32 + 8 * fq;
            f32x4 ba[2], bb[2];
#pragma unroll
            for (int n = 0; n < 2; ++n) { ba[n] = *(const f32x4*)(bias + GOFF + c0 + 4 * n); bb[n] = *(const f32x4*)(bias + GOFF + D + c0 + 4 * n); }
#pragma unroll
            for (int ai = 0; ai < 2; ++ai)
#pragma unroll
                for (int m = 0; m < 4; ++m) { bf16_t* rowp = U + (size_t)(row0 + ai * HALF + m * 16) * INC + GOFF + c0; f32x4 rr[2], sb[2];
#pragma unroll
                    for (int n = 0; n < 2; ++n) { const f32x4 a = acc[ai][0][m][n] + ba[n], b = acc[ai][1][m][n] + bb[n];
#pragma unroll
                        for (int i = 0; i < 4; ++i) { const float ea = __builtin_amdgcn_exp2f(-LOG2E * a[i]), eb = __builtin_amdgcn_exp2f(-LOG2E * b[i]); const float s2 = __builtin_amdgcn_rcpf(1.0f + eb);
                            sb[n][i] = s2; rr[n][i] = (1.0f + eb) * __builtin_amdgcn_rcpf(1.0f + ea); } }
                    const u32x4 wr_ = pack8(rr[0], rr[1]), ws_ = pack8(sb[0], sb[1]);
                    if (MODE == 0) { *(u32x4*)rowp = wr_; *(u32x4*)(rowp + D) = ws_; } else asm volatile("" :: "v"(wr_), "v"(ws_)); }
            return;
        }
        const bool sig = false;
        f32x4 bv[2][2];
#pragma unroll
        for (int bj = 0; bj < 2; ++bj)
#pragma unroll
            for (int n = 0; n < 2; ++n) bv[bj][n] = *(const f32x4*)(bias + col0 + bj * HALF + 4 * n);
#pragma unroll
        for (int ai = 0; ai < 2; ++ai)
#pragma unroll
            for (int m = 0; m < 4; ++m) { bf16_t* rowp = U + (size_t)(row0 + ai * HALF + m * 16) * INC + col0;
#pragma unroll
                for (int bj = 0; bj < 2; ++bj) { f32x4 v0 = (acc[ai][bj][m][0] + bv[bj][0]) * qs, v1 = (acc[ai][bj][m][1] + bv[bj][1]) * qs;
                    if (sig) {
#pragma unroll
                        for (int i = 0; i < 4; ++i) { v0[i] = fsig(v0[i]); v1[i] = fsig(v1[i]); } }
                    const u32x4 w_ = pack8(v0, v1);
                    if (MODE == 0) *(u32x4*)(rowp + bj * HALF) = w_; else asm volatile("" :: "v"(w_)); } }
    }
};
typedef EpiInprojT<0> EpiInproj;
template <int P> struct EpiCat {
    static constexpr bool PERM = true;
    bf16_t* Mg; const bf16_t* U;
    __device__ __forceinline__ void operator()(const f32x4 (&acc)[2][2][4][2], const Unit& u, int wr, int wc, int fr, int fq) const {
        const int row0 = u.pm * BM + wr * 64 + fr, col0 = u.pn * BM + wc * 32 + 8 * fq;
#pragma unroll
        for (int ai = 0; ai < 2; ++ai)
#pragma unroll
            for (int m = 0; m < 4; ++m) { const size_t row = (size_t)(row0 + ai * HALF + m * 16);
#pragma unroll
                for (int bj = 0; bj < 2; ++bj) { const u32x4 gw = *(const u32x4*)(U + row * INC + GOFF + P * D + col0 + bj * HALF);
                    f32x4 g0, g1; unpack8(gw, g0, g1); f32x4 v0 = acc[ai][bj][m][0] * g0, v1 = acc[ai][bj][m][1] * g1;
                    bf16_t* mp = Mg + row * D + col0 + bj * HALF;
                    if (P == 1) { const u32x4 tw = *(const u32x4*)mp; f32x4 t0, t1; unpack8(tw, t0, t1); v0 += t0; v1 += t1; }
                    *(u32x4*)mp = pack8(v0, v1); } }
    }
};
struct EpiCatR {
    static constexpr bool PERM = true;
    bf16_t* Mg; const bf16_t* U;
    __device__ __forceinline__ void mid(f32x4 (&acc)[2][2][4][2], const Unit& u, int wr, int wc, int fr, int fq) const {
        int row0 = u.pm * BM + wr * 64 + fr; asm volatile("" : "+v"(row0));
        const int col0 = u.pn * BM + wc * 32 + 8 * fq;
#pragma unroll
        for (int ai = 0; ai < 2; ++ai) { asm volatile("" ::: "memory");
#pragma unroll
            for (int m = 0; m < 4; ++m) { const size_t row = (size_t)(row0 + ai * HALF + m * 16);
#pragma unroll
                for (int bj = 0; bj < 2; ++bj) { const u32x4 gw1 = *(const u32x4*)(U + row * INC + GOFF + col0 + bj * HALF);
                    f32x4 a0, a1; unpack8(gw1, a0, a1); acc[ai][bj][m][0] *= a0; acc[ai][bj][m][1] *= a1; } } }
        asm volatile("" ::: "memory");
    }
    __device__ __forceinline__ void operator()(const f32x4 (&acc)[2][2][4][2], const Unit& u, int wr, int wc, int fr, int fq) const {
        const int row0 = u.pm * BM + wr * 64 + fr, col0 = u.pn * BM + wc * 32 + 8 * fq;
#pragma unroll
        for (int ai = 0; ai < 2; ++ai)
#pragma unroll
            for (int m = 0; m < 4; ++m) { const size_t row = (size_t)(row0 + ai * HALF + m * 16);
#pragma unroll
                for (int bj = 0; bj < 2; ++bj) { const u32x4 gw = *(const u32x4*)(U + row * INC + GOFF + D + col0 + bj * HALF);
                    f32x4 g0, g1; unpack8(gw, g0, g1);
                    *(u32x4*)(Mg + row * D + col0 + bj * HALF) = pack8(acc[ai][bj][m][0] * g0, acc[ai][bj][m][1] * g1); } }
    }
};
struct EpiMix {
    static constexpr bool PERM = true;
    const float* X; bf16_t* O; const float* mod; float* ssq;
    __device__ __forceinline__ void operator()(const f32x4 (&acc)[2][2][4][2], const Unit& u, int wr, int wc, int fr, int fq) const {
        const int row0 = u.pm * BM + wr * 64 + fr, col0 = u.pn * BM + wc * 32 + 8 * fq; const int b = (u.pm * BM) / SEQ;
        f32x4 gv[2][2];
#pragma unroll
        for (int bj = 0; bj < 2; ++bj)
#pragma unroll
            for (int n = 0; n < 2; ++n) gv[bj][n] = *(const f32x4*)(mod + (size_t)b * 6 * D + 2 * D + col0 + bj * HALF + 4 * n);
#pragma unroll
        for (int ai = 0; ai < 2; ++ai)
#pragma unroll
            for (int m = 0; m < 4; ++m) { const size_t off = (size_t)(row0 + ai * HALF + m * 16) * D + col0; float sq = 0.f;
#pragma unroll
                for (int bj = 0; bj < 2; ++bj) { f32x4 v[2];
#pragma unroll
                    for (int n = 0; n < 2; ++n) { v[n] = *(const f32x4*)(X + off + bj * HALF + 4 * n) + gv[bj][n] * acc[ai][bj][m][n]; }
                    const u32x4 w = pack8(v[0], v[1]); *(u32x4*)(O + off + bj * HALF) = w;
                    f32x4 r0, r1; unpack8(w, r0, r1);
                    sq += ((r0.x * r0.x + r0.y * r0.y) + (r0.z * r0.z + r0.w * r0.w)) + ((r1.x * r1.x + r1.y * r1.y) + (r1.z * r1.z + r1.w * r1.w)); }
                sq += __shfl_xor(sq, 16); sq += __shfl_xor(sq, 32);
                if (fq == 0) ssq[(size_t)(row0 + ai * HALF + m * 16) * 16 + u.pn * 4 + wc] = sq; }
    }
};
struct EpiGateUp {
    static constexpr bool PERM = true;
    bf16_t* Act; const float* bgu;
    __device__ __forceinline__ void operator()(const f32x4 (&acc)[2][2][4][2], const Unit& u, int wr, int wc, int fr, int fq) const {
        const int e = u.pn >> 3, j = u.pn & 7; const int row0 = u.pm * BM + wr * 64 + fr, col0 = 128 * j + wc * 32 + 8 * fq;
        f32x4 bg[2], bu[2];
#pragma unroll
        for (int n = 0; n < 2; ++n) { bg[n] = *(const f32x4*)(bgu + (size_t)e * 2 * D + col0 + 4 * n); bu[n] = *(const f32x4*)(bgu + (size_t)e * 2 * D + D + col0 + 4 * n); }
#pragma unroll
        for (int ai = 0; ai < 2; ++ai)
#pragma unroll
            for (int m = 0; m < 4; ++m) { f32x4 r[2];
#pragma unroll
                for (int n = 0; n < 2; ++n) { const f32x4 gt = acc[ai][0][m][n] + bg[n], up = acc[ai][1][m][n] + bu[n];
#pragma unroll
                    for (int i = 0; i < 4; ++i) { const float gg = fminf(gt[i], 7.0f), uu = fminf(fmaxf(up[i], -7.0f), 7.0f); r[n][i] = (uu + 1.0f) * (gg * fsig(1.702f * gg)); } }
                *(u32x4*)(Act + (size_t)(row0 + ai * HALF + m * 16) * D + col0) = pack8(r[0], r[1]); }
    }
};
struct EpiDown {
    static constexpr bool PERM = true;
    bf16_t* Slots; const float* bd; const float* roww;
    __device__ __forceinline__ void operator()(const f32x4 (&acc)[2][2][4][2], const Unit& u, int wr, int wc, int fr, int fq) const {
        const int e = u.pn >> 2, j = u.pn & 3; const int row0 = u.pm * BM + wr * 64 + fr, col0 = 256 * j + wc * 32 + 8 * fq;
        f32x4 bv[2][2];
#pragma unroll
        for (int bj = 0; bj < 2; ++bj)
#pragma unroll
            for (int n = 0; n < 2; ++n) bv[bj][n] = *(const f32x4*)(bd + (size_t)e * D + col0 + bj * HALF + 4 * n);
#pragma unroll
        for (int ai = 0; ai < 2; ++ai)
#pragma unroll
            for (int m = 0; m < 4; ++m) { const int row = row0 + ai * HALF + m * 16; const float w = roww[row];
#pragma unroll
                for (int bj = 0; bj < 2; ++bj) { const f32x4 v0 = (acc[ai][bj][m][0] + bv[bj][0]) * w, v1 = (acc[ai][bj][m][1] + bv[bj][1]) * w;
                    *(u32x4*)(Slots + (size_t)row * D + col0 + bj * HALF) = pack8(v0, v1); } }
    }
};
}

#define LASP __attribute__((address_space(3)))
__device__ __forceinline__ void glds16(const void* gsrc, unsigned lds_dst) { unsigned keep;
    asm volatile("s_mov_b32 %0, m0\n\ts_mov_b32 m0, %2\n\ts_nop 0\n\tglobal_load_lds_dwordx4 %1, off\n\ts_mov_b32 m0, %0" : "=&s"(keep) : "v"(gsrc), "s"(lds_dst) : "memory"); }
__device__ __forceinline__ void glds16s(const void* sbase, unsigned voff, unsigned lds_dst) { unsigned keep;
    asm volatile("s_nop 4\n\ts_mov_b32 %0, m0\n\ts_mov_b32 m0, %3\n\ts_nop 0\n\tglobal_load_lds_dwordx4 %1, %2\n\ts_mov_b32 m0, %0" : "=&s"(keep) : "v"(voff), "s"(sbase), "s"(lds_dst) : "memory"); }
typedef short v4i16_t __attribute__((ext_vector_type(4)));
__device__ __forceinline__ s16x4 vtr(const LASP char* p) { return __builtin_bit_cast(s16x4, __builtin_amdgcn_ds_read_tr16_b64_v4i16((LASP v4i16_t*)p)); }

__device__ __forceinline__ float max3f(float a, float b, float c) { float r; asm("v_max3_f32 %0, %1, %2, %3" : "=v"(r) : "v"(a), "v"(b), "v"(c)); return r; }
__device__ __forceinline__ float fadd_s(float a, float b) { float r; asm("v_add_f32_e32 %0, %1, %2" : "=v"(r) : "v"(a), "v"(b)); return r; }
__device__ __forceinline__ unsigned bfbits(float f) { return f2bf(f); }
__device__ __forceinline__ void phase_attn_fast(Ctx& C) {
    const bf16_t* u = (const bf16_t*)(C.ws + WS_U); bf16_t* ycat = (bf16_t*)(C.ws + WS_YCAT);
    const int wave = C.wave;
    const float* lq = C.in[18];
    float lam;
    { const int l_ = lane_id(); const float d1 = wave_sum(lq[l_] * lq[64 + l_]), d2 = wave_sum(lq[128 + l_] * lq[192 + l_]); lam = __builtin_bit_cast(float, __builtin_amdgcn_readfirstlane(__builtin_bit_cast(int, expf(d1) - expf(d2) + 0.2f))); }
    const unsigned lds0 = (unsigned)(uintptr_t)C.lds;
    const LASP char* ldsp = (const LASP char*)C.lds;
    constexpr int SLOT = 24576;
    const int vcu = (C.nblk % 8 == 0) ? (C.blk % 8) * (C.nblk / 8) + C.blk / 8 : C.blk;
    for (int idx = vcu; idx < 256; idx += C.nblk)
#pragma unroll 1
    for (int sub = 0; sub < 2; ++sub) {
        const int b = idx >> 4, hA = (idx >> 3) & 1, qb = idx & 7; const int hh = sub ? 3 - hA : hA;
        const int lane = fresh_lane();
        const int l31 = lane & 31, hi = lane >> 5;
        const int krow = 8 * wave + (lane >> 3), kchunk = (lane & 7) ^ (lane >> 3);
        const int st0 = 4 * wave + (lane >> 5), st1 = st0 + 2;
        const int vrow = (lane & 31) >> 2, vch = lane & 3;
        const unsigned koffb = (unsigned)((krow * INC + kchunk * 8) * 2);
        const unsigned voffb0 = (unsigned)(((8 * (st0 >> 2) + vrow) * INC + 32 * (st0 & 3) + 8 * vch) * 2);
        const unsigned voffb1 = (unsigned)(((8 * (st1 >> 2) + vrow) * INC + 32 * (st1 & 3) + 8 * vch) * 2);
        const int koff0 = l31 * 128, kx = l31 & 7;
        const int vboff = 8192 + (4 * hi + ((lane & 15) >> 2)) * 64 + ((lane >> 4) & 1) * 32 + (lane & 3) * 8;
        const unsigned hm0 = hi ? 0u : 0xffffffffu;
        const unsigned dkdk = hi ? 0u : bfbits((float)l31) * 0x10001u;
        const int q0 = qb * 256 + wave * 32;
        const float slope2 = exp2f(-2.0f * (float)(hh + 1)) * LOG2E;
        const unsigned SH = bfbits(slope2); const unsigned SL = bfbits(slope2 - bf2f(SH)); const unsigned SHSL = SH | (SL << 16);
        const float slope2q = bf2f(SH) + bf2f(SL);
        const unsigned kw0b = hi ? 0x3f803f80u : SHSL, kw1b = hi ? 0x00003f80u : SHSL, ksm = hi ? 0u : 0x80008000u;
        const unsigned qa0 = bfbits((float)q0) * 0x10001u, qa1 = bfbits((float)l31) * 0x10001u;
        const float qpos = (float)(q0 + l31 - 4 * hi);
        const bf16_t* qrow = u + (size_t)(b * SEQ + q0 + l31) * INC + QOFF + hh * 128;
        const bf16_t* kgb = u + (size_t)(b * SEQ) * INC + KOFF + hh * 128;
        const bf16_t* vgb = u + (size_t)(b * SEQ) * INC + VOFF + hh * 128;
        const int t0 = qb * 4, tdiag = q0 >> 6;
#pragma unroll 1
        for (int c = 0; c < 2; ++c) {
            const bf16_t* kgc = kgb + c * 64;
#define ATT_DMA(t, sl) do { const size_t _o = (size_t)(t) * 64 * INC; const unsigned _b = lds0 + (unsigned)(sl) * SLOT; \
        glds16s(kgc + _o, koffb, (unsigned)__builtin_amdgcn_readfirstlane(_b + wave * 1024)); \
        glds16s(vgb + _o, voffb0, (unsigned)__builtin_amdgcn_readfirstlane(_b + 8192 + (2 * wave) * 1024)); \
        glds16s(vgb + _o, voffb1, (unsigned)__builtin_amdgcn_readfirstlane(_b + 8192 + (2 * wave + 1) * 1024)); } while (0)
#define ATT_WAITBAR() asm volatile("s_waitcnt vmcnt(0) lgkmcnt(0)\n\ts_barrier" ::: "memory")
#define ATT_WAITBAR3() asm volatile("s_waitcnt vmcnt(3) lgkmcnt(0)\n\ts_barrier" ::: "memory")
#define ATT_SB() __builtin_amdgcn_sched_barrier(0)
#define ATT_QK(sl, tt) do { const LASP char* Kb_ = ldsp + (sl) * SLOT + koff0; \
        const int kvb_ = (tt) * 64; const bool diag_ = (tt) == tdiag; const bool before_ = kvb_ < q0; \
        const unsigned spos_ = before_ ? 0x80008000u : 0u, sneg_ = before_ ? 0u : 0x80008000u; \
        const unsigned dm_ = diag_ ? ~hm0 : 0xffffffffu; \
        const unsigned w0_ = (kw0b ^ (spos_ & ksm)) & dm_, w1_ = (kw1b ^ (spos_ & ksm)) & dm_, w3_ = (dkdk ^ (sneg_ & ksm)) & dm_; \
        const unsigned k0_ = ((bfbits((float)kvb_) * 0x10001u) ^ sneg_) & hm0 & dm_, k1_ = ((bfbits((float)(kvb_ + 32)) * 0x10001u) ^ sneg_) & hm0 & dm_; \
        const bf16x8 ka0_ = __builtin_bit_cast(bf16x8, (u32x4){w0_, w1_, k0_, w3_}), ka1_ = __builtin_bit_cast(bf16x8, (u32x4){w0_, w1_, k1_, w3_}); \
        P0 = __builtin_amdgcn_mfma_f32_32x32x16_bf16(ka0_, qaug, zero16, 0, 0, 0); P1 = __builtin_amdgcn_mfma_f32_32x32x16_bf16(ka1_, qaug, zero16, 0, 0, 0); \
        _Pragma("unroll") for (int ks = 0; ks < 4; ++ks) { \
            const bf16x8 kf0_ = *(const LASP bf16x8*)(Kb_ + (((2 * ks + hi) ^ kx) * 16)); \
            const bf16x8 kf1_ = *(const LASP bf16x8*)(Kb_ + 4096 + (((2 * ks + hi) ^ kx) * 16)); \
            const bf16x8 qf_ = *(const LASP bf16x8*)(qlds + ks * 1024); \
            P0 = __builtin_amdgcn_mfma_f32_32x32x16_bf16(kf0_, qf_, P0, 0, 0, 0); P1 = __builtin_amdgcn_mfma_f32_32x32x16_bf16(kf1_, qf_, P1, 0, 0, 0); } \
        asm volatile("s_nop 15\n\ts_nop 7" : "+v"(P0), "+v"(P1));     \
        ATT_SB(); } while (0)
#define ATT_SM(tt) do { \
        if ((tt) == tdiag) { const float a_ = qpos - (float)((tt) * 64); \
            _Pragma("unroll") for (int r = 0; r < 16; ++r) { const float x0 = a_ - (float)crow(r, 0); P0[r] = fmaf(fabsf(x0), -slope2q, P0[r]); P1[r] = fmaf(fabsf(x0 - 32.0f), -slope2q, P1[r]); } } \
        float rm_ = max3f(P0[0], P0[1], P1[0]); rm_ = max3f(rm_, P1[1], P0[2]); float rn_ = max3f(P0[3], P1[2], P1[3]); \
        _Pragma("unroll") for (int r = 4; r < 16; r += 2) { rm_ = max3f(rm_, P0[r], P0[r + 1]); rn_ = max3f(rn_, P1[r], P1[r + 1]); } \
        float rm; { const float rq_ = fmaxf(rm_, rn_); auto rr = __builtin_amdgcn_permlane32_swap(__float_as_uint(rq_), __float_as_uint(rq_), false, false); rm = max3f(__uint_as_float(rr[0]), __uint_as_float(rr[1]), -1e30f); } \
        live = !__all(rm < mrel - 40.0f);       \
        if (live) { \
            mrel = fmaxf(mrel, rm); \
            if (__any(rm > 8.0f)) { const float dl = fmaxf(rm, 0.f); mhat += dl; mrel -= dl; \
                _Pragma("unroll") for (int r = 0; r < 16; ++r) { P0[r] -= dl; P1[r] -= dl; } \
                { const unsigned mh_ = bfbits(mhat); const float r1_ = mhat - bf2f(mh_); const unsigned mm_ = bfbits(r1_); const unsigned ml_ = bfbits(r1_ - bf2f(mm_)); \
                  const unsigned a0_ = hi ? ((mh_ | (mm_ << 16)) ^ 0x80008000u) : qa0, a1_ = hi ? (ml_ ^ 0x8000u) : qa1; \
                  qaug = __builtin_bit_cast(bf16x8, (u32x4){a0_, a1_, hi ? 0u : SHSL, hi ? 0u : SHSL}); } \
                const float f = exp2f(-dl); lsum *= f; \
                _Pragma("unroll") for (int eb = 0; eb < 4; ++eb) _Pragma("unroll") for (int r = 0; r < 16; ++r) o[eb][r] *= f; } \
            _Pragma("unroll") for (int r = 0; r < 16; ++r) { P0[r] = __builtin_amdgcn_exp2f(P0[r]); P1[r] = __builtin_amdgcn_exp2f(P1[r]); } \
            asm volatile("s_nop 1" : "+v"(P0), "+v"(P1));     \
            float ps0 = fadd_s(P0[0], P1[0]), ps1 = fadd_s(P0[1], P1[1]); \
            _Pragma("unroll") for (int r = 2; r < 16; r += 2) { ps0 = fadd_s(ps0, P0[r]); ps1 = fadd_s(ps1, P0[r + 1]); ps0 = fadd_s(ps0, P1[r]); ps1 = fadd_s(ps1, P1[r + 1]); } \
            lsum += fadd_s(ps0, ps1); \
            _Pragma("unroll") for (int s2 = 0; s2 < 2; ++s2) { \
                u32x4 w_; w_.x = cvtpk(P0[8 * s2 + 0], P0[8 * s2 + 1]); w_.y = cvtpk(P0[8 * s2 + 2], P0[8 * s2 + 3]); w_.z = cvtpk(P0[8 * s2 + 4], P0[8 * s2 + 5]); w_.w = cvtpk(P0[8 * s2 + 6], P0[8 * s2 + 7]); pf[s2] = __builtin_bit_cast(bf16x8, w_); \
                u32x4 v_; v_.x = cvtpk(P1[8 * s2 + 0], P1[8 * s2 + 1]); v_.y = cvtpk(P1[8 * s2 + 2], P1[8 * s2 + 3]); v_.z = cvtpk(P1[8 * s2 + 4], P1[8 * s2 + 5]); v_.w = cvtpk(P1[8 * s2 + 6], P1[8 * s2 + 7]); pf[2 + s2] = __builtin_bit_cast(bf16x8, v_); } \
        } ATT_SB(); } while (0)
#define ATT_PV(sl) do { if (live) { const LASP char* Vb_ = ldsp + (sl) * SLOT + vboff; \
            _Pragma("unroll") for (int eb = 0; eb < 4; ++eb) _Pragma("unroll") for (int s = 0; s < 4; ++s) { \
                const s16x4 lo_ = vtr(Vb_ + s * 4096 + eb * 512), h4_ = vtr(Vb_ + s * 4096 + 2048 + eb * 512); \
                const bf16x8 vf_ = (bf16x8){lo_[0], lo_[1], lo_[2], lo_[3], h4_[0], h4_[1], h4_[2], h4_[3]}; \
                o[eb] = __builtin_amdgcn_mfma_f32_32x32x16_bf16(vf_, pf[s], o[eb], 0, 0, 0); } } ATT_SB(); } while (0)
            { bf16x8 qf_[4];
#pragma unroll
              for (int ks = 0; ks < 4; ++ks) qf_[ks] = *(const bf16x8*)(qrow + c * 64 + 16 * ks + 8 * hi);
#pragma unroll
              for (int ks = 0; ks < 4; ++ks) *(LASP bf16x8*)((LASP char*)C.lds + 4 * SLOT + wave * 4096 + ks * 1024 + lane * 16) = qf_[ks]; }
            asm volatile("s_waitcnt vmcnt(0)" ::: "memory");
            ATT_DMA(t0, 0); ATT_DMA((t0 + 1) & 31, 1);
            const LASP char* qlds = ldsp + 4 * SLOT + wave * 4096 + lane * 16;
            f32x16 o[4], zero16, P0, P1;
#pragma unroll
            for (int r = 0; r < 16; ++r) zero16[r] = 0.f;
#pragma unroll
            for (int eb = 0; eb < 4; ++eb)
#pragma unroll
                for (int r = 0; r < 16; ++r) o[eb][r] = 0.f;
            float mhat = 0.f, lsum = 0.f, mrel = -1e30f;
            bf16x8 qaug = __builtin_bit_cast(bf16x8, (u32x4){hi ? 0u : qa0, hi ? 0u : qa1, hi ? 0u : SHSL, hi ? 0u : SHSL});
            bf16x8 pf[4]; bool live = false;
            if (wave < 4) {
#pragma unroll 1
                for (int i = 0; i < 32; ++i) {
                    if (i + 1 < 32) ATT_WAITBAR3(); else ATT_WAITBAR();
                    if (i + 2 < 32) ATT_DMA((t0 + i + 2) & 31, (i + 2) & 3);
                    const int tt = (t0 + i) & 31;
                    ATT_QK(i & 3, tt); ATT_SM(tt); ATT_PV(i & 3);
                }
            } else {
#pragma unroll 1
                for (int i = 0; i < 32; ++i) {
                    if (i + 1 < 32) ATT_WAITBAR3(); else ATT_WAITBAR();
                    if (i + 2 < 32) ATT_DMA((t0 + i + 2) & 31, (i + 2) & 3);
                    const int tt = (t0 + i) & 31;
                    ATT_PV((i - 1) & 3); ATT_QK(i & 3, tt); ATT_SM(tt);
                }
                ATT_PV(31 & 3);
            }
#undef ATT_DMA
#undef ATT_QK
#undef ATT_SM
#undef ATT_PV
#undef ATT_SB
            { auto rr = __builtin_amdgcn_permlane32_swap(__float_as_uint(lsum), __float_as_uint(lsum), false, false); lsum = __uint_as_float(rr[0]) + __uint_as_float(rr[1]); }
            const float inv = 1.0f / lsum;
            float* pk = (float*)(C.ws + WS_H2LO) + (size_t)C.gw * 4096;
            pk += fresh_lane();
            if (c == 0) {
#pragma unroll
                for (int eb = 0; eb < 4; ++eb)
#pragma unroll
                    for (int r = 0; r < 16; ++r) pk[(eb * 16 + r) * 64] = o[eb][r] * inv;
            } else {
                float ss = 0.f;
#pragma unroll
                for (int eb = 0; eb < 4; ++eb)
#pragma unroll
                    for (int r = 0; r < 16; ++r) { const float y = pk[(eb * 16 + r) * 64] - lam * (o[eb][r] * inv); o[eb][r] = y; ss += y * y; }
                { auto rr = __builtin_amdgcn_permlane32_swap(__float_as_uint(ss), __float_as_uint(ss), false, false); ss = __uint_as_float(rr[0]) + __uint_as_float(rr[1]); }
                const float rinv = 1.0f / sqrtf(ss * (1.0f / 128.0f) + EPS);
                bf16_t* orow = ycat + (size_t)(b * SEQ + q0 + l31) * D + 512 + hh * 128 + 4 * hi;
#pragma unroll
                for (int eb = 0; eb < 4; ++eb)
#pragma unroll
                    for (int g4 = 0; g4 < 4; ++g4) { const int e = 32 * eb + 8 * g4;
                        u32x2 w; w.x = cvtpk(o[eb][4 * g4] * rinv, o[eb][4 * g4 + 1] * rinv); w.y = cvtpk(o[eb][4 * g4 + 2] * rinv, o[eb][4 * g4 + 3] * rinv);
                        *(u32x2*)(orow + e) = w; }
            }
        }
    }
    ATT_WAITBAR();
#undef ATT_WAITBAR
#undef ATT_WAITBAR3
}

#define LDS_BAR() asm volatile("s_waitcnt lgkmcnt(0)\n\ts_barrier" ::: "memory")
__device__ __forceinline__ void phase_hy_pre_fast(Ctx& C) {
    const bf16_t* u = (const bf16_t*)(C.ws + WS_U); bf16_t* vpt = (bf16_t*)(C.ws + WS_VP); bf16_t* x0t = (bf16_t*)(C.ws + WS_X0C);
    const float* cw = C.in[7]; const float* cb = C.in[8];
    bf16_t* sv = (bf16_t*)C.lds; bf16_t* sx = sv + 64 * 72 + 64;
    const int tl = C.tid >> 3, c8 = C.tid & 7;
    constexpr int NTILES = NB * 32 * 8;
#define HYP_LOAD(dst, tile_) do { const int cq_ = (tile_) & 7, tq_ = ((tile_) >> 3) & 31, b_ = (tile_) >> 8; const int c0_ = cq_ * 64 + c8 * 8, t_ = tq_ * 64 + tl; const size_t row_ = (size_t)b_ * SEQ + t_; \
        const u32x4 z_ = {0u, 0u, 0u, 0u}; \
        _Pragma("unroll") for (int s_ = 0; s_ < 3; ++s_) { const int ch_ = s_ * HW + c0_; \
            dst[s_][0] = (t_ > 0) ? *(const u32x4*)(u + (row_ - 1) * INC + ch_) : z_; dst[s_][1] = *(const u32x4*)(u + row_ * INC + ch_); dst[s_][2] = (t_ < SEQ - 1) ? *(const u32x4*)(u + (row_ + 1) * INC + ch_) : z_; } } while (0)
    u32x4 cur[3][3], nxt[3][3];
    int tile = C.blk;
    if (tile < NTILES) HYP_LOAD(cur, tile);
    for (; tile < NTILES; tile += C.nblk) {
        const bool more = tile + C.nblk < NTILES;
        if (more) HYP_LOAD(nxt, tile + C.nblk);
        const int cq = tile & 7, tq = (tile >> 3) & 31, b = tile >> 8;
        const int c0 = cq * 64 + c8 * 8;
        float r[3][8];
#pragma unroll
        for (int s = 0; s < 3; ++s) {
            const int ch = s * HW + c0;
            f32x4 m0, m1, z0, z1, p0, p1; pg8::unpack8(cur[s][0], m0, m1); pg8::unpack8(cur[s][1], z0, z1); pg8::unpack8(cur[s][2], p0, p1);
            const f32x4 w00 = *(const f32x4*)(cw + ch), w01 = *(const f32x4*)(cw + ch + 4), w10 = *(const f32x4*)(cw + 3 * HW + ch), w11 = *(const f32x4*)(cw + 3 * HW + ch + 4);
            const f32x4 w20 = *(const f32x4*)(cw + 6 * HW + ch), w21 = *(const f32x4*)(cw + 6 * HW + ch + 4), bb0 = *(const f32x4*)(cb + ch), bb1 = *(const f32x4*)(cb + ch + 4);
            const f32x4 a0 = m0 * w00 + z0 * w10 + p0 * w20 + bb0, a1 = m1 * w01 + z1 * w11 + p1 * w21 + bb1;
#pragma unroll
            for (int i = 0; i < 4; ++i) { r[s][i] = a0[i]; r[s][4 + i] = a1[i]; }
        }
        LDS_BAR();
#pragma unroll
        for (int i = 0; i < 8; ++i) { sx[(c8 * 8 + i) * 72 + c8 * 8 + tl] = (bf16_t)f2bf(r[0][i]); sv[(c8 * 8 + i) * 72 + c8 * 8 + tl] = (bf16_t)f2bf(r[2][i] * r[1][i]); }
        LDS_BAR();
        { const int cl = C.tid >> 3, chk = C.tid & 7; const size_t o = ((size_t)(cq * 64 + cl) * NB + b) * SEQ + tq * 64 + chk * 8;
          *(u32x4*)(vpt + o) = *(const u32x4*)(sv + cl * 72 + (cl >> 3) * 8 + chk * 8); *(u32x4*)(x0t + o) = *(const u32x4*)(sx + cl * 72 + (cl >> 3) * 8 + chk * 8); }
        if (more) {
#pragma unroll
            for (int s = 0; s < 3; ++s)
#pragma unroll
                for (int q = 0; q < 3; ++q) cur[s][q] = nxt[s][q]; }
    }
#undef HYP_LOAD
    __syncthreads();
}

__device__ __forceinline__ void phase_toeplitz(Ctx& C) {
    constexpr int VROW = 4096 + 16, FCOPY = 8192 + 32, FL = 16 * VROW;
    const bf16_t* vpt = (const bf16_t*)(C.ws + WS_VP); const bf16_t* x0t = (const bf16_t*)(C.ws + WS_X0C); bf16_t* yt = (bf16_t*)(C.ws + WS_YT);
    const float* kfc = (const float*)(C.ws + WS_KFC); const float* dsk = C.in[17];
    const int lane = C.lane, a = lane & 15, g = lane >> 4, wave = C.wave;
    const unsigned lds0 = (unsigned)(uintptr_t)C.lds;
    const LASP char* ldsp = (const LASP char*)C.lds;
    const int t0 = 256 * wave;
    const int c0 = 2048 - t0 + 8 * g - a;
    const LASP char* fbase = ldsp + FL + (c0 & 7) * FCOPY + 2 * (c0 & ~7);
    const LASP char* vbase = ldsp + a * VROW + 16 * g;
    for (int c = C.blk; c < HW; c += C.nblk) {
        asm volatile("s_waitcnt vmcnt(0) lgkmcnt(0)\n\ts_barrier" ::: "memory");
        { const char* src = (const char*)(vpt + (size_t)c * NB * SEQ) + lane * 16;
#pragma unroll
          for (int j = 0; j < 8; ++j) { const int p = wave * 8 + j;
              glds16(src + (size_t)p * 1024, (unsigned)__builtin_amdgcn_readfirstlane(lds0 + (p >> 2) * VROW + (p & 3) * 1024)); } }
        { const int q = C.tid; const float* kc = kfc + (size_t)c * 4096; float f[15];
#pragma unroll
          for (int i = 0; i < 15; ++i) { const int idx = 4096 - 8 * q - i; f[i] = (idx >= 1 && idx <= 4095) ? kc[idx] : 0.f; }
#pragma unroll
          for (int m = 0; m < 8; ++m) { u32x4 w; w.x = pk2(f[m], f[m + 1]); w.y = pk2(f[m + 2], f[m + 3]); w.z = pk2(f[m + 4], f[m + 5]); w.w = pk2(f[m + 6], f[m + 7]);
              *(LASP u32x4*)((LASP char*)C.lds + FL + m * FCOPY + q * 16) = w; } }
        asm volatile("s_waitcnt vmcnt(0) lgkmcnt(0)\n\ts_barrier" ::: "memory");
        f32x4 acc[16]; bf16x8 W[16];
#pragma unroll
        for (int r = 0; r < 16; ++r) { acc[r] = (f32x4){0.f, 0.f, 0.f, 0.f}; W[r] = *(const LASP bf16x8*)(fbase - 32 * r); }
#pragma unroll 1
        for (int ko = 0; ko < 8; ++ko) {
            const LASP char* fb = fbase + ko * 512; const LASP char* vb = vbase + ko * 512;
#pragma unroll
            for (int kk = 0; kk < 8; ++kk) {
                const bf16x8 Bf = *(const LASP bf16x8*)(vb + 64 * kk);
#pragma unroll
                for (int r = 0; r < 16; ++r) acc[r] = __builtin_amdgcn_mfma_f32_16x16x32_bf16(W[(r - 2 * kk) & 15], Bf, acc[r], 0, 0, 0);
                if (ko < 7 || kk < 7) { W[(-2 * kk - 2) & 15] = *(const LASP bf16x8*)(fb + 64 * kk + 64); W[(-2 * kk - 1) & 15] = *(const LASP bf16x8*)(fb + 64 * kk + 32); }
            }
        }
        const float dd = dsk[c];
#pragma unroll
        for (int r = 0; r < 16; ++r) { const int t = t0 + 16 * r + 4 * g; const size_t o = ((size_t)c * NB + a) * SEQ + t;
            const u32x2 vv = *(const LASP u32x2*)(ldsp + a * VROW + t * 2); const u32x2 xx = *(const u32x2*)(x0t + o);
            const float y0 = (acc[r][0] + bflo(vv.x) * dd) * bflo(xx.x), y1 = (acc[r][1] + bfhi(vv.x) * dd) * bfhi(xx.x);
            const float y2 = (acc[r][2] + bflo(vv.y) * dd) * bflo(xx.y), y3 = (acc[r][3] + bfhi(vv.y) * dd) * bfhi(xx.y);
            u32x2 w; w.x = pk2(y0, y1); w.y = pk2(y2, y3); *(u32x2*)(yt + o) = w; }
    }
    asm volatile("s_waitcnt vmcnt(0) lgkmcnt(0)\n\ts_barrier" ::: "memory");
}

__device__ __forceinline__ void phase_hy_post(Ctx& C) {
    const bf16_t* yt = (const bf16_t*)(C.ws + WS_YT); bf16_t* ycat = (bf16_t*)(C.ws + WS_YCAT);
    bf16_t* sy = (bf16_t*)C.lds;
    constexpr int NTILES = NB * 32 * 8;
    const int cl = C.tid >> 3, chk = C.tid & 7, tl = C.tid >> 3, c8 = C.tid & 7;
#define HYQ_LOAD(tile_) (*(const u32x4*)(yt + ((size_t)(((tile_) & 7) * 64 + cl) * NB + ((tile_) >> 8)) * SEQ + (((tile_) >> 3) & 31) * 64 + chk * 8))
    int tile = C.blk; u32x4 cur = {0u, 0u, 0u, 0u}, nxt = cur;
    if (tile < NTILES) cur = HYQ_LOAD(tile);
    for (; tile < NTILES; tile += C.nblk) {
        const bool more = tile + C.nblk < NTILES;
        if (more) nxt = HYQ_LOAD(tile + C.nblk);
        const int cq = tile & 7, tq = (tile >> 3) & 31, b = tile >> 8;
        LDS_BAR();
        *(u32x4*)(sy + cl * 72 + (cl >> 3) * 8 + chk * 8) = cur;
        LDS_BAR();
        { unsigned short e[8];
#pragma unroll
          for (int i = 0; i < 8; ++i) e[i] = sy[(c8 * 8 + i) * 72 + c8 * 8 + tl];
          u32x4 w; w.x = e[0] | ((unsigned)e[1] << 16); w.y = e[2] | ((unsigned)e[3] << 16); w.z = e[4] | ((unsigned)e[5] << 16); w.w = e[6] | ((unsigned)e[7] << 16);
          *(u32x4*)(ycat + ((size_t)b * SEQ + tq * 64 + tl) * D + cq * 64 + c8 * 8) = w; }
        cur = nxt;
    }
#undef HYQ_LOAD
    __syncthreads();
}

__device__ __forceinline__ void phase_route(Ctx& C) {
    const float* mod = (const float*)(C.ws + WS_MOD); const float* ssq = (const float*)(C.ws + WS_LOGITS); bf16_t* h2 = (bf16_t*)(C.ws + WS_H); const bf16_t* wrt = (const bf16_t*)(C.ws + WS_WRT);
    int* tope = (int*)(C.ws + WS_TOPE); float* topw = (float*)(C.ws + WS_TOPW); int* blkcnt = (int*)(C.ws + WS_BLKCNT);
    const float* g = C.in[23]; const float* br = C.in[25];
    constexpr int WROW = 4096 + 16;
    LASP char* wl_ = (LASP char*)C.lds;
    int* hist = (int*)(C.lds + 32 * WROW); float* slog = (float*)(C.lds + 32 * WROW + 256) + C.wave * 512;
    const int lane = C.lane, tk = lane & 15, gq = lane >> 4;
    __syncthreads();
    for (int i = C.tid; i < NE * 256; i += NTHREADS) { const int e = i >> 8, ch = i & 255; *(LASP u32x4*)(wl_ + e * WROW + ch * 16) = *(const u32x4*)(wrt + (size_t)e * 2048 + ch * 8); }
    const float* mult2 = mod + 16 * 6 * D;
    for (int vb = C.blk; vb < 256; vb += C.nblk) {
        __syncthreads();
        if (C.tid < NE) hist[C.tid] = 0;
        __syncthreads();
        const int tok = vb * 128 + C.wave * 16 + tk; const int b = tok / SEQ;
        float rstd;
        { const f32x4* sp = (const f32x4*)(ssq + (size_t)tok * 16); const f32x4 a0 = sp[0], a1 = sp[1], a2 = sp[2], a3 = sp[3];
          const float ss = ((a0.x + a0.y) + (a0.z + a0.w)) + ((a1.x + a1.y) + (a1.z + a1.w)) + ((a2.x + a2.y) + (a2.z + a2.w)) + ((a3.x + a3.y) + (a3.z + a3.w));
          rstd = 1.0f / sqrtf(ss * (1.0f / D) + EPS); }
        const bf16_t* xr = (const bf16_t*)(C.ws + WS_X1) + (size_t)tok * D + 8 * gq; const float* sh = mod + (size_t)b * 6 * D + 3 * D + 8 * gq; const float* ml = mult2 + (size_t)b * D + 8 * gq;
        bf16_t* hr = h2 + (size_t)tok * D + 8 * gq;
        const LASP char* wb = wl_ + tk * WROW + 16 * gq;
        f32x4 acc[2]; acc[0] = (f32x4){0.f, 0.f, 0.f, 0.f}; acc[1] = acc[0];
#pragma unroll 1
        for (int kh = 0; kh < D; kh += 512) {
        u32x4 xall[16];
#pragma unroll
        for (int q = 0; q < 16; ++q) xall[q] = __builtin_nontemporal_load((const u32x4*)(xr + kh + 32 * q));
#pragma unroll
        for (int q = 0; q < 16; ++q) { const int k = kh + 32 * q;
            f32x4 x0, x1v; pg8::unpack8(xall[q], x0, x1v);
            const f32x4 m0 = *(const f32x4*)(ml + k) * rstd, m1 = *(const f32x4*)(ml + k + 4) * rstd, s0 = *(const f32x4*)(sh + k), s1 = *(const f32x4*)(sh + k + 4);
            const f32x4 h0 = x0 * m0 + s0, h1 = x1v * m1 + s1;
            u32x4 wh; wh.x = cvtpk(h0[0], h0[1]); wh.y = cvtpk(h0[2], h0[3]); wh.z = cvtpk(h1[0], h1[1]); wh.w = cvtpk(h1[2], h1[3]);
            *(u32x4*)(hr + k) = wh;
            u32x4 wlo; wlo.x = cvtpk(h0[0] - bflo(wh.x), h0[1] - bfhi(wh.x)); wlo.y = cvtpk(h0[2] - bflo(wh.y), h0[3] - bfhi(wh.y)); wlo.z = cvtpk(h1[0] - bflo(wh.z), h1[1] - bfhi(wh.z)); wlo.w = cvtpk(h1[2] - bflo(wh.w), h1[3] - bfhi(wh.w));
            const bf16x8 a_h = __builtin_bit_cast(bf16x8, wh), a_l = __builtin_bit_cast(bf16x8, wlo);
#pragma unroll
            for (int n = 0; n < 2; ++n) { const LASP char* bp = wb + n * 16 * WROW + k * 2;
                const bf16x8 b_h = *(const LASP bf16x8*)(bp), b_l = *(const LASP bf16x8*)(bp + 2048);
                acc[n] = __builtin_amdgcn_mfma_f32_16x16x32_bf16(b_h, a_h, acc[n], 0, 0, 0);
                acc[n] = __builtin_amdgcn_mfma_f32_16x16x32_bf16(b_h, a_l, acc[n], 0, 0, 0);
                acc[n] = __builtin_amdgcn_mfma_f32_16x16x32_bf16(b_l, a_h, acc[n], 0, 0, 0); }
        } }
#pragma unroll
        for (int n = 0; n < 2; ++n) *(f32x4*)(slog + tk * 32 + n * 16 + 4 * gq) = acc[n];
        __builtin_amdgcn_s_waitcnt(0xc07f); asm volatile("" ::: "memory");
        if (lane < 16) {
            const int t = vb * 128 + C.wave * 16 + lane;
            float v[32];
#pragma unroll
            for (int q = 0; q < 8; ++q) { const f32x4 x = *(const f32x4*)(slog + lane * 32 + 4 * q), bb = *(const f32x4*)(br + 4 * q);
                v[4 * q] = x.x + bb.x; v[4 * q + 1] = x.y + bb.y; v[4 * q + 2] = x.z + bb.z; v[4 * q + 3] = x.w + bb.w; }
            float tv[4]; int ti[4];
#pragma unroll
            for (int k = 0; k < 4; ++k) {
                float best = -INFINITY; int bi = 0;
#pragma unroll
                for (int e = 0; e < 32; ++e) if (v[e] > best) { best = v[e]; bi = e; }
                tv[k] = best; ti[k] = bi;
#pragma unroll
                for (int e = 0; e < 32; ++e) v[e] = (e == bi) ? -INFINITY : v[e];
            }
            const float e0 = 1.0f, e1 = expf(tv[1] - tv[0]), e2 = expf(tv[2] - tv[0]), e3 = expf(tv[3] - tv[0]);
            const float inv = 1.0f / (e0 + e1 + e2 + e3);
            *(int4*)(tope + (size_t)t * 4) = make_int4(ti[0], ti[1], ti[2], ti[3]);
            *(f32x4*)(topw + (size_t)t * 4) = (f32x4){e0 * inv, e1 * inv, e2 * inv, e3 * inv};
#pragma unroll
            for (int k = 0; k < 4; ++k) atomicAdd(&hist[ti[k]], 1);
        }
        __syncthreads();
        if (C.tid < NE) blkcnt[vb * NE + C.tid] = hist[C.tid];
    }
    __syncthreads();
}

__device__ __forceinline__ void phase_rowlist(Ctx& C) {
    const int* tope = (const int*)(C.ws + WS_TOPE); const int* blkcnt = (const int*)(C.ws + WS_BLKCNT);
    int* rowpair = (int*)(C.ws + WS_ROWPAIR); int* tileexp = (int*)(C.ws + WS_TILEEXP); int* meta = (int*)(C.ws + WS_META);
    float* roww = (float*)(C.ws + WS_ROWW); const float* topw = (const float*)(C.ws + WS_TOPW); int* rowinv = (int*)(C.ws + WS_TOPE);
    int* s_total = (int*)C.lds; int* s_base = s_total + 32; int* s_pstart = s_base + 32; int* s_e = s_pstart + 36; int* s_cnt = s_e + 512; int* s_wc = s_cnt + 256 * 32;
    for (int vb = C.blk; vb < 256; vb += C.nblk) {
        __syncthreads();
        { const int4* src = (const int4*)blkcnt; int4* dst = (int4*)s_cnt;
#pragma unroll
          for (int q = 0; q < 4; ++q) dst[q * NTHREADS + C.tid] = src[q * NTHREADS + C.tid]; }
        s_e[C.tid] = tope[(size_t)vb * 512 + C.tid];
        __syncthreads();
        if (C.tid < NE) { int tot = 0, base = 0;
#pragma unroll 8
            for (int q = 0; q < 256; ++q) { const int c = s_cnt[q * NE + C.tid]; tot += c; if (q < vb) base += c; } s_total[C.tid] = tot; s_base[C.tid] = base; }
        __syncthreads();
        if (C.tid == 0) { int ps = 0; for (int e = 0; e < NE; ++e) { s_pstart[e] = ps; ps += ((s_total[e] + 255) / 256) * 256; } s_pstart[NE] = ps; }
        __syncthreads();
        { const int e = s_e[C.tid]; int rank = 0;
          for (int q = 0; q < NE; ++q) { const unsigned long long mq = __ballot(e == q); if (e == q) rank = __builtin_popcountll(mq & ((1ull << C.lane) - 1ull)); if (C.lane == 0) s_wc[C.wave * NE + q] = __builtin_popcountll(mq); }
          __syncthreads();
          for (int w = 0; w < C.wave; ++w) rank += s_wc[w * NE + e];
          rowpair[s_pstart[e] + s_base[e] + rank] = vb * 512 + C.tid; roww[s_pstart[e] + s_base[e] + rank] = topw[vb * 512 + C.tid]; rowinv[vb * 512 + C.tid] = s_pstart[e] + s_base[e] + rank; }
        if (vb < NE) { const int e = vb; for (int r = s_pstart[e] + s_total[e] + C.tid; r < s_pstart[e + 1]; r += NTHREADS) { rowpair[r] = -1; roww[r] = 0.f; } }
        if (vb == 0) {
            if (C.tid < NE) { for (int tl = s_pstart[C.tid] / 256; tl < s_pstart[C.tid + 1] / 256; ++tl) tileexp[tl] = C.tid; }
            if (C.tid == 0) meta[0] = s_pstart[NE] / 256;
        }
    }
    __syncthreads();
}


#define LDS3(C) ((PG8_LAS unsigned char*)(C).lds)
__device__ __forceinline__ void phase_inproj_fast(Ctx& C) {
    pg8::Gemm g{(const bf16_t*)(C.ws + WS_H), (const bf16_t*)(C.ws + WS_WIN), D, D, D, nullptr};
    pg8::StaticOrder S; S.init(T / 256, INC / 256, C.nblk, C.blk);
    pg8::EpiInproj E{(bf16_t*)(C.ws + WS_U), C.in[6]};
    pg8::gemm_phase<pg8::EpiInproj, pg8::StaticOrder, false>(LDS3(C), g, S, E, C.wave);
}
#ifndef XVAR
#define XVAR 0
#endif
__device__ __forceinline__ void phase_probe_x(Ctx& C) {
#if XVAR == 1 || XVAR == 2
    pg8::Gemm g{(const bf16_t*)(C.ws + WS_H), (const bf16_t*)(C.ws + WS_WIN), D, D, D, nullptr};
    pg8::StaticOrder S; S.init(T / 256, INC / 256, C.nblk, C.blk);
    pg8::EpiInprojT<XVAR> E{(bf16_t*)(C.ws + WS_U), C.in[6]};
    pg8::gemm_phase<pg8::EpiInprojT<XVAR>, pg8::StaticOrder, false>(LDS3(C), g, S, E, C.wave);
#endif
}
__device__ __forceinline__ void phase_cat_fast(Ctx& C) {
    pg8::StaticOrder S; S.init(T / 256, D / 256, C.nblk, C.blk);
    pg8::Gemm g{(const bf16_t*)(C.ws + WS_YCAT), (const bf16_t*)(C.ws + WS_WCAT), D, D, D, nullptr};
    pg8::EpiCatR E{(bf16_t*)(C.ws + WS_MERGED), (const bf16_t*)(C.ws + WS_U)};
    pg8::gemm_phase<pg8::EpiCatR, pg8::StaticOrder, false, true>(LDS3(C), g, S, E, C.wave);
}
__device__ __forceinline__ void phase_mix_fast(Ctx& C) {
    pg8::Gemm g{(const bf16_t*)(C.ws + WS_MERGED), (const bf16_t*)(C.ws + WS_WMIX), D, D, D, nullptr};
    pg8::StaticOrder S; S.init(T / 256, D / 256, C.nblk, C.blk);
    pg8::EpiMix E{C.in[0], (bf16_t*)(C.ws + WS_X1), (const float*)(C.ws + WS_MOD), (float*)(C.ws + WS_LOGITS)};
    pg8::gemm_phase<pg8::EpiMix, pg8::StaticOrder, false>(LDS3(C), g, S, E, C.wave);
}
__device__ __forceinline__ void phase_gateup_fast(Ctx& C) {
    const int nmt = ((const int*)(C.ws + WS_META))[0];
    pg8::Gemm g{(const bf16_t*)(C.ws + WS_H), (const bf16_t*)(C.ws + WS_WGU), D, D, D, (const int*)(C.ws + WS_ROWPAIR)};
    { PG8_LAS int* te = (PG8_LAS int*)(LDS3(C) + 131072); const int* tg = (const int*)(C.ws + WS_TILEEXP); for (int i = C.tid; i < nmt; i += NTHREADS) te[i] = tg[i]; __syncthreads(); }
    pg8::MoeOrder S; S.b.init(nmt, 8, C.nblk, C.blk); S.tileexp = (const PG8_LAS int*)(LDS3(C) + 131072); S.nN = 8;
    pg8::EpiGateUp E{(bf16_t*)(C.ws + WS_ACT), C.in[27]};
    pg8::gemm_phase<pg8::EpiGateUp, pg8::MoeOrder, true>(LDS3(C), g, S, E, C.wave);
}
__device__ __forceinline__ void phase_down_fast(Ctx& C) {
    const int nmt = ((const int*)(C.ws + WS_META))[0];
    pg8::Gemm g{(const bf16_t*)(C.ws + WS_ACT), (const bf16_t*)(C.ws + WS_WDN), D, D, D, nullptr};
    { PG8_LAS int* te = (PG8_LAS int*)(LDS3(C) + 131072); const int* tg = (const int*)(C.ws + WS_TILEEXP); for (int i = C.tid; i < nmt; i += NTHREADS) te[i] = tg[i]; __syncthreads(); }
    pg8::MoeOrder S; S.b.init(nmt, 4, C.nblk, C.blk); S.tileexp = (const PG8_LAS int*)(LDS3(C) + 131072); S.nN = 4;
    pg8::EpiDown E{(bf16_t*)(C.ws + WS_SLOTS), C.in[29], (const float*)(C.ws + WS_ROWW)};
    pg8::gemm_phase<pg8::EpiDown, pg8::MoeOrder, false>(LDS3(C), g, S, E, C.wave);
}


#define XB_TMO      128
#define XB_XCNT(j)  (256  + 64 * (j))
#define XB_XSUB(j)  (1280 + 64 * (j))
#define XB_XGEN(j)  (2304 + 64 * (j))
#define XB_TOP      3328
#define XB_TOPGEN   3392
#define XCD_BAR_WORDS 3456
#define XB_SPIN_CAP (1u << 18)
#define XLAS __attribute__((address_space(3)))
__device__ __forceinline__ unsigned xb_ld(unsigned* p)              { return __hip_atomic_load(p, __ATOMIC_RELAXED, __HIP_MEMORY_SCOPE_AGENT); }
__device__ __forceinline__ unsigned xb_add(unsigned* p, unsigned v) { return __hip_atomic_fetch_add(p, v, __ATOMIC_RELAXED, __HIP_MEMORY_SCOPE_AGENT); }
__device__ __forceinline__ unsigned xb_xcc_id() { return (unsigned)__builtin_amdgcn_s_getreg((3 << 11) | 20) & 0xFu; }
#define XB_SPIN(cond, bar) do { unsigned _sp = 0; while (cond) { __builtin_amdgcn_s_sleep(1); \
    if ((++_sp & 255u) == 0u) { if (xb_ld(&(bar)[XB_TMO])) break; if (_sp > XB_SPIN_CAP) { atomicAdd(&(bar)[XB_TMO], 1u); break; } } } } while (0)
struct XcdBarrier { unsigned* bar; unsigned x; volatile XLAS unsigned* st; };
__device__ __forceinline__ XcdBarrier xcd_barrier_post(unsigned* bar, volatile XLAS unsigned* st, bool leader) {
    XcdBarrier b; b.bar = bar; b.x = xb_xcc_id(); b.st = st;
    if (leader) (void)xb_add(&bar[XB_XCNT(b.x)], 1u);
    return b;
}
__device__ __forceinline__ void xcd_barrier_complete(unsigned* bar, unsigned x, unsigned& nloc, unsigned& nx) {
    const unsigned G = gridDim.x * gridDim.y * gridDim.z;
    unsigned sum, cnt, mine, sp = 0u;
    for (;;) {
        sum = 0u; cnt = 0u; mine = 0u;
#pragma unroll
        for (unsigned j = 0; j < 16; ++j) { const unsigned c = xb_ld(&bar[XB_XCNT(j)]); sum += c; cnt += (c > 0u) ? 1u : 0u; mine = (j == x) ? c : mine; }
        if (sum == G) break;
        __builtin_amdgcn_s_sleep(1);
        if ((++sp & 255u) == 0u) { if (xb_ld(&bar[XB_TMO])) break; if (sp > XB_SPIN_CAP) { atomicAdd(&bar[XB_TMO], 1u); break; } }
    }
    nloc = mine > 0u ? mine : 1u; nx = cnt > 0u ? cnt : 1u;
}
__device__ __forceinline__ void xcd_barrier(const XcdBarrier& b, int wave_) {
    asm volatile("s_waitcnt vmcnt(0)" ::: "memory");
    __syncthreads();
    if (wave_ == 0 && lane_id() == 0) {
        unsigned* bar = b.bar;
        __builtin_amdgcn_s_waitcnt(0);
        unsigned nloc = b.st[0], nx = b.st[1];
        if (nloc == 0u) { xcd_barrier_complete(bar, b.x, nloc, nx); b.st[0] = nloc; b.st[1] = nx; }
        const unsigned old = xb_add(&bar[XB_XSUB(b.x)], 1u);
        const unsigned gen = old / nloc;
        if (old + 1u == (gen + 1u) * nloc) {
            __builtin_amdgcn_fence(__ATOMIC_RELEASE, "agent");
            asm volatile("s_waitcnt vmcnt(0)" ::: "memory");
            const unsigned og = xb_add(&bar[XB_TOP], 1u);
            const unsigned tg = og / nx;
            if (og + 1u == (tg + 1u) * nx) xb_add(&bar[XB_TOPGEN], 1u);
            else XB_SPIN(xb_ld(&bar[XB_TOPGEN]) == tg, bar);
            __builtin_amdgcn_fence(__ATOMIC_ACQUIRE, "agent");
            xb_add(&bar[XB_XGEN(b.x)], 1u);
            asm volatile("s_waitcnt vmcnt(0)" ::: "memory");
        } else {
            XB_SPIN(xb_ld(&bar[XB_XGEN(b.x)]) == gen, bar);
            __builtin_amdgcn_fence(__ATOMIC_ACQUIRE, "agent");
            asm volatile("s_waitcnt vmcnt(0)" ::: "memory");
        }
    }
    __syncthreads();
}

constexpr int NPHASES = 13;
}

__global__ void __launch_bounds__(NTHREADS, 2) fwd_kernel(Params p) {
    extern __shared__ __attribute__((aligned(16))) unsigned char lds[];
    cg::grid_group grid = cg::this_grid();
    Ctx C;
#pragma unroll
    for (int i = 0; i < 31; ++i) C.in[i] = p.in[i];
    C.out = p.out; C.ws = p.ws; C.lds = lds;
    const int wave_s = __builtin_amdgcn_readfirstlane(threadIdx.x >> 6);
    C.lane = lane_id(); C.wave = wave_s; C.tid = wave_s * 64 + C.lane;
    C.blk = blockIdx.x; C.nblk = gridDim.x; C.gw = C.blk * NWAVES + C.wave; C.ngw = C.nblk * NWAVES;
    const int lo = p.ph_lo, hi = p.ph_hi;
    volatile XLAS unsigned* misc = (volatile XLAS unsigned*)((XLAS unsigned char*)lds + (LDS_BYTES - 64));
    if (C.tid < 16) misc[C.tid] = 0u;
    __syncthreads();
    const XcdBarrier xbar = xcd_barrier_post((unsigned*)(p.ws + WS_CTL), misc, C.tid == 0);
#define GSYNC(k) do { xcd_barrier(xbar, wave_s); } while (0)
    if (lo < 0) grid.sync();
#ifndef PHMASK
#define PHMASK 0xffff
#endif
#ifndef REPMASK
#define REPMASK 0
#endif
#ifndef PROBE_PHASE
#define PROBE_PHASE (-1)
#endif
    unsigned long long tp0 = 0, tp1 = 0;
#define PH(k, body) do { if ((PHMASK >> (k)) & 1) { if (lo <= (k) && (k) < hi) { if ((k) == PROBE_PHASE) tp0 = __builtin_amdgcn_s_memrealtime(); _Pragma("unroll 1") for (int rep_ = (REPMASK >> (k)) & 1; rep_ >= 0; --rep_) { { C.lane = fresh_lane(); C.wave = wave_s; C.tid = wave_s * 64 + C.lane; C.gw = C.blk * NWAVES + C.wave; } body; if (rep_ > 0 || (k) + 1 < hi) GSYNC(k); } if ((k) == PROBE_PHASE) tp1 = __builtin_amdgcn_s_memrealtime(); } } } while (0)
#ifdef SYNCPROBE
    for (int i = 0; i < 20; ++i) GSYNC(1);
#endif
    PH(0, { phase_mod(C); phase_filters(C); });
    PH(1, { phase_weights(C); __syncthreads(); phase_norm1(C); });
#ifndef FASTMASK
#define FASTMASK 0xffff
#endif
#define FAST(k) ((FASTMASK >> (k)) & 1)
    PH(2, phase_inproj_fast(C));
#if XVAR == 1 || XVAR == 2
    PH(13, phase_probe_x(C));
#endif
    PH(3, phase_hy_pre_fast(C));
    PH(4, { phase_toeplitz(C); phase_attn_fast(C); });
    PH(5, phase_hy_post(C));
    PH(6, phase_cat_fast(C));
    PH(7, phase_mix_fast(C));
    PH(8, phase_route(C));
    PH(9, phase_rowlist(C));
    PH(10, phase_gateup_fast(C));
    PH(11, phase_down_fast(C));
    PH(12, phase_final(C));
#undef PH
    if (PROBE_PHASE >= 0 && C.blk == 0) { const unsigned long long te = __builtin_amdgcn_s_memrealtime(), span = 4ull * (tp1 - tp0); while (__builtin_amdgcn_s_memrealtime() - te < span) __builtin_amdgcn_s_sleep(8); }
}

extern "C" void kernel_launch(void* const* d_in, const int* in_sizes, int n_in, void* d_out, int out_size, void* d_ws, size_t ws_size, hipStream_t stream) {
    static int grid = 0;
    if (grid == 0) {
        if (n_in != 31 || ws_size < WS_END) { fprintf(stderr, "kernel_launch: unexpected n_in %d or ws_size %zu\n", n_in, ws_size); grid = -1; return; }
        int dev = 0, cus = 0, per_cu = 0;
        hipGetDevice(&dev); hipDeviceGetAttribute(&cus, hipDeviceAttributeMultiprocessorCount, dev);
        hipFuncSetAttribute((const void*)fwd_kernel, hipFuncAttributeMaxDynamicSharedMemorySize, LDS_BYTES);
        hipOccupancyMaxActiveBlocksPerMultiprocessor(&per_cu, (const void*)fwd_kernel, NTHREADS, LDS_BYTES);
        if (per_cu < 1) { fprintf(stderr, "kernel_launch: occupancy query says %d blocks/CU\n", per_cu); per_cu = 1; }
        (void)hipGetLastError();
        grid = cus * 1;
        fprintf(stderr, "kernel_launch: cus %d per_cu %d grid %d\n", cus, per_cu, grid);
    }
    if (grid < 0) return;
    if (hipMemsetAsync((char*)d_ws + WS_CTL, 0, 65536, stream) != hipSuccess) { fprintf(stderr, "kernel_launch: memset failed\n"); return; }
    Params p{};
    for (int i = 0; i < 31; ++i) p.in[i] = (const float*)d_in[i];
    p.out = (float*)d_out; p.ws = (unsigned char*)d_ws; p.ph_lo = 0; p.ph_hi = NPHASES + (XVAR ? 1 : 0);
    void* args[] = {&p};
    hipError_t e = hipLaunchCooperativeKernel((const void*)fwd_kernel, dim3(grid), dim3(NTHREADS), args, LDS_BYTES, stream);
    if (e != hipSuccess) fprintf(stderr, "cooperative launch failed: %s (grid %d)\n", hipGetErrorString(e), grid);
}
```

```cpp
#include <hip/hip_runtime.h>
#include <hip/hip_cooperative_groups.h>
#include <cstdio>
#include <cstdint>
namespace cg = cooperative_groups;

namespace {
typedef unsigned short bf16_t;
typedef short bf16x8 __attribute__((ext_vector_type(8)));
typedef short s16x4 __attribute__((ext_vector_type(4)));
typedef float f32x4 __attribute__((ext_vector_type(4)));
typedef float f32x16 __attribute__((ext_vector_type(16)));
typedef unsigned u32x4 __attribute__((ext_vector_type(4)));
typedef unsigned u32x2 __attribute__((ext_vector_type(2)));

constexpr int D = 1024, NB = 16, SEQ = 2048, T = NB * SEQ, HW = 512, INC = 5120, NE = 32, FHID = 64;
constexpr int QOFF = 1536, KOFF = 2048, VOFF = 2560, GOFF = 3072;
constexpr int NTHREADS = 512, NWAVES = 8;
constexpr float EPS = 1e-5f;
constexpr float LOG2E = 1.4426950408889634f;
constexpr float QSCALE = 0.125f * 1.4426950408889634f;
constexpr size_t MiB = 1u << 20;
constexpr size_t WS_CTL = 0;
constexpr size_t WS_MOD = 1 * MiB;
constexpr size_t WS_META = 1 * MiB + 512 * 1024;
constexpr size_t WS_BLKCNT = WS_META + 4096;
constexpr size_t WS_TILEEXP = WS_BLKCNT + 256 * 32 * 4;
constexpr size_t WS_LOGITS = 2 * MiB;
constexpr size_t WS_TOPE = 6 * MiB;
constexpr size_t WS_TOPW = 6 * MiB + 512 * 1024;
constexpr size_t WS_ROWPAIR = 7 * MiB;
constexpr size_t WS_ROWW = 7 * MiB + 576 * 1024;
constexpr size_t WS_KFILT = 8 * MiB;
constexpr size_t WS_U = 16 * MiB;
constexpr size_t WS_ACT = WS_U;
constexpr size_t WS_H = 336 * MiB;
constexpr size_t WS_R1 = 400 * MiB;
constexpr size_t WS_YCAT = WS_R1;
constexpr size_t WS_MERGED = WS_R1 + 64 * MiB;
constexpr size_t WS_VP = WS_R1 + 128 * MiB;
constexpr size_t WS_X0C = WS_R1 + 160 * MiB;
constexpr size_t WS_VT = WS_R1 + 192 * MiB;
constexpr size_t WS_H2LO = WS_R1 + 224 * MiB;
constexpr size_t WS_SLOTS = WS_R1;
constexpr size_t WS_WIN = 688 * MiB;
constexpr size_t WS_WCAT = 698 * MiB;
constexpr size_t WS_WMIX = 700 * MiB;
constexpr size_t WS_WGU = 702 * MiB;
constexpr size_t WS_WDN = 830 * MiB;
constexpr size_t WS_WRT = 894 * MiB;
constexpr size_t WS_KFC = 896 * MiB;
constexpr size_t WS_X1 = 904 * MiB;
constexpr size_t WS_END = 968 * MiB;
constexpr size_t WS_YT = WS_R1 + 192 * MiB;
constexpr int MAXROWS = 4 * T + NE * 256;
constexpr int LDS_BYTES = 163840;

struct Params { const float* in[31]; float* out; unsigned char* ws; int ph_lo, ph_hi; };

__device__ __forceinline__ unsigned f2bf(float f) { unsigned u = __float_as_uint(f); return (u + 0x7fffu + ((u >> 16) & 1u)) >> 16; }
__device__ __forceinline__ unsigned pk2(float lo, float hi) { return f2bf(lo) | (f2bf(hi) << 16); }
__device__ __forceinline__ float bf2f(unsigned h) { return __uint_as_float(h << 16); }
__device__ __forceinline__ float bflo(unsigned w) { return __uint_as_float(w << 16); }
__device__ __forceinline__ float bfhi(unsigned w) { return __uint_as_float(w & 0xffff0000u); }
__device__ __forceinline__ float wave_sum(float v) {
#pragma unroll
    for (int o = 1; o < 64; o <<= 1) v += __shfl_xor(v, o);
    return v;
}
__device__ __forceinline__ float sigmoidf_(float x) { return 1.0f / (1.0f + __expf(-x)); }
typedef float f32x2_t __attribute__((ext_vector_type(2))); typedef __bf16 bf16x2_t __attribute__((ext_vector_type(2)));
__device__ __forceinline__ unsigned cvtpk(float lo, float hi) { f32x2_t v = {lo, hi}; bf16x2_t b = __builtin_convertvector(v, bf16x2_t); return __builtin_bit_cast(unsigned, b); }
__device__ __forceinline__ int crow(int r, int hi) { return (r & 3) + 8 * (r >> 2) + 4 * hi; }
__device__ __forceinline__ int lane_id() { return (int)__builtin_amdgcn_mbcnt_hi(~0u, __builtin_amdgcn_mbcnt_lo(~0u, 0u)); }
__device__ __forceinline__ int fresh_lane() { int l = lane_id(); asm volatile("" : "+v"(l)); return l; }

struct Ctx {
    const float* in[31]; float* out; unsigned char* ws;
    int tid, lane, wave, gw, ngw, nblk, blk;
    unsigned char* lds;
};

struct WItem { const float* src; bf16_t* dst; int N; int sk; };
__device__ __forceinline__ WItem witem(const Ctx& C, int it) {
    constexpr int I_IN = (D / 64) * (INC / 64), I_HY = (HW / 64) * (D / 64), I_MIX = (D / 64) * (D / 64), I_GU1 = (D / 64) * (2 * D / 64), I_DN1 = (D / 64) * (D / 64);
    const float* W; int N, k0, n0, kd, nd, sk = -1; bf16_t* WT;
    int r = it;
    if (r < NE * I_GU1) { const int e = r / I_GU1, q = r % I_GU1; const int nb = 2 * D / 64; n0 = 64 * (q % nb); k0 = 64 * (q / nb);
        const int s = n0 / 1024, rem = n0 % 1024, j = rem / 128, i0 = rem % 128; nd = 256 * j + 128 * s + i0; kd = k0; N = 2 * D;
        W = C.in[26] + (size_t)e * D * 2 * D; WT = (bf16_t*)(C.ws + WS_WGU) + (size_t)e * 2 * D * D; }
    else if ((r -= NE * I_GU1) < NE * I_DN1) { const int e = r / I_DN1, q = r % I_DN1; const int nb = D / 64; n0 = 64 * (q % nb); k0 = 64 * (q / nb); nd = n0; kd = k0; N = D;
        W = C.in[28] + (size_t)e * D * D; WT = (bf16_t*)(C.ws + WS_WDN) + (size_t)e * D * D; }
    else if ((r -= NE * I_DN1) < I_IN) { const int nb = INC / 64; n0 = 64 * (r % nb); k0 = 64 * (r / nb); nd = n0; kd = k0; N = INC; W = C.in[5]; WT = (bf16_t*)(C.ws + WS_WIN);
        if (n0 >= GOFF) { const int rel = n0 - GOFF, sg_ = rel / 1024, rem = rel % 1024; nd = GOFF + 256 * (rem / 128) + 128 * sg_ + (rem % 128); } }
    else if ((r -= I_IN) < I_HY) { const int nb = D / 64; n0 = 64 * (r % nb); k0 = 64 * (r / nb); nd = n0; kd = k0; N = D; W = C.in[20]; WT = (bf16_t*)(C.ws + WS_WCAT); }
    else if ((r -= I_HY) < I_HY) { const int nb = D / 64; n0 = 64 * (r % nb); k0 = 64 * (r / nb); nd = n0; kd = 512 + k0; N = D; W = C.in[21]; WT = (bf16_t*)(C.ws + WS_WCAT); sk = k0; }
    else { r -= I_HY; const int nb = D / 64; n0 = 64 * (r % nb); k0 = 64 * (r / nb); nd = n0; kd = k0; N = D; W = C.in[22]; WT = (bf16_t*)(C.ws + WS_WMIX); }
    WItem w; w.N = N; w.sk = sk; w.src = W + (size_t)(k0 + (C.lane >> 4)) * N + n0 + 4 * (C.lane & 15); w.dst = WT + (size_t)(nd + (C.lane >> 3)) * D + kd + 8 * (C.lane & 7);
    return w;
}
__device__ __forceinline__ void phase_weights(Ctx& C) {
    float* scr = (float*)(C.lds + C.wave * 16640);
    constexpr int NITEMS = (D / 64) * (INC / 64) + 2 * (HW / 64) * (D / 64) + (D / 64) * (D / 64) + NE * (D / 64) * (2 * D / 64) + NE * (D / 64) * (D / 64);
    const int lane = C.lane;
    int it = C.gw;
    f32x4 v[16], vn[16];
    WItem cur;
    if (it < NITEMS) { cur = witem(C, it);
#pragma unroll
        for (int i = 0; i < 16; ++i) v[i] = __builtin_nontemporal_load((const f32x4*)(cur.src + (size_t)(4 * i) * cur.N)); }
    for (; it < NITEMS; it += C.ngw) {
        const bool more = it + C.ngw < NITEMS; WItem nx = cur;
        if (more) { nx = witem(C, it + C.ngw);
#pragma unroll
            for (int i = 0; i < 16; ++i) vn[i] = __builtin_nontemporal_load((const f32x4*)(nx.src + (size_t)(4 * i) * nx.N)); }
        if (cur.sk >= 0) {
#pragma unroll
            for (int i = 0; i < 16; ++i) v[i] = v[i] * (0.8f * C.in[19][(cur.sk + 4 * i + (lane >> 4)) & 127]); }
#pragma unroll
        for (int i = 0; i < 16; ++i) { float* d = scr + (4 * i + (lane >> 4)) * 65 + 4 * (lane & 15); d[0] = v[i].x; d[1] = v[i].y; d[2] = v[i].z; d[3] = v[i].w; }
        __builtin_amdgcn_s_waitcnt(0xc07f); asm volatile("" ::: "memory");
        const int c = lane & 7;
#pragma unroll
        for (int j = 0; j < 8; ++j) { const int n = (lane >> 3) + 8 * j; const float* s = scr + (8 * c) * 65 + n;
            u32x4 o; o.x = pk2(s[0 * 65], s[1 * 65]); o.y = pk2(s[2 * 65], s[3 * 65]); o.z = pk2(s[4 * 65], s[5 * 65]); o.w = pk2(s[6 * 65], s[7 * 65]);
            __builtin_nontemporal_store(o, (u32x4*)(cur.dst + (size_t)(8 * j) * D)); }
        __builtin_amdgcn_s_waitcnt(0xc07f); asm volatile("" ::: "memory");
        if (more) {
#pragma unroll
            for (int i = 0; i < 16; ++i) v[i] = vn[i]; }
        cur = nx;
    }
    bf16_t* wrt = (bf16_t*)(C.ws + WS_WRT);
    for (int i = C.blk * NTHREADS + C.tid; i < NE * D; i += C.nblk * NTHREADS) {
        const int e = i / D, k = i % D; const float w = C.in[24][(size_t)k * NE + e];
        const unsigned hi = f2bf(w); const float lo = w - bf2f(hi);
        wrt[(size_t)e * 2048 + k] = (bf16_t)hi; wrt[(size_t)e * 2048 + 1024 + k] = (bf16_t)f2bf(lo);
    }
}

__device__ __forceinline__ void phase_mod(Ctx& C) {
    float* sc = (float*)C.lds;
    float* part = sc + 16 * 1024;
    float* mod = (float*)(C.ws + WS_MOD);
    for (int vb = C.blk; vb < 256; vb += C.nblk) {
        const int j0 = vb * 24;
        __syncthreads();
        for (int i = C.tid; i < 16 * D; i += NTHREADS) { const float c = C.in[1][i]; sc[i] = c / (1.0f + expf(-c)); }
        __syncthreads();
        if (C.tid < 504) {
            const int jj = C.tid % 24, isub = C.tid / 24;
            float acc[16];
#pragma unroll
            for (int b = 0; b < 16; ++b) acc[b] = 0.f;
            const float* w = C.in[2] + j0 + jj;
            float wv[49];
#pragma unroll
            for (int q = 0; q < 49; ++q) { const int i = isub + 21 * q; wv[q] = (i < D) ? w[(size_t)i * 6 * D] : 0.f; }
#pragma unroll
            for (int q = 0; q < 49; ++q) { const int i = (isub + 21 * q < D) ? isub + 21 * q : 0;
#pragma unroll
                for (int b = 0; b < 16; ++b) acc[b] = fmaf(sc[b * D + i], wv[q], acc[b]);
                __builtin_amdgcn_sched_barrier(0); }
#pragma unroll
            for (int b = 0; b < 16; ++b) part[(isub * 16 + b) * 24 + jj] = acc[b];
        }
        __syncthreads();
        if (C.tid < 384) { const int b = C.tid / 24, jj = C.tid % 24; float a = C.in[3][j0 + jj];
            for (int q = 0; q < 21; ++q) a += part[(q * 16 + b) * 24 + jj];
            mod[b * 6 * D + j0 + jj] = a;
            { const int j = j0 + jj; if (j >= 4 * D && j < 5 * D) mod[16 * 6 * D + b * D + (j - 4 * D)] = C.in[23][j - 4 * D] * (1.0f + a); } }
    }
    __syncthreads();
}

__device__ __forceinline__ void phase_filters(Ctx& C) {
    float* sh = (float*)C.lds;
    float* h3t = sh + 8 * 160;
    float* lw1 = h3t + 512; float* lw2 = lw1 + 17 * FHID; float* lw3 = lw2 + FHID * FHID; float* lb = lw3 + FHID * FHID;
    float* kfc = (float*)(C.ws + WS_KFC);
    const float* w4 = C.in[15];
    const int pl = C.tid >> 6, j = C.tid & 63;
    float* z = sh + pl * 160; float* ha = z + 32; float* hb = ha + 64;
    __syncthreads();
    for (int i = C.tid; i < 17 * FHID; i += NTHREADS) lw1[i] = C.in[9][i];
    for (int i = C.tid; i < FHID * FHID; i += NTHREADS) { lw2[i] = C.in[11][i]; lw3[i] = C.in[13][i]; }
    if (C.tid < 64) { lb[C.tid] = C.in[10][C.tid]; lb[64 + C.tid] = C.in[12][C.tid]; lb[128 + C.tid] = C.in[14][C.tid]; lb[192 + C.tid] = C.in[16][C.tid]; }
    for (int vb = C.blk; vb < SEQ / 8; vb += C.nblk) {
        const int pos = vb * 8 + pl;
        const float tt = (float)pos / (float)(SEQ - 1);
        const float w = 6.283185307179586f * (float)pos / (float)SEQ;
        __syncthreads();
        if (j < 17) {
            float v;
            if (j == 0) v = tt;
            else { const int i = (j - 1) & 7; const float fr = 1e-4f + (float)i * ((7.0f - 1e-4f) / 7.0f); v = (j <= 8) ? cosf(fr * w) : -sinf(fr * w); }
            z[j] = v;
        }
        __syncthreads();
        const float fqj = lb[192 + j];
        { float a = lb[j];
#pragma unroll
          for (int i = 0; i < 17; ++i) a = fmaf(z[i], lw1[i * FHID + j], a); ha[j] = sinf(fqj * a); }
        __syncthreads();
        { float a = lb[64 + j];
#pragma unroll 16
          for (int i = 0; i < FHID; ++i) a = fmaf(ha[i], lw2[i * FHID + j], a); hb[j] = sinf(fqj * a); }
        __syncthreads();
        { float a = lb[128 + j];
#pragma unroll 16
          for (int i = 0; i < FHID; ++i) a = fmaf(hb[i], lw3[i * FHID + j], a); h3t[j * 8 + pl] = sinf(fqj * a); }
        __syncthreads();
        float af[8], ab[8];
#pragma unroll
        for (int p = 0; p < 8; ++p) { af[p] = 0.f; ab[p] = 0.f; }
#pragma unroll 1
        for (int ih = 0; ih < FHID; ih += 32) {
            float wa[32], wb[32];
#pragma unroll
            for (int i = 0; i < 32; ++i) { wa[i] = w4[(ih + i) * 2 * HW + C.tid]; wb[i] = w4[(ih + i) * 2 * HW + HW + C.tid]; }
#pragma unroll
            for (int i = 0; i < 32; ++i) {
                const f32x4 h0 = *(const f32x4*)(h3t + (ih + i) * 8), h1 = *(const f32x4*)(h3t + (ih + i) * 8 + 4);
#pragma unroll
                for (int p = 0; p < 4; ++p) { af[p] = fmaf(h0[p], wa[i], af[p]); af[4 + p] = fmaf(h1[p], wa[i], af[4 + p]); ab[p] = fmaf(h0[p], wb[i], ab[p]); ab[4 + p] = fmaf(h1[p], wb[i], ab[4 + p]); } } }
        const float min_decay = logf(1e-2f) / 1.5f, max_decay = logf(1e-2f) / 0.3f;
        const int c = C.tid, pos0 = vb * 8;
        const float adelta = fabsf(min_decay + (float)c * ((max_decay - min_decay) / 511.0f));
#pragma unroll
        for (int p = 0; p < 8; ++p) { const float dec = expf(-((float)(pos0 + p) / (float)(SEQ - 1)) * adelta); af[p] *= dec; ab[p] *= dec; }
        float* dst = kfc + (size_t)c * 4096 + 2048 + pos0;
        *(f32x4*)dst = (f32x4){af[0], af[1], af[2], af[3]}; *(f32x4*)(dst + 4) = (f32x4){af[4], af[5], af[6], af[7]};
        float* dsb = kfc + (size_t)c * 4096 + 2048 - pos0;
#pragma unroll
        for (int p = 0; p < 8; ++p) if (pos0 + p >= 1) dsb[-p] = ab[p];
    }
    __syncthreads();
}

__device__ __forceinline__ void phase_norm1(Ctx& C) {
    const float* mod = (const float*)(C.ws + WS_MOD); bf16_t* h = (bf16_t*)(C.ws + WS_H);
    const float* g = C.in[4];
    for (int row = C.gw; row < T; row += C.ngw) {
        const int b = row / SEQ;
        const f32x4* xr = (const f32x4*)(C.in[0] + (size_t)row * D) + C.lane;
        f32x4 v[4]; float s = 0.f;
#pragma unroll
        for (int j = 0; j < 4; ++j) { v[j] = __builtin_nontemporal_load(xr + 64 * j); s += (v[j].x * v[j].x + v[j].y * v[j].y) + (v[j].z * v[j].z + v[j].w * v[j].w); }
        const float rstd = 1.0f / sqrtf(wave_sum(s) * (1.0f / D) + EPS);
        const float* sh = mod + (size_t)b * 6 * D; const float* sc = sh + D;
        u32x2* o = (u32x2*)(h + (size_t)row * D) + C.lane;
#pragma unroll
        for (int j = 0; j < 4; ++j) { const int i0 = 4 * C.lane + 256 * j;
            const f32x4 gg = *(const f32x4*)(g + i0), s1 = *(const f32x4*)(sc + i0), s0 = *(const f32x4*)(sh + i0);
            f32x4 r; r.x = v[j].x * rstd * gg.x * (1.f + s1.x) + s0.x; r.y = v[j].y * rstd * gg.y * (1.f + s1.y) + s0.y;
            r.z = v[j].z * rstd * gg.z * (1.f + s1.z) + s0.z; r.w = v[j].w * rstd * gg.w * (1.f + s1.w) + s0.w;
            u32x2 w; w.x = pk2(r.x, r.y); w.y = pk2(r.z, r.w); o[64 * j] = w; }
    }
}

__device__ __forceinline__ void phase_final(Ctx& C) {
    const float* mod = (const float*)(C.ws + WS_MOD); const bf16_t* slots = (const bf16_t*)(C.ws + WS_SLOTS); const int* rowinv = (const int*)(C.ws + WS_TOPE);
    const bf16_t* x1 = (const bf16_t*)(C.ws + WS_X1);
    const float* g = C.in[30];
    for (int row = C.gw; row < T; row += C.ngw) {
        const int b = row / SEQ;
        f32x4* xr = (f32x4*)(C.out + (size_t)row * D) + C.lane;
        const float* g2 = mod + (size_t)b * 6 * D + 5 * D;
        f32x4 v[4]; float s = 0.f; const int4 rr4 = *(const int4*)(rowinv + (size_t)row * 4); const int rk[4] = {rr4.x, rr4.y, rr4.z, rr4.w};
#pragma unroll
        for (int j = 0; j < 4; ++j) { const int i0 = 4 * C.lane + 256 * j;
            f32x4 m = {0.f, 0.f, 0.f, 0.f};
#pragma unroll
            for (int k = 0; k < 4; ++k) { const u32x2 w = __builtin_nontemporal_load((const u32x2*)(slots + (size_t)rk[k] * D + i0));
                m.x += bflo(w.x); m.y += bfhi(w.x); m.z += bflo(w.y); m.w += bfhi(w.y); }
            const f32x4 gg = *(const f32x4*)(g2 + i0);
            const u32x2 xw = __builtin_nontemporal_load((const u32x2*)(x1 + (size_t)row * D + i0));
            v[j].x = bflo(xw.x) + gg.x * m.x; v[j].y = bfhi(xw.x) + gg.y * m.y; v[j].z = bflo(xw.y) + gg.z * m.z; v[j].w = bfhi(xw.y) + gg.w * m.w;
            s += (v[j].x * v[j].x + v[j].y * v[j].y) + (v[j].z * v[j].z + v[j].w * v[j].w); }
        const float rstd = 1.0f / sqrtf(wave_sum(s) * (1.0f / D) + EPS);
#pragma unroll
        for (int j = 0; j < 4; ++j) { const int i0 = 4 * C.lane + 256 * j; const f32x4 gg = *(const f32x4*)(g + i0);
            f32x4 r; r.x = v[j].x * rstd * gg.x; r.y = v[j].y * rstd * gg.y; r.z = v[j].z * rstd * gg.z; r.w = v[j].w * rstd * gg.w; __builtin_nontemporal_store(r, xr + 64 * j); }
    }
}

namespace pg8 {
#define PG8_LAS __attribute__((address_space(3)))
constexpr int BM = 256, BK = 64, HALF = 128, HTB = HALF * BK * 2, STAGE_BYTES = 8 * HTB, NXCD = 8, WGM = 8;
__device__ __forceinline__ int lds_byte(int r, int c) { const int st = (r >> 4) * 2 + (c >> 5), rr = r & 15, cc = c & 31, ob = rr * 64 + cc * 2; return st * 1024 + (ob ^ (((ob >> 9) & 1) << 5)); }
__device__ __forceinline__ void stage_rc(int b, int& R, int& C) { const int st = b / 1024, sb = b % 1024, swz = sb ^ (((sb >> 9) & 1) << 5); R = (st >> 1) * 16 + swz / 64; C = (st & 1) * 32 + (swz % 64) / 2; }
__device__ __forceinline__ int perm32(int rho) { const int n = rho >> 4, i = rho & 15; return 8 * (i >> 2) + 4 * n + (i & 3); }
struct Unit { int pm, pn; };
struct Gemm { const bf16_t* A; const bf16_t* Bt; int lda, ldb, K; const int* rowidx; };
struct StaticOrder {
    int nM, nN, nwg, G, c;
    __device__ void init(int nM_, int nN_, int G_, int c_) { nM = nM_; nN = nN_; nwg = nM * nN; G = G_; c = c_; }
    __device__ bool next(int i, Unit& u) const {
        const long L = (long)i * G + c; if (L >= nwg) return false;
        int wgid = (int)L; { const int q = nwg / NXCD, r = nwg % NXCD, xcd = wgid % NXCD, off = wgid / NXCD; wgid = (xcd < r ? xcd * (q + 1) : r * (q + 1) + (xcd - r) * q) + off; }
        const int nig = WGM * nN, gid = wgid / nig, fm = gid * WGM, gsz = (nM - fm) < WGM ? (nM - fm) : WGM;
        u.pm = fm + ((wgid % nig) % gsz); u.pn = (wgid % nig) / gsz; return true;
    }
};
struct MoeOrder {
    StaticOrder b; const PG8_LAS int* tileexp; int nN;
    __device__ bool next(int i, Unit& u) const { if (!b.next(i, u)) return false; u.pn = tileexp[u.pm] * nN + u.pn; return true; }
};
__device__ __forceinline__ unsigned cvt_pk_bf16(float lo, float hi) { unsigned r; asm volatile("v_cvt_pk_bf16_f32 %0, %1, %2" : "=v"(r) : "v"(lo), "v"(hi)); return r; }

template <class Epi, class Sched, bool GATHER, bool MIDHOOK = false>
__device__ __forceinline__ void gemm_phase(PG8_LAS unsigned char* lds, const Gemm g, const Sched& S, const Epi& E, const int wid_) {
    const int wid = wid_, lane = fresh_lane(), tid = wid * 64 + lane, wr = wid >> 2, wc = wid & 3, fr = lane & 15, fq = lane >> 4;
    const int K = g.K, nt = K / BK;
    int RA[2]; unsigned cA2[2], voffB[2];
#pragma unroll
    for (int i = 0; i < 2; ++i) { int R, C; stage_rc(tid * 16 + i * 8192, R, C); const int Rb = Epi::PERM ? ((R & ~31) + perm32(R & 31)) : R;
        RA[i] = R; cA2[i] = (unsigned)C * 2u; voffB[i] = (unsigned)(Rb * g.ldb + C) * 2u; }
    const unsigned lda2 = (unsigned)g.lda * 2u;
    const size_t kstep = (size_t)(BK * 2);
    const size_t hstep = (size_t)HALF * g.ldb * 2;
    const size_t tstep = 2 * hstep;
    const unsigned ldsw = (unsigned)wid * 1024u;
    const int aoff = lds_byte(wr * 64 + fr, fq * 8), boff = lds_byte(wc * 32 + fr, fq * 8);
#define PG8_SA(b, h) (((b) * 2 + (h)) * HTB)
#define PG8_SB(b, h) ((4 + (b) * 2 + (h)) * HTB)
#define PG8_STAGE(bufoff, gbase, voff) do { _Pragma("unroll") for (int _i = 0; _i < 2; ++_i) \
        __builtin_amdgcn_global_load_lds((const unsigned*)((const char*)(gbase) + (voff)[_i]), (PG8_LAS unsigned*)(lds + (bufoff) + ldsw + _i * 8192), 16, 0, 0); } while (0)
#define PG8_AOFFS(dst, u_) do { _Pragma("unroll") for (int _h = 0; _h < 2; ++_h) _Pragma("unroll") for (int _i = 0; _i < 2; ++_i) { \
        int _row = (u_).pm * BM + _h * HALF + RA[_i]; if (GATHER) { const int _p = g.rowidx[_row]; _row = _p >= 0 ? (_p >> 2) : 0; } \
        dst[_h][_i] = (unsigned)_row * lda2 + cA2[_i]; } } while (0)
      \
#define PG8_AOFFS_RAW(dst, u_) do { _Pragma("unroll") for (int _h = 0; _h < 2; ++_h) _Pragma("unroll") for (int _i = 0; _i < 2; ++_i) { \
        const int _row = (u_).pm * BM + _h * HALF + RA[_i]; dst[_h][_i] = GATHER ? (unsigned)g.rowidx[_row] : (unsigned)_row; } } while (0)
#define PG8_AOFFS_FIN(dst) do { _Pragma("unroll") for (int _h = 0; _h < 2; ++_h) _Pragma("unroll") for (int _i = 0; _i < 2; ++_i) { \
        int _row = (int)dst[_h][_i]; if (GATHER) _row = _row >= 0 ? (_row >> 2) : 0; dst[_h][_i] = (unsigned)_row * lda2 + cA2[_i]; } } while (0)
#define PG8_LDA(dst, b, h) do { _Pragma("unroll") for (int m = 0; m < 4; ++m) _Pragma("unroll") for (int k = 0; k < 2; ++k) dst[m][k] = *(const PG8_LAS bf16x8*)(lds + PG8_SA(b, h) + aoff + m * 2048 + k * 1024); } while (0)
#define PG8_LDB(dst, b, h) do { _Pragma("unroll") for (int n = 0; n < 2; ++n) _Pragma("unroll") for (int k = 0; k < 2; ++k) dst[n][k] = *(const PG8_LAS bf16x8*)(lds + PG8_SB(b, h) + boff + n * 2048 + k * 1024); } while (0)
#define PG8_MMA(ai, bj, At, Bt) do { __builtin_amdgcn_s_setprio(1); _Pragma("unroll") for (int m = 0; m < 4; ++m) _Pragma("unroll") for (int n = 0; n < 2; ++n) _Pragma("unroll") for (int k = 0; k < 2; ++k) \
        acc[ai][bj][m][n] = __builtin_amdgcn_mfma_f32_16x16x32_bf16(Bt[n][k], At[m][k], acc[ai][bj][m][n], 0, 0, 0); __builtin_amdgcn_s_setprio(0); } while (0)
#define PG8_WAIT_V(n) asm volatile("s_waitcnt vmcnt(" #n ")" ::: "memory")
#define PG8_WAIT_L(n) asm volatile("s_waitcnt lgkmcnt(" #n ")" ::: "memory")
#define PG8_BAR __builtin_amdgcn_s_barrier()
#define PG8_SCHED __builtin_amdgcn_sched_barrier(0)
    Unit cur, nxt; int ui = 0;
    if (!S.next(0, cur)) return;
    f32x4 acc[2][2][4][2];
#pragma unroll
    for (int a = 0; a < 2; ++a)
#pragma unroll
        for (int b = 0; b < 2; ++b)
#pragma unroll
            for (int m = 0; m < 4; ++m)
#pragma unroll
                for (int n = 0; n < 2; ++n) acc[a][b][m][n] = (f32x4){0.f, 0.f, 0.f, 0.f};
    bf16x8 At[4][2], B0[2][2], B1[2][2];
    unsigned cv[2][2], nv[2][2];
    PG8_AOFFS(cv, cur);
    const char* const Ab = (const char*)g.A;
    const char* cB = (const char*)g.Bt + (size_t)cur.pn * tstep;
    PG8_STAGE(PG8_SB(0, 0), cB, voffB); PG8_STAGE(PG8_SB(0, 1), cB + hstep, voffB); PG8_STAGE(PG8_SA(0, 0), Ab, cv[0]); PG8_STAGE(PG8_SA(0, 1), Ab, cv[1]);
    if (wr == 1) PG8_BAR;
    PG8_WAIT_V(2); PG8_BAR;
    PG8_STAGE(PG8_SB(1, 0), cB + kstep, voffB); PG8_STAGE(PG8_SA(1, 0), Ab + kstep, cv[0]); PG8_STAGE(PG8_SB(1, 1), cB + hstep + kstep, voffB);
    PG8_WAIT_V(6); PG8_BAR;
    for (;;) {
        const bool has_next = S.next(ui + 1, nxt);
        if (has_next) { if constexpr (GATHER) { PG8_AOFFS_RAW(nv, nxt); } else { PG8_AOFFS(nv, nxt); } } else {
#pragma unroll
            for (int h = 0; h < 2; ++h)
#pragma unroll
                for (int i = 0; i < 2; ++i) nv[h][i] = cv[h][i]; }
        const char* nB = has_next ? (const char*)g.Bt + (size_t)nxt.pn * tstep : cB;
#define PG8_KSTEP(t) do { \
            const bool last = (t == nt - 2); \
            const char* a1 = Ab + (size_t)(t + 1) * kstep; \
            const char* a2 = last ? Ab : Ab + (size_t)(t + 2) * kstep; const char* b2 = last ? nB : cB + (size_t)(t + 2) * kstep; \
            const char* a3 = a2 + kstep; const char* b3 = b2 + kstep; \
            unsigned sv[2][2]; \
            if constexpr (GATHER) { \
                _Pragma("unroll") for (int h = 0; h < 2; ++h) _Pragma("unroll") for (int i = 0; i < 2; ++i) sv[h][i] = cv[h][i]; \
                if (last) { asm volatile("" : "+v"(nv[0][0]), "+v"(nv[0][1]), "+v"(nv[1][0]), "+v"(nv[1][1])); if (has_next) PG8_AOFFS_FIN(nv); _Pragma("unroll") for (int h = 0; h < 2; ++h) _Pragma("unroll") for (int i = 0; i < 2; ++i) sv[h][i] = nv[h][i]; } \
            } else { _Pragma("unroll") for (int h = 0; h < 2; ++h) _Pragma("unroll") for (int i = 0; i < 2; ++i) sv[h][i] = last ? nv[h][i] : cv[h][i]; } \
            PG8_LDB(B0, 0, 0); PG8_LDB(B1, 0, 1); PG8_SCHED; PG8_LDA(At, 0, 0); PG8_STAGE(PG8_SA(1, 1), a1, cv[1]); \
            PG8_WAIT_V(8); PG8_WAIT_L(0); PG8_BAR; PG8_MMA(0, 0, At, B0); PG8_MMA(0, 1, At, B1); PG8_BAR; PG8_SCHED; \
            PG8_LDA(At, 0, 1); PG8_STAGE(PG8_SB(0, 0), b2, voffB); PG8_STAGE(PG8_SB(0, 1), b2 + hstep, voffB); PG8_STAGE(PG8_SA(0, 0), a2, sv[0]); \
            PG8_WAIT_V(8); PG8_WAIT_L(0); PG8_BAR; PG8_MMA(1, 0, At, B0); PG8_MMA(1, 1, At, B1); PG8_BAR; PG8_SCHED; \
            PG8_LDB(B0, 1, 0); PG8_LDB(B1, 1, 1); PG8_SCHED; PG8_LDA(At, 1, 0); PG8_STAGE(PG8_SA(0, 1), a2, sv[1]); \
            PG8_WAIT_V(8); PG8_WAIT_L(0); PG8_BAR; PG8_MMA(0, 0, At, B0); PG8_MMA(0, 1, At, B1); PG8_BAR; PG8_SCHED; \
            PG8_LDA(At, 1, 1); PG8_STAGE(PG8_SB(1, 0), b3, voffB); PG8_STAGE(PG8_SB(1, 1), b3 + hstep, voffB); PG8_STAGE(PG8_SA(1, 0), a3, sv[0]); \
            PG8_WAIT_V(8); PG8_WAIT_L(0); PG8_BAR; PG8_MMA(1, 0, At, B0); PG8_MMA(1, 1, At, B1); PG8_BAR; PG8_SCHED; \
        } while (0)
        if constexpr (MIDHOOK) {
            for (int t = 0; t < nt / 2; t += 2) PG8_KSTEP(t);
            E.mid(acc, cur, wr, wc, fr, fq);
            for (int t = nt / 2; t < nt; t += 2) PG8_KSTEP(t);
        } else {
            for (int t = 0; t < nt; t += 2) PG8_KSTEP(t);
        }
#undef PG8_KSTEP
        if (wr == 0) PG8_BAR;
        E(acc, cur, wr, wc, fr, fq);
        if (!has_next) break;
#pragma unroll
        for (int a = 0; a < 2; ++a)
#pragma unroll
            for (int b = 0; b < 2; ++b)
#pragma unroll
                for (int m = 0; m < 4; ++m)
#pragma unroll
                    for (int n = 0; n < 2; ++n) acc[a][b][m][n] = (f32x4){0.f, 0.f, 0.f, 0.f};
        cur = nxt; cB = nB; ++ui;
#pragma unroll
        for (int h = 0; h < 2; ++h)
#pragma unroll
            for (int i = 0; i < 2; ++i) cv[h][i] = nv[h][i];
        if (wr == 1) PG8_BAR;
    }
    PG8_WAIT_V(0);
    PG8_BAR;
#undef PG8_SA
#undef PG8_SB
#undef PG8_STAGE
#undef PG8_AOFFS
#undef PG8_AOFFS_RAW
#undef PG8_AOFFS_FIN
#undef PG8_LDA
#undef PG8_LDB
#undef PG8_MMA
#undef PG8_WAIT_V
#undef PG8_WAIT_L
#undef PG8_BAR
#undef PG8_SCHED
}

__device__ __forceinline__ u32x4 pack8(const f32x4& v0, const f32x4& v1) { u32x4 w; w.x = cvt_pk_bf16(v0[0], v0[1]); w.y = cvt_pk_bf16(v0[2], v0[3]); w.z = cvt_pk_bf16(v1[0], v1[1]); w.w = cvt_pk_bf16(v1[2], v1[3]); return w; }
__device__ __forceinline__ void unpack8(const u32x4& w, f32x4& v0, f32x4& v1) { v0 = (f32x4){bflo(w.x), bfhi(w.x), bflo(w.y), bfhi(w.y)}; v1 = (f32x4){bflo(w.z), bfhi(w.z), bflo(w.w), bfhi(w.w)}; }
__device__ __forceinline__ float fsig(float x) { return __builtin_amdgcn_rcpf(1.0f + __builtin_amdgcn_exp2f(-LOG2E * x)); }

template <int MODE = 0> struct EpiInprojT {
    static constexpr bool PERM = true;
    bf16_t* U; const float* bias;
    __device__ __forceinline__ void operator()(const f32x4 (&acc)[2][2][4][2], const Unit& u, int wr, int wc, int fr, int fq) const {
        if (MODE == 2) { _Pragma("unroll") for (int a_ = 0; a_ < 2; ++a_) _Pragma("unroll") for (int b_ = 0; b_ < 2; ++b_) _Pragma("unroll") for (int m_ = 0; m_ < 4; ++m_) _Pragma("unroll") for (int n_ = 0; n_ < 2; ++n_) asm volatile("" :: "v"(acc[a_][b_][m_][n_])); return; }
        const int row0 = u.pm * BM + wr * 64 + fr, col0 = u.pn * BM + wc * 32 + 8 * fq; const float qs = (u.pn == 6 || u.pn == 7) ? QSCALE : 1.0f;
        if (u.pn >= 12) {
            const int c0 = 128 * (u.pn - 12) + wc * 32 + 8 * fq;
            f32x4 ba[2], bb[2];
#pragma unroll
            for (int n = 0; n < 2; ++n) { ba[n] = *(const f32x4*)(bias + GOFF + c0 + 4 * n); bb[n] = *(const f32x4*)(bias + GOFF + D + c0 + 4 * n); }
#pragma unroll
            for (int ai = 0; ai < 2; ++ai)
#pragma unroll
                for (int m = 0; m < 4; ++m) { bf16_t* rowp = U + (size_t)(row0 + ai * HALF + m * 16) * INC + GOFF + c0; f32x4 rr[2], sb[2];
#pragma unroll
                    for (int n = 0; n < 2; ++n) { const f32x4 a = acc[ai][0][m][n] + ba[n], b = acc[ai][1][m][n] + bb[n];
#pragma unroll
                        for (int i = 0; i < 4; ++i) { const float ea = fminf(__builtin_amdgcn_exp2f(-LOG2E * a[i]), 1e18f), eb = fminf(__builtin_amdgcn_exp2f(-LOG2E * b[i]), 1e18f);     const float s2 = __builtin_amdgcn_rcpf(1.0f + eb);
                            sb[n][i] = s2; rr[n][i] = (1.0f + eb) * __builtin_amdgcn_rcpf(1.0f + ea); } }
                    const u32x4 wr_ = pack8(rr[0], rr[1]), ws_ = pack8(sb[0], sb[1]);
                    if (MODE == 0) { *(u32x4*)rowp = wr_; *(u32x4*)(rowp + D) = ws_; } else asm volatile("" :: "v"(wr_), "v"(ws_)); }
            return;
        }
        const bool sig = false;
        f32x4 bv[2][2];
#pragma unroll
        for (int bj = 0; bj < 2; ++bj)
#pragma unroll
            for (int n = 0; n < 2; ++n) bv[bj][n] = *(const f32x4*)(bias + col0 + bj * HALF + 4 * n);
#pragma unroll
        for (int ai = 0; ai < 2; ++ai)
#pragma unroll
            for (int m = 0; m < 4; ++m) { bf16_t* rowp = U + (size_t)(row0 + ai * HALF + m * 16) * INC + col0;
#pragma unroll
                for (int bj = 0; bj < 2; ++bj) { f32x4 v0 = (acc[ai][bj][m][0] + bv[bj][0]) * qs, v1 = (acc[ai][bj][m][1] + bv[bj][1]) * qs;
                    if (sig) {
#pragma unroll
                        for (int i = 0; i < 4; ++i) { v0[i] = fsig(v0[i]); v1[i] = fsig(v1[i]); } }
                    const u32x4 w_ = pack8(v0, v1);
                    if (MODE == 0) *(u32x4*)(rowp + bj * HALF) = w_; else asm volatile("" :: "v"(w_)); } }
    }
};
typedef EpiInprojT<0> EpiInproj;
template <int P> struct EpiCat {
    static constexpr bool PERM = true;
    bf16_t* Mg; const bf16_t* U;
    __device__ __forceinline__ void operator()(const f32x4 (&acc)[2][2][4][2], const Unit& u, int wr, int wc, int fr, int fq) const {
        const int row0 = u.pm * BM + wr * 64 + fr, col0 = u.pn * BM + wc * 32 + 8 * fq;
#pragma unroll
        for (int ai = 0; ai < 2; ++ai)
#pragma unroll
            for (int m = 0; m < 4; ++m) { const size_t row = (size_t)(row0 + ai * HALF + m * 16);
#pragma unroll
                for (int bj = 0; bj < 2; ++bj) { const u32x4 gw = *(const u32x4*)(U + row * INC + GOFF + P * D + col0 + bj * HALF);
                    f32x4 g0, g1; unpack8(gw, g0, g1); f32x4 v0 = acc[ai][bj][m][0] * g0, v1 = acc[ai][bj][m][1] * g1;
                    bf16_t* mp = Mg + row * D + col0 + bj * HALF;
                    if (P == 1) { const u32x4 tw = *(const u32x4*)mp; f32x4 t0, t1; unpack8(tw, t0, t1); v0 += t0; v1 += t1; }
                    *(u32x4*)mp = pack8(v0, v1); } }
    }
};
struct EpiCatR {
    static constexpr bool PERM = true;
    bf16_t* Mg; const bf16_t* U;
    __device__ __forceinline__ void mid(f32x4 (&acc)[2][2][4][2], const Unit& u, int wr, int wc, int fr, int fq) const {
        int row0 = u.pm * BM + wr * 64 + fr; asm volatile("" : "+v"(row0));
        const int col0 = u.pn * BM + wc * 32 + 8 * fq;
#pragma unroll
        for (int ai = 0; ai < 2; ++ai) { asm volatile("" ::: "memory");
#pragma unroll
            for (int m = 0; m < 4; ++m) { const size_t row = (size_t)(row0 + ai * HALF + m * 16);
#pragma unroll
                for (int bj = 0; bj < 2; ++bj) { const u32x4 gw1 = *(const u32x4*)(U + row * INC + GOFF + col0 + bj * HALF);
                    f32x4 a0, a1; unpack8(gw1, a0, a1); acc[ai][bj][m][0] *= a0; acc[ai][bj][m][1] *= a1; } } }
        asm volatile("" ::: "memory");
    }
    __device__ __forceinline__ void operator()(const f32x4 (&acc)[2][2][4][2], const Unit& u, int wr, int wc, int fr, int fq) const {
        const int row0 = u.pm * BM + wr * 64 + fr, col0 = u.pn * BM + wc * 32 + 8 * fq;
#pragma unroll
        for (int ai = 0; ai < 2; ++ai)
#pragma unroll
            for (int m = 0; m < 4; ++m) { const size_t row = (size_t)(row0 + ai * HALF + m * 16);
#pragma unroll
                for (int bj = 0; bj < 2; ++bj) { const u32x4 gw = *(const u32x4*)(U + row * INC + GOFF + D + col0 + bj * HALF);
                    f32x4 g0, g1; unpack8(gw, g0, g1);
                    *(u32x4*)(Mg + row * D + col0 + bj * HALF) = pack8(acc[ai][bj][m][0] * g0, acc[ai][bj][m][1] * g1); } }
    }
};
struct EpiMix {
    static constexpr bool PERM = true;
    const float* X; bf16_t* O; const float* mod; float* ssq;
    __device__ __forceinline__ void operator()(const f32x4 (&acc)[2][2][4][2], const Unit& u, int wr, int wc, int fr, int fq) const {
        const int row0 = u.pm * BM + wr * 64 + fr, col0 = u.pn * BM + wc * 32 + 8 * fq; const int b = (u.pm * BM) / SEQ;
        f32x4 gv[2][2];
#pragma unroll
        for (int bj = 0; bj < 2; ++bj)
#pragma unroll
            for (int n = 0; n < 2; ++n) gv[bj][n] = *(const f32x4*)(mod + (size_t)b * 6 * D + 2 * D + col0 + bj * HALF + 4 * n);
#pragma unroll
        for (int ai = 0; ai < 2; ++ai)
#pragma unroll
            for (int m = 0; m < 4; ++m) { const size_t off = (size_t)(row0 + ai * HALF + m * 16) * D + col0; float sq = 0.f;
#pragma unroll
                for (int bj = 0; bj < 2; ++bj) { f32x4 v[2];
#pragma unroll
                    for (int n = 0; n < 2; ++n) { v[n] = *(const f32x4*)(X + off + bj * HALF + 4 * n) + gv[bj][n] * acc[ai][bj][m][n]; }
                    const u32x4 w = pack8(v[0], v[1]); *(u32x4*)(O + off + bj * HALF) = w;
                    f32x4 r0, r1; unpack8(w, r0, r1);
                    sq += ((r0.x * r0.x + r0.y * r0.y) + (r0.z * r0.z + r0.w * r0.w)) + ((r1.x * r1.x + r1.y * r1.y) + (r1.z * r1.z + r1.w * r1.w)); }
                sq += __shfl_xor(sq, 16); sq += __shfl_xor(sq, 32);
                if (fq == 0) ssq[(size_t)(row0 + ai * HALF + m * 16) * 16 + u.pn * 4 + wc] = sq; }
    }
};
struct EpiGateUp {
    static constexpr bool PERM = true;
    bf16_t* Act; const float* bgu;
    __device__ __forceinline__ void operator()(const f32x4 (&acc)[2][2][4][2], const Unit& u, int wr, int wc, int fr, int fq) const {
        const int e = u.pn >> 3, j = u.pn & 7; const int row0 = u.pm * BM + wr * 64 + fr, col0 = 128 * j + wc * 32 + 8 * fq;
        f32x4 bg[2], bu[2];
#pragma unroll
        for (int n = 0; n < 2; ++n) { bg[n] = *(const f32x4*)(bgu + (size_t)e * 2 * D + col0 + 4 * n); bu[n] = *(const f32x4*)(bgu + (size_t)e * 2 * D + D + col0 + 4 * n); }
#pragma unroll
        for (int ai = 0; ai < 2; ++ai)
#pragma unroll
            for (int m = 0; m < 4; ++m) { f32x4 r[2];
#pragma unroll
                for (int n = 0; n < 2; ++n) { const f32x4 gt = acc[ai][0][m][n] + bg[n], up = acc[ai][1][m][n] + bu[n];
#pragma unroll
                    for (int i = 0; i < 4; ++i) { const float gg = fminf(gt[i], 7.0f), uu = fminf(fmaxf(up[i], -7.0f), 7.0f); r[n][i] = (uu + 1.0f) * (gg * fsig(1.702f * gg)); } }
                *(u32x4*)(Act + (size_t)(row0 + ai * HALF + m * 16) * D + col0) = pack8(r[0], r[1]); }
    }
};
struct EpiDown {
    static constexpr bool PERM = true;
    bf16_t* Slots; const float* bd; const float* roww;
    __device__ __forceinline__ void operator()(const f32x4 (&acc)[2][2][4][2], const Unit& u, int wr, int wc, int fr, int fq) const {
        const int e = u.pn >> 2, j = u.pn & 3; const int row0 = u.pm * BM + wr * 64 + fr, col0 = 256 * j + wc * 32 + 8 * fq;
        f32x4 bv[2][2];
#pragma unroll
        for (int bj = 0; bj < 2; ++bj)
#pragma unroll
            for (int n = 0; n < 2; ++n) bv[bj][n] = *(const f32x4*)(bd + (size_t)e * D + col0 + bj * HALF + 4 * n);
#pragma unroll
        for (int ai = 0; ai < 2; ++ai)
#pragma unroll
            for (int m = 0; m < 4; ++m) { const int row = row0 + ai * HALF + m * 16; const float w = roww[row];
#pragma unroll
                for (int bj = 0; bj < 2; ++bj) { const f32x4 v0 = (acc[ai][bj][m][0] + bv[bj][0]) * w, v1 = (acc[ai][bj][m][1] + bv[bj][1]) * w;
                    *(u32x4*)(Slots + (size_t)row * D + col0 + bj * HALF) = pack8(v0, v1); } }
    }
};
}

#define LASP __attribute__((address_space(3)))
__device__ __forceinline__ void glds16(const void* gsrc, unsigned lds_dst) { unsigned keep;
    asm volatile("s_mov_b32 %0, m0\n\ts_mov_b32 m0, %2\n\ts_nop 0\n\tglobal_load_lds_dwordx4 %1, off\n\ts_mov_b32 m0, %0" : "=&s"(keep) : "v"(gsrc), "s"(lds_dst) : "memory"); }
__device__ __forceinline__ void glds16s(const void* sbase, unsigned voff, unsigned lds_dst) { unsigned keep;
    asm volatile("s_nop 4\n\ts_mov_b32 %0, m0\n\ts_mov_b32 m0, %3\n\ts_nop 0\n\tglobal_load_lds_dwordx4 %1, %2\n\ts_mov_b32 m0, %0" : "=&s"(keep) : "v"(voff), "s"(sbase), "s"(lds_dst) : "memory"); }
typedef short v4i16_t __attribute__((ext_vector_type(4)));
__device__ __forceinline__ s16x4 vtr(const LASP char* p) { return __builtin_bit_cast(s16x4, __builtin_amdgcn_ds_read_tr16_b64_v4i16((LASP v4i16_t*)p)); }

__device__ __forceinline__ float max3f(float a, float b, float c) { float r; asm("v_max3_f32 %0, %1, %2, %3" : "=v"(r) : "v"(a), "v"(b), "v"(c)); return r; }
__device__ __forceinline__ float fadd_s(float a, float b) { float r; asm("v_add_f32_e32 %0, %1, %2" : "=v"(r) : "v"(a), "v"(b)); return r; }
__device__ __forceinline__ unsigned bfbits(float f) { return f2bf(f); }
__device__ __forceinline__ void phase_attn_fast(Ctx& C) {
    const bf16_t* u = (const bf16_t*)(C.ws + WS_U); bf16_t* ycat = (bf16_t*)(C.ws + WS_YCAT);
    const int wave = C.wave;
    const float* lq = C.in[18];
    float lam;
    { const int l_ = lane_id(); const float d1 = wave_sum(lq[l_] * lq[64 + l_]), d2 = wave_sum(lq[128 + l_] * lq[192 + l_]); lam = __builtin_bit_cast(float, __builtin_amdgcn_readfirstlane(__builtin_bit_cast(int, expf(d1) - expf(d2) + 0.2f))); }
    const unsigned lds0 = (unsigned)(uintptr_t)C.lds;
    const LASP char* ldsp = (const LASP char*)C.lds;
    constexpr int SLOT = 24576;
    const int vcu = (C.nblk % 8 == 0) ? (C.blk % 8) * (C.nblk / 8) + C.blk / 8 : C.blk;
    for (int idx = vcu; idx < 256; idx += C.nblk)
#pragma unroll 1
    for (int sub = 0; sub < 2; ++sub) {
        const int b = idx >> 4, hA = (idx >> 3) & 1, qb = idx & 7; const int hh = sub ? 3 - hA : hA;
        const int lane = fresh_lane();
        const int l31 = lane & 31, hi = lane >> 5;
        const int krow = 8 * wave + (lane >> 3), kchunk = (lane & 7) ^ (lane >> 3);
        const int st0 = 4 * wave + (lane >> 5), st1 = st0 + 2;
        const int vrow = (lane & 31) >> 2, vch = lane & 3;
        const unsigned koffb = (unsigned)((krow * INC + kchunk * 8) * 2);
        const unsigned voffb0 = (unsigned)(((8 * (st0 >> 2) + vrow) * INC + 32 * (st0 & 3) + 8 * vch) * 2);
        const unsigned voffb1 = (unsigned)(((8 * (st1 >> 2) + vrow) * INC + 32 * (st1 & 3) + 8 * vch) * 2);
        const int koff0 = l31 * 128, kx = l31 & 7;
        const int vboff = 8192 + (4 * hi + ((lane & 15) >> 2)) * 64 + ((lane >> 4) & 1) * 32 + (lane & 3) * 8;
        const unsigned hm0 = hi ? 0u : 0xffffffffu;
        const unsigned dkdk = hi ? 0u : bfbits((float)l31) * 0x10001u;
        const int q0 = qb * 256 + wave * 32;
        const float slope2 = exp2f(-2.0f * (float)(hh + 1)) * LOG2E;
        const unsigned SH = bfbits(slope2); const unsigned SL = bfbits(slope2 - bf2f(SH)); const unsigned SHSL = SH | (SL << 16);
        const float slope2q = bf2f(SH) + bf2f(SL);
        const unsigned kw0b = hi ? 0x3f803f80u : SHSL, kw1b = hi ? 0x00003f80u : SHSL, ksm = hi ? 0u : 0x80008000u;
        const unsigned qa0 = bfbits((float)q0) * 0x10001u, qa1 = bfbits((float)l31) * 0x10001u;
        const float qpos = (float)(q0 + l31 - 4 * hi);
        const bf16_t* qrow = u + (size_t)(b * SEQ + q0 + l31) * INC + QOFF + hh * 128;
        const bf16_t* kgb = u + (size_t)(b * SEQ) * INC + KOFF + hh * 128;
        const bf16_t* vgb = u + (size_t)(b * SEQ) * INC + VOFF + hh * 128;
        const int t0 = qb * 4, tdiag = q0 >> 6;
#pragma unroll 1
        for (int c = 0; c < 2; ++c) {
            const bf16_t* kgc = kgb + c * 64;
#define ATT_DMA(t, sl) do { const size_t _o = (size_t)(t) * 64 * INC; const unsigned _b = lds0 + (unsigned)(sl) * SLOT; \
        glds16s(kgc + _o, koffb, (unsigned)__builtin_amdgcn_readfirstlane(_b + wave * 1024)); \
        glds16s(vgb + _o, voffb0, (unsigned)__builtin_amdgcn_readfirstlane(_b + 8192 + (2 * wave) * 1024)); \
        glds16s(vgb + _o, voffb1, (unsigned)__builtin_amdgcn_readfirstlane(_b + 8192 + (2 * wave + 1) * 1024)); } while (0)
#define ATT_WAITBAR() asm volatile("s_waitcnt vmcnt(0) lgkmcnt(0)\n\ts_barrier" ::: "memory")
#define ATT_WAITBAR3() asm volatile("s_waitcnt vmcnt(3) lgkmcnt(0)\n\ts_barrier" ::: "memory")
#define ATT_SB() __builtin_amdgcn_sched_barrier(0)
#define ATT_QK(sl, tt) do { const LASP char* Kb_ = ldsp + (sl) * SLOT + koff0; \
        const int kvb_ = (tt) * 64; const bool diag_ = (tt) == tdiag; const bool before_ = kvb_ < q0; \
        const unsigned spos_ = before_ ? 0x80008000u : 0u, sneg_ = before_ ? 0u : 0x80008000u; \
        const unsigned dm_ = diag_ ? ~hm0 : 0xffffffffu; \
        const unsigned w0_ = (kw0b ^ (spos_ & ksm)) & dm_, w1_ = (kw1b ^ (spos_ & ksm)) & dm_, w3_ = (dkdk ^ (sneg_ & ksm)) & dm_; \
        const unsigned k0_ = ((bfbits((float)kvb_) * 0x10001u) ^ sneg_) & hm0 & dm_, k1_ = ((bfbits((float)(kvb_ + 32)) * 0x10001u) ^ sneg_) & hm0 & dm_; \
        const bf16x8 ka0_ = __builtin_bit_cast(bf16x8, (u32x4){w0_, w1_, k0_, w3_}), ka1_ = __builtin_bit_cast(bf16x8, (u32x4){w0_, w1_, k1_, w3_}); \
        P0 = __builtin_amdgcn_mfma_f32_32x32x16_bf16(ka0_, qaug, zero16, 0, 0, 0); P1 = __builtin_amdgcn_mfma_f32_32x32x16_bf16(ka1_, qaug, zero16, 0, 0, 0); \
        _Pragma("unroll") for (int ks = 0; ks < 4; ++ks) { \
            const bf16x8 kf0_ = *(const LASP bf16x8*)(Kb_ + (((2 * ks + hi) ^ kx) * 16)); \
            const bf16x8 kf1_ = *(const LASP bf16x8*)(Kb_ + 4096 + (((2 * ks + hi) ^ kx) * 16)); \
            const bf16x8 qf_ = *(const LASP bf16x8*)(qlds + ks * 1024); \
            P0 = __builtin_amdgcn_mfma_f32_32x32x16_bf16(kf0_, qf_, P0, 0, 0, 0); P1 = __builtin_amdgcn_mfma_f32_32x32x16_bf16(kf1_, qf_, P1, 0, 0, 0); } \
        asm volatile("s_nop 15\n\ts_nop 7" : "+v"(P0), "+v"(P1));     \
        ATT_SB(); } while (0)
#define ATT_SM(tt) do { \
        if ((tt) == tdiag) { const float a_ = qpos - (float)((tt) * 64); \
            _Pragma("unroll") for (int r = 0; r < 16; ++r) { const float x0 = a_ - (float)crow(r, 0); P0[r] = fmaf(fabsf(x0), -slope2q, P0[r]); P1[r] = fmaf(fabsf(x0 - 32.0f), -slope2q, P1[r]); } } \
        float rm_ = max3f(P0[0], P0[1], P1[0]); rm_ = max3f(rm_, P1[1], P0[2]); float rn_ = max3f(P0[3], P1[2], P1[3]); \
        _Pragma("unroll") for (int r = 4; r < 16; r += 2) { rm_ = max3f(rm_, P0[r], P0[r + 1]); rn_ = max3f(rn_, P1[r], P1[r + 1]); } \
        float rm; { const float rq_ = fmaxf(rm_, rn_); auto rr = __builtin_amdgcn_permlane32_swap(__float_as_uint(rq_), __float_as_uint(rq_), false, false); rm = max3f(__uint_as_float(rr[0]), __uint_as_float(rr[1]), -1e30f); } \
        live = !__all(rm < mrel - 40.0f);       \
        if (live) { \
            mrel = fmaxf(mrel, rm); \
            if (__any(rm > 8.0f)) { const float dl = fmaxf(rm, 0.f); mhat += dl; mrel -= dl; \
                _Pragma("unroll") for (int r = 0; r < 16; ++r) { P0[r] -= dl; P1[r] -= dl; } \
                { const unsigned mh_ = bfbits(mhat); const float r1_ = mhat - bf2f(mh_); const unsigned mm_ = bfbits(r1_); const unsigned ml_ = bfbits(r1_ - bf2f(mm_)); \
                  const unsigned a0_ = hi ? ((mh_ | (mm_ << 16)) ^ 0x80008000u) : qa0, a1_ = hi ? (ml_ ^ 0x8000u) : qa1; \
                  qaug = __builtin_bit_cast(bf16x8, (u32x4){a0_, a1_, hi ? 0u : SHSL, hi ? 0u : SHSL}); } \
                const float f = exp2f(-dl); lsum *= f; \
                _Pragma("unroll") for (int eb = 0; eb < 4; ++eb) _Pragma("unroll") for (int r = 0; r < 16; ++r) o[eb][r] *= f; } \
            _Pragma("unroll") for (int r = 0; r < 16; ++r) { P0[r] = __builtin_amdgcn_exp2f(P0[r]); P1[r] = __builtin_amdgcn_exp2f(P1[r]); } \
            asm volatile("s_nop 1" : "+v"(P0), "+v"(P1));     \
            float ps0 = fadd_s(P0[0], P1[0]), ps1 = fadd_s(P0[1], P1[1]); \
            _Pragma("unroll") for (int r = 2; r < 16; r += 2) { ps0 = fadd_s(ps0, P0[r]); ps1 = fadd_s(ps1, P0[r + 1]); ps0 = fadd_s(ps0, P1[r]); ps1 = fadd_s(ps1, P1[r + 1]); } \
            lsum += fadd_s(ps0, ps1); \
            _Pragma("unroll") for (int s2 = 0; s2 < 2; ++s2) { \
                u32x4 w_; w_.x = cvtpk(P0[8 * s2 + 0], P0[8 * s2 + 1]); w_.y = cvtpk(P0[8 * s2 + 2], P0[8 * s2 + 3]); w_.z = cvtpk(P0[8 * s2 + 4], P0[8 * s2 + 5]); w_.w = cvtpk(P0[8 * s2 + 6], P0[8 * s2 + 7]); pf[s2] = __builtin_bit_cast(bf16x8, w_); \
                u32x4 v_; v_.x = cvtpk(P1[8 * s2 + 0], P1[8 * s2 + 1]); v_.y = cvtpk(P1[8 * s2 + 2], P1[8 * s2 + 3]); v_.z = cvtpk(P1[8 * s2 + 4], P1[8 * s2 + 5]); v_.w = cvtpk(P1[8 * s2 + 6], P1[8 * s2 + 7]); pf[2 + s2] = __builtin_bit_cast(bf16x8, v_); } \
        } ATT_SB(); } while (0)
#define ATT_PV(sl) do { if (live) { const LASP char* Vb_ = ldsp + (sl) * SLOT + vboff; \
            _Pragma("unroll") for (int eb = 0; eb < 4; ++eb) _Pragma("unroll") for (int s = 0; s < 4; ++s) { \
                const s16x4 lo_ = vtr(Vb_ + s * 4096 + eb * 512), h4_ = vtr(Vb_ + s * 4096 + 2048 + eb * 512); \
                const bf16x8 vf_ = (bf16x8){lo_[0], lo_[1], lo_[2], lo_[3], h4_[0], h4_[1], h4_[2], h4_[3]}; \
                o[eb] = __builtin_amdgcn_mfma_f32_32x32x16_bf16(vf_, pf[s], o[eb], 0, 0, 0); } } ATT_SB(); } while (0)
            { bf16x8 qf_[4];
#pragma unroll
              for (int ks = 0; ks < 4; ++ks) qf_[ks] = *(const bf16x8*)(qrow + c * 64 + 16 * ks + 8 * hi);
#pragma unroll
              for (int ks = 0; ks < 4; ++ks) *(LASP bf16x8*)((LASP char*)C.lds + 4 * SLOT + wave * 4096 + ks * 1024 + lane * 16) = qf_[ks]; }
            asm volatile("s_waitcnt vmcnt(0)" ::: "memory");
            ATT_DMA(t0, 0); ATT_DMA((t0 + 1) & 31, 1);
            const LASP char* qlds = ldsp + 4 * SLOT + wave * 4096 + lane * 16;
            f32x16 o[4], zero16, P0, P1;
#pragma unroll
            for (int r = 0; r < 16; ++r) zero16[r] = 0.f;
#pragma unroll
            for (int eb = 0; eb < 4; ++eb)
#pragma unroll
                for (int r = 0; r < 16; ++r) o[eb][r] = 0.f;
            float mhat = 0.f, lsum = 0.f, mrel = -1e30f;
            bf16x8 qaug = __builtin_bit_cast(bf16x8, (u32x4){hi ? 0u : qa0, hi ? 0u : qa1, hi ? 0u : SHSL, hi ? 0u : SHSL});
            bf16x8 pf[4]; bool live = false;
            if (wave < 4) {
#pragma unroll 1
                for (int i = 0; i < 32; ++i) {
                    if (i + 1 < 32) ATT_WAITBAR3(); else ATT_WAITBAR();
                    if (i + 2 < 32) ATT_DMA((t0 + i + 2) & 31, (i + 2) & 3);
                    const int tt = (t0 + i) & 31;
                    ATT_QK(i & 3, tt); ATT_SM(tt); ATT_PV(i & 3);
                }
            } else {
#pragma unroll 1
                for (int i = 0; i < 32; ++i) {
                    if (i + 1 < 32) ATT_WAITBAR3(); else ATT_WAITBAR();
                    if (i + 2 < 32) ATT_DMA((t0 + i + 2) & 31, (i + 2) & 3);
                    const int tt = (t0 + i) & 31;
                    ATT_PV((i - 1) & 3); ATT_QK(i & 3, tt); ATT_SM(tt);
                }
                ATT_PV(31 & 3);
            }
#undef ATT_DMA
#undef ATT_QK
#undef ATT_SM
#undef ATT_PV
#undef ATT_SB
            { auto rr = __builtin_amdgcn_permlane32_swap(__float_as_uint(lsum), __float_as_uint(lsum), false, false); lsum = __uint_as_float(rr[0]) + __uint_as_float(rr[1]); }
            const float inv = 1.0f / lsum;
            float* pk = (float*)(C.ws + WS_H2LO) + (size_t)C.gw * 4096;
            pk += fresh_lane();
            if (c == 0) {
#pragma unroll
                for (int eb = 0; eb < 4; ++eb)
#pragma unroll
                    for (int r = 0; r < 16; ++r) pk[(eb * 16 + r) * 64] = o[eb][r] * inv;
            } else {
                float ss = 0.f;
#pragma unroll
                for (int eb = 0; eb < 4; ++eb)
#pragma unroll
                    for (int r = 0; r < 16; ++r) { const float y = pk[(eb * 16 + r) * 64] - lam * (o[eb][r] * inv); o[eb][r] = y; ss += y * y; }
                { auto rr = __builtin_amdgcn_permlane32_swap(__float_as_uint(ss), __float_as_uint(ss), false, false); ss = __uint_as_float(rr[0]) + __uint_as_float(rr[1]); }
                const float rinv = 1.0f / sqrtf(ss * (1.0f / 128.0f) + EPS);
                bf16_t* orow = ycat + (size_t)(b * SEQ + q0 + l31) * D + 512 + hh * 128 + 4 * hi;
#pragma unroll
                for (int eb = 0; eb < 4; ++eb)
#pragma unroll
                    for (int g4 = 0; g4 < 4; ++g4) { const int e = 32 * eb + 8 * g4;
                        u32x2 w; w.x = cvtpk(o[eb][4 * g4] * rinv, o[eb][4 * g4 + 1] * rinv); w.y = cvtpk(o[eb][4 * g4 + 2] * rinv, o[eb][4 * g4 + 3] * rinv);
                        *(u32x2*)(orow + e) = w; }
            }
        }
    }
    ATT_WAITBAR();
#undef ATT_WAITBAR
#undef ATT_WAITBAR3
}

#define LDS_BAR() asm volatile("s_waitcnt lgkmcnt(0)\n\ts_barrier" ::: "memory")
__device__ __forceinline__ void phase_hy_pre_fast(Ctx& C) {
    const bf16_t* u = (const bf16_t*)(C.ws + WS_U); bf16_t* vpt = (bf16_t*)(C.ws + WS_VP); bf16_t* x0t = (bf16_t*)(C.ws + WS_X0C);
    const float* cw = C.in[7]; const float* cb = C.in[8];
    bf16_t* sv = (bf16_t*)C.lds; bf16_t* sx = sv + 64 * 72 + 64;
    const int tl = C.tid >> 3, c8 = C.tid & 7;
    constexpr int NTILES = NB * 32 * 8;
#define HYP_LOAD(dst, tile_) do { const int cq_ = (tile_) & 7, tq_ = ((tile_) >> 3) & 31, b_ = (tile_) >> 8; const int c0_ = cq_ * 64 + c8 * 8, t_ = tq_ * 64 + tl; const size_t row_ = (size_t)b_ * SEQ + t_; \
        const u32x4 z_ = {0u, 0u, 0u, 0u}; \
        _Pragma("unroll") for (int s_ = 0; s_ < 3; ++s_) { const int ch_ = s_ * HW + c0_; \
            dst[s_][1] = *(const u32x4*)(u + row_ * INC + ch_); \
            dst[s_][0] = (C.lane < 8 && t_ > 0) ? *(const u32x4*)(u + (row_ - 1) * INC + ch_) : z_;            \
            dst[s_][2] = (C.lane >= 56 && t_ < SEQ - 1) ? *(const u32x4*)(u + (row_ + 1) * INC + ch_) : z_; } } while (0)
    u32x4 cur[3][3], nxt[3][3];
    int tile = C.blk;
    if (tile < NTILES) HYP_LOAD(cur, tile);
    for (; tile < NTILES; tile += C.nblk) {
        const bool more = tile + C.nblk < NTILES;
        if (more) HYP_LOAD(nxt, tile + C.nblk);
        const int cq = tile & 7, tq = (tile >> 3) & 31, b = tile >> 8;
        const int c0 = cq * 64 + c8 * 8;
        float r[3][8];
#pragma unroll
        for (int s = 0; s < 3; ++s) {
            const int ch = s * HW + c0;
            u32x4 um_ = cur[s][0], up_ = cur[s][2];
#pragma unroll
            for (int w_ = 0; w_ < 4; ++w_) { const unsigned a_ = __shfl_up(cur[s][1][w_], 8), b_ = __shfl_down(cur[s][1][w_], 8); if (C.lane >= 8) um_[w_] = a_; if (C.lane < 56) up_[w_] = b_; }
            f32x4 m0, m1, z0, z1, p0, p1; pg8::unpack8(um_, m0, m1); pg8::unpack8(cur[s][1], z0, z1); pg8::unpack8(up_, p0, p1);
            const f32x4 w00 = *(const f32x4*)(cw + ch), w01 = *(const f32x4*)(cw + ch + 4), w10 = *(const f32x4*)(cw + 3 * HW + ch), w11 = *(const f32x4*)(cw + 3 * HW + ch + 4);
            const f32x4 w20 = *(const f32x4*)(cw + 6 * HW + ch), w21 = *(const f32x4*)(cw + 6 * HW + ch + 4), bb0 = *(const f32x4*)(cb + ch), bb1 = *(const f32x4*)(cb + ch + 4);
            const f32x4 a0 = m0 * w00 + z0 * w10 + p0 * w20 + bb0, a1 = m1 * w01 + z1 * w11 + p1 * w21 + bb1;
#pragma unroll
            for (int i = 0; i < 4; ++i) { r[s][i] = a0[i]; r[s][4 + i] = a1[i]; }
        }
        LDS_BAR();
#pragma unroll
        for (int i = 0; i < 8; ++i) { sx[(c8 * 8 + i) * 72 + c8 * 8 + tl] = (bf16_t)f2bf(r[0][i]); sv[(c8 * 8 + i) * 72 + c8 * 8 + tl] = (bf16_t)f2bf(r[2][i] * r[1][i]); }
        LDS_BAR();
        { const int cl = C.tid >> 3, chk = C.tid & 7; const size_t o = ((size_t)(cq * 64 + cl) * NB + b) * SEQ + tq * 64 + chk * 8;
          *(u32x4*)(vpt + o) = *(const u32x4*)(sv + cl * 72 + (cl >> 3) * 8 + chk * 8); *(u32x4*)(x0t + o) = *(const u32x4*)(sx + cl * 72 + (cl >> 3) * 8 + chk * 8); }
        if (more) {
#pragma unroll
            for (int s = 0; s < 3; ++s)
#pragma unroll
                for (int q = 0; q < 3; ++q) cur[s][q] = nxt[s][q]; }
    }
#undef HYP_LOAD
    __syncthreads();
}

__device__ __forceinline__ void phase_toeplitz(Ctx& C) {
    constexpr int VROW = 4096 + 16, FCOPY = 8192 + 32, FL = 16 * VROW;
    const bf16_t* vpt = (const bf16_t*)(C.ws + WS_VP); const bf16_t* x0t = (const bf16_t*)(C.ws + WS_X0C); bf16_t* yt = (bf16_t*)(C.ws + WS_YT);
    const float* kfc = (const float*)(C.ws + WS_KFC); const float* dsk = C.in[17];
    const int lane = C.lane, a = lane & 15, g = lane >> 4, wave = C.wave;
    const unsigned lds0 = (unsigned)(uintptr_t)C.lds;
    const LASP char* ldsp = (const LASP char*)C.lds;
    const int t0 = 256 * wave;
    const int c0 = 2048 - t0 + 8 * g - a;
    const LASP char* fbase = ldsp + FL + (c0 & 7) * FCOPY + 2 * (c0 & ~7);
    const LASP char* vbase = ldsp + a * VROW + 16 * g;
    for (int c = C.blk; c < HW; c += C.nblk) {
        asm volatile("s_waitcnt vmcnt(0) lgkmcnt(0)\n\ts_barrier" ::: "memory");
        { const char* src = (const char*)(vpt + (size_t)c * NB * SEQ) + lane * 16;
#pragma unroll
          for (int j = 0; j < 8; ++j) { const int p = wave * 8 + j;
              glds16(src + (size_t)p * 1024, (unsigned)__builtin_amdgcn_readfirstlane(lds0 + (p >> 2) * VROW + (p & 3) * 1024)); } }
        { const int q = C.tid; const float* kc = kfc + (size_t)c * 4096; float f[15];
#pragma unroll
          for (int i = 0; i < 15; ++i) { const int idx = 4096 - 8 * q - i; f[i] = (idx >= 1 && idx <= 4095) ? kc[idx] : 0.f; }
#pragma unroll
          for (int m = 0; m < 8; ++m) { u32x4 w; w.x = pk2(f[m], f[m + 1]); w.y = pk2(f[m + 2], f[m + 3]); w.z = pk2(f[m + 4], f[m + 5]); w.w = pk2(f[m + 6], f[m + 7]);
              *(LASP u32x4*)((LASP char*)C.lds + FL + m * FCOPY + q * 16) = w; } }
        asm volatile("s_waitcnt vmcnt(0) lgkmcnt(0)\n\ts_barrier" ::: "memory");
        f32x4 acc[16]; bf16x8 W[16];
#pragma unroll
        for (int r = 0; r < 16; ++r) { acc[r] = (f32x4){0.f, 0.f, 0.f, 0.f}; W[r] = *(const LASP bf16x8*)(fbase - 32 * r); }
#pragma unroll 1
        for (int ko = 0; ko < 8; ++ko) {
            const LASP char* fb = fbase + ko * 512; const LASP char* vb = vbase + ko * 512;
#pragma unroll
            for (int kk = 0; kk < 8; ++kk) {
                const bf16x8 Bf = *(const LASP bf16x8*)(vb + 64 * kk);
#pragma unroll
                for (int r = 0; r < 16; ++r) acc[r] = __builtin_amdgcn_mfma_f32_16x16x32_bf16(W[(r - 2 * kk) & 15], Bf, acc[r], 0, 0, 0);
                if (ko < 7 || kk < 7) { W[(-2 * kk - 2) & 15] = *(const LASP bf16x8*)(fb + 64 * kk + 64); W[(-2 * kk - 1) & 15] = *(const LASP bf16x8*)(fb + 64 * kk + 32); }
            }
        }
        const float dd = dsk[c];
#pragma unroll
        for (int r = 0; r < 16; ++r) { const int t = t0 + 16 * r + 4 * g; const size_t o = ((size_t)c * NB + a) * SEQ + t;
            const u32x2 vv = *(const LASP u32x2*)(ldsp + a * VROW + t * 2); const u32x2 xx = *(const u32x2*)(x0t + o);
            const float y0 = (acc[r][0] + bflo(vv.x) * dd) * bflo(xx.x), y1 = (acc[r][1] + bfhi(vv.x) * dd) * bfhi(xx.x);
            const float y2 = (acc[r][2] + bflo(vv.y) * dd) * bflo(xx.y), y3 = (acc[r][3] + bfhi(vv.y) * dd) * bfhi(xx.y);
            u32x2 w; w.x = pk2(y0, y1); w.y = pk2(y2, y3); *(u32x2*)(yt + o) = w; }
    }
    asm volatile("s_waitcnt vmcnt(0) lgkmcnt(0)\n\ts_barrier" ::: "memory");
}

__device__ __forceinline__ void phase_hy_post(Ctx& C) {
    const bf16_t* yt = (const bf16_t*)(C.ws + WS_YT); bf16_t* ycat = (bf16_t*)(C.ws + WS_YCAT);
    bf16_t* sy = (bf16_t*)C.lds;
    constexpr int NTILES = NB * 32 * 8;
    const int cl = C.tid >> 3, chk = C.tid & 7, tl = C.tid >> 3, c8 = C.tid & 7;
#define HYQ_LOAD(tile_) (*(const u32x4*)(yt + ((size_t)(((tile_) & 7) * 64 + cl) * NB + ((tile_) >> 8)) * SEQ + (((tile_) >> 3) & 31) * 64 + chk * 8))
    int tile = C.blk; u32x4 cur = {0u, 0u, 0u, 0u}, nxt = cur;
    if (tile < NTILES) cur = HYQ_LOAD(tile);
    for (; tile < NTILES; tile += C.nblk) {
        const bool more = tile + C.nblk < NTILES;
        if (more) nxt = HYQ_LOAD(tile + C.nblk);
        const int cq = tile & 7, tq = (tile >> 3) & 31, b = tile >> 8;
        LDS_BAR();
        *(u32x4*)(sy + cl * 72 + (cl >> 3) * 8 + chk * 8) = cur;
        LDS_BAR();
        { unsigned short e[8];
#pragma unroll
          for (int i = 0; i < 8; ++i) e[i] = sy[(c8 * 8 + i) * 72 + c8 * 8 + tl];
          u32x4 w; w.x = e[0] | ((unsigned)e[1] << 16); w.y = e[2] | ((unsigned)e[3] << 16); w.z = e[4] | ((unsigned)e[5] << 16); w.w = e[6] | ((unsigned)e[7] << 16);
          *(u32x4*)(ycat + ((size_t)b * SEQ + tq * 64 + tl) * D + cq * 64 + c8 * 8) = w; }
        cur = nxt;
    }
#undef HYQ_LOAD
    __syncthreads();
}

__device__ __forceinline__ void phase_route(Ctx& C) {
    const float* mod = (const float*)(C.ws + WS_MOD); const float* ssq = (const float*)(C.ws + WS_LOGITS); bf16_t* h2 = (bf16_t*)(C.ws + WS_H); const bf16_t* wrt = (const bf16_t*)(C.ws + WS_WRT);
    int* tope = (int*)(C.ws + WS_TOPE); float* topw = (float*)(C.ws + WS_TOPW); int* blkcnt = (int*)(C.ws + WS_BLKCNT);
    const float* g = C.in[23]; const float* br = C.in[25];
    constexpr int WROW = 4096 + 16;
    LASP char* wl_ = (LASP char*)C.lds;
    int* hist = (int*)(C.lds + 32 * WROW); float* slog = (float*)(C.lds + 32 * WROW + 256) + C.wave * 512;
    const int lane = C.lane, tk = lane & 15, gq = lane >> 4;
    __syncthreads();
    for (int i = C.tid; i < NE * 256; i += NTHREADS) { const int e = i >> 8, ch = i & 255; *(LASP u32x4*)(wl_ + e * WROW + ch * 16) = *(const u32x4*)(wrt + (size_t)e * 2048 + ch * 8); }
    const float* mult2 = mod + 16 * 6 * D;
    for (int vb = C.blk; vb < 256; vb += C.nblk) {
        __syncthreads();
        if (C.tid < NE) hist[C.tid] = 0;
        __syncthreads();
        const int tok = vb * 128 + C.wave * 16 + tk; const int b = tok / SEQ;
        float rstd;
        { const f32x4* sp = (const f32x4*)(ssq + (size_t)tok * 16); const f32x4 a0 = sp[0], a1 = sp[1], a2 = sp[2], a3 = sp[3];
          const float ss = ((a0.x + a0.y) + (a0.z + a0.w)) + ((a1.x + a1.y) + (a1.z + a1.w)) + ((a2.x + a2.y) + (a2.z + a2.w)) + ((a3.x + a3.y) + (a3.z + a3.w));
          rstd = 1.0f / sqrtf(ss * (1.0f / D) + EPS); }
        const bf16_t* xr = (const bf16_t*)(C.ws + WS_X1) + (size_t)tok * D + 8 * gq; const float* sh = mod + (size_t)b * 6 * D + 3 * D + 8 * gq; const float* ml = mult2 + (size_t)b * D + 8 * gq;
        bf16_t* hr = h2 + (size_t)tok * D + 8 * gq;
        const LASP char* wb = wl_ + tk * WROW + 16 * gq;
        f32x4 acc[2]; acc[0] = (f32x4){0.f, 0.f, 0.f, 0.f}; acc[1] = acc[0];
#pragma unroll 1
        for (int kh = 0; kh < D; kh += 512) {
        u32x4 xall[16];
#pragma unroll
        for (int q = 0; q < 16; ++q) xall[q] = __builtin_nontemporal_load((const u32x4*)(xr + kh + 32 * q));
#pragma unroll
        for (int q = 0; q < 16; ++q) { const int k = kh + 32 * q;
            f32x4 x0, x1v; pg8::unpack8(xall[q], x0, x1v);
            const f32x4 m0 = *(const f32x4*)(ml + k) * rstd, m1 = *(const f32x4*)(ml + k + 4) * rstd, s0 = *(const f32x4*)(sh + k), s1 = *(const f32x4*)(sh + k + 4);
            const f32x4 h0 = x0 * m0 + s0, h1 = x1v * m1 + s1;
            u32x4 wh; wh.x = cvtpk(h0[0], h0[1]); wh.y = cvtpk(h0[2], h0[3]); wh.z = cvtpk(h1[0], h1[1]); wh.w = cvtpk(h1[2], h1[3]);
            *(u32x4*)(hr + k) = wh;
            u32x4 wlo; wlo.x = cvtpk(h0[0] - bflo(wh.x), h0[1] - bfhi(wh.x)); wlo.y = cvtpk(h0[2] - bflo(wh.y), h0[3] - bfhi(wh.y)); wlo.z = cvtpk(h1[0] - bflo(wh.z), h1[1] - bfhi(wh.z)); wlo.w = cvtpk(h1[2] - bflo(wh.w), h1[3] - bfhi(wh.w));
            const bf16x8 a_h = __builtin_bit_cast(bf16x8, wh), a_l = __builtin_bit_cast(bf16x8, wlo);
#pragma unroll
            for (int n = 0; n < 2; ++n) { const LASP char* bp = wb + n * 16 * WROW + k * 2;
                const bf16x8 b_h = *(const LASP bf16x8*)(bp), b_l = *(const LASP bf16x8*)(bp + 2048);
                acc[n] = __builtin_amdgcn_mfma_f32_16x16x32_bf16(b_h, a_h, acc[n], 0, 0, 0);
                acc[n] = __builtin_amdgcn_mfma_f32_16x16x32_bf16(b_h, a_l, acc[n], 0, 0, 0);
                acc[n] = __builtin_amdgcn_mfma_f32_16x16x32_bf16(b_l, a_h, acc[n], 0, 0, 0); }
        } }
#pragma unroll
        for (int n = 0; n < 2; ++n) *(f32x4*)(slog + tk * 32 + n * 16 + 4 * gq) = acc[n];
        __builtin_amdgcn_s_waitcnt(0xc07f); asm volatile("" ::: "memory");
        if (lane < 16) {
            const int t = vb * 128 + C.wave * 16 + lane;
            float v[32];
#pragma unroll
            for (int q = 0; q < 8; ++q) { const f32x4 x = *(const f32x4*)(slog + lane * 32 + 4 * q), bb = *(const f32x4*)(br + 4 * q);
                v[4 * q] = x.x + bb.x; v[4 * q + 1] = x.y + bb.y; v[4 * q + 2] = x.z + bb.z; v[4 * q + 3] = x.w + bb.w; }
            float tv[4]; int ti[4];
#pragma unroll
            for (int k = 0; k < 4; ++k) {
                float best = -INFINITY; int bi = 0;
#pragma unroll
                for (int e = 0; e < 32; ++e) if (v[e] > best) { best = v[e]; bi = e; }
                tv[k] = best; ti[k] = bi;
#pragma unroll
                for (int e = 0; e < 32; ++e) v[e] = (e == bi) ? -INFINITY : v[e];
            }
            const float e0 = 1.0f, e1 = expf(tv[1] - tv[0]), e2 = expf(tv[2] - tv[0]), e3 = expf(tv[3] - tv[0]);
            const float inv = 1.0f / (e0 + e1 + e2 + e3);
            *(int4*)(tope + (size_t)t * 4) = make_int4(ti[0], ti[1], ti[2], ti[3]);
            *(f32x4*)(topw + (size_t)t * 4) = (f32x4){e0 * inv, e1 * inv, e2 * inv, e3 * inv};
#pragma unroll
            for (int k = 0; k < 4; ++k) atomicAdd(&hist[ti[k]], 1);
        }
        __syncthreads();
        if (C.tid < NE) blkcnt[vb * NE + C.tid] = hist[C.tid];
    }
    __syncthreads();
}

__device__ __forceinline__ void phase_rowlist(Ctx& C) {
    const int* tope = (const int*)(C.ws + WS_TOPE); const int* blkcnt = (const int*)(C.ws + WS_BLKCNT);
    int* rowpair = (int*)(C.ws + WS_ROWPAIR); int* tileexp = (int*)(C.ws + WS_TILEEXP); int* meta = (int*)(C.ws + WS_META);
    float* roww = (float*)(C.ws + WS_ROWW); const float* topw = (const float*)(C.ws + WS_TOPW); int* rowinv = (int*)(C.ws + WS_TOPE);
    int* s_total = (int*)C.lds; int* s_base = s_total + 32; int* s_pstart = s_base + 32; int* s_e = s_pstart + 36; int* s_cnt = s_e + 512; int* s_wc = s_cnt + 256 * 32;
    for (int vb = C.blk; vb < 256; vb += C.nblk) {
        __syncthreads();
        { const int4* src = (const int4*)blkcnt; int4* dst = (int4*)s_cnt;
#pragma unroll
          for (int q = 0; q < 4; ++q) dst[q * NTHREADS + C.tid] = src[q * NTHREADS + C.tid]; }
        s_e[C.tid] = tope[(size_t)vb * 512 + C.tid];
        __syncthreads();
        if (C.tid < NE) { int tot = 0, base = 0;
#pragma unroll 8
            for (int q = 0; q < 256; ++q) { const int c = s_cnt[q * NE + C.tid]; tot += c; if (q < vb) base += c; } s_total[C.tid] = tot; s_base[C.tid] = base; }
        __syncthreads();
        if (C.tid == 0) { int ps = 0; for (int e = 0; e < NE; ++e) { s_pstart[e] = ps; ps += ((s_total[e] + 255) / 256) * 256; } s_pstart[NE] = ps; }
        __syncthreads();
        { const int e = s_e[C.tid]; int rank = 0;
          for (int q = 0; q < NE; ++q) { const unsigned long long mq = __ballot(e == q); if (e == q) rank = __builtin_popcountll(mq & ((1ull << C.lane) - 1ull)); if (C.lane == 0) s_wc[C.wave * NE + q] = __builtin_popcountll(mq); }
          __syncthreads();
          for (int w = 0; w < C.wave; ++w) rank += s_wc[w * NE + e];
          rowpair[s_pstart[e] + s_base[e] + rank] = vb * 512 + C.tid; roww[s_pstart[e] + s_base[e] + rank] = topw[vb * 512 + C.tid]; rowinv[vb * 512 + C.tid] = s_pstart[e] + s_base[e] + rank; }
        if (vb < NE) { const int e = vb; for (int r = s_pstart[e] + s_total[e] + C.tid; r < s_pstart[e + 1]; r += NTHREADS) { rowpair[r] = -1; roww[r] = 0.f; } }
        if (vb == 0) {
            if (C.tid < NE) { for (int tl = s_pstart[C.tid] / 256; tl < s_pstart[C.tid + 1] / 256; ++tl) tileexp[tl] = C.tid; }
            if (C.tid == 0) meta[0] = s_pstart[NE] / 256;
        }
    }
    __syncthreads();
}


#define LDS3(C) ((PG8_LAS unsigned char*)(C).lds)
__device__ __forceinline__ void phase_inproj_fast(Ctx& C) {
    pg8::Gemm g{(const bf16_t*)(C.ws + WS_H), (const bf16_t*)(C.ws + WS_WIN), D, D, D, nullptr};
    pg8::StaticOrder S; S.init(T / 256, INC / 256, C.nblk, C.blk);
    pg8::EpiInproj E{(bf16_t*)(C.ws + WS_U), C.in[6]};
    pg8::gemm_phase<pg8::EpiInproj, pg8::StaticOrder, false>(LDS3(C), g, S, E, C.wave);
}
#ifndef XVAR
#define XVAR 0
#endif
__device__ __forceinline__ void phase_probe_x(Ctx& C) {
#if XVAR == 1 || XVAR == 2
    pg8::Gemm g{(const bf16_t*)(C.ws + WS_H), (const bf16_t*)(C.ws + WS_WIN), D, D, D, nullptr};
    pg8::StaticOrder S; S.init(T / 256, INC / 256, C.nblk, C.blk);
    pg8::EpiInprojT<XVAR> E{(bf16_t*)(C.ws + WS_U), C.in[6]};
    pg8::gemm_phase<pg8::EpiInprojT<XVAR>, pg8::StaticOrder, false>(LDS3(C), g, S, E, C.wave);
#endif
}
__device__ __forceinline__ void phase_cat_fast(Ctx& C) {
    pg8::StaticOrder S; S.init(T / 256, D / 256, C.nblk, C.blk);
    pg8::Gemm g{(const bf16_t*)(C.ws + WS_YCAT), (const bf16_t*)(C.ws + WS_WCAT), D, D, D, nullptr};
    pg8::EpiCatR E{(bf16_t*)(C.ws + WS_MERGED), (const bf16_t*)(C.ws + WS_U)};
    pg8::gemm_phase<pg8::EpiCatR, pg8::StaticOrder, false, true>(LDS3(C), g, S, E, C.wave);
}
__device__ __forceinline__ void phase_mix_fast(Ctx& C) {
    pg8::Gemm g{(const bf16_t*)(C.ws + WS_MERGED), (const bf16_t*)(C.ws + WS_WMIX), D, D, D, nullptr};
    pg8::StaticOrder S; S.init(T / 256, D / 256, C.nblk, C.blk);
    pg8::EpiMix E{C.in[0], (bf16_t*)(C.ws + WS_X1), (const float*)(C.ws + WS_MOD), (float*)(C.ws + WS_LOGITS)};
    pg8::gemm_phase<pg8::EpiMix, pg8::StaticOrder, false>(LDS3(C), g, S, E, C.wave);
}
__device__ __forceinline__ void phase_gateup_fast(Ctx& C) {
    const int nmt = ((const int*)(C.ws + WS_META))[0];
    pg8::Gemm g{(const bf16_t*)(C.ws + WS_H), (const bf16_t*)(C.ws + WS_WGU), D, D, D, (const int*)(C.ws + WS_ROWPAIR)};
    { PG8_LAS int* te = (PG8_LAS int*)(LDS3(C) + 131072); const int* tg = (const int*)(C.ws + WS_TILEEXP); for (int i = C.tid; i < nmt; i += NTHREADS) te[i] = tg[i]; __syncthreads(); }
    pg8::MoeOrder S; S.b.init(nmt, 8, C.nblk, C.blk); S.tileexp = (const PG8_LAS int*)(LDS3(C) + 131072); S.nN = 8;
    pg8::EpiGateUp E{(bf16_t*)(C.ws + WS_ACT), C.in[27]};
    pg8::gemm_phase<pg8::EpiGateUp, pg8::MoeOrder, true>(LDS3(C), g, S, E, C.wave);
}
__device__ __forceinline__ void phase_down_fast(Ctx& C) {
    const int nmt = ((const int*)(C.ws + WS_META))[0];
    pg8::Gemm g{(const bf16_t*)(C.ws + WS_ACT), (const bf16_t*)(C.ws + WS_WDN), D, D, D, nullptr};
    { PG8_LAS int* te = (PG8_LAS int*)(LDS3(C) + 131072); const int* tg = (const int*)(C.ws + WS_TILEEXP); for (int i = C.tid; i < nmt; i += NTHREADS) te[i] = tg[i]; __syncthreads(); }
    pg8::MoeOrder S; S.b.init(nmt, 4, C.nblk, C.blk); S.tileexp = (const PG8_LAS int*)(LDS3(C) + 131072); S.nN = 4;
    pg8::EpiDown E{(bf16_t*)(C.ws + WS_SLOTS), C.in[29], (const float*)(C.ws + WS_ROWW)};
    pg8::gemm_phase<pg8::EpiDown, pg8::MoeOrder, false>(LDS3(C), g, S, E, C.wave);
}


#define XB_TMO      128
#define XB_XCNT(j)  (256  + 64 * (j))
#define XB_XSUB(j)  (1280 + 64 * (j))
#define XB_XGEN(j)  (2304 + 64 * (j))
#define XB_TOP      3328
#define XB_TOPGEN   3392
#define XCD_BAR_WORDS 3456
#define XB_SPIN_CAP (1u << 18)
#define XLAS __attribute__((address_space(3)))
__device__ __forceinline__ unsigned xb_ld(unsigned* p)              { return __hip_atomic_load(p, __ATOMIC_RELAXED, __HIP_MEMORY_SCOPE_AGENT); }
__device__ __forceinline__ unsigned xb_add(unsigned* p, unsigned v) { return __hip_atomic_fetch_add(p, v, __ATOMIC_RELAXED, __HIP_MEMORY_SCOPE_AGENT); }
__device__ __forceinline__ unsigned xb_xcc_id() { return (unsigned)__builtin_amdgcn_s_getreg((3 << 11) | 20) & 0xFu; }
#define XB_SPIN(cond, bar) do { unsigned _sp = 0; while (cond) { __builtin_amdgcn_s_sleep(1); \
    if ((++_sp & 255u) == 0u) { if (xb_ld(&(bar)[XB_TMO])) break; if (_sp > XB_SPIN_CAP) { atomicAdd(&(bar)[XB_TMO], 1u); break; } } } } while (0)
struct XcdBarrier { unsigned* bar; unsigned x; volatile XLAS unsigned* st; };
__device__ __forceinline__ XcdBarrier xcd_barrier_post(unsigned* bar, volatile XLAS unsigned* st, bool leader) {
    XcdBarrier b; b.bar = bar; b.x = xb_xcc_id(); b.st = st;
    if (leader) (void)xb_add(&bar[XB_XCNT(b.x)], 1u);
    return b;
}
__device__ __forceinline__ void xcd_barrier_complete(unsigned* bar, unsigned x, unsigned& nloc, unsigned& nx) {
    const unsigned G = gridDim.x * gridDim.y * gridDim.z;
    unsigned sum, cnt, mine, sp = 0u;
    for (;;) {
        sum = 0u; cnt = 0u; mine = 0u;
#pragma unroll
        for (unsigned j = 0; j < 16; ++j) { const unsigned c = xb_ld(&bar[XB_XCNT(j)]); sum += c; cnt += (c > 0u) ? 1u : 0u; mine = (j == x) ? c : mine; }
        if (sum == G) break;
        __builtin_amdgcn_s_sleep(1);
        if ((++sp & 255u) == 0u) { if (xb_ld(&bar[XB_TMO])) break; if (sp > XB_SPIN_CAP) { atomicAdd(&bar[XB_TMO], 1u); break; } }
    }
    nloc = mine > 0u ? mine : 1u; nx = cnt > 0u ? cnt : 1u;
}
__device__ __forceinline__ void xcd_barrier(const XcdBarrier& b, int wave_) {
    asm volatile("s_waitcnt vmcnt(0)" ::: "memory");
    __syncthreads();
    if (wave_ == 0 && lane_id() == 0) {
        unsigned* bar = b.bar;
        __builtin_amdgcn_s_waitcnt(0);
        unsigned nloc = b.st[0], nx = b.st[1];
        if (nloc == 0u) { xcd_barrier_complete(bar, b.x, nloc, nx); b.st[0] = nloc; b.st[1] = nx; }
        const unsigned old = xb_add(&bar[XB_XSUB(b.x)], 1u);
        const unsigned gen = old / nloc;
        if (old + 1u == (gen + 1u) * nloc) {
            __builtin_amdgcn_fence(__ATOMIC_RELEASE, "agent");
            asm volatile("s_waitcnt vmcnt(0)" ::: "memory");
            const unsigned og = xb_add(&bar[XB_TOP], 1u);
            const unsigned tg = og / nx;
            if (og + 1u == (tg + 1u) * nx) xb_add(&bar[XB_TOPGEN], 1u);
            else XB_SPIN(xb_ld(&bar[XB_TOPGEN]) == tg, bar);
            __builtin_amdgcn_fence(__ATOMIC_ACQUIRE, "agent");
            xb_add(&bar[XB_XGEN(b.x)], 1u);
            asm volatile("s_waitcnt vmcnt(0)" ::: "memory");
        } else {
            XB_SPIN(xb_ld(&bar[XB_XGEN(b.x)]) == gen, bar);
            __builtin_amdgcn_fence(__ATOMIC_ACQUIRE, "agent");
            asm volatile("s_waitcnt vmcnt(0)" ::: "memory");
        }
    }
    __syncthreads();
}

constexpr int NPHASES = 13;
}

__global__ void __launch_bounds__(NTHREADS, 2) fwd_kernel(Params p) {
    extern __shared__ __attribute__((aligned(16))) unsigned char lds[];
    cg::grid_group grid = cg::this_grid();
    Ctx C;
#pragma unroll
    for (int i = 0; i < 31; ++i) C.in[i] = p.in[i];
    C.out = p.out; C.ws = p.ws; C.lds = lds;
    const int wave_s = __builtin_amdgcn_readfirstlane(threadIdx.x >> 6);
    C.lane = lane_id(); C.wave = wave_s; C.tid = wave_s * 64 + C.lane;
    C.blk = blockIdx.x; C.nblk = gridDim.x; C.gw = C.blk * NWAVES + C.wave; C.ngw = C.nblk * NWAVES;
    const int lo = p.ph_lo, hi = p.ph_hi;
    volatile XLAS unsigned* misc = (volatile XLAS unsigned*)((XLAS unsigned char*)lds + (LDS_BYTES - 64));
    if (C.tid < 16) misc[C.tid] = 0u;
    __syncthreads();
    const XcdBarrier xbar = xcd_barrier_post((unsigned*)(p.ws + WS_CTL), misc, C.tid == 0);
#define GSYNC(k) do { xcd_barrier(xbar, wave_s); } while (0)
    if (lo < 0) grid.sync();
#ifndef PHMASK
#define PHMASK 0xffff
#endif
#ifndef REPMASK
#define REPMASK 0
#endif
#ifndef PROBE_PHASE
#define PROBE_PHASE (-1)
#endif
    unsigned long long tp0 = 0, tp1 = 0;
#define PH(k, body) do { if ((PHMASK >> (k)) & 1) { if (lo <= (k) && (k) < hi) { if ((k) == PROBE_PHASE) tp0 = __builtin_amdgcn_s_memrealtime(); _Pragma("unroll 1") for (int rep_ = (REPMASK >> (k)) & 1; rep_ >= 0; --rep_) { { C.lane = fresh_lane(); C.wave = wave_s; C.tid = wave_s * 64 + C.lane; C.gw = C.blk * NWAVES + C.wave; } body; if (rep_ > 0 || (k) + 1 < hi) GSYNC(k); } if ((k) == PROBE_PHASE) tp1 = __builtin_amdgcn_s_memrealtime(); } } } while (0)
#ifdef SYNCPROBE
    for (int i = 0; i < 20; ++i) GSYNC(1);
#endif
    PH(0, { phase_mod(C); phase_filters(C); });
    PH(1, { phase_weights(C); __syncthreads(); phase_norm1(C); });
#ifndef FASTMASK
#define FASTMASK 0xffff
#endif
#define FAST(k) ((FASTMASK >> (k)) & 1)
    PH(2, phase_inproj_fast(C));
#if XVAR == 1 || XVAR == 2
    PH(13, phase_probe_x(C));
#endif
    PH(3, phase_hy_pre_fast(C));
    PH(4, { phase_toeplitz(C); phase_attn_fast(C); });
    PH(5, phase_hy_post(C));
    PH(6, phase_cat_fast(C));
    PH(7, phase_mix_fast(C));
    PH(8, phase_route(C));
    PH(9, phase_rowlist(C));
    PH(10, phase_gateup_fast(C));
    PH(11, phase_down_fast(C));
    PH(12, phase_final(C));
#undef PH
    if (PROBE_PHASE >= 0 && C.blk == 0) { const unsigned long long te = __builtin_amdgcn_s_memrealtime(), span = 4ull * (tp1 - tp0); while (__builtin_amdgcn_s_memrealtime() - te < span) __builtin_amdgcn_s_sleep(8); }
}

extern "C" void kernel_launch(void* const* d_in, const int* in_sizes, int n_in, void* d_out, int out_size, void* d_ws, size_t ws_size, hipStream_t stream) {
    static int grid = 0;
    if (grid == 0) {
        if (n_in != 31 || ws_size < WS_END) { fprintf(stderr, "kernel_launch: unexpected n_in %d or ws_size %zu\n", n_in, ws_size); grid = -1; return; }
        int dev = 0, cus = 0, per_cu = 0;
        hipGetDevice(&dev); hipDeviceGetAttribute(&cus, hipDeviceAttributeMultiprocessorCount, dev);
        hipFuncSetAttribute((const void*)fwd_kernel, hipFuncAttributeMaxDynamicSharedMemorySize, LDS_BYTES);
        hipOccupancyMaxActiveBlocksPerMultiprocessor(&per_cu, (const void*)fwd_kernel, NTHREADS, LDS_BYTES);
        if (per_cu < 1) { fprintf(stderr, "kernel_launch: occupancy query says %d blocks/CU\n", per_cu); per_cu = 1; }
        (void)hipGetLastError();
        grid = cus * 1;
        fprintf(stderr, "kernel_launch: cus %d per_cu %d grid %d\n", cus, per_cu, grid);
    }
    if (grid < 0) return;
    if (hipMemsetAsync((char*)d_ws + WS_CTL, 0, 65536, stream) != hipSuccess) { fprintf(stderr, "kernel_launch: memset failed\n"); return; }
    Params p{};
    for (int i = 0; i < 31; ++i) p.in[i] = (const float*)d_in[i];
    p.out = (float*)d_out; p.ws = (unsigned char*)d_ws; p.ph_lo = 0; p.ph_hi = NPHASES + (XVAR ? 1 : 0);
    void* args[] = {&p};
    hipError_t e = hipLaunchCooperativeKernel((const void*)fwd_kernel, dim3(grid), dim3(NTHREADS), args, LDS_BYTES, stream);
    if (e != hipSuccess) fprintf(stderr, "cooperative launch failed: %s (grid %d)\n", hipGetErrorString(e), grid);
}
```

```cpp
#include <hip/hip_runtime.h>
#include <hip/hip_cooperative_groups.h>
#include <cstdio>
#include <cstdint>
namespace cg = cooperative_groups;

namespace {
typedef unsigned short bf16_t;
typedef short bf16x8 __attribute__((ext_vector_type(8)));
typedef short s16x4 __attribute__((ext_vector_type(4)));
typedef float f32x4 __attribute__((ext_vector_type(4)));
typedef float f32x16 __attribute__((ext_vector_type(16)));
typedef unsigned u32x4 __attribute__((ext_vector_type(4)));
typedef unsigned u32x2 __attribute__((ext_vector_type(2)));

constexpr int D = 1024, NB = 16, SEQ = 2048, T = NB * SEQ, HW = 512, INC = 5120, NE = 32, FHID = 64;
constexpr int QOFF = 1536, KOFF = 2048, VOFF = 2560, GOFF = 3072;
constexpr int NTHREADS = 512, NWAVES = 8;
constexpr float EPS = 1e-5f;
constexpr float LOG2E = 1.4426950408889634f;
constexpr float QSCALE = 0.125f * 1.4426950408889634f;
constexpr size_t MiB = 1u << 20;
constexpr size_t WS_CTL = 0;
constexpr size_t WS_MOD = 1 * MiB;
constexpr size_t WS_META = 1 * MiB + 512 * 1024;
constexpr size_t WS_BLKCNT = WS_META + 4096;
constexpr size_t WS_TILEEXP = WS_BLKCNT + 256 * 32 * 4;
constexpr size_t WS_LOGITS = 2 * MiB;
constexpr size_t WS_TOPE = 6 * MiB;
constexpr size_t WS_TOPW = 6 * MiB + 512 * 1024;
constexpr size_t WS_ROWPAIR = 7 * MiB;
constexpr size_t WS_ROWW = 7 * MiB + 576 * 1024;
constexpr size_t WS_KFILT = 8 * MiB;
constexpr size_t WS_U = 16 * MiB;
constexpr size_t WS_ACT = WS_U;
constexpr size_t WS_H = 336 * MiB;
constexpr size_t WS_R1 = 400 * MiB;
constexpr size_t WS_YCAT = WS_R1;
constexpr size_t WS_MERGED = WS_R1 + 64 * MiB;
constexpr size_t WS_UT = WS_R1 + 64 * MiB;
constexpr size_t WS_VP = WS_R1 + 128 * MiB;
constexpr size_t WS_X0C = WS_R1 + 160 * MiB;
constexpr size_t WS_VT = WS_R1 + 192 * MiB;
constexpr size_t WS_H2LO = WS_R1 + 224 * MiB;
constexpr size_t WS_SLOTS = WS_R1;
constexpr size_t WS_WIN = 688 * MiB;
constexpr size_t WS_WCAT = 698 * MiB;
constexpr size_t WS_WMIX = 700 * MiB;
constexpr size_t WS_WGU = 702 * MiB;
constexpr size_t WS_WDN = 830 * MiB;
constexpr size_t WS_WRT = 894 * MiB;
constexpr size_t WS_KFC = 896 * MiB;
constexpr size_t WS_X1 = 904 * MiB;
constexpr size_t WS_END = 968 * MiB;
constexpr size_t WS_YT = WS_R1 + 192 * MiB;
constexpr int MAXROWS = 4 * T + NE * 256;
constexpr int LDS_BYTES = 163840;

struct Params { const float* in[31]; float* out; unsigned char* ws; int ph_lo, ph_hi; };

__device__ __forceinline__ unsigned f2bf(float f) { unsigned u = __float_as_uint(f); return (u + 0x7fffu + ((u >> 16) & 1u)) >> 16; }
__device__ __forceinline__ unsigned pk2(float lo, float hi) { return f2bf(lo) | (f2bf(hi) << 16); }
__device__ __forceinline__ float bf2f(unsigned h) { return __uint_as_float(h << 16); }
__device__ __forceinline__ float bflo(unsigned w) { return __uint_as_float(w << 16); }
__device__ __forceinline__ float bfhi(unsigned w) { return __uint_as_float(w & 0xffff0000u); }
__device__ __forceinline__ float wave_sum(float v) {
#pragma unroll
    for (int o = 1; o < 64; o <<= 1) v += __shfl_xor(v, o);
    return v;
}
__device__ __forceinline__ float sigmoidf_(float x) { return 1.0f / (1.0f + __expf(-x)); }
typedef float f32x2_t __attribute__((ext_vector_type(2))); typedef __bf16 bf16x2_t __attribute__((ext_vector_type(2)));
typedef int v8i_t __attribute__((ext_vector_type(8)));
typedef int v4i_t __attribute__((ext_vector_type(4)));
__device__ __forceinline__ unsigned pk4_fp8(float a, float b, float c, float d) {
    a = fminf(fmaxf(a, -448.f), 448.f); b = fminf(fmaxf(b, -448.f), 448.f); c = fminf(fmaxf(c, -448.f), 448.f); d = fminf(fmaxf(d, -448.f), 448.f);
    int w = 0; w = __builtin_amdgcn_cvt_pk_fp8_f32(a, b, w, false); w = __builtin_amdgcn_cvt_pk_fp8_f32(c, d, w, true); return (unsigned)w; }
__device__ __forceinline__ unsigned pk4_fp8_nc(float a, float b, float c, float d) { int w = 0; w = __builtin_amdgcn_cvt_pk_fp8_f32(a, b, w, false); w = __builtin_amdgcn_cvt_pk_fp8_f32(c, d, w, true); return (unsigned)w; }
constexpr float F8S_H = 8.0f, F8S_W = 32.0f, F8S_ACT = 4.0f, F8S_SLOT = 32.0f;
__device__ __forceinline__ unsigned cvtpk(float lo, float hi) { f32x2_t v = {lo, hi}; bf16x2_t b = __builtin_convertvector(v, bf16x2_t); return __builtin_bit_cast(unsigned, b); }
__device__ __forceinline__ int crow(int r, int hi) { return (r & 3) + 8 * (r >> 2) + 4 * hi; }
__device__ __forceinline__ int lane_id() { return (int)__builtin_amdgcn_mbcnt_hi(~0u, __builtin_amdgcn_mbcnt_lo(~0u, 0u)); }
__device__ __forceinline__ int fresh_lane() { int l = lane_id(); asm volatile("" : "+v"(l)); return l; }

struct Ctx {
    const float* in[31]; float* out; unsigned char* ws;
    int tid, lane, wave, gw, ngw, nblk, blk;
    unsigned char* lds;
};

struct WItem { const float* src; bf16_t* dst; int N; int sk; };
__device__ __forceinline__ WItem witem(const Ctx& C, int it) {
    constexpr int I_IN = (D / 64) * (INC / 64), I_HY = (HW / 64) * (D / 64), I_MIX = (D / 64) * (D / 64), I_GU1 = (D / 64) * (2 * D / 64), I_DN1 = (D / 64) * (D / 64);
    const float* W; int N, k0, n0, kd, nd, sk = -1; bf16_t* WT;
    int r = it;
    if (r < NE * I_GU1) { const int e = r / I_GU1, q = r % I_GU1; const int nb = 2 * D / 64; n0 = 64 * (q % nb); k0 = 64 * (q / nb);
        const int s = n0 / 1024, rem = n0 % 1024, j = rem / 128, i0 = rem % 128; nd = 256 * j + 128 * s + i0; kd = k0; N = 2 * D;
        W = C.in[26] + (size_t)e * D * 2 * D; WT = (bf16_t*)(C.ws + WS_WGU) + (size_t)e * 2 * D * D; sk = -2 - e; }
    else if ((r -= NE * I_GU1) < NE * I_DN1) { const int e = r / I_DN1, q = r % I_DN1; const int nb = D / 64; n0 = 64 * (q % nb); k0 = 64 * (q / nb); nd = n0; kd = k0; N = D;
        W = C.in[28] + (size_t)e * D * D; WT = (bf16_t*)(C.ws + WS_WDN) + (size_t)e * D * D; sk = -2 - e - NE; }
    else if ((r -= NE * I_DN1) < I_IN) { const int nb = INC / 64; n0 = 64 * (r % nb); k0 = 64 * (r / nb); nd = n0; kd = k0; N = INC; W = C.in[5]; WT = (bf16_t*)(C.ws + WS_WIN);
        if (n0 >= GOFF) { const int rel = n0 - GOFF, sg_ = rel / 1024, rem = rel % 1024; nd = GOFF + 256 * (rem / 128) + 128 * sg_ + (rem % 128); } }
    else if ((r -= I_IN) < I_HY) { const int nb = D / 64; n0 = 64 * (r % nb); k0 = 64 * (r / nb); nd = n0; kd = k0; N = D; W = C.in[20]; WT = (bf16_t*)(C.ws + WS_WCAT); }
    else if ((r -= I_HY) < I_HY) { const int nb = D / 64; n0 = 64 * (r % nb); k0 = 64 * (r / nb); nd = n0; kd = 512 + k0; N = D; W = C.in[21]; WT = (bf16_t*)(C.ws + WS_WCAT); sk = k0; }
    else { r -= I_HY; const int nb = D / 64; n0 = 64 * (r % nb); k0 = 64 * (r / nb); nd = n0; kd = k0; N = D; W = C.in[22]; WT = (bf16_t*)(C.ws + WS_WMIX); }
    WItem w; w.N = N; w.sk = sk; w.src = W + (size_t)(k0 + (C.lane >> 4)) * N + n0 + 4 * (C.lane & 15); w.dst = WT + (size_t)(nd + (C.lane >> 3)) * D + kd + 8 * (C.lane & 7);
    if (sk <= -2) {
        const int e = (-2 - sk) % NE; const bool dn = (-2 - sk) >= NE; char* base = (char*)(C.ws + (dn ? WS_WDN : WS_WGU)) + (size_t)e * (dn ? D : 2 * D) * D;
        w.dst = (bf16_t*)(base + (size_t)(nd + (C.lane >> 3)) * D + kd + 8 * (C.lane & 7)); w.sk = -2; }
    return w;
}
constexpr int W_NITEMS = (D / 64) * (INC / 64) + 2 * (HW / 64) * (D / 64) + (D / 64) * (D / 64) + NE * (D / 64) * (2 * D / 64) + NE * (D / 64) * (D / 64);
constexpr int W_GU_Q = 8 * (D / 64) * (2 * D / 64);
constexpr int W_DN_LO = NE * (D / 64) * (2 * D / 64), W_DN_N = 32 * (D / 64) * (D / 64);
__device__ __forceinline__ void phase_weights(Ctx& C, const int v0, const int vstride, const int nv, const int skip0, const int remap_lo, const int remap_add, const bool router) {
    float* scr = (float*)(C.lds + C.wave * 16640);
    const int lane = C.lane;
    int it = v0;
    f32x4 v[16], vn[16];
    WItem cur;
#define WREMAP(v_) ((v_) + skip0 < remap_lo ? (v_) + skip0 : (v_) + skip0 + remap_add)
    if (it < nv) { cur = witem(C, WREMAP(it));
#pragma unroll
        for (int i = 0; i < 16; ++i) v[i] = __builtin_nontemporal_load((const f32x4*)(cur.src + (size_t)(4 * i) * cur.N)); }
    for (; it < nv; it += vstride) {
        const bool more = it + vstride < nv; WItem nx = cur;
        if (more) { nx = witem(C, WREMAP(it + vstride));
#pragma unroll
            for (int i = 0; i < 16; ++i) vn[i] = __builtin_nontemporal_load((const f32x4*)(nx.src + (size_t)(4 * i) * nx.N)); }
        if (cur.sk >= 0) {
#pragma unroll
            for (int i = 0; i < 16; ++i) v[i] = v[i] * (0.8f * C.in[19][(cur.sk + 4 * i + (lane >> 4)) & 127]); }
#pragma unroll
        for (int i = 0; i < 16; ++i) { float* d = scr + (4 * i + (lane >> 4)) * 65 + 4 * (lane & 15); d[0] = v[i].x; d[1] = v[i].y; d[2] = v[i].z; d[3] = v[i].w; }
        __builtin_amdgcn_s_waitcnt(0xc07f); asm volatile("" ::: "memory");
        const int c = lane & 7;
        if (cur.sk == -2) {
#pragma unroll
            for (int j = 0; j < 8; ++j) { const int n = (lane >> 3) + 8 * j; const float* s = scr + (8 * c) * 65 + n;
                u32x2 o; o.x = pk4_fp8(F8S_W * s[0 * 65], F8S_W * s[1 * 65], F8S_W * s[2 * 65], F8S_W * s[3 * 65]); o.y = pk4_fp8(F8S_W * s[4 * 65], F8S_W * s[5 * 65], F8S_W * s[6 * 65], F8S_W * s[7 * 65]);
                __builtin_nontemporal_store(o, (u32x2*)((char*)cur.dst + (size_t)(8 * j) * D)); }
        } else {
#pragma unroll
        for (int j = 0; j < 8; ++j) { const int n = (lane >> 3) + 8 * j; const float* s = scr + (8 * c) * 65 + n;
            u32x4 o; o.x = pk2(s[0 * 65], s[1 * 65]); o.y = pk2(s[2 * 65], s[3 * 65]); o.z = pk2(s[4 * 65], s[5 * 65]); o.w = pk2(s[6 * 65], s[7 * 65]);
            __builtin_nontemporal_store(o, (u32x4*)(cur.dst + (size_t)(8 * j) * D)); } }
        __builtin_amdgcn_s_waitcnt(0xc07f); asm volatile("" ::: "memory");
        if (more) {
#pragma unroll
            for (int i = 0; i < 16; ++i) v[i] = vn[i]; }
        cur = nx;
    }
#undef WREMAP
    bf16_t* wrt = (bf16_t*)(C.ws + WS_WRT);
    if (router) for (int i = C.blk * NTHREADS + C.tid; i < NE * D; i += C.nblk * NTHREADS) {
        const int e = i / D, k = i % D; const float w = C.in[24][(size_t)k * NE + e];
        const unsigned hi = f2bf(w); const float lo = w - bf2f(hi);
        wrt[(size_t)e * 2048 + k] = (bf16_t)hi; wrt[(size_t)e * 2048 + 1024 + k] = (bf16_t)f2bf(lo);
    }
}
__device__ __forceinline__ void phase_weights_chunks(Ctx& C, unsigned* ctr, const int nv, const int base) {
    int* sh = (int*)(C.lds + LDS_BYTES - 128);
    for (;;) {
        __syncthreads();
        if (C.tid == 0) *sh = (int)__hip_atomic_fetch_add(ctr, 1u, __ATOMIC_RELAXED, __HIP_MEMORY_SCOPE_AGENT);
        __syncthreads();
        const int chunk = __builtin_amdgcn_readfirstlane(*sh);
        if (chunk * 16 >= nv) break;
        const int lo = chunk * 16, hi = lo + 16 < nv ? lo + 16 : nv;
        phase_weights(C, lo + C.wave, NWAVES, hi, base, 0x7fffffff, 0, false);
    }
}

__device__ __forceinline__ void phase_mod(Ctx& C) {
    float* sc = (float*)C.lds;
    float* part = sc + 16 * 1024;
    float* mod = (float*)(C.ws + WS_MOD);
    for (int vb = C.blk; vb < 256; vb += C.nblk) {
        const int j0 = vb * 24;
        __syncthreads();
        for (int i = C.tid; i < 16 * D; i += NTHREADS) { const float c = C.in[1][i]; sc[i] = c / (1.0f + expf(-c)); }
        __syncthreads();
        if (C.tid < 504) {
            const int jj = C.tid % 24, isub = C.tid / 24;
            float acc[16];
#pragma unroll
            for (int b = 0; b < 16; ++b) acc[b] = 0.f;
            const float* w = C.in[2] + j0 + jj;
            float wv[49];
#pragma unroll
            for (int q = 0; q < 49; ++q) { const int i = isub + 21 * q; wv[q] = (i < D) ? w[(size_t)i * 6 * D] : 0.f; }
#pragma unroll
            for (int q = 0; q < 49; ++q) { const int i = (isub + 21 * q < D) ? isub + 21 * q : 0;
#pragma unroll
                for (int b = 0; b < 16; ++b) acc[b] = fmaf(sc[b * D + i], wv[q], acc[b]);
                __builtin_amdgcn_sched_barrier(0); }
#pragma unroll
            for (int b = 0; b < 16; ++b) part[(isub * 16 + b) * 24 + jj] = acc[b];
        }
        __syncthreads();
        if (C.tid < 384) { const int b = C.tid / 24, jj = C.tid % 24; float a = C.in[3][j0 + jj];
            for (int q = 0; q < 21; ++q) a += part[(q * 16 + b) * 24 + jj];
            mod[b * 6 * D + j0 + jj] = a;
            { const int j = j0 + jj; if (j >= 4 * D && j < 5 * D) mod[16 * 6 * D + b * D + (j - 4 * D)] = C.in[23][j - 4 * D] * (1.0f + a); } }
    }
    __syncthreads();
}

__device__ __forceinline__ void phase_filters(Ctx& C) {
    float* sh = (float*)C.lds;
    float* h3t = sh + 8 * 160;
    float* lw1 = h3t + 512; float* lw2 = lw1 + 17 * FHID; float* lw3 = lw2 + FHID * FHID; float* lb = lw3 + FHID * FHID;
    float* kfc = (float*)(C.ws + WS_KFC);
    const float* w4 = C.in[15];
    const int pl = C.tid >> 6, j = C.tid & 63;
    float* z = sh + pl * 160; float* ha = z + 32; float* hb = ha + 64;
    __syncthreads();
    for (int i = C.tid; i < 17 * FHID; i += NTHREADS) lw1[i] = C.in[9][i];
    for (int i = C.tid; i < FHID * FHID; i += NTHREADS) { lw2[i] = C.in[11][i]; lw3[i] = C.in[13][i]; }
    if (C.tid < 64) { lb[C.tid] = C.in[10][C.tid]; lb[64 + C.tid] = C.in[12][C.tid]; lb[128 + C.tid] = C.in[14][C.tid]; lb[192 + C.tid] = C.in[16][C.tid]; }
    for (int vb = C.blk; vb < SEQ / 8; vb += C.nblk) {
        const int pos = vb * 8 + pl;
        const float tt = (float)pos / (float)(SEQ - 1);
        const float w = 6.283185307179586f * (float)pos / (float)SEQ;
        __syncthreads();
        if (j < 17) {
            float v;
            if (j == 0) v = tt;
            else { const int i = (j - 1) & 7; const float fr = 1e-4f + (float)i * ((7.0f - 1e-4f) / 7.0f); v = (j <= 8) ? cosf(fr * w) : -sinf(fr * w); }
            z[j] = v;
        }
        __syncthreads();
        const float fqj = lb[192 + j];
        { float a = lb[j];
#pragma unroll
          for (int i = 0; i < 17; ++i) a = fmaf(z[i], lw1[i * FHID + j], a); ha[j] = sinf(fqj * a); }
        __syncthreads();
        { float a = lb[64 + j];
#pragma unroll 16
          for (int i = 0; i < FHID; ++i) a = fmaf(ha[i], lw2[i * FHID + j], a); hb[j] = sinf(fqj * a); }
        __syncthreads();
        { float a = lb[128 + j];
#pragma unroll 16
          for (int i = 0; i < FHID; ++i) a = fmaf(hb[i], lw3[i * FHID + j], a); h3t[j * 8 + pl] = sinf(fqj * a); }
        __syncthreads();
        float af[8], ab[8];
#pragma unroll
        for (int p = 0; p < 8; ++p) { af[p] = 0.f; ab[p] = 0.f; }
#pragma unroll 1
        for (int ih = 0; ih < FHID; ih += 32) {
            float wa[32], wb[32];
#pragma unroll
            for (int i = 0; i < 32; ++i) { wa[i] = w4[(ih + i) * 2 * HW + C.tid]; wb[i] = w4[(ih + i) * 2 * HW + HW + C.tid]; }
#pragma unroll
            for (int i = 0; i < 32; ++i) {
                const f32x4 h0 = *(const f32x4*)(h3t + (ih + i) * 8), h1 = *(const f32x4*)(h3t + (ih + i) * 8 + 4);
#pragma unroll
                for (int p = 0; p < 4; ++p) { af[p] = fmaf(h0[p], wa[i], af[p]); af[4 + p] = fmaf(h1[p], wa[i], af[4 + p]); ab[p] = fmaf(h0[p], wb[i], ab[p]); ab[4 + p] = fmaf(h1[p], wb[i], ab[4 + p]); } } }
        const float min_decay = logf(1e-2f) / 1.5f, max_decay = logf(1e-2f) / 0.3f;
        const int c = C.tid, pos0 = vb * 8;
        const float adelta = fabsf(min_decay + (float)c * ((max_decay - min_decay) / 511.0f));
#pragma unroll
        for (int p = 0; p < 8; ++p) { const float dec = expf(-((float)(pos0 + p) / (float)(SEQ - 1)) * adelta); af[p] *= dec; ab[p] *= dec; }
        float* dst = kfc + (size_t)c * 4096 + 2048 + pos0;
        *(f32x4*)dst = (f32x4){af[0], af[1], af[2], af[3]}; *(f32x4*)(dst + 4) = (f32x4){af[4], af[5], af[6], af[7]};
        float* dsb = kfc + (size_t)c * 4096 + 2048 - pos0;
#pragma unroll
        for (int p = 0; p < 8; ++p) if (pos0 + p >= 1) dsb[-p] = ab[p];
    }
    __syncthreads();
}

__device__ __forceinline__ void phase_norm1(Ctx& C) {
    const float* mod = (const float*)(C.ws + WS_MOD); bf16_t* h = (bf16_t*)(C.ws + WS_H);
    const float* g = C.in[4];
    constexpr int NR = 4;
    for (int row = C.gw; row < T; row += NR * C.ngw) {
        f32x4 v[NR][4]; float s[NR];
#pragma unroll
        for (int q = 0; q < NR; ++q) { const int rr = row + q * C.ngw < T ? row + q * C.ngw : row; const f32x4* xr = (const f32x4*)(C.in[0] + (size_t)rr * D) + C.lane;
#pragma unroll
            for (int j = 0; j < 4; ++j) v[q][j] = __builtin_nontemporal_load(xr + 64 * j); }
#pragma unroll
        for (int q = 0; q < NR; ++q) { s[q] = 0.f;
#pragma unroll
            for (int j = 0; j < 4; ++j) s[q] += (v[q][j].x * v[q][j].x + v[q][j].y * v[q][j].y) + (v[q][j].z * v[q][j].z + v[q][j].w * v[q][j].w); }
#pragma unroll
        for (int q = 0; q < NR; ++q) {
            const int rr = row + q * C.ngw;
            if (rr < T) {
                const float rs = 1.0f / sqrtf(wave_sum(s[q]) * (1.0f / D) + EPS);
                const int b = rr / SEQ; const float* sh = mod + (size_t)b * 6 * D; const float* sc = sh + D;
                u32x2* o = (u32x2*)(h + (size_t)rr * D) + C.lane;
#pragma unroll
                for (int j = 0; j < 4; ++j) { const int i0 = 4 * C.lane + 256 * j; const f32x4 x = v[q][j];
                    const f32x4 gg = *(const f32x4*)(g + i0), s1 = *(const f32x4*)(sc + i0), s0 = *(const f32x4*)(sh + i0);
                    f32x4 r; r.x = x.x * rs * gg.x * (1.f + s1.x) + s0.x; r.y = x.y * rs * gg.y * (1.f + s1.y) + s0.y;
                    r.z = x.z * rs * gg.z * (1.f + s1.z) + s0.z; r.w = x.w * rs * gg.w * (1.f + s1.w) + s0.w;
                    u32x2 w; w.x = pk2(r.x, r.y); w.y = pk2(r.z, r.w); o[64 * j] = w; }
            }
        }
    }
}

__device__ __forceinline__ void phase_final(Ctx& C) {
    const float* mod = (const float*)(C.ws + WS_MOD); const bf16_t* slots = (const bf16_t*)(C.ws + WS_SLOTS); const int* rowinv = (const int*)(C.ws + WS_TOPE);
    const bf16_t* x1 = (const bf16_t*)(C.ws + WS_X1);
    const float* g = C.in[30];
    for (int row = C.gw; row < T; row += C.ngw) {
        const int b = row / SEQ;
        f32x4* xr = (f32x4*)(C.out + (size_t)row * D) + C.lane;
        const float* g2 = mod + (size_t)b * 6 * D + 5 * D;
        f32x4 v[4]; float s = 0.f; const int4 rr4 = *(const int4*)(rowinv + (size_t)row * 4); const int rk[4] = {rr4.x, rr4.y, rr4.z, rr4.w};
#pragma unroll
        for (int j = 0; j < 4; ++j) { const int i0 = 4 * C.lane + 256 * j;
            f32x4 m = {0.f, 0.f, 0.f, 0.f};
#pragma unroll
            for (int k = 0; k < 4; ++k) { const unsigned w = __builtin_nontemporal_load((const unsigned*)((const char*)slots + (size_t)rk[k] * D + i0));
                const f32x2_t lo_ = __builtin_amdgcn_cvt_pk_f32_fp8(w, false), hi_ = __builtin_amdgcn_cvt_pk_f32_fp8(w, true);
                m.x += lo_.x; m.y += lo_.y; m.z += hi_.x; m.w += hi_.y; }
            m = m * (1.0f / F8S_SLOT);
            const f32x4 gg = *(const f32x4*)(g2 + i0);
            const u32x2 xw = __builtin_nontemporal_load((const u32x2*)(x1 + (size_t)row * D + i0));
            v[j].x = bflo(xw.x) + gg.x * m.x; v[j].y = bfhi(xw.x) + gg.y * m.y; v[j].z = bflo(xw.y) + gg.z * m.z; v[j].w = bfhi(xw.y) + gg.w * m.w;
            s += (v[j].x * v[j].x + v[j].y * v[j].y) + (v[j].z * v[j].z + v[j].w * v[j].w); }
        const float rstd = 1.0f / sqrtf(wave_sum(s) * (1.0f / D) + EPS);
#pragma unroll
        for (int j = 0; j < 4; ++j) { const int i0 = 4 * C.lane + 256 * j; const f32x4 gg = *(const f32x4*)(g + i0);
            f32x4 r; r.x = v[j].x * rstd * gg.x; r.y = v[j].y * rstd * gg.y; r.z = v[j].z * rstd * gg.z; r.w = v[j].w * rstd * gg.w; __builtin_nontemporal_store(r, xr + 64 * j); }
    }
}

namespace pg8 {
#define PG8_LAS __attribute__((address_space(3)))
constexpr int BM = 256, BK = 64, HALF = 128, HTB = HALF * BK * 2, STAGE_BYTES = 8 * HTB, NXCD = 8, WGM = 8;
__device__ __forceinline__ int lds_byte(int r, int c) { const int st = (r >> 4) * 2 + (c >> 5), rr = r & 15, cc = c & 31, ob = rr * 64 + cc * 2; return st * 1024 + (ob ^ (((ob >> 9) & 1) << 5)); }
__device__ __forceinline__ void stage_rc(int b, int& R, int& C) { const int st = b / 1024, sb = b % 1024, swz = sb ^ (((sb >> 9) & 1) << 5); R = (st >> 1) * 16 + swz / 64; C = (st & 1) * 32 + (swz % 64) / 2; }
__device__ __forceinline__ int perm32(int rho) { const int n = rho >> 4, i = rho & 15; return 8 * (i >> 2) + 4 * n + (i & 3); }
struct Unit { int pm, pn; };
struct Gemm { const bf16_t* A; const bf16_t* Bt; int lda, ldb, K; const int* rowidx; };
struct StaticOrder {
    int nM, nN, nwg, G, c;
    __device__ void init(int nM_, int nN_, int G_, int c_) { nM = nM_; nN = nN_; nwg = nM * nN; G = G_; c = c_; }
    __device__ bool next(int i, Unit& u) const {
        const long L = (long)i * G + c; if (L >= nwg) return false;
        int wgid = (int)L; { const int q = nwg / NXCD, r = nwg % NXCD, xcd = wgid % NXCD, off = wgid / NXCD; wgid = (xcd < r ? xcd * (q + 1) : r * (q + 1) + (xcd - r) * q) + off; }
        const int nig = WGM * nN, gid = wgid / nig, fm = gid * WGM, gsz = (nM - fm) < WGM ? (nM - fm) : WGM;
        u.pm = fm + ((wgid % nig) % gsz); u.pn = (wgid % nig) / gsz; return true;
    }
};
struct RowRunOrder {
    int nM, nN, G, c;
    __device__ bool next(int i, Unit& u) const { const int tot = nM * nN, per = (tot + G - 1) / G; const int L = c * per + i; if (i >= per || L >= tot) return false; u.pm = L / nN; u.pn = L % nN; return true; }
};
struct MoeOrder {
    StaticOrder b; const PG8_LAS int* tileexp; int nN;
    __device__ bool next(int i, Unit& u) const { if (!b.next(i, u)) return false; u.pn = tileexp[u.pm] * nN + u.pn; return true; }
};
__device__ __forceinline__ unsigned cvt_pk_bf16(float lo, float hi) { unsigned r; asm volatile("v_cvt_pk_bf16_f32 %0, %1, %2" : "=v"(r) : "v"(lo), "v"(hi)); return r; }

template <class Epi, class Sched, bool GATHER, bool MIDHOOK = false, bool FP8 = false>
__device__ __forceinline__ void gemm_phase(PG8_LAS unsigned char* lds, const Gemm g, const Sched& S, const Epi& E, const int wid_) {
    const int wid = wid_, lane = fresh_lane(), tid = wid * 64 + lane, wr = wid >> 2, wc = wid & 3, fr = lane & 15, fq = lane >> 4;
    const int K = g.K, nt = K / BK;
    int RA[2]; unsigned cA2[2], voffB[2];
#pragma unroll
    for (int i = 0; i < 2; ++i) { int R, C; stage_rc(tid * 16 + i * 8192, R, C); const int Rb = Epi::PERM ? ((R & ~31) + perm32(R & 31)) : R;
        RA[i] = R; cA2[i] = (unsigned)C * 2u; voffB[i] = (unsigned)(Rb * g.ldb + C) * 2u; }
    const unsigned lda2 = (unsigned)g.lda * 2u;
    const size_t kstep = (size_t)(BK * 2);
    const size_t hstep = (size_t)HALF * g.ldb * 2;
    const size_t tstep = 2 * hstep;
    const unsigned ldsw = (unsigned)wid * 1024u;
    const int aoff = lds_byte(wr * 64 + fr, fq * 8), boff = lds_byte(wc * 32 + fr, fq * 8);
#define PG8_SA(b, h) (((b) * 2 + (h)) * HTB)
#define PG8_SB(b, h) ((4 + (b) * 2 + (h)) * HTB)
#define PG8_STAGE(bufoff, gbase, voff) do { _Pragma("unroll") for (int _i = 0; _i < 2; ++_i) \
        __builtin_amdgcn_global_load_lds((const unsigned*)((const char*)(gbase) + (voff)[_i]), (PG8_LAS unsigned*)(lds + (bufoff) + ldsw + _i * 8192), 16, 0, 0); } while (0)
#define PG8_AOFFS(dst, u_) do { _Pragma("unroll") for (int _h = 0; _h < 2; ++_h) _Pragma("unroll") for (int _i = 0; _i < 2; ++_i) { \
        int _row = (u_).pm * BM + _h * HALF + RA[_i]; if (GATHER) { const int _p = g.rowidx[_row]; _row = _p >= 0 ? (_p >> 2) : 0; } \
        dst[_h][_i] = (unsigned)_row * lda2 + cA2[_i]; } } while (0)
      \
#define PG8_AOFFS_RAW(dst, u_) do { _Pragma("unroll") for (int _h = 0; _h < 2; ++_h) _Pragma("unroll") for (int _i = 0; _i < 2; ++_i) { \
        const int _row = (u_).pm * BM + _h * HALF + RA[_i]; dst[_h][_i] = GATHER ? (unsigned)g.rowidx[_row] : (unsigned)_row; } } while (0)
#define PG8_AOFFS_FIN(dst) do { _Pragma("unroll") for (int _h = 0; _h < 2; ++_h) _Pragma("unroll") for (int _i = 0; _i < 2; ++_i) { \
        int _row = (int)dst[_h][_i]; if (GATHER) _row = _row >= 0 ? (_row >> 2) : 0; dst[_h][_i] = (unsigned)_row * lda2 + cA2[_i]; } } while (0)
#define PG8_LDA(dst, b, h) do { _Pragma("unroll") for (int m = 0; m < 4; ++m) _Pragma("unroll") for (int k = 0; k < 2; ++k) dst[m][k] = *(const PG8_LAS bf16x8*)(lds + PG8_SA(b, h) + aoff + m * 2048 + k * 1024); } while (0)
#define PG8_LDB(dst, b, h) do { _Pragma("unroll") for (int n = 0; n < 2; ++n) _Pragma("unroll") for (int k = 0; k < 2; ++k) dst[n][k] = *(const PG8_LAS bf16x8*)(lds + PG8_SB(b, h) + boff + n * 2048 + k * 1024); } while (0)
#define PG8_CAT8(x, y) __builtin_shufflevector(__builtin_bit_cast(v4i_t, x), __builtin_bit_cast(v4i_t, y), 0, 1, 2, 3, 4, 5, 6, 7)
#define PG8_MMA(ai, bj, At, Bt) do { __builtin_amdgcn_s_setprio(1); _Pragma("unroll") for (int m = 0; m < 4; ++m) _Pragma("unroll") for (int n = 0; n < 2; ++n) { \
        if constexpr (FP8) { const v8i_t b8_ = PG8_CAT8(Bt[n][0], Bt[n][1]), a8_ = PG8_CAT8(At[m][0], At[m][1]); asm("v_mfma_f32_16x16x128_f8f6f4 %0, %1, %2, %0" : "+v"(acc[ai][bj][m][n]) : "v"(b8_), "v"(a8_)); }     \
        else { _Pragma("unroll") for (int k = 0; k < 2; ++k) acc[ai][bj][m][n] = __builtin_amdgcn_mfma_f32_16x16x32_bf16(Bt[n][k], At[m][k], acc[ai][bj][m][n], 0, 0, 0); } } __builtin_amdgcn_s_setprio(0); } while (0)
#define PG8_WAIT_V(n) asm volatile("s_waitcnt vmcnt(" #n ")" ::: "memory")
#define PG8_WAIT_L(n) asm volatile("s_waitcnt lgkmcnt(" #n ")" ::: "memory")
#define PG8_BAR __builtin_amdgcn_s_barrier()
#define PG8_SCHED __builtin_amdgcn_sched_barrier(0)
    Unit cur, nxt; int ui = 0;
    if (!S.next(0, cur)) return;
    f32x4 acc[2][2][4][2];
#pragma unroll
    for (int a = 0; a < 2; ++a)
#pragma unroll
        for (int b = 0; b < 2; ++b)
#pragma unroll
            for (int m = 0; m < 4; ++m)
#pragma unroll
                for (int n = 0; n < 2; ++n) acc[a][b][m][n] = (f32x4){0.f, 0.f, 0.f, 0.f};
    bf16x8 At[4][2], B0[2][2], B1[2][2];
    unsigned cv[2][2], nv[2][2];
    PG8_AOFFS(cv, cur);
    const char* const Ab = (const char*)g.A;
    const char* cB = (const char*)g.Bt + (size_t)cur.pn * tstep;
    PG8_STAGE(PG8_SB(0, 0), cB, voffB); PG8_STAGE(PG8_SB(0, 1), cB + hstep, voffB); PG8_STAGE(PG8_SA(0, 0), Ab, cv[0]); PG8_STAGE(PG8_SA(0, 1), Ab, cv[1]);
    if (wr == 1) PG8_BAR;
    PG8_WAIT_V(2); PG8_BAR;
    PG8_STAGE(PG8_SB(1, 0), cB + kstep, voffB); PG8_STAGE(PG8_SA(1, 0), Ab + kstep, cv[0]); PG8_STAGE(PG8_SB(1, 1), cB + hstep + kstep, voffB);
    PG8_WAIT_V(6); PG8_BAR;
    for (;;) {
        const bool has_next = S.next(ui + 1, nxt);
        if (has_next) { if constexpr (GATHER) { PG8_AOFFS_RAW(nv, nxt); } else { PG8_AOFFS(nv, nxt); } } else {
#pragma unroll
            for (int h = 0; h < 2; ++h)
#pragma unroll
                for (int i = 0; i < 2; ++i) nv[h][i] = cv[h][i]; }
        const char* nB = has_next ? (const char*)g.Bt + (size_t)nxt.pn * tstep : cB;
#define PG8_KSTEP(t) do { \
            const bool last = (t == nt - 2); \
            const char* a1 = Ab + (size_t)(t + 1) * kstep; \
            const char* a2 = last ? Ab : Ab + (size_t)(t + 2) * kstep; const char* b2 = last ? nB : cB + (size_t)(t + 2) * kstep; \
            const char* a3 = a2 + kstep; const char* b3 = b2 + kstep; \
            unsigned sv[2][2]; \
            if constexpr (GATHER) { \
                _Pragma("unroll") for (int h = 0; h < 2; ++h) _Pragma("unroll") for (int i = 0; i < 2; ++i) sv[h][i] = cv[h][i]; \
                if (last) { asm volatile("" : "+v"(nv[0][0]), "+v"(nv[0][1]), "+v"(nv[1][0]), "+v"(nv[1][1])); if (has_next) PG8_AOFFS_FIN(nv); _Pragma("unroll") for (int h = 0; h < 2; ++h) _Pragma("unroll") for (int i = 0; i < 2; ++i) sv[h][i] = nv[h][i]; } \
            } else { _Pragma("unroll") for (int h = 0; h < 2; ++h) _Pragma("unroll") for (int i = 0; i < 2; ++i) sv[h][i] = last ? nv[h][i] : cv[h][i]; } \
            PG8_LDB(B0, 0, 0); PG8_LDB(B1, 0, 1); PG8_SCHED; PG8_LDA(At, 0, 0); PG8_STAGE(PG8_SA(1, 1), a1, cv[1]); \
            PG8_WAIT_V(8); PG8_WAIT_L(0); PG8_BAR; PG8_MMA(0, 0, At, B0); PG8_MMA(0, 1, At, B1); PG8_BAR; PG8_SCHED; \
            PG8_LDA(At, 0, 1); PG8_STAGE(PG8_SB(0, 0), b2, voffB); PG8_STAGE(PG8_SB(0, 1), b2 + hstep, voffB); PG8_STAGE(PG8_SA(0, 0), a2, sv[0]); \
            PG8_WAIT_V(8); PG8_WAIT_L(0); PG8_BAR; PG8_MMA(1, 0, At, B0); PG8_MMA(1, 1, At, B1); PG8_BAR; PG8_SCHED; \
            PG8_LDB(B0, 1, 0); PG8_LDB(B1, 1, 1); PG8_SCHED; PG8_LDA(At, 1, 0); PG8_STAGE(PG8_SA(0, 1), a2, sv[1]); \
            PG8_WAIT_V(8); PG8_WAIT_L(0); PG8_BAR; PG8_MMA(0, 0, At, B0); PG8_MMA(0, 1, At, B1); PG8_BAR; PG8_SCHED; \
            PG8_LDA(At, 1, 1); PG8_STAGE(PG8_SB(1, 0), b3, voffB); PG8_STAGE(PG8_SB(1, 1), b3 + hstep, voffB); PG8_STAGE(PG8_SA(1, 0), a3, sv[0]); \
            PG8_WAIT_V(8); PG8_WAIT_L(0); PG8_BAR; PG8_MMA(1, 0, At, B0); PG8_MMA(1, 1, At, B1); PG8_BAR; PG8_SCHED; \
        } while (0)
        if constexpr (MIDHOOK) {
            for (int t = 0; t < nt / 2; t += 2) PG8_KSTEP(t);
            E.mid(acc, cur, wr, wc, fr, fq);
            for (int t = nt / 2; t < nt; t += 2) PG8_KSTEP(t);
        } else {
            for (int t = 0; t < nt; t += 2) PG8_KSTEP(t);
        }
#undef PG8_KSTEP
        if (wr == 0) PG8_BAR;
        if constexpr (FP8) asm volatile("s_nop 15\n\ts_nop 7" ::: "memory");
        E(acc, cur, wr, wc, fr, fq);
        if (!has_next) break;
#pragma unroll
        for (int a = 0; a < 2; ++a)
#pragma unroll
            for (int b = 0; b < 2; ++b)
#pragma unroll
                for (int m = 0; m < 4; ++m)
#pragma unroll
                    for (int n = 0; n < 2; ++n) acc[a][b][m][n] = (f32x4){0.f, 0.f, 0.f, 0.f};
        cur = nxt; cB = nB; ++ui;
#pragma unroll
        for (int h = 0; h < 2; ++h)
#pragma unroll
            for (int i = 0; i < 2; ++i) cv[h][i] = nv[h][i];
        if (wr == 1) PG8_BAR;
    }
    PG8_WAIT_V(0);
    PG8_BAR;
#undef PG8_SA
#undef PG8_SB
#undef PG8_STAGE
#undef PG8_AOFFS
#undef PG8_AOFFS_RAW
#undef PG8_AOFFS_FIN
#undef PG8_LDA
#undef PG8_LDB
#undef PG8_MMA
#undef PG8_CAT8
#undef PG8_WAIT_V
#undef PG8_WAIT_L
#undef PG8_BAR
#undef PG8_SCHED
}

__device__ __forceinline__ u32x4 pack8(const f32x4& v0, const f32x4& v1) { u32x4 w; w.x = cvt_pk_bf16(v0[0], v0[1]); w.y = cvt_pk_bf16(v0[2], v0[3]); w.z = cvt_pk_bf16(v1[0], v1[1]); w.w = cvt_pk_bf16(v1[2], v1[3]); return w; }
__device__ __forceinline__ void unpack8(const u32x4& w, f32x4& v0, f32x4& v1) { v0 = (f32x4){bflo(w.x), bfhi(w.x), bflo(w.y), bfhi(w.y)}; v1 = (f32x4){bflo(w.z), bfhi(w.z), bflo(w.w), bfhi(w.w)}; }
__device__ __forceinline__ float fsig(float x) { return __builtin_amdgcn_rcpf(1.0f + __builtin_amdgcn_exp2f(-LOG2E * x)); }

template <int MODE = 0> struct EpiInprojT {
    static constexpr bool PERM = true;
    bf16_t* U; const float* bias; int pn0;
    __device__ __forceinline__ void operator()(const f32x4 (&acc)[2][2][4][2], const Unit& u_, int wr, int wc, int fr, int fq) const {
        Unit u = u_; u.pn += pn0;
        if (MODE == 2) { _Pragma("unroll") for (int a_ = 0; a_ < 2; ++a_) _Pragma("unroll") for (int b_ = 0; b_ < 2; ++b_) _Pragma("unroll") for (int m_ = 0; m_ < 4; ++m_) _Pragma("unroll") for (int n_ = 0; n_ < 2; ++n_) asm volatile("" :: "v"(acc[a_][b_][m_][n_])); return; }
        const int row0 = u.pm * BM + wr * 64 + fr, col0 = u.pn * BM + wc * 32 + 8 * fq; const float qs = (u.pn == 6 || u.pn == 7) ? QSCALE : 1.0f;
        if (u.pn >= 12) {
            const int c0 = 128 * (u.pn - 12) + wc * 32 + 8 * fq;
            f32x4 ba[2], bb[2];
#pragma unroll
            for (int n = 0; n < 2; ++n) { ba[n] = *(const f32x4*)(bias + GOFF + c0 + 4 * n); bb[n] = *(const f32x4*)(bias + GOFF + D + c0 + 4 * n); }
#pragma unroll
            for (int ai = 0; ai < 2; ++ai)
#pragma unroll
                for (int m = 0; m < 4; ++m) { bf16_t* rowp = U + (size_t)(row0 + ai * HALF + m * 16) * INC + GOFF + c0; f32x4 rr[2], sb[2];
#pragma unroll
                    for (int n = 0; n < 2; ++n) { const f32x4 a = (acc[ai][0][m][n] + ba[n]) * (-LOG2E), b = (acc[ai][1][m][n] + bb[n]) * (-LOG2E);
                        f32x4 ea, eb, ra, rb;
#pragma unroll
                        for (int i = 0; i < 4; ++i) { ea[i] = fminf(__builtin_amdgcn_exp2f(a[i]), 1e18f); eb[i] = fminf(__builtin_amdgcn_exp2f(b[i]), 1e18f); }
                        const f32x4 da = ea + 1.0f, db = eb + 1.0f;
#pragma unroll
                        for (int i = 0; i < 4; ++i) { ra[i] = __builtin_amdgcn_rcpf(da[i]); rb[i] = __builtin_amdgcn_rcpf(db[i]); }
                        sb[n] = rb; rr[n] = db * ra; }
                    const u32x4 wr_ = pack8(rr[0], rr[1]), ws_ = pack8(sb[0], sb[1]);
                    if (MODE == 0) { *(u32x4*)rowp = wr_; *(u32x4*)(rowp + D) = ws_; } else asm volatile("" :: "v"(wr_), "v"(ws_)); }
            return;
        }
        const bool sig = false;
        f32x4 bv[2][2];
#pragma unroll
        for (int bj = 0; bj < 2; ++bj)
#pragma unroll
            for (int n = 0; n < 2; ++n) bv[bj][n] = *(const f32x4*)(bias + col0 + bj * HALF + 4 * n);
#pragma unroll
        for (int ai = 0; ai < 2; ++ai)
#pragma unroll
            for (int m = 0; m < 4; ++m) { bf16_t* rowp = U + (size_t)(row0 + ai * HALF + m * 16) * INC + col0;
#pragma unroll
                for (int bj = 0; bj < 2; ++bj) { f32x4 v0 = (acc[ai][bj][m][0] + bv[bj][0]) * qs, v1 = (acc[ai][bj][m][1] + bv[bj][1]) * qs;
                    if (sig) {
#pragma unroll
                        for (int i = 0; i < 4; ++i) { v0[i] = fsig(v0[i]); v1[i] = fsig(v1[i]); } }
                    const u32x4 w_ = pack8(v0, v1);
                    if (MODE == 0) *(u32x4*)(rowp + bj * HALF) = w_; else asm volatile("" :: "v"(w_)); } }
    }
};
typedef EpiInprojT<0> EpiInproj;
struct EpiHyT {
    static constexpr bool PERM = true;
    bf16_t* UT; const float* bias;
    __device__ __forceinline__ void operator()(const f32x4 (&acc)[2][2][4][2], const Unit& u, int wr, int wc, int fr, int fq) const {
        const int c0 = u.pm * BM + wr * 64 + fr, t0 = u.pn * BM + wc * 32 + 8 * fq;
#pragma unroll
        for (int ai = 0; ai < 2; ++ai)
#pragma unroll
            for (int m = 0; m < 4; ++m) { const int c = c0 + ai * HALF + m * 16; const float bv = bias[c]; bf16_t* rowp = UT + (size_t)c * T + t0;
#pragma unroll
                for (int bj = 0; bj < 2; ++bj) { const f32x4 v0 = acc[ai][bj][m][0] + bv, v1 = acc[ai][bj][m][1] + bv; *(u32x4*)(rowp + bj * HALF) = pack8(v0, v1); } }
    }
};
template <int P> struct EpiCat {
    static constexpr bool PERM = true;
    bf16_t* Mg; const bf16_t* U;
    __device__ __forceinline__ void operator()(const f32x4 (&acc)[2][2][4][2], const Unit& u, int wr, int wc, int fr, int fq) const {
        const int row0 = u.pm * BM + wr * 64 + fr, col0 = u.pn * BM + wc * 32 + 8 * fq;
#pragma unroll
        for (int ai = 0; ai < 2; ++ai)
#pragma unroll
            for (int m = 0; m < 4; ++m) { const size_t row = (size_t)(row0 + ai * HALF + m * 16);
#pragma unroll
                for (int bj = 0; bj < 2; ++bj) { const u32x4 gw = *(const u32x4*)(U + row * INC + GOFF + P * D + col0 + bj * HALF);
                    f32x4 g0, g1; unpack8(gw, g0, g1); f32x4 v0 = acc[ai][bj][m][0] * g0, v1 = acc[ai][bj][m][1] * g1;
                    bf16_t* mp = Mg + row * D + col0 + bj * HALF;
                    if (P == 1) { const u32x4 tw = *(const u32x4*)mp; f32x4 t0, t1; unpack8(tw, t0, t1); v0 += t0; v1 += t1; }
                    *(u32x4*)mp = pack8(v0, v1); } }
    }
};
struct EpiCatR {
    static constexpr bool PERM = true;
    bf16_t* Mg; const bf16_t* U;
    __device__ __forceinline__ void mid(f32x4 (&acc)[2][2][4][2], const Unit& u, int wr, int wc, int fr, int fq) const {
        int row0 = u.pm * BM + wr * 64 + fr; asm volatile("" : "+v"(row0));
        const int col0 = u.pn * BM + wc * 32 + 8 * fq;
#pragma unroll
        for (int ai = 0; ai < 2; ++ai) { asm volatile("" ::: "memory");
#pragma unroll
            for (int m = 0; m < 4; ++m) { const size_t row = (size_t)(row0 + ai * HALF + m * 16);
#pragma unroll
                for (int bj = 0; bj < 2; ++bj) { const u32x4 gw1 = *(const u32x4*)(U + row * INC + GOFF + col0 + bj * HALF);
                    f32x4 a0, a1; unpack8(gw1, a0, a1); acc[ai][bj][m][0] *= a0; acc[ai][bj][m][1] *= a1; } } }
        asm volatile("" ::: "memory");
    }
    __device__ __forceinline__ void operator()(const f32x4 (&acc)[2][2][4][2], const Unit& u, int wr, int wc, int fr, int fq) const {
        const int row0 = u.pm * BM + wr * 64 + fr, col0 = u.pn * BM + wc * 32 + 8 * fq;
#pragma unroll
        for (int ai = 0; ai < 2; ++ai)
#pragma unroll
            for (int m = 0; m < 4; ++m) { const size_t row = (size_t)(row0 + ai * HALF + m * 16);
#pragma unroll
                for (int bj = 0; bj < 2; ++bj) { const u32x4 gw = *(const u32x4*)(U + row * INC + GOFF + D + col0 + bj * HALF);
                    f32x4 g0, g1; unpack8(gw, g0, g1);
                    *(u32x4*)(Mg + row * D + col0 + bj * HALF) = pack8(acc[ai][bj][m][0] * g0, acc[ai][bj][m][1] * g1); } }
    }
};
struct EpiMix {
    static constexpr bool PERM = true;
    const float* X; bf16_t* O; const float* mod; float* ssq;
    __device__ __forceinline__ void operator()(const f32x4 (&acc)[2][2][4][2], const Unit& u, int wr, int wc, int fr, int fq) const {
        const int row0 = u.pm * BM + wr * 64 + fr, col0 = u.pn * BM + wc * 32 + 8 * fq; const int b = (u.pm * BM) / SEQ;
        f32x4 gv[2][2];
#pragma unroll
        for (int bj = 0; bj < 2; ++bj)
#pragma unroll
            for (int n = 0; n < 2; ++n) gv[bj][n] = *(const f32x4*)(mod + (size_t)b * 6 * D + 2 * D + col0 + bj * HALF + 4 * n);
#pragma unroll
        for (int ai = 0; ai < 2; ++ai)
#pragma unroll
            for (int m = 0; m < 4; ++m) { const size_t off = (size_t)(row0 + ai * HALF + m * 16) * D + col0; float sq = 0.f;
#pragma unroll
                for (int bj = 0; bj < 2; ++bj) { f32x4 v[2];
#pragma unroll
                    for (int n = 0; n < 2; ++n) { v[n] = *(const f32x4*)(X + off + bj * HALF + 4 * n) + gv[bj][n] * acc[ai][bj][m][n]; }
                    const u32x4 w = pack8(v[0], v[1]); *(u32x4*)(O + off + bj * HALF) = w;
                    f32x4 r0, r1; unpack8(w, r0, r1);
                    sq += ((r0.x * r0.x + r0.y * r0.y) + (r0.z * r0.z + r0.w * r0.w)) + ((r1.x * r1.x + r1.y * r1.y) + (r1.z * r1.z + r1.w * r1.w)); }
                sq += __shfl_xor(sq, 16); sq += __shfl_xor(sq, 32);
                if (fq == 0) ssq[(size_t)(row0 + ai * HALF + m * 16) * 16 + u.pn * 4 + wc] = sq; }
    }
};
struct EpiGateUp {
    static constexpr bool PERM = true;
    bf16_t* Act; const float* bgu;
    __device__ __forceinline__ void operator()(const f32x4 (&acc)[2][2][4][2], const Unit& u, int wr, int wc, int fr, int fq) const {
        const int e = u.pn >> 3, j = u.pn & 7; const int row0 = u.pm * BM + wr * 64 + fr, col0 = 128 * j + wc * 32 + 8 * fq;
        f32x4 bg[2], bu[2];
#pragma unroll
        for (int n = 0; n < 2; ++n) { bg[n] = *(const f32x4*)(bgu + (size_t)e * 2 * D + col0 + 4 * n); bu[n] = *(const f32x4*)(bgu + (size_t)e * 2 * D + D + col0 + 4 * n); }
#pragma unroll
        for (int ai = 0; ai < 2; ++ai)
#pragma unroll
            for (int m = 0; m < 4; ++m) { f32x4 r[2];
#pragma unroll
                for (int n = 0; n < 2; ++n) {
                    const f32x4 gt = acc[ai][0][m][n] * (1.0f / (F8S_H * F8S_W)) + bg[n], up = acc[ai][1][m][n] * (1.0f / (F8S_H * F8S_W)) + bu[n];
                    f32x4 gg, uu, ex;
#pragma unroll
                    for (int i = 0; i < 4; ++i) { gg[i] = fminf(gt[i], 7.0f); uu[i] = fminf(fmaxf(up[i], -7.0f), 7.0f); }
                    const f32x4 arg = gg * (-1.702f * LOG2E);
#pragma unroll
                    for (int i = 0; i < 4; ++i) ex[i] = __builtin_amdgcn_exp2f(arg[i]);
                    const f32x4 den = ex + 1.0f; f32x4 rc;
#pragma unroll
                    for (int i = 0; i < 4; ++i) rc[i] = __builtin_amdgcn_rcpf(den[i]);
                    r[n] = (uu * F8S_ACT + F8S_ACT) * (gg * rc); }
                u32x2 w8; w8.x = pk4_fp8_nc(r[0][0], r[0][1], r[0][2], r[0][3]); w8.y = pk4_fp8_nc(r[1][0], r[1][1], r[1][2], r[1][3]);
                *(u32x2*)((char*)Act + (size_t)(row0 + ai * HALF + m * 16) * D + col0) = w8; }
    }
};
struct EpiDown {
    static constexpr bool PERM = true;
    bf16_t* Slots; const float* bd; const float* roww;
    __device__ __forceinline__ void operator()(const f32x4 (&acc)[2][2][4][2], const Unit& u, int wr, int wc, int fr, int fq) const {
        const int e = u.pn >> 2, j = u.pn & 3; const int row0 = u.pm * BM + wr * 64 + fr, col0 = 256 * j + wc * 32 + 8 * fq;
        f32x4 bv[2][2];
#pragma unroll
        for (int bj = 0; bj < 2; ++bj)
#pragma unroll
            for (int n = 0; n < 2; ++n) bv[bj][n] = *(const f32x4*)(bd + (size_t)e * D + col0 + bj * HALF + 4 * n);
#pragma unroll
        for (int ai = 0; ai < 2; ++ai)
#pragma unroll
            for (int m = 0; m < 4; ++m) { const int row = row0 + ai * HALF + m * 16; const float w = roww[row];
#pragma unroll
                for (int bj = 0; bj < 2; ++bj) { const f32x4 v0 = (acc[ai][bj][m][0] * (1.0f / (F8S_ACT * F8S_W)) + bv[bj][0]) * (w * F8S_SLOT), v1 = (acc[ai][bj][m][1] * (1.0f / (F8S_ACT * F8S_W)) + bv[bj][1]) * (w * F8S_SLOT);
                    u32x2 w8; w8.x = pk4_fp8(v0[0], v0[1], v0[2], v0[3]); w8.y = pk4_fp8(v1[0], v1[1], v1[2], v1[3]);
                    *(u32x2*)((char*)Slots + (size_t)row * D + col0 + bj * HALF) = w8; } }
    }
};
}

#define LASP __attribute__((address_space(3)))
__device__ __forceinline__ void glds16(const void* gsrc, unsigned lds_dst) { unsigned keep;
    asm volatile("s_mov_b32 %0, m0\n\ts_mov_b32 m0, %2\n\ts_nop 0\n\tglobal_load_lds_dwordx4 %1, off\n\ts_mov_b32 m0, %0" : "=&s"(keep) : "v"(gsrc), "s"(lds_dst) : "memory"); }
__device__ __forceinline__ void glds16s(const void* sbase, unsigned voff, unsigned lds_dst) { unsigned keep;
    asm volatile("s_nop 4\n\ts_mov_b32 %0, m0\n\ts_mov_b32 m0, %3\n\ts_nop 0\n\tglobal_load_lds_dwordx4 %1, %2\n\ts_mov_b32 m0, %0" : "=&s"(keep) : "v"(voff), "s"(sbase), "s"(lds_dst) : "memory"); }
typedef short v4i16_t __attribute__((ext_vector_type(4)));
__device__ __forceinline__ s16x4 vtr(const LASP char* p) { return __builtin_bit_cast(s16x4, __builtin_amdgcn_ds_read_tr16_b64_v4i16((LASP v4i16_t*)p)); }

__device__ __forceinline__ float max3f(float a, float b, float c) { return fmaxf(fmaxf(a, b), c); }
__device__ __forceinline__ float fadd_s(float a, float b) { return a + b; }
__device__ __forceinline__ unsigned bfbits(float f) { return f2bf(f); }
__device__ __forceinline__ void phase_attn_fast(Ctx& C) {
    const bf16_t* u = (const bf16_t*)(C.ws + WS_U); bf16_t* ycat = (bf16_t*)(C.ws + WS_YCAT);
    const int wave = C.wave;
    const float* lq = C.in[18];
    float lam;
    { const int l_ = lane_id(); const float d1 = wave_sum(lq[l_] * lq[64 + l_]), d2 = wave_sum(lq[128 + l_] * lq[192 + l_]); lam = __builtin_bit_cast(float, __builtin_amdgcn_readfirstlane(__builtin_bit_cast(int, expf(d1) - expf(d2) + 0.2f))); }
    const unsigned lds0 = (unsigned)(uintptr_t)C.lds;
    const LASP char* ldsp = (const LASP char*)C.lds;
    constexpr int SLOT = 24576;
    int sbase = 0;
#define ATT_S6(x_) ((x_) >= 6 ? (x_) - 6 : (x_))
    const int vcu = (C.nblk % 8 == 0) ? (C.blk % 8) * (C.nblk / 8) + C.blk / 8 : C.blk;
    for (int idx = vcu; idx < 256; idx += C.nblk)
#pragma unroll 1
    for (int sub = 0; sub < 2; ++sub) {
        const int b = idx >> 4, hA = (idx >> 3) & 1, qb = idx & 7; const int hh = sub ? 3 - hA : hA;
        const int lane = fresh_lane();
        const int l31 = lane & 31, hi = lane >> 5;
        const int krow = 8 * wave + (lane >> 3), kchunk = (lane & 7) ^ (lane >> 3);
        const int st0 = 4 * wave + (lane >> 5), st1 = st0 + 2;
        const int vrow = (lane & 31) >> 2, vch = lane & 3;
        const unsigned koffb = (unsigned)((krow * INC + kchunk * 8) * 2);
        const unsigned voffb0 = (unsigned)(((8 * (st0 >> 2) + vrow) * INC + 32 * (st0 & 3) + 8 * vch) * 2);
        const unsigned voffb1 = (unsigned)(((8 * (st1 >> 2) + vrow) * INC + 32 * (st1 & 3) + 8 * vch) * 2);
        const int koff0 = l31 * 128, kx = l31 & 7;
        const int vboff = 8192 + (4 * hi + ((lane & 15) >> 2)) * 64 + ((lane >> 4) & 1) * 32 + (lane & 3) * 8;
        const unsigned hm0 = hi ? 0u : 0xffffffffu;
        const unsigned dkdk = hi ? 0u : bfbits((float)l31) * 0x10001u;
        const int q0 = qb * 256 + wave * 32;
        const float slope2 = exp2f(-2.0f * (float)(hh + 1)) * LOG2E;
        const unsigned SH = bfbits(slope2); const unsigned SL = bfbits(slope2 - bf2f(SH)); const unsigned SHSL = SH | (SL << 16);
        const float slope2q = bf2f(SH) + bf2f(SL);
        const unsigned kw0b = hi ? 0x3f803f80u : SHSL, kw1b = hi ? 0x00003f80u : SHSL, ksm = hi ? 0u : 0x80008000u;
        const unsigned qa0 = bfbits((float)q0) * 0x10001u, qa1 = bfbits((float)l31) * 0x10001u;
        const float qpos = (float)(q0 + l31 - 4 * hi);
        const bf16_t* qrow = u + (size_t)(b * SEQ + q0 + l31) * INC + QOFF + hh * 128;
        const bf16_t* kgb = u + (size_t)(b * SEQ) * INC + KOFF + hh * 128;
        const bf16_t* vgb = u + (size_t)(b * SEQ) * INC + VOFF + hh * 128;
        const int t0 = qb * 4, tdiag = q0 >> 6;
#pragma unroll 1
        for (int c = 0; c < 2; ++c) {
            const bf16_t* kgc = kgb + c * 64;
#define ATT_DMA(t, sl) do { const size_t _o = (size_t)(t) * 64 * INC; const unsigned _b = lds0 + (unsigned)(sl) * SLOT; \
        glds16s(kgc + _o, koffb, (unsigned)__builtin_amdgcn_readfirstlane(_b + wave * 1024)); \
        glds16s(vgb + _o, voffb0, (unsigned)__builtin_amdgcn_readfirstlane(_b + 8192 + (2 * wave) * 1024)); \
        glds16s(vgb + _o, voffb1, (unsigned)__builtin_amdgcn_readfirstlane(_b + 8192 + (2 * wave + 1) * 1024)); } while (0)
#define ATT_WAITBAR() asm volatile("s_waitcnt vmcnt(0) lgkmcnt(0)\n\ts_barrier" ::: "memory")
#define ATT_WAITBAR3() asm volatile("s_waitcnt vmcnt(3) lgkmcnt(0)\n\ts_barrier" ::: "memory")
#define ATT_SB() __builtin_amdgcn_sched_barrier(0)
#define ATT_QK(sl, tt) do { const LASP char* Kb_ = ldsp + (sl) * SLOT + koff0; \
        const int kvb_ = (tt) * 64; const bool diag_ = (tt) == tdiag; const bool before_ = kvb_ < q0; \
        const unsigned spos_ = before_ ? 0x80008000u : 0u, sneg_ = before_ ? 0u : 0x80008000u; \
        const unsigned dm_ = diag_ ? ~hm0 : 0xffffffffu; \
        const unsigned w0_ = (kw0b ^ (spos_ & ksm)) & dm_, w1_ = (kw1b ^ (spos_ & ksm)) & dm_, w3_ = (dkdk ^ (sneg_ & ksm)) & dm_; \
        const unsigned k0_ = ((bfbits((float)kvb_) * 0x10001u) ^ sneg_) & hm0 & dm_, k1_ = ((bfbits((float)(kvb_ + 32)) * 0x10001u) ^ sneg_) & hm0 & dm_; \
        const bf16x8 ka0_ = __builtin_bit_cast(bf16x8, (u32x4){w0_, w1_, k0_, w3_}), ka1_ = __builtin_bit_cast(bf16x8, (u32x4){w0_, w1_, k1_, w3_}); \
        bf16x8 kc0_ = *(const LASP bf16x8*)(Kb_ + (((0 + hi) ^ kx) * 16)), kc1_ = *(const LASP bf16x8*)(Kb_ + 4096 + (((0 + hi) ^ kx) * 16));        \
        P0 = __builtin_amdgcn_mfma_f32_32x32x16_bf16(ka0_, qaug, zero16, 0, 0, 0); P1 = __builtin_amdgcn_mfma_f32_32x32x16_bf16(ka1_, qaug, zero16, 0, 0, 0); \
        _Pragma("unroll") for (int ks = 0; ks < 4; ++ks) { \
            bf16x8 kn0_ = kc0_, kn1_ = kc1_; \
            if (ks < 3) { kn0_ = *(const LASP bf16x8*)(Kb_ + (((2 * (ks + 1) + hi) ^ kx) * 16)); kn1_ = *(const LASP bf16x8*)(Kb_ + 4096 + (((2 * (ks + 1) + hi) ^ kx) * 16)); } \
            P0 = __builtin_amdgcn_mfma_f32_32x32x16_bf16(kc0_, qf[ks], P0, 0, 0, 0); P1 = __builtin_amdgcn_mfma_f32_32x32x16_bf16(kc1_, qf[ks], P1, 0, 0, 0); \
            kc0_ = kn0_; kc1_ = kn1_; } \
          \
        ATT_SB(); } while (0)
#define ATT_SM(tt) do { \
        if ((tt) == tdiag) { const float a_ = qpos - (float)((tt) * 64); \
            _Pragma("unroll") for (int r = 0; r < 16; ++r) { const float x0 = a_ - (float)crow(r, 0); P0[r] = fmaf(fabsf(x0), -slope2q, P0[r]); P1[r] = fmaf(fabsf(x0 - 32.0f), -slope2q, P1[r]); } } \
        float rm_ = max3f(P0[0], P0[1], P1[0]); rm_ = max3f(rm_, P1[1], P0[2]); float rn_ = max3f(P0[3], P1[2], P1[3]); \
        _Pragma("unroll") for (int r = 4; r < 16; r += 2) { rm_ = max3f(rm_, P0[r], P0[r + 1]); rn_ = max3f(rn_, P1[r], P1[r + 1]); } \
        float rm; { const float rq_ = fmaxf(rm_, rn_); auto rr = __builtin_amdgcn_permlane32_swap(__float_as_uint(rq_), __float_as_uint(rq_), false, false); rm = max3f(__uint_as_float(rr[0]), __uint_as_float(rr[1]), -1e30f); } \
        live = !__all(rm < mrel - 40.0f);       \
        if (live) { \
            mrel = fmaxf(mrel, rm); \
            if (__any(rm > 8.0f)) { const float dl = fmaxf(rm, 0.f); mhat += dl; mrel -= dl; \
                _Pragma("unroll") for (int r = 0; r < 16; ++r) { P0[r] -= dl; P1[r] -= dl; } \
                { const unsigned mh_ = bfbits(mhat); const float r1_ = mhat - bf2f(mh_); const unsigned mm_ = bfbits(r1_); const unsigned ml_ = bfbits(r1_ - bf2f(mm_)); \
                  const unsigned a0_ = hi ? ((mh_ | (mm_ << 16)) ^ 0x80008000u) : qa0, a1_ = hi ? (ml_ ^ 0x8000u) : qa1; \
                  qaug = __builtin_bit_cast(bf16x8, (u32x4){a0_, a1_, hi ? 0u : SHSL, hi ? 0u : SHSL}); } \
                const float f = exp2f(-dl); lsum *= f; \
                _Pragma("unroll") for (int eb = 0; eb < 4; ++eb) _Pragma("unroll") for (int r = 0; r < 16; ++r) o[eb][r] *= f; } \
            _Pragma("unroll") for (int r = 0; r < 16; ++r) { P0[r] = __builtin_amdgcn_exp2f(P0[r]); P1[r] = __builtin_amdgcn_exp2f(P1[r]); } \
              \
            float ps0 = fadd_s(P0[0], P1[0]), ps1 = fadd_s(P0[1], P1[1]); \
            _Pragma("unroll") for (int r = 2; r < 16; r += 2) { ps0 = fadd_s(ps0, P0[r]); ps1 = fadd_s(ps1, P0[r + 1]); ps0 = fadd_s(ps0, P1[r]); ps1 = fadd_s(ps1, P1[r + 1]); } \
            lsum += fadd_s(ps0, ps1); \
            _Pragma("unroll") for (int s2 = 0; s2 < 2; ++s2) { \
                u32x4 w_; w_.x = cvtpk(P0[8 * s2 + 0], P0[8 * s2 + 1]); w_.y = cvtpk(P0[8 * s2 + 2], P0[8 * s2 + 3]); w_.z = cvtpk(P0[8 * s2 + 4], P0[8 * s2 + 5]); w_.w = cvtpk(P0[8 * s2 + 6], P0[8 * s2 + 7]); pf[s2] = __builtin_bit_cast(bf16x8, w_); \
                u32x4 v_; v_.x = cvtpk(P1[8 * s2 + 0], P1[8 * s2 + 1]); v_.y = cvtpk(P1[8 * s2 + 2], P1[8 * s2 + 3]); v_.z = cvtpk(P1[8 * s2 + 4], P1[8 * s2 + 5]); v_.w = cvtpk(P1[8 * s2 + 6], P1[8 * s2 + 7]); pf[2 + s2] = __builtin_bit_cast(bf16x8, v_); } \
        } ATT_SB(); } while (0)
#define ATT_PV(sl) do { if (live) { const LASP char* Vb_ = ldsp + (sl) * SLOT + vboff; \
            _Pragma("unroll") for (int eb = 0; eb < 4; ++eb) _Pragma("unroll") for (int s = 0; s < 4; ++s) { \
                const s16x4 lo_ = vtr(Vb_ + s * 4096 + eb * 512), h4_ = vtr(Vb_ + s * 4096 + 2048 + eb * 512); \
                const bf16x8 vf_ = (bf16x8){lo_[0], lo_[1], lo_[2], lo_[3], h4_[0], h4_[1], h4_[2], h4_[3]}; \
                o[eb] = __builtin_amdgcn_mfma_f32_32x32x16_bf16(vf_, pf[s], o[eb], 0, 0, 0); } } ATT_SB(); } while (0)
            bf16x8 qf[4];
#pragma unroll
            for (int ks = 0; ks < 4; ++ks) qf[ks] = *(const bf16x8*)(qrow + c * 64 + 16 * ks + 8 * hi);
            asm volatile("s_waitcnt vmcnt(0)" : "+v"(qf[0]), "+v"(qf[1]), "+v"(qf[2]), "+v"(qf[3]) :: "memory");
            int sl = sbase;
            ATT_DMA(t0, sl); ATT_DMA((t0 + 1) & 31, ATT_S6(sl + 1)); ATT_DMA((t0 + 2) & 31, ATT_S6(sl + 2));
            f32x16 o[4], zero16, P0, P1;
#pragma unroll
            for (int r = 0; r < 16; ++r) zero16[r] = 0.f;
#pragma unroll
            for (int eb = 0; eb < 4; ++eb)
#pragma unroll
                for (int r = 0; r < 16; ++r) o[eb][r] = 0.f;
            float mhat = 0.f, lsum = 0.f, mrel = -1e30f;
            bf16x8 qaug = __builtin_bit_cast(bf16x8, (u32x4){hi ? 0u : qa0, hi ? 0u : qa1, hi ? 0u : SHSL, hi ? 0u : SHSL});
            bf16x8 pf[4]; bool live = false;
            if (wave < 4) {
#pragma unroll 1
                for (int i = 0; i < 32; ++i) {
                    if ((i & 1) == 0) { if (i + 2 < 32) ATT_WAITBAR3(); else ATT_WAITBAR(); }
                    if (i + 3 < 32) ATT_DMA((t0 + i + 3) & 31, ATT_S6(sl + 3));
                    const int tt = (t0 + i) & 31;
                    ATT_QK(sl, tt); ATT_SM(tt); ATT_PV(sl);
                    sl = ATT_S6(sl + 1);
                }
            } else {
#pragma unroll 1
                for (int i = 0; i < 32; ++i) {
                    if ((i & 1) == 0) { if (i + 2 < 32) ATT_WAITBAR3(); else ATT_WAITBAR(); }
                    if (i + 3 < 32) ATT_DMA((t0 + i + 3) & 31, ATT_S6(sl + 3));
                    const int tt = (t0 + i) & 31;
                    ATT_PV(ATT_S6(sl + 5)); ATT_QK(sl, tt); ATT_SM(tt);
                    sl = ATT_S6(sl + 1);
                }
                ATT_PV(ATT_S6(sl + 5));
            }
            sbase = ATT_S6(sbase + 2);
#undef ATT_DMA
#undef ATT_QK
#undef ATT_SM
#undef ATT_PV
#undef ATT_SB
            { auto rr = __builtin_amdgcn_permlane32_swap(__float_as_uint(lsum), __float_as_uint(lsum), false, false); lsum = __uint_as_float(rr[0]) + __uint_as_float(rr[1]); }
            const float inv = 1.0f / lsum;
            float* pk = (float*)(C.ws + WS_H2LO) + (size_t)C.gw * 4096;
            pk += fresh_lane();
            if (c == 0) {
#pragma unroll
                for (int eb = 0; eb < 4; ++eb)
#pragma unroll
                    for (int r = 0; r < 16; ++r) pk[(eb * 16 + r) * 64] = o[eb][r] * inv;
            } else {
                float ss = 0.f;
#pragma unroll
                for (int eb = 0; eb < 4; ++eb)
#pragma unroll
                    for (int r = 0; r < 16; ++r) { const float y = pk[(eb * 16 + r) * 64] - lam * (o[eb][r] * inv); o[eb][r] = y; ss += y * y; }
                { auto rr = __builtin_amdgcn_permlane32_swap(__float_as_uint(ss), __float_as_uint(ss), false, false); ss = __uint_as_float(rr[0]) + __uint_as_float(rr[1]); }
                const float rinv = 1.0f / sqrtf(ss * (1.0f / 128.0f) + EPS);
                bf16_t* orow = ycat + (size_t)(b * SEQ + q0 + l31) * D + 512 + hh * 128 + 4 * hi;
#pragma unroll
                for (int eb = 0; eb < 4; ++eb)
#pragma unroll
                    for (int g4 = 0; g4 < 4; ++g4) { const int e = 32 * eb + 8 * g4;
                        u32x2 w; w.x = cvtpk(o[eb][4 * g4] * rinv, o[eb][4 * g4 + 1] * rinv); w.y = cvtpk(o[eb][4 * g4 + 2] * rinv, o[eb][4 * g4 + 3] * rinv);
                        *(u32x2*)(orow + e) = w; }
            }
        }
    }
    ATT_WAITBAR();
#undef ATT_WAITBAR
#undef ATT_WAITBAR3
}

#define LDS_BAR() asm volatile("s_waitcnt lgkmcnt(0)\n\ts_barrier" ::: "memory")
__device__ __forceinline__ void phase_toeplitz(Ctx& C, unsigned* ctr) {
    constexpr int VROW = 4096 + 16, FCOPY = 8192 + 32, FL = 16 * VROW;
    const bf16_t* uT = (const bf16_t*)(C.ws + WS_UT); bf16_t* yt = (bf16_t*)(C.ws + WS_YT); const float* cw = C.in[7]; const float* cb = C.in[8];
    const float* kfc = (const float*)(C.ws + WS_KFC); const float* dsk = C.in[17];
    const int lane = C.lane, a = lane & 15, g = lane >> 4, wave = C.wave;
    const unsigned lds0 = (unsigned)(uintptr_t)C.lds;
    const LASP char* ldsp = (const LASP char*)C.lds;
    const int t0 = 256 * wave;
    const int c0 = 2048 - t0 + 8 * g - a;
    const LASP char* fbase = ldsp + FL + (c0 & 7) * FCOPY + 2 * (c0 & ~7);
    const LASP char* vbase = ldsp + a * VROW + 16 * g;
    int* shc = (int*)(C.lds + LDS_BYTES - 128);
    for (;;) {
        __syncthreads();
        if (C.tid == 0) *shc = (int)__hip_atomic_fetch_add(ctr, 1u, __ATOMIC_RELAXED, __HIP_MEMORY_SCOPE_AGENT);
        __syncthreads();
        const int c = __builtin_amdgcn_readfirstlane(*shc);
        if (c >= HW) break;
        asm volatile("s_waitcnt vmcnt(0) lgkmcnt(0)\n\ts_barrier" ::: "memory");
        { const int tc = (C.tid & 255) * 8, bh = C.tid >> 8;
          const float wv0 = cw[2 * HW + c], wv1 = cw[3 * HW + 2 * HW + c], wv2 = cw[6 * HW + 2 * HW + c], bv = cb[2 * HW + c];
          const float wx0 = cw[HW + c], wx1 = cw[3 * HW + HW + c], wx2 = cw[6 * HW + HW + c], bx = cb[HW + c];
          const bf16_t* vrow = uT + ((size_t)(2 * HW + c) * NB + bh) * SEQ + tc; const bf16_t* xrow = uT + ((size_t)(HW + c) * NB + bh) * SEQ + tc;
#pragma unroll
          for (int jh = 0; jh < 2; ++jh) {
              u32x4 vv[4], xx[4]; unsigned vm[4], vp[4], xm[4], xp[4];
#pragma unroll
              for (int j = 0; j < 4; ++j) { const size_t o = (size_t)(2 * (4 * jh + j)) * SEQ;
                  vv[j] = *(const u32x4*)(vrow + o); xx[j] = *(const u32x4*)(xrow + o);
                  vm[j] = (lane == 0 && tc > 0) ? (unsigned)vrow[o - 1] : 0u; vp[j] = (lane == 63 && tc + 8 < SEQ) ? (unsigned)vrow[o + 8] : 0u;
                  xm[j] = (lane == 0 && tc > 0) ? (unsigned)xrow[o - 1] : 0u; xp[j] = (lane == 63 && tc + 8 < SEQ) ? (unsigned)xrow[o + 8] : 0u; }
#pragma unroll
              for (int j = 0; j < 4; ++j) {
                  const unsigned a1 = __shfl_up(vv[j].w, 1) >> 16, a2 = __shfl_down(vv[j].x, 1) & 0xffffu, a3 = __shfl_up(xx[j].w, 1) >> 16, a4 = __shfl_down(xx[j].x, 1) & 0xffffu;
                  if (lane != 0) { vm[j] = a1; xm[j] = a3; } if (lane != 63) { vp[j] = a2; xp[j] = a4; }
                  float ev[10], ex[10]; ev[0] = __uint_as_float(vm[j] << 16); ex[0] = __uint_as_float(xm[j] << 16); ev[9] = __uint_as_float(vp[j] << 16); ex[9] = __uint_as_float(xp[j] << 16);
#pragma unroll
                  for (int i = 0; i < 4; ++i) { ev[1 + 2 * i] = bflo(vv[j][i]); ev[2 + 2 * i] = bfhi(vv[j][i]); ex[1 + 2 * i] = bflo(xx[j][i]); ex[2 + 2 * i] = bfhi(xx[j][i]); }
                  float o_[8];
#pragma unroll
                  for (int i = 0; i < 8; ++i) o_[i] = (ev[i] * wv0 + ev[i + 1] * wv1 + ev[i + 2] * wv2 + bv) * (ex[i] * wx0 + ex[i + 1] * wx1 + ex[i + 2] * wx2 + bx);
                  u32x4 w; w.x = pk2(o_[0], o_[1]); w.y = pk2(o_[2], o_[3]); w.z = pk2(o_[4], o_[5]); w.w = pk2(o_[6], o_[7]);
                  *(LASP u32x4*)((LASP char*)C.lds + (2 * (4 * jh + j) + bh) * VROW + tc * 2) = w; } } }
        { const int q = C.tid; const float* kc = kfc + (size_t)c * 4096; float f[15];
#pragma unroll
          for (int i = 0; i < 15; ++i) { const int idx = 4096 - 8 * q - i; f[i] = (idx >= 1 && idx <= 4095) ? kc[idx] : 0.f; }
#pragma unroll
          for (int m = 0; m < 8; ++m) { u32x4 w; w.x = pk2(f[m], f[m + 1]); w.y = pk2(f[m + 2], f[m + 3]); w.z = pk2(f[m + 4], f[m + 5]); w.w = pk2(f[m + 6], f[m + 7]);
              *(LASP u32x4*)((LASP char*)C.lds + FL + m * FCOPY + q * 16) = w; } }
        asm volatile("s_waitcnt vmcnt(0) lgkmcnt(0)\n\ts_barrier" ::: "memory");
        f32x4 acc[16]; bf16x8 W[16];
#pragma unroll
        for (int r = 0; r < 16; ++r) { acc[r] = (f32x4){0.f, 0.f, 0.f, 0.f}; W[r] = *(const LASP bf16x8*)(fbase - 32 * r); }
#pragma unroll 1
        for (int ko = 0; ko < 8; ++ko) {
            const LASP char* fb = fbase + ko * 512; const LASP char* vb = vbase + ko * 512;
#pragma unroll
            for (int kk = 0; kk < 8; ++kk) {
                const bf16x8 Bf = *(const LASP bf16x8*)(vb + 64 * kk);
#pragma unroll
                for (int r = 0; r < 16; ++r) acc[r] = __builtin_amdgcn_mfma_f32_16x16x32_bf16(W[(r - 2 * kk) & 15], Bf, acc[r], 0, 0, 0);
                if (ko < 7 || kk < 7) { W[(-2 * kk - 2) & 15] = *(const LASP bf16x8*)(fb + 64 * kk + 64); W[(-2 * kk - 1) & 15] = *(const LASP bf16x8*)(fb + 64 * kk + 32); }
            }
        }
        const float dd = dsk[c]; const float w0 = cw[c], w1 = cw[3 * HW + c], w2 = cw[6 * HW + c], b0 = cb[c];
        const bf16_t* x0row = uT + ((size_t)c * NB + a) * SEQ;
#pragma unroll
        for (int r = 0; r < 16; ++r) { const int t = t0 + 16 * r + 4 * g; const size_t o = ((size_t)c * NB + a) * SEQ + t;
            const u32x2 vv = *(const LASP u32x2*)(ldsp + a * VROW + t * 2); const u32x2 xx = *(const u32x2*)(x0row + t);
            const float em = t > 0 ? __uint_as_float((unsigned)x0row[t - 1] << 16) : 0.f, ep = t + 4 < SEQ ? __uint_as_float((unsigned)x0row[t + 4] << 16) : 0.f;
            const float e0 = bflo(xx.x), e1 = bfhi(xx.x), e2 = bflo(xx.y), e3 = bfhi(xx.y);
            const float x0 = em * w0 + e0 * w1 + e1 * w2 + b0, x1 = e0 * w0 + e1 * w1 + e2 * w2 + b0, x2 = e1 * w0 + e2 * w1 + e3 * w2 + b0, x3 = e2 * w0 + e3 * w1 + ep * w2 + b0;
            const float y0 = (acc[r][0] + bflo(vv.x) * dd) * x0, y1 = (acc[r][1] + bfhi(vv.x) * dd) * x1;
            const float y2 = (acc[r][2] + bflo(vv.y) * dd) * x2, y3 = (acc[r][3] + bfhi(vv.y) * dd) * x3;
            u32x2 w; w.x = pk2(y0, y1); w.y = pk2(y2, y3); *(u32x2*)(yt + o) = w; }
    }
    asm volatile("s_waitcnt vmcnt(0) lgkmcnt(0)\n\ts_barrier" ::: "memory");
}

__device__ __forceinline__ void phase_hy_post(Ctx& C) {
    const bf16_t* yt = (const bf16_t*)(C.ws + WS_YT); bf16_t* ycat = (bf16_t*)(C.ws + WS_YCAT);
    bf16_t* sy = (bf16_t*)C.lds;
    constexpr int NTILES = NB * 32 * 8;
    const int cl = C.tid >> 3, chk = C.tid & 7, tl = C.tid >> 3, c8 = C.tid & 7;
#define HYQ_LOAD(tile_) (*(const u32x4*)(yt + ((size_t)(((tile_) & 7) * 64 + cl) * NB + ((tile_) >> 8)) * SEQ + (((tile_) >> 3) & 31) * 64 + chk * 8))
    int tile = C.blk; u32x4 cur = {0u, 0u, 0u, 0u}, nxt = cur;
    if (tile < NTILES) cur = HYQ_LOAD(tile);
    for (; tile < NTILES; tile += C.nblk) {
        const bool more = tile + C.nblk < NTILES;
        if (more) nxt = HYQ_LOAD(tile + C.nblk);
        const int cq = tile & 7, tq = (tile >> 3) & 31, b = tile >> 8;
        LDS_BAR();
        *(u32x4*)(sy + cl * 72 + (cl >> 3) * 8 + chk * 8) = cur;
        LDS_BAR();
        { unsigned short e[8];
#pragma unroll
          for (int i = 0; i < 8; ++i) e[i] = sy[(c8 * 8 + i) * 72 + c8 * 8 + tl];
          u32x4 w; w.x = e[0] | ((unsigned)e[1] << 16); w.y = e[2] | ((unsigned)e[3] << 16); w.z = e[4] | ((unsigned)e[5] << 16); w.w = e[6] | ((unsigned)e[7] << 16);
          *(u32x4*)(ycat + ((size_t)b * SEQ + tq * 64 + tl) * D + cq * 64 + c8 * 8) = w; }
        cur = nxt;
    }
#undef HYQ_LOAD
    __syncthreads();
}

__device__ __forceinline__ void phase_route(Ctx& C) {
    const float* mod = (const float*)(C.ws + WS_MOD); const float* ssq = (const float*)(C.ws + WS_LOGITS); bf16_t* h2 = (bf16_t*)(C.ws + WS_H); const bf16_t* wrt = (const bf16_t*)(C.ws + WS_WRT);
    int* tope = (int*)(C.ws + WS_TOPE); float* topw = (float*)(C.ws + WS_TOPW); int* blkcnt = (int*)(C.ws + WS_BLKCNT);
    const float* g = C.in[23]; const float* br = C.in[25];
    constexpr int WROW = 4096 + 16;
    LASP char* wl_ = (LASP char*)C.lds;
    int* hist = (int*)(C.lds + 32 * WROW); float* slog = (float*)(C.lds + 32 * WROW + 256) + C.wave * 512;
    LASP float* lmod = (LASP float*)(C.lds + 32 * WROW + 256 + 8 * 2048);
    const int lane = C.lane, tk = lane & 15, gq = lane >> 4;
    const float* mult2 = mod + 16 * 6 * D;
    int bfill = -1; bool wfill = false;
    for (int vb = C.blk; vb < 256; vb += C.nblk) {
        const int tok = vb * 128 + C.wave * 16 + tk; const int b = tok / SEQ;
        const bf16_t* xr = (const bf16_t*)(C.ws + WS_X1) + (size_t)tok * D + 8 * gq;
        u32x4 xall[32];
#pragma unroll
        for (int q = 0; q < 32; ++q) xall[q] = __builtin_nontemporal_load((const u32x4*)(xr + 32 * q));
        const f32x4* sp = (const f32x4*)(ssq + (size_t)tok * 16); const f32x4 a0 = sp[0], a1 = sp[1], a2 = sp[2], a3 = sp[3];
        __syncthreads();
        if (!wfill) { wfill = true;
            for (int i = C.tid; i < NE * 256; i += NTHREADS) { const int e = i >> 8, ch = i & 255; *(LASP u32x4*)(wl_ + e * WROW + ch * 16) = *(const u32x4*)(wrt + (size_t)e * 2048 + ch * 8); } }
        if (bfill != b) { bfill = b; const int i = C.tid; const float* src = i < 256 ? mult2 + (size_t)b * D + 4 * i : mod + (size_t)b * 6 * D + 3 * D + 4 * (i - 256); *(LASP f32x4*)(lmod + 4 * i) = *(const f32x4*)src; }
        if (C.tid < NE) hist[C.tid] = 0;
        __syncthreads();
        const float ss = ((a0.x + a0.y) + (a0.z + a0.w)) + ((a1.x + a1.y) + (a1.z + a1.w)) + ((a2.x + a2.y) + (a2.z + a2.w)) + ((a3.x + a3.y) + (a3.z + a3.w));
        const float rstd = 1.0f / sqrtf(ss * (1.0f / D) + EPS);
        bf16_t* hr = h2 + (size_t)tok * D + 8 * gq;
        const LASP char* wb = wl_ + tk * WROW + 16 * gq;
        const LASP float* ml = lmod + 8 * gq; const LASP float* sh = lmod + D + 8 * gq;
        f32x4 acc[2]; acc[0] = (f32x4){0.f, 0.f, 0.f, 0.f}; acc[1] = acc[0];
#pragma unroll
        for (int q = 0; q < 32; ++q) { const int k = 32 * q;
            f32x4 x0, x1v; pg8::unpack8(xall[q], x0, x1v);
            const f32x4 m0 = *(const LASP f32x4*)(ml + k) * rstd, m1 = *(const LASP f32x4*)(ml + k + 4) * rstd, s0 = *(const LASP f32x4*)(sh + k), s1 = *(const LASP f32x4*)(sh + k + 4);
            const f32x4 h0 = x0 * m0 + s0, h1 = x1v * m1 + s1;
            u32x4 wh; wh.x = cvtpk(h0[0], h0[1]); wh.y = cvtpk(h0[2], h0[3]); wh.z = cvtpk(h1[0], h1[1]); wh.w = cvtpk(h1[2], h1[3]);
            { u32x2 w8; w8.x = pk4_fp8(F8S_H * h0[0], F8S_H * h0[1], F8S_H * h0[2], F8S_H * h0[3]); w8.y = pk4_fp8(F8S_H * h1[0], F8S_H * h1[1], F8S_H * h1[2], F8S_H * h1[3]); *(u32x2*)((char*)h2 + (size_t)tok * D + 8 * gq + k) = w8; }
            u32x4 wlo; wlo.x = cvtpk(h0[0] - bflo(wh.x), h0[1] - bfhi(wh.x)); wlo.y = cvtpk(h0[2] - bflo(wh.y), h0[3] - bfhi(wh.y)); wlo.z = cvtpk(h1[0] - bflo(wh.z), h1[1] - bfhi(wh.z)); wlo.w = cvtpk(h1[2] - bflo(wh.w), h1[3] - bfhi(wh.w));
            const bf16x8 a_h = __builtin_bit_cast(bf16x8, wh), a_l = __builtin_bit_cast(bf16x8, wlo);
#pragma unroll
            for (int n = 0; n < 2; ++n) { const LASP char* bp = wb + n * 16 * WROW + k * 2;
                const bf16x8 b_h = *(const LASP bf16x8*)(bp), b_l = *(const LASP bf16x8*)(bp + 2048);
                acc[n] = __builtin_amdgcn_mfma_f32_16x16x32_bf16(b_h, a_h, acc[n], 0, 0, 0);
                acc[n] = __builtin_amdgcn_mfma_f32_16x16x32_bf16(b_h, a_l, acc[n], 0, 0, 0);
                acc[n] = __builtin_amdgcn_mfma_f32_16x16x32_bf16(b_l, a_h, acc[n], 0, 0, 0); }
        }
#pragma unroll
        for (int n = 0; n < 2; ++n) *(f32x4*)(slog + tk * 32 + n * 16 + 4 * gq) = acc[n];
        __builtin_amdgcn_s_waitcnt(0xc07f); asm volatile("" ::: "memory");
        if (lane < 16) {
            const int t = vb * 128 + C.wave * 16 + lane;
            float v[32];
#pragma unroll
            for (int q = 0; q < 8; ++q) { const f32x4 x = *(const f32x4*)(slog + lane * 32 + 4 * q), bb = *(const f32x4*)(br + 4 * q);
                v[4 * q] = x.x + bb.x; v[4 * q + 1] = x.y + bb.y; v[4 * q + 2] = x.z + bb.z; v[4 * q + 3] = x.w + bb.w; }
            float tv[4]; int ti[4];
#pragma unroll
            for (int k = 0; k < 4; ++k) {
                float best = -INFINITY; int bi = 0;
#pragma unroll
                for (int e = 0; e < 32; ++e) if (v[e] > best) { best = v[e]; bi = e; }
                tv[k] = best; ti[k] = bi;
#pragma unroll
                for (int e = 0; e < 32; ++e) v[e] = (e == bi) ? -INFINITY : v[e];
            }
            const float e0 = 1.0f, e1 = expf(tv[1] - tv[0]), e2 = expf(tv[2] - tv[0]), e3 = expf(tv[3] - tv[0]);
            const float inv = 1.0f / (e0 + e1 + e2 + e3);
            *(int4*)(tope + (size_t)t * 4) = make_int4(ti[0], ti[1], ti[2], ti[3]);
            *(f32x4*)(topw + (size_t)t * 4) = (f32x4){e0 * inv, e1 * inv, e2 * inv, e3 * inv};
#pragma unroll
            for (int k = 0; k < 4; ++k) atomicAdd(&hist[ti[k]], 1);
        }
        __syncthreads();
        if (C.tid < NE) blkcnt[vb * NE + C.tid] = hist[C.tid];
    }
    __syncthreads();
}

__device__ __forceinline__ void phase_rowlist(Ctx& C) {
    const int* tope = (const int*)(C.ws + WS_TOPE); const int* blkcnt = (const int*)(C.ws + WS_BLKCNT);
    int* rowpair = (int*)(C.ws + WS_ROWPAIR); int* tileexp = (int*)(C.ws + WS_TILEEXP); int* meta = (int*)(C.ws + WS_META);
    float* roww = (float*)(C.ws + WS_ROWW); const float* topw = (const float*)(C.ws + WS_TOPW); int* rowinv = (int*)(C.ws + WS_TOPE);
    int* s_total = (int*)C.lds; int* s_base = s_total + 32; int* s_pstart = s_base + 32; int* s_e = s_pstart + 36; int* s_cnt = s_e + 512; int* s_wc = s_cnt + 256 * 32;
    for (int vb = C.blk; vb < 256; vb += C.nblk) {
        __syncthreads();
        { const int4* src = (const int4*)blkcnt; int4* dst = (int4*)s_cnt;
#pragma unroll
          for (int q = 0; q < 4; ++q) dst[q * NTHREADS + C.tid] = src[q * NTHREADS + C.tid]; }
        s_e[C.tid] = tope[(size_t)vb * 512 + C.tid];
        __syncthreads();
        if (C.tid < NE) { int tot = 0, base = 0;
#pragma unroll 8
            for (int q = 0; q < 256; ++q) { const int c = s_cnt[q * NE + C.tid]; tot += c; if (q < vb) base += c; } s_total[C.tid] = tot; s_base[C.tid] = base; }
        __syncthreads();
        if (C.tid == 0) { int ps = 0; for (int e = 0; e < NE; ++e) { s_pstart[e] = ps; ps += ((s_total[e] + 255) / 256) * 256; } s_pstart[NE] = ps; }
        __syncthreads();
        { const int e = s_e[C.tid]; int rank = 0;
          for (int q = 0; q < NE; ++q) { const unsigned long long mq = __ballot(e == q); if (e == q) rank = __builtin_popcountll(mq & ((1ull << C.lane) - 1ull)); if (C.lane == 0) s_wc[C.wave * NE + q] = __builtin_popcountll(mq); }
          __syncthreads();
          for (int w = 0; w < C.wave; ++w) rank += s_wc[w * NE + e];
          rowpair[s_pstart[e] + s_base[e] + rank] = vb * 512 + C.tid; roww[s_pstart[e] + s_base[e] + rank] = topw[vb * 512 + C.tid]; rowinv[vb * 512 + C.tid] = s_pstart[e] + s_base[e] + rank; }
        if (vb < NE) { const int e = vb; for (int r = s_pstart[e] + s_total[e] + C.tid; r < s_pstart[e + 1]; r += NTHREADS) { rowpair[r] = -1; roww[r] = 0.f; } }
        if (vb == 0) {
            if (C.tid < NE) { for (int tl = s_pstart[C.tid] / 256; tl < s_pstart[C.tid + 1] / 256; ++tl) tileexp[tl] = C.tid; }
            if (C.tid == 0) meta[0] = s_pstart[NE] / 256;
        }
    }
    __syncthreads();
}


#define LDS3(C) ((PG8_LAS unsigned char*)(C).lds)
__device__ __forceinline__ void phase_inproj_fast(Ctx& C) {
    pg8::Gemm g{(const bf16_t*)(C.ws + WS_H), (const bf16_t*)(C.ws + WS_WIN), D, D, D, nullptr};
    if ((C.blk & 8) != 0) { phase_weights(C, C.gw, C.ngw, W_DN_LO - W_GU_Q, W_GU_Q, 0x7fffffff, 0, false); asm volatile("s_waitcnt vmcnt(0) lgkmcnt(0)\n\ts_barrier" ::: "memory"); }
    { pg8::Gemm ga = g; ga.Bt = g.Bt + (size_t)(3 * HW) * D;
      pg8::StaticOrder S; S.init(T / 256, (INC - 3 * HW) / 256, C.nblk, C.blk);
      pg8::EpiInproj E{(bf16_t*)(C.ws + WS_U), C.in[6], 3 * HW / 256};
      pg8::gemm_phase<pg8::EpiInproj, pg8::StaticOrder, false>(LDS3(C), ga, S, E, C.wave); }
    asm volatile("s_waitcnt vmcnt(0) lgkmcnt(0)\n\ts_barrier" ::: "memory");
    { pg8::Gemm gb{g.Bt, g.A, D, D, D, nullptr};
      pg8::StaticOrder S; S.init(3 * HW / 256, T / 256, C.nblk, C.blk);
      pg8::EpiHyT E{(bf16_t*)(C.ws + WS_UT), C.in[6]};
      pg8::gemm_phase<pg8::EpiHyT, pg8::StaticOrder, false>(LDS3(C), gb, S, E, C.wave); }
    asm volatile("s_waitcnt vmcnt(0) lgkmcnt(0)\n\ts_barrier" ::: "memory");
    if ((C.blk & 8) == 0) { C.lane = fresh_lane(); C.tid = C.wave * 64 + C.lane; phase_weights(C, C.gw, C.ngw, W_DN_LO - W_GU_Q, W_GU_Q, 0x7fffffff, 0, false); }
}
#ifndef XVAR
#define XVAR 0
#endif
__device__ __forceinline__ void phase_probe_x(Ctx& C) {
#if XVAR == 1 || XVAR == 2
    pg8::Gemm g{(const bf16_t*)(C.ws + WS_H), (const bf16_t*)(C.ws + WS_WIN), D, D, D, nullptr};
    pg8::StaticOrder S; S.init(T / 256, INC / 256, C.nblk, C.blk);
    pg8::EpiInprojT<XVAR> E{(bf16_t*)(C.ws + WS_U), C.in[6]};
    pg8::gemm_phase<pg8::EpiInprojT<XVAR>, pg8::StaticOrder, false>(LDS3(C), g, S, E, C.wave);
#endif
}
__device__ __forceinline__ void phase_cat_fast(Ctx& C) {
    pg8::Gemm g{(const bf16_t*)(C.ws + WS_YCAT), (const bf16_t*)(C.ws + WS_WCAT), D, D, D, nullptr};
    pg8::EpiCatR E{(bf16_t*)(C.ws + WS_MERGED), (const bf16_t*)(C.ws + WS_U)};
    pg8::RowRunOrder S{T / 256, D / 256, C.nblk, C.blk}; pg8::gemm_phase<pg8::EpiCatR, pg8::RowRunOrder, false, true>(LDS3(C), g, S, E, C.wave);
}
__device__ __forceinline__ void phase_mix_fast(Ctx& C) {
    pg8::Gemm g{(const bf16_t*)(C.ws + WS_MERGED), (const bf16_t*)(C.ws + WS_WMIX), D, D, D, nullptr};
    pg8::EpiMix E{C.in[0], (bf16_t*)(C.ws + WS_X1), (const float*)(C.ws + WS_MOD), (float*)(C.ws + WS_LOGITS)};
    pg8::StaticOrder S; S.init(T / 256, D / 256, C.nblk, C.blk);
    pg8::gemm_phase<pg8::EpiMix, pg8::StaticOrder, false>(LDS3(C), g, S, E, C.wave);
}
__device__ __forceinline__ void phase_gateup_fast(Ctx& C) {
    const int nmt = __builtin_amdgcn_readfirstlane(((const int*)(C.ws + WS_META))[0]);
    pg8::Gemm g{(const bf16_t*)(C.ws + WS_H), (const bf16_t*)(C.ws + WS_WGU), D / 2, D / 2, D / 2, (const int*)(C.ws + WS_ROWPAIR)};
    { PG8_LAS int* te = (PG8_LAS int*)(LDS3(C) + 131072); const int* tg = (const int*)(C.ws + WS_TILEEXP); for (int i = C.tid; i < nmt; i += NTHREADS) te[i] = tg[i]; __syncthreads(); }
    pg8::MoeOrder S; S.b.init(nmt, 8, C.nblk, C.blk); S.tileexp = (const PG8_LAS int*)(LDS3(C) + 131072); S.nN = 8;
    pg8::EpiGateUp E{(bf16_t*)(C.ws + WS_ACT), C.in[27]};
    pg8::gemm_phase<pg8::EpiGateUp, pg8::MoeOrder, true, false, true>(LDS3(C), g, S, E, C.wave);
    phase_weights_chunks(C, (unsigned*)(C.ws + WS_CTL + 32768 + 256), W_DN_N, W_DN_LO);
}
__device__ __forceinline__ void phase_down_fast(Ctx& C) {
    const int nmt = __builtin_amdgcn_readfirstlane(((const int*)(C.ws + WS_META))[0]);
    pg8::Gemm g{(const bf16_t*)(C.ws + WS_ACT), (const bf16_t*)(C.ws + WS_WDN), D / 2, D / 2, D / 2, nullptr};
    { PG8_LAS int* te = (PG8_LAS int*)(LDS3(C) + 131072); const int* tg = (const int*)(C.ws + WS_TILEEXP); for (int i = C.tid; i < nmt; i += NTHREADS) te[i] = tg[i]; __syncthreads(); }
    pg8::MoeOrder S; S.b.init(nmt, 4, C.nblk, C.blk); S.tileexp = (const PG8_LAS int*)(LDS3(C) + 131072); S.nN = 4;
    pg8::EpiDown E{(bf16_t*)(C.ws + WS_SLOTS), C.in[29], (const float*)(C.ws + WS_ROWW)};
    pg8::gemm_phase<pg8::EpiDown, pg8::MoeOrder, false, false, true>(LDS3(C), g, S, E, C.wave);
}


#define XB_TMO      128
#define XB_XCNT(j)  (256  + 64 * (j))
#define XB_XSUB(j)  (1280 + 64 * (j))
#define XB_XGEN(j)  (2304 + 64 * (j))
#define XB_TOP      3328
#define XB_TOPGEN   3392
#define XCD_BAR_WORDS 3456
#define XB_SPIN_CAP (1u << 18)
#define XLAS __attribute__((address_space(3)))
__device__ __forceinline__ unsigned xb_ld(unsigned* p)              { return __hip_atomic_load(p, __ATOMIC_RELAXED, __HIP_MEMORY_SCOPE_AGENT); }
__device__ __forceinline__ unsigned xb_add(unsigned* p, unsigned v) { return __hip_atomic_fetch_add(p, v, __ATOMIC_RELAXED, __HIP_MEMORY_SCOPE_AGENT); }
__device__ __forceinline__ unsigned xb_xcc_id() { return (unsigned)__builtin_amdgcn_s_getreg((3 << 11) | 20) & 0xFu; }
#define XB_SPIN(cond, bar) do { unsigned _sp = 0; while (cond) { __builtin_amdgcn_s_sleep(1); \
    if ((++_sp & 255u) == 0u) { if (xb_ld(&(bar)[XB_TMO])) break; if (_sp > XB_SPIN_CAP) { atomicAdd(&(bar)[XB_TMO], 1u); break; } } } } while (0)
struct XcdBarrier { unsigned* bar; unsigned x; volatile XLAS unsigned* st; };
__device__ __forceinline__ XcdBarrier xcd_barrier_post(unsigned* bar, volatile XLAS unsigned* st, bool leader) {
    XcdBarrier b; b.bar = bar; b.x = xb_xcc_id(); b.st = st;
    if (leader) (void)xb_add(&bar[XB_XCNT(b.x)], 1u);
    return b;
}
__device__ __forceinline__ void xcd_barrier_complete(unsigned* bar, unsigned x, unsigned& nloc, unsigned& nx) {
    const unsigned G = gridDim.x * gridDim.y * gridDim.z;
    unsigned sum, cnt, mine, sp = 0u;
    for (;;) {
        sum = 0u; cnt = 0u; mine = 0u;
#pragma unroll
        for (unsigned j = 0; j < 16; ++j) { const unsigned c = xb_ld(&bar[XB_XCNT(j)]); sum += c; cnt += (c > 0u) ? 1u : 0u; mine = (j == x) ? c : mine; }
        if (sum == G) break;
        __builtin_amdgcn_s_sleep(1);
        if ((++sp & 255u) == 0u) { if (xb_ld(&bar[XB_TMO])) break; if (sp > XB_SPIN_CAP) { atomicAdd(&bar[XB_TMO], 1u); break; } }
    }
    nloc = mine > 0u ? mine : 1u; nx = cnt > 0u ? cnt : 1u;
}
__device__ __forceinline__ void xcd_barrier(const XcdBarrier& b, int wave_) {
    asm volatile("s_waitcnt vmcnt(0)" ::: "memory");
    __syncthreads();
    if (wave_ == 0 && lane_id() == 0) {
        unsigned* bar = b.bar;
        __builtin_amdgcn_s_waitcnt(0);
        unsigned nloc = b.st[0], nx = b.st[1];
        if (nloc == 0u) { xcd_barrier_complete(bar, b.x, nloc, nx); b.st[0] = nloc; b.st[1] = nx; }
        const unsigned old = xb_add(&bar[XB_XSUB(b.x)], 1u);
        const unsigned gen = old / nloc;
        if (old + 1u == (gen + 1u) * nloc) {
            __builtin_amdgcn_fence(__ATOMIC_RELEASE, "agent");
            asm volatile("s_waitcnt vmcnt(0)" ::: "memory");
            const unsigned og = xb_add(&bar[XB_TOP], 1u);
            const unsigned tg = og / nx;
            if (og + 1u == (tg + 1u) * nx) xb_add(&bar[XB_TOPGEN], 1u);
            else XB_SPIN(xb_ld(&bar[XB_TOPGEN]) == tg, bar);
            __builtin_amdgcn_fence(__ATOMIC_ACQUIRE, "agent");
            xb_add(&bar[XB_XGEN(b.x)], 1u);
            asm volatile("s_waitcnt vmcnt(0)" ::: "memory");
        } else {
            XB_SPIN(xb_ld(&bar[XB_XGEN(b.x)]) == gen, bar);
            __builtin_amdgcn_fence(__ATOMIC_ACQUIRE, "agent");
            asm volatile("s_waitcnt vmcnt(0)" ::: "memory");
        }
    }
    __syncthreads();
}

constexpr int NPHASES = 13;
}

__global__ void __launch_bounds__(NTHREADS, 2) fwd_kernel(Params p) {
    extern __shared__ __attribute__((aligned(16))) unsigned char lds[];
    cg::grid_group grid = cg::this_grid();
    Ctx C;
#pragma unroll
    for (int i = 0; i < 31; ++i) C.in[i] = p.in[i];
    C.out = p.out; C.ws = p.ws; C.lds = lds;
    const int wave_s = __builtin_amdgcn_readfirstlane(threadIdx.x >> 6);
    C.lane = lane_id(); C.wave = wave_s; C.tid = wave_s * 64 + C.lane;
    C.blk = blockIdx.x; C.nblk = gridDim.x; C.gw = C.blk * NWAVES + C.wave; C.ngw = C.nblk * NWAVES;
    const int lo = p.ph_lo, hi = p.ph_hi;
    volatile XLAS unsigned* misc = (volatile XLAS unsigned*)((XLAS unsigned char*)lds + (LDS_BYTES - 64));
    if (C.tid < 16) misc[C.tid] = 0u;
    __syncthreads();
    const XcdBarrier xbar = xcd_barrier_post((unsigned*)(p.ws + WS_CTL), misc, C.tid == 0);
#define GSYNC(k) do { xcd_barrier(xbar, wave_s); } while (0)
    if (lo < 0) grid.sync();
#ifndef PHMASK
#define PHMASK 0xffff
#endif
#ifndef REPMASK
#define REPMASK 0
#endif
#ifndef PROBE_PHASE
#define PROBE_PHASE (-1)
#endif
#ifndef CLKPROBE
#define CLKPROBE 0
#endif
    unsigned long long tp0 = 0, tp1 = 0, tc0 = 0, tc1 = 0;
#define PH(k, body) do { if ((PHMASK >> (k)) & 1) { if (lo <= (k) && (k) < hi) { if ((k) == PROBE_PHASE) { tp0 = __builtin_amdgcn_s_memrealtime(); tc0 = __builtin_amdgcn_s_memtime(); } _Pragma("unroll 1") for (int rep_ = (REPMASK >> (k)) & 1; rep_ >= 0; --rep_) { { C.lane = fresh_lane(); C.wave = wave_s; C.tid = wave_s * 64 + C.lane; C.gw = C.blk * NWAVES + C.wave; } body; if (rep_ > 0 || (k) + 1 < hi) GSYNC(k); } if ((k) == PROBE_PHASE) { tp1 = __builtin_amdgcn_s_memrealtime(); tc1 = __builtin_amdgcn_s_memtime(); } } } } while (0)
#ifdef SYNCPROBE
    for (int i = 0; i < 20; ++i) GSYNC(1);
#endif
    PH(0, { phase_mod(C); phase_filters(C); });
    PH(1, { phase_weights(C, C.gw, C.ngw, W_NITEMS - W_DN_LO - W_DN_N, W_DN_LO + W_DN_N, 0x7fffffff, 0, true); __syncthreads(); phase_norm1(C); });
#ifndef FASTMASK
#define FASTMASK 0xffff
#endif
#define FAST(k) ((FASTMASK >> (k)) & 1)
    PH(2, phase_inproj_fast(C));
#if XVAR == 1 || XVAR == 2
    PH(13, phase_probe_x(C));
#endif
    PH(4, { phase_attn_fast(C); __syncthreads(); { C.lane = fresh_lane(); C.tid = C.wave * 64 + C.lane; } phase_toeplitz(C, (unsigned*)(p.ws + WS_CTL + 32768 + 512)); phase_weights_chunks(C, (unsigned*)(p.ws + WS_CTL + 32768), W_GU_Q, 0); });
    PH(5, phase_hy_post(C));
    PH(6, phase_cat_fast(C));
    PH(7, phase_mix_fast(C));
    PH(8, phase_route(C));
    PH(9, phase_rowlist(C));
    PH(10, phase_gateup_fast(C));
    PH(11, phase_down_fast(C));
    PH(12, phase_final(C));
#undef PH
    if (PROBE_PHASE >= 0 && C.blk == 0) { const unsigned long long te = __builtin_amdgcn_s_memrealtime(), span = CLKPROBE ? (4ull * (tc1 - tc0)) / 24ull : 4ull * (tp1 - tp0); while (__builtin_amdgcn_s_memrealtime() - te < span) __builtin_amdgcn_s_sleep(8); }
}

extern "C" void kernel_launch(void* const* d_in, const int* in_sizes, int n_in, void* d_out, int out_size, void* d_ws, size_t ws_size, hipStream_t stream) {
    static int grid = 0;
    if (grid == 0) {
        if (n_in != 31 || ws_size < WS_END) { fprintf(stderr, "kernel_launch: unexpected n_in %d or ws_size %zu\n", n_in, ws_size); grid = -1; return; }
        int dev = 0, cus = 0, per_cu = 0;
        hipGetDevice(&dev); hipDeviceGetAttribute(&cus, hipDeviceAttributeMultiprocessorCount, dev);
        hipFuncSetAttribute((const void*)fwd_kernel, hipFuncAttributeMaxDynamicSharedMemorySize, LDS_BYTES);
        hipOccupancyMaxActiveBlocksPerMultiprocessor(&per_cu, (const void*)fwd_kernel, NTHREADS, LDS_BYTES);
        if (per_cu < 1) { fprintf(stderr, "kernel_launch: occupancy query says %d blocks/CU\n", per_cu); per_cu = 1; }
        (void)hipGetLastError();
        grid = cus * 1;
        fprintf(stderr, "kernel_launch: cus %d per_cu %d grid %d\n", cus, per_cu, grid);
    }
    if (grid < 0) return;
    if (hipMemsetAsync((char*)d_ws + WS_CTL, 0, 65536, stream) != hipSuccess) { fprintf(stderr, "kernel_launch: memset failed\n"); return; }
    Params p{};
    for (int i = 0; i < 31; ++i) p.in[i] = (const float*)d_in[i];
    p.out = (float*)d_out; p.ws = (unsigned char*)d_ws; p.ph_lo = 0; p.ph_hi = NPHASES + (XVAR ? 1 : 0);
    void* args[] = {&p};
    hipError_t e = hipLaunchCooperativeKernel((const void*)fwd_kernel, dim3(grid), dim3(NTHREADS), args, LDS_BYTES, stream);
    if (e != hipSuccess) fprintf(stderr, "cooperative launch failed: %s (grid %d)\n", hipGetErrorString(e), grid);
}
```
